# Optimizing an MI355X kernel written in HIP

```python
import math
import jax, jax.numpy as jnp
from jax import lax
import numpy as np

D_MODEL = 1024
BATCH = 16
SEQ = 2048
DEPTH = 1

CHUNK = 64
Q_BLOCK = 128
A_QK_DIM = 64
A_V_DIM = 2 * A_QK_DIM
A_HEADS = D_MODEL // 256
A_WIDTH = A_HEADS * A_V_DIM
B_HEAD_DIM = 64
B_HEADS = D_MODEL // 128
B_WIDTH = B_HEADS * B_HEAD_DIM
B_KV_RANK = D_MODEL // 8
IDX_HEADS = 8
IDX_DIM = 64
TOPK_MAX = 256
N_ALIBI_HEADS = A_HEADS + B_HEADS
IN_SPLITS = (
    A_HEADS * 2 * A_QK_DIM,
    A_HEADS * 2 * A_QK_DIM,
    A_WIDTH,
    B_WIDTH,
    B_KV_RANK,
    IDX_HEADS * IDX_DIM,
    IDX_DIM,
    IDX_HEADS,
    2 * D_MODEL,
)
IN_COLS = sum(IN_SPLITS)
N_GROUPS = 4
EXPERTS_PER_GROUP = 4
N_EXPERTS = N_GROUPS * EXPERTS_PER_GROUP
TOP_K_IN_GROUP = 2
D_FF_EXPERT = D_MODEL // 4
LN_EPS = 1e-5
RMS_EPS = 1e-5
DEEPNORM_ALPHA = (2.0 * DEPTH) ** 0.25
DEEPNORM_BETA = (8.0 * DEPTH) ** -0.25

kernel_name = "hybrid_diffattn_dsa_hmoe_block"


def _layer_norm(x, g, b):
    xf = x.astype(jnp.float32)
    mu = jnp.mean(xf, axis=-1, keepdims=True)
    var = jnp.mean(jnp.square(xf - mu), axis=-1, keepdims=True)
    return ((xf - mu) * lax.rsqrt(var + LN_EPS) * g.astype(jnp.float32) + b.astype(jnp.float32)).astype(x.dtype)


def _rms_norm(x, g):
    xf = x.astype(jnp.float32)
    y = xf * lax.rsqrt(jnp.mean(xf * xf, axis=-1, keepdims=True) + RMS_EPS)
    return (y * g.astype(jnp.float32)).astype(x.dtype)


def _alibi_slopes():
    n = N_ALIBI_HEADS
    slopes = (2.0 ** (-8.0 * np.arange(1, n + 1) / n)).astype(np.float32)
    a_idx = np.arange(A_HEADS) * (n // A_HEADS)
    b_idx = np.setdiff1d(np.arange(n), a_idx)
    return jnp.asarray(slopes[a_idx]), jnp.asarray(slopes[b_idx])


def _to_blocks(t):
    b, s = t.shape[:2]
    t = t.reshape((b, s // Q_BLOCK, Q_BLOCK) + t.shape[2:])
    return jnp.moveaxis(t, 1, 0)


def _from_blocks(t):
    t = jnp.moveaxis(t, 0, 1)
    return t.reshape((t.shape[0], t.shape[1] * t.shape[2]) + t.shape[3:])


def _diff_attention(q, k, v, slopes, lam, lam_init, subln_g):
    b, s = q.shape[:2]
    n_blk = s // Q_BLOCK
    scale = A_QK_DIM ** -0.5
    k_pos = jnp.arange(s)

    def block(args):
        q_blk, blk = args
        q_pos = blk * Q_BLOCK + jnp.arange(Q_BLOCK)
        logits = jnp.einsum('bqhmd,bshmd->bhmqs', q_blk, k).astype(jnp.float32) * scale
        dist = jnp.abs(q_pos[:, None] - k_pos[None, :]).astype(jnp.float32)
        bias = -slopes[:, None, None] * dist
        visible = (k_pos // CHUNK)[None, :] <= (q_pos // CHUNK)[:, None]
        logits = jnp.where(visible, logits + bias[None, :, None], -jnp.inf)
        p = jax.nn.softmax(logits, axis=-1)
        attn = p[:, :, 0] - lam * p[:, :, 1]
        return jnp.einsum('bhqs,bshe->bqhe', attn.astype(v.dtype), v)

    o = _from_blocks(lax.map(block, (_to_blocks(q), jnp.arange(n_blk))))
    o = _rms_norm(o, subln_g) * (1.0 - lam_init)
    return o.reshape(b, s, A_WIDTH)


def _sparse_indexed_attention(q_abs, c_kv, idx_q, idx_k, idx_w, slopes):
    b, s = q_abs.shape[:2]
    n_blk = s // Q_BLOCK
    top_k = min(TOPK_MAX, s // 4)
    scale = B_HEAD_DIM ** -0.5
    k_pos = jnp.arange(s)

    def block(args):
        qa, iq, iw, blk = args
        q_pos = blk * Q_BLOCK + jnp.arange(Q_BLOCK)
        idx_logits = jnp.einsum('bqhd,bsd->bqhs', iq, idx_k).astype(jnp.float32)
        score = jnp.einsum('bqh,bqhs->bqs', iw.astype(jnp.float32), jax.nn.relu(idx_logits))
        visible = (k_pos // CHUNK)[None, :] <= (q_pos // CHUNK)[:, None]
        score = jnp.where(visible[None], score, -jnp.inf)
        _, sel = lax.top_k(score, top_k)
        kv_sel = jax.vmap(lambda kv, ix: kv[ix])(c_kv, sel)
        logits = jnp.einsum('bqhr,bqkr->bhqk', qa, kv_sel).astype(jnp.float32) * scale
        dist = jnp.abs(q_pos[None, :, None] - sel).astype(jnp.float32)
        sel_ok = (sel // CHUNK) <= (q_pos // CHUNK)[None, :, None]
        logits = jnp.where(sel_ok[:, None], logits - slopes[None, :, None, None] * dist[:, None], -jnp.inf)
        p = jax.nn.softmax(logits, axis=-1)
        return jnp.einsum('bhqk,bqkr->bqhr', p.astype(kv_sel.dtype), kv_sel)

    args = (_to_blocks(q_abs), _to_blocks(idx_q), _to_blocks(idx_w), jnp.arange(n_blk))
    return _from_blocks(lax.map(block, args))


def _hier_moe(u, w_group, b_group, w_expert_router, b_expert_router, w_gate, w_up, w_down):
    g_logits = (jnp.einsum('bsd,dg->bsg', u, w_group) + b_group).astype(jnp.float32)
    g_prob = jax.nn.softmax(g_logits, axis=-1)
    g_top_p, g_top_i = lax.top_k(g_prob, 1)
    e_logits = (jnp.einsum('bsd,de->bse', u, w_expert_router) + b_expert_router).astype(jnp.float32)
    e_logits = e_logits.reshape(u.shape[0], u.shape[1], N_GROUPS, EXPERTS_PER_GROUP)
    e_logits = jnp.einsum('bsge,bsg->bse', e_logits, jax.nn.one_hot(g_top_i[..., 0], N_GROUPS, dtype=jnp.float32))
    e_prob = jax.nn.softmax(e_logits, axis=-1)
    e_top_p, e_top_i = lax.top_k(e_prob, TOP_K_IN_GROUP)
    e_top_p = e_top_p / jnp.sum(e_top_p, axis=-1, keepdims=True)
    expert_id = g_top_i * EXPERTS_PER_GROUP + e_top_i
    weight = g_top_p * e_top_p
    comb = jnp.einsum('bsk,bske->bse', weight, jax.nn.one_hot(expert_id, N_EXPERTS, dtype=jnp.float32))
    comb = comb.astype(u.dtype)
    y = jnp.zeros_like(u)
    for e in range(N_EXPERTS):
        h = jax.nn.silu(u @ w_gate[e]) * (u @ w_up[e])
        y = y + comb[..., e:e + 1] * (h @ w_down[e])
    return y


def setup_inputs(seed: int = 0) -> dict:
    key = jax.random.key(seed)
    ks = jax.random.split(key, 27)
    f32 = jnp.float32
    L, D = DEPTH, D_MODEL

    def nrm(k, shape, scale):
        return jax.random.normal(k, shape, f32) * scale

    return {
        "x": nrm(ks[0], (BATCH, SEQ, D), 1.0),
        "c": nrm(ks[1], (BATCH, D), 1.0),
        "ada_w": nrm(ks[2], (L, D, 6 * D), 0.5 * D ** -0.5),
        "ada_b": nrm(ks[3], (L, 6 * D), 0.02),
        "w_in": nrm(ks[4], (L, D, IN_COLS), D ** -0.5),
        "lambda_q1": nrm(ks[5], (L, A_QK_DIM), 0.1),
        "lambda_k1": nrm(ks[6], (L, A_QK_DIM), 0.1),
        "lambda_q2": nrm(ks[7], (L, A_QK_DIM), 0.1),
        "lambda_k2": nrm(ks[8], (L, A_QK_DIM), 0.1),
        "a_subln_g": 1.0 + nrm(ks[9], (L, A_V_DIM), 0.02),
        "kv_norm_g": 1.0 + nrm(ks[10], (L, B_KV_RANK), 0.02),
        "w_uk": nrm(ks[11], (L, B_KV_RANK, B_HEADS, B_HEAD_DIM), B_KV_RANK ** -0.5),
        "w_uv": nrm(ks[12], (L, B_KV_RANK, B_HEADS, B_HEAD_DIM), B_KV_RANK ** -0.5),
        "w_a_proj": nrm(ks[13], (L, A_WIDTH, D), A_WIDTH ** -0.5),
        "w_b_proj": nrm(ks[14], (L, B_WIDTH, D), B_WIDTH ** -0.5),
        "w_o": nrm(ks[15], (L, D, D), DEEPNORM_BETA * D ** -0.5),
        "ln1_g": 1.0 + nrm(ks[16], (L, D), 0.02),
        "ln1_b": nrm(ks[17], (L, D), 0.02),
        "w_group": nrm(ks[18], (L, D, N_GROUPS), D ** -0.5),
        "b_group": nrm(ks[19], (L, N_GROUPS), 0.01),
        "w_expert_router": nrm(ks[20], (L, D, N_EXPERTS), D ** -0.5),
        "b_expert_router": nrm(ks[21], (L, N_EXPERTS), 0.01),
        "w_exp_gate": nrm(ks[22], (L, N_EXPERTS, D, D_FF_EXPERT), D ** -0.5),
        "w_exp_up": nrm(ks[23], (L, N_EXPERTS, D, D_FF_EXPERT), D ** -0.5),
        "w_exp_down": nrm(ks[24], (L, N_EXPERTS, D_FF_EXPERT, D), DEEPNORM_BETA * D_FF_EXPERT ** -0.5),
        "ln2_g": 1.0 + nrm(ks[25], (L, D), 0.02),
        "ln2_b": nrm(ks[26], (L, D), 0.02),
    }


def reference(x, c, ada_w, ada_b, w_in, lambda_q1, lambda_k1, lambda_q2, lambda_k2, a_subln_g,
              kv_norm_g, w_uk, w_uv, w_a_proj, w_b_proj, w_o, ln1_g, ln1_b, w_group, b_group,
              w_expert_router, b_expert_router, w_exp_gate, w_exp_up, w_exp_down, ln2_g, ln2_b):
    b, s, d = x.shape
    slopes_a, slopes_b = _alibi_slopes()
    cond = jax.nn.silu(c)
    offsets = [int(o) for o in np.cumsum(IN_SPLITS)[:-1]]
    for l in range(DEPTH):
        mod = cond @ ada_w[l] + ada_b[l]
        shift1, scale1, gate1, shift2, scale2, gate2 = [m[:, None, :] for m in jnp.split(mod, 6, axis=-1)]

        u = x * (1.0 + scale1) + shift1
        proj = u @ w_in[l]
        a_q, a_k, a_v, b_q, b_kv, i_q, i_k, i_w, gates = jnp.split(proj, offsets, axis=-1)

        lam_init = 0.8 - 0.6 * math.exp(-0.3 * l)
        lam = (jnp.exp(jnp.sum(lambda_q1[l].astype(jnp.float32) * lambda_k1[l].astype(jnp.float32)))
               - jnp.exp(jnp.sum(lambda_q2[l].astype(jnp.float32) * lambda_k2[l].astype(jnp.float32)))
               + lam_init)
        y_a = _diff_attention(a_q.reshape(b, s, A_HEADS, 2, A_QK_DIM),
                              a_k.reshape(b, s, A_HEADS, 2, A_QK_DIM),
                              a_v.reshape(b, s, A_HEADS, A_V_DIM),
                              slopes_a, lam, lam_init, a_subln_g[l])

        c_kv = _rms_norm(b_kv, kv_norm_g[l])
        q_abs = jnp.einsum('bshe,rhe->bshr', b_q.reshape(b, s, B_HEADS, B_HEAD_DIM), w_uk[l])
        o_lat = _sparse_indexed_attention(q_abs, c_kv, i_q.reshape(b, s, IDX_HEADS, IDX_DIM),
                                          i_k, i_w, slopes_b)
        y_b = jnp.einsum('bshr,rhe->bshe', o_lat, w_uv[l]).reshape(b, s, B_WIDTH)

        g = jax.nn.sigmoid(gates).reshape(b, s, 2, d)
        mixed = g[:, :, 0] * (y_a @ w_a_proj[l]) + g[:, :, 1] * (y_b @ w_b_proj[l])
        x = _layer_norm(DEEPNORM_ALPHA * x + gate1 * (mixed @ w_o[l]), ln1_g[l], ln1_b[l])

        u2 = x * (1.0 + scale2) + shift2
        y = _hier_moe(u2, w_group[l], b_group[l], w_expert_router[l], b_expert_router[l],
                      w_exp_gate[l], w_exp_up[l], w_exp_down[l])
        x = _layer_norm(DEEPNORM_ALPHA * x + gate2 * y, ln2_g[l], ln2_b[l])
    return x
```

```cpp
#include <hip/hip_runtime.h>
#include <hip/hip_bf16.h>
#include <cstdio>
#include <cstdint>

#define GAS __attribute__((address_space(1)))
#define LAS __attribute__((address_space(3)))
typedef unsigned short bf16;
typedef GAS unsigned gu32;
typedef unsigned v4u __attribute__((ext_vector_type(4)));
typedef unsigned v2u __attribute__((ext_vector_type(2)));
typedef float f32x4 __attribute__((ext_vector_type(4)));
#define RLX_AGENT __ATOMIC_RELAXED, __HIP_MEMORY_SCOPE_AGENT

constexpr int BATCH = 16, SEQ = 2048, D = 1024, T = BATCH * SEQ;
constexpr int NP = 4864;
constexpr int C_AQ = 0, C_AK = 512, C_AV = 1024, C_BQ = 1536, C_BKV = 2048, C_IQ = 2176, C_IK = 2688, C_IW = 2752, C_PADB = 2760, C_G = 2816;
constexpr int IN_COLS = 4808;
constexpr float LOG2E = 1.4426950408889634f;
constexpr float QSCALE = 0.125f * LOG2E;
constexpr float ALPHA = 1.189207115002721f;
constexpr float LN_EPS = 1e-5f, RMS_EPS = 1e-5f;
constexpr int TOPK = 256;
constexpr int MAXSLOT = 40960;

__device__ __constant__ float SLOPE_A[4] = {0.6299605369567871f, 0.15749013423919678f, 0.039372533559799194f, 0.009843133389949799f};
__device__ __constant__ float SLOPE_B[8] = {0.39685025811195374f, 0.25f, 0.09921256452798843f, 0.0625f, 0.02480314113199711f, 0.015625f, 0.006200785282999277f, 0.00390625f};

constexpr size_t MiB = 1u << 20;
constexpr size_t WS_CTL = 0, CTL_ZERO_BYTES = 1 * MiB;
constexpr size_t WS_MOD = 1 * MiB;
constexpr size_t WS_R = WS_MOD + 512 * 1024;
constexpr size_t WS_ROUTE = WS_R + 128 * 1024;
constexpr size_t WS_WIN = 2 * MiB;
constexpr size_t WS_WA = 12 * MiB;
constexpr size_t WS_WB = 13 * MiB;
constexpr size_t WS_WO = 14 * MiB;
constexpr size_t WS_WKV = 16 * MiB;
constexpr size_t WS_W1 = 17 * MiB;
constexpr size_t WS_W2P = 33 * MiB;
constexpr size_t WS_ROUTE2 = 57 * MiB;
constexpr size_t WS_RW = 59 * MiB;
constexpr size_t WS_MODP = 59 * MiB + 128 * 1024;
constexpr size_t WS_MASK = 60 * MiB;
constexpr size_t WS_KV = 68 * MiB;
constexpr size_t WS_U = 132 * MiB;
constexpr size_t WS_PROJ = 196 * MiB;
constexpr size_t WS_U2 = 196 * MiB;
constexpr size_t WS_H = 260 * MiB;
constexpr size_t WS_XS = 300 * MiB;
constexpr size_t WS_MODPART = 500 * MiB;
constexpr size_t WS_END = 512 * MiB;

constexpr int CW_BAR = 4096;

constexpr int LDSCTL_OFF = 139264, MISC_OFF = LDSCTL_OFF + 320, LDS_BYTES = 147456;

__device__ __forceinline__ unsigned f2bf(float f) { unsigned u = __float_as_uint(f); return (u + 0x7fffu + ((u >> 16) & 1u)) >> 16; }
__device__ __forceinline__ float bf2f(unsigned h) { return __uint_as_float(h << 16); }
__device__ __forceinline__ float bflo(unsigned w) { return __uint_as_float(w << 16); }
__device__ __forceinline__ float bfhi(unsigned w) { return __uint_as_float(w & 0xffff0000u); }
__device__ __forceinline__ unsigned pk2(float lo, float hi) { return f2bf(lo) | (f2bf(hi) << 16); }
__device__ __forceinline__ float wave_sum(float v) {
#pragma unroll
    for (int o = 1; o < 64; o <<= 1) v += __shfl_xor(v, o);
    return v;
}
__device__ __forceinline__ float wave_max(float v) {
#pragma unroll
    for (int o = 1; o < 64; o <<= 1) v = fmaxf(v, __shfl_xor(v, o));
    return v;
}
__device__ __forceinline__ int wave_sum_i(int v) {
#pragma unroll
    for (int o = 1; o < 64; o <<= 1) v += __shfl_xor(v, o);
    return v;
}
#define LDS_WAIT() asm volatile("s_waitcnt lgkmcnt(0)" ::: "memory")

#define XB_TMO      128
#define XB_XCNT(j)  (256  + 64 * (j))
#define XB_XSUB(j)  (1280 + 64 * (j))
#define XB_XGEN(j)  (2304 + 64 * (j))
#define XB_TOP      3328
#define XB_TOPGEN   3392
#define XCD_BAR_WORDS 3456
#define XB_SPIN_CAP (1u << 22)
__device__ __forceinline__ unsigned xb_ld(unsigned* p)              { return __hip_atomic_load(p, __ATOMIC_RELAXED, __HIP_MEMORY_SCOPE_AGENT); }
__device__ __forceinline__ unsigned xb_add(unsigned* p, unsigned v) { return __hip_atomic_fetch_add(p, v, __ATOMIC_RELAXED, __HIP_MEMORY_SCOPE_AGENT); }
__device__ __forceinline__ unsigned xb_xcc_id() { return (unsigned)__builtin_amdgcn_s_getreg((3 << 11) | 20) & 0xFu; }
#define XB_SPIN(cond, bar) do { unsigned _sp = 0; while (cond) { __builtin_amdgcn_s_sleep(1); \
    if ((++_sp & 255u) == 0u) { if (xb_ld(&(bar)[XB_TMO])) break; if (_sp > XB_SPIN_CAP) { atomicAdd(&(bar)[XB_TMO], 1u); break; } } } } while (0)
struct XcdBarrier { unsigned* bar; unsigned x; volatile LAS unsigned* st; };
__device__ __forceinline__ XcdBarrier xcd_barrier_post(unsigned* bar, volatile LAS unsigned* st) {
    XcdBarrier b; b.bar = bar; b.x = xb_xcc_id(); b.st = st;
    if (threadIdx.x == 0) (void)xb_add(&bar[XB_XCNT(b.x)], 1u);
    return b;
}
__device__ __forceinline__ void xcd_barrier_complete(unsigned* bar, unsigned x, unsigned& nloc, unsigned& nx) {
    const unsigned G = gridDim.x * gridDim.y * gridDim.z;
    unsigned sum, cnt, mine, sp = 0u;
    for (;;) {
        sum = 0u; cnt = 0u; mine = 0u;
#pragma unroll
        for (unsigned j = 0; j < 16; ++j) { const unsigned c = xb_ld(&bar[XB_XCNT(j)]); sum += c; cnt += (c > 0u) ? 1u : 0u; mine = (j == x) ? c : mine; }
        if (sum == G) break;
        __builtin_amdgcn_s_sleep(1);
        if ((++sp & 255u) == 0u) { if (xb_ld(&bar[XB_TMO])) break; if (sp > XB_SPIN_CAP) { atomicAdd(&bar[XB_TMO], 1u); break; } }
    }
    nloc = mine > 0u ? mine : 1u; nx = cnt > 0u ? cnt : 1u;
}
__device__ __forceinline__ void xcd_barrier(const XcdBarrier& b) {
    asm volatile("s_waitcnt vmcnt(0)" ::: "memory");
    __syncthreads();
    if (threadIdx.x == 0) {
        unsigned* bar = b.bar;
        __builtin_amdgcn_s_waitcnt(0);
        unsigned nloc = b.st[0], nx = b.st[1];
        if (nloc == 0u) { xcd_barrier_complete(bar, b.x, nloc, nx); b.st[0] = nloc; b.st[1] = nx; }
        const unsigned old = xb_add(&bar[XB_XSUB(b.x)], 1u);
        const unsigned gen = old / nloc;
        if (old + 1u == (gen + 1u) * nloc) {
            __builtin_amdgcn_fence(__ATOMIC_RELEASE, "agent");
            asm volatile("s_waitcnt vmcnt(0)" ::: "memory");
            const unsigned og = xb_add(&bar[XB_TOP], 1u);
            const unsigned tg = og / nx;
            if (og + 1u == (tg + 1u) * nx) xb_add(&bar[XB_TOPGEN], 1u);
            else XB_SPIN(xb_ld(&bar[XB_TOPGEN]) == tg, bar);
            __builtin_amdgcn_fence(__ATOMIC_ACQUIRE, "agent");
            xb_add(&bar[XB_XGEN(b.x)], 1u);
            asm volatile("s_waitcnt vmcnt(0)" ::: "memory");
        } else {
            XB_SPIN(xb_ld(&bar[XB_XGEN(b.x)]) == gen, bar);
            __builtin_amdgcn_fence(__ATOMIC_ACQUIRE, "agent");
            asm volatile("s_waitcnt vmcnt(0)" ::: "memory");
        }
    }
    __syncthreads();
}

struct Args { const float* in[27]; float* out; unsigned char* ws; };
enum { I_X = 0, I_C, I_ADAW, I_ADAB, I_WIN, I_LQ1, I_LK1, I_LQ2, I_LK2, I_SUBLN, I_KVG, I_WUK, I_WUV, I_WA, I_WB, I_WO, I_LN1G, I_LN1B, I_WGRP, I_BGRP, I_WER, I_BER, I_WEG, I_WEU, I_WED, I_LN2G, I_LN2B };

template <class Epi>
__device__ __forceinline__ void naive_gemm(float* sm, const bf16* A, int lda, const bf16* Bt, int ldb, int M, int N, int K, const Epi& epi) {
    const int tid = threadIdx.x, ty = tid >> 5, tx = tid & 31;
    float* As = sm; float* Bs = sm + 16 * 132;
    const int ntn = N / 128, ntiles = (M / 128) * ntn;
    for (int tile = blockIdx.x; tile < ntiles; tile += gridDim.x) {
        const int m0 = (tile / ntn) * 128, n0 = (tile % ntn) * 128;
        float acc[8][4];
#pragma unroll
        for (int i = 0; i < 8; ++i)
#pragma unroll
            for (int j = 0; j < 4; ++j) acc[i][j] = 0.f;
        for (int k0 = 0; k0 < K; k0 += 16) {
            {
                const int row = tid >> 2, kq = (tid & 3) * 4;
                const v2u av = *(const v2u*)(A + (size_t)(m0 + row) * lda + k0 + kq);
                As[(kq + 0) * 132 + row] = bflo(av.x); As[(kq + 1) * 132 + row] = bfhi(av.x);
                As[(kq + 2) * 132 + row] = bflo(av.y); As[(kq + 3) * 132 + row] = bfhi(av.y);
                const v2u bv = *(const v2u*)(Bt + (size_t)(n0 + row) * ldb + k0 + kq);
                Bs[(kq + 0) * 132 + row] = bflo(bv.x); Bs[(kq + 1) * 132 + row] = bfhi(bv.x);
                Bs[(kq + 2) * 132 + row] = bflo(bv.y); Bs[(kq + 3) * 132 + row] = bfhi(bv.y);
            }
            __syncthreads();
#pragma unroll
            for (int kk = 0; kk < 16; ++kk) {
                float a[8], b[4];
#pragma unroll
                for (int i = 0; i < 8; ++i) a[i] = As[kk * 132 + ty * 8 + i];
#pragma unroll
                for (int j = 0; j < 4; ++j) b[j] = Bs[kk * 132 + tx * 4 + j];
#pragma unroll
                for (int i = 0; i < 8; ++i)
#pragma unroll
                    for (int j = 0; j < 4; ++j) acc[i][j] = fmaf(a[i], b[j], acc[i][j]);
            }
            __syncthreads();
        }
#pragma unroll
        for (int i = 0; i < 8; ++i)
#pragma unroll
            for (int j = 0; j < 4; ++j) epi(m0 + ty * 8 + i, n0 + tx * 4 + j, acc[i][j]);
    }
}

struct EpiProj {
    bf16* P;
    __device__ __forceinline__ void operator()(int r, int c, float v) const {
        if (c < C_AK || (c >= C_BQ && c < C_BKV)) v *= QSCALE;
        else if (c >= C_G) v = 1.f / (1.f + __expf(-v));
        P[(size_t)r * NP + c] = (bf16)f2bf(v);
    }
};
struct EpiKV { bf16* KV; const float* R; __device__ __forceinline__ void operator()(int r, int c, float v) const { KV[(size_t)r * 1024 + c] = (bf16)f2bf(v * R[r]); } };
struct EpiMixA { bf16* MX; const bf16* P; __device__ __forceinline__ void operator()(int r, int c, float v) const { MX[(size_t)r * 1024 + c] = (bf16)f2bf(v * bf2f(P[(size_t)r * NP + C_G + c])); } };
struct EpiMixB { bf16* MX; const bf16* P; __device__ __forceinline__ void operator()(int r, int c, float v) const { const size_t o = (size_t)r * 1024 + c; MX[o] = (bf16)f2bf(bf2f(MX[o]) + v * bf2f(P[(size_t)r * NP + C_G + 1024 + c])); } };
struct EpiWo { float* out; const float* x; const float* MOD; __device__ __forceinline__ void operator()(int r, int c, float v) const { const size_t o = (size_t)r * 1024 + c; out[o] = ALPHA * x[o] + MOD[(r >> 11) * 6144 + 2048 + c] * v; } };

__device__ __forceinline__ void p0_naive(const Args& a, unsigned char* lds) {
    unsigned char* ws = a.ws;
    const int tid = threadIdx.x; const size_t gt = (size_t)blockIdx.x * 512 + tid, NT = (size_t)gridDim.x * 512;
    bf16* WIN = (bf16*)(ws + WS_WIN); bf16* WA = (bf16*)(ws + WS_WA); bf16* WB = (bf16*)(ws + WS_WB); bf16* WO = (bf16*)(ws + WS_WO);
    bf16* WKV = (bf16*)(ws + WS_WKV); bf16* W1 = (bf16*)(ws + WS_W1); bf16* W2P = (bf16*)(ws + WS_W2P); float* RW = (float*)(ws + WS_RW);
    for (size_t i = gt; i < (size_t)NP * 1024; i += NT) { const int n = (int)(i >> 10), k = (int)(i & 1023); const int o = n < C_PADB ? n : (n >= C_G ? n - 56 : -1);
        WIN[i] = o >= 0 ? (bf16)f2bf(a.in[I_WIN][(size_t)k * IN_COLS + o]) : (bf16)0; }
    for (size_t i = gt; i < (size_t)1024 * 512; i += NT) { const int n = (int)(i >> 9), k = (int)(i & 511);
        WA[i] = (bf16)f2bf(a.in[I_WA][(size_t)k * 1024 + n]); WB[i] = (bf16)f2bf(a.in[I_WB][(size_t)k * 1024 + n]); }
    for (size_t i = gt; i < (size_t)1024 * 1024; i += NT) { const int n = (int)(i >> 10), k = (int)(i & 1023); WO[i] = (bf16)f2bf(a.in[I_WO][(size_t)k * 1024 + n]); }
    for (size_t i = gt; i < (size_t)1024 * 128; i += NT) { const int n = (int)(i >> 7), r = (int)(i & 127);
        const float g = a.in[I_KVG][r]; const float w = n < 512 ? a.in[I_WUK][r * 512 + n] : a.in[I_WUV][r * 512 + (n - 512)]; WKV[i] = (bf16)f2bf(g * w); }
    for (size_t i = gt; i < (size_t)16 * 512 * 1024; i += NT) { const int k = (int)(i & 1023), row = (int)((i >> 10) & 511), e = (int)(i >> 19);
        const int tile = row >> 8, half = (row >> 7) & 1, j = row & 127, col = tile * 128 + j;
        const float* src = half ? a.in[I_WEU] : a.in[I_WEG]; W1[i] = (bf16)f2bf(src[((size_t)e * 1024 + k) * 256 + col]); }
    for (size_t i = gt; i < (size_t)24 * 1024 * 512; i += NT) { const int kk = (int)(i & 511), n = (int)((i >> 9) & 1023), p = (int)(i >> 19);
        const int g = p / 6, pi = p % 6; const int ei = pi < 3 ? 0 : (pi < 5 ? 1 : 2); const int ej = pi < 3 ? pi + 1 : (pi < 5 ? pi - 1 : 3);
        const int e = 4 * g + (kk < 256 ? ei : ej); W2P[i] = (bf16)f2bf(a.in[I_WED][((size_t)e * 256 + (kk & 255)) * 1024 + n]); }
    for (size_t i = gt; i < (size_t)20 * 1024; i += NT) { const int c = (int)(i >> 10), k = (int)(i & 1023); RW[i] = c < 4 ? a.in[I_WGRP][k * 4 + c] : a.in[I_WER][k * 16 + (c - 4)]; }
    {
        float* sc = (float*)lds;
        const int kb = blockIdx.x >> 4, cb = blockIdx.x & 15;
        for (int i = tid; i < 16 * 64; i += 512) { const int b = i >> 6, kk = i & 63; const float cv = a.in[I_C][b * 1024 + kb * 64 + kk]; sc[i] = cv / (1.f + __expf(-cv)); }
        __syncthreads();
        if (tid < 384) {
            const int j = cb * 384 + tid; float acc[16];
#pragma unroll
            for (int b = 0; b < 16; ++b) acc[b] = 0.f;
            for (int kk = 0; kk < 64; ++kk) { const float w = a.in[I_ADAW][(size_t)(kb * 64 + kk) * 6144 + j];
#pragma unroll
                for (int b = 0; b < 16; ++b) acc[b] = fmaf(sc[b * 64 + kk], w, acc[b]); }
            float* MP = (float*)(ws + WS_MODPART);
#pragma unroll
            for (int b = 0; b < 16; ++b) MP[((size_t)kb * 16 + b) * 6144 + j] = acc[b];
        }
        __syncthreads();
    }
}
__device__ __forceinline__ float mod_sum(const float* MP, const float* adab, int b, int j) {
    float s = adab[j];
#pragma unroll
    for (int ks = 0; ks < 16; ++ks) s += MP[((size_t)ks * 16 + b) * 6144 + j];
    return s;
}
__device__ __forceinline__ void p1_modulate(const Args& a, unsigned char* lds) {
    unsigned char* ws = a.ws; const int tid = threadIdx.x, blk = blockIdx.x;
    const float* MP = (const float*)(ws + WS_MODPART); float* MOD = (float*)(ws + WS_MOD); bf16* U = (bf16*)(ws + WS_U);
    float* sh = (float*)lds; float* sc = sh + 1024;
    const int b = blk >> 4;
    for (int j = tid; j < 1024; j += 512) { sh[j] = mod_sum(MP, a.in[I_ADAB], b, j); sc[j] = 1.f + mod_sum(MP, a.in[I_ADAB], b, 1024 + j); }
    for (int e = tid; e < 384; e += 512) { const int flat = blk * 384 + e; MOD[flat] = mod_sum(MP, a.in[I_ADAB], flat / 6144, flat % 6144); }
    __syncthreads();
    const f32x4* X = (const f32x4*)(a.in[I_X] + (size_t)blk * 128 * 1024); v2u* Uo = (v2u*)(U + (size_t)blk * 128 * 1024);
    for (int i = tid; i < 128 * 256; i += 512) { const int c4 = (i & 255) * 4; const f32x4 x = X[i];
        v2u o; o.x = pk2(x.x * sc[c4] + sh[c4], x.y * sc[c4 + 1] + sh[c4 + 1]); o.y = pk2(x.z * sc[c4 + 2] + sh[c4 + 2], x.w * sc[c4 + 3] + sh[c4 + 3]); Uo[i] = o; }
    __syncthreads();
}
__device__ __forceinline__ void naive_rms_rows(const Args& a) {
    const bf16* P = (const bf16*)(a.ws + WS_PROJ); float* R = (float*)(a.ws + WS_R);
    const int lane = threadIdx.x & 63, gw = blockIdx.x * 8 + (threadIdx.x >> 6), NW = gridDim.x * 8;
    for (int t = gw; t < T; t += NW) { const unsigned w = *(const unsigned*)(P + (size_t)t * NP + C_BKV + lane * 2); const float x0 = bflo(w), x1 = bfhi(w);
        const float ss = wave_sum(x0 * x0 + x1 * x1); if (lane == 0) R[t] = 1.f / sqrtf(ss * (1.f / 128.f) + RMS_EPS); }
}
__device__ __forceinline__ unsigned sortable(float s) { const unsigned u = __float_as_uint(s); return (u & 0x80000000u) ? ~u : (u | 0x80000000u); }
__device__ __forceinline__ void naive_indexer(const Args& a, unsigned char* lds) {
    const bf16* P = (const bf16*)(a.ws + WS_PROJ); unsigned* MASK = (unsigned*)(a.ws + WS_MASK);
    const int tid = threadIdx.x, lane = tid & 63;
    float* qf = (float*)lds; float* wq = (float*)(lds + 2048); unsigned* keys = (unsigned*)(lds + 4096); unsigned* lcnt = (unsigned*)(lds + 12288); unsigned* maskw = (unsigned*)(lds + 12544);
    for (int t = blockIdx.x; t < T; t += gridDim.x) {
        const int b = t >> 11, s = t & 2047, vis = ((s >> 6) + 1) << 6;
        { const bf16* qr = P + (size_t)t * NP + C_IQ; qf[tid] = bf2f(qr[tid]); if (tid < 8) wq[tid] = bf2f(P[(size_t)t * NP + C_IW + tid]); if (tid < 40) lcnt[tid] = 0u; if (tid < 64) maskw[tid] = 0u; }
        __syncthreads();
        for (int k = tid; k < vis; k += 512) {
            const v4u* kr = (const v4u*)(P + (size_t)(b * SEQ + k) * NP + C_IK); float kf[64];
#pragma unroll
            for (int i = 0; i < 8; ++i) { const v4u v = kr[i]; kf[8 * i] = bflo(v.x); kf[8 * i + 1] = bfhi(v.x); kf[8 * i + 2] = bflo(v.y); kf[8 * i + 3] = bfhi(v.y); kf[8 * i + 4] = bflo(v.z); kf[8 * i + 5] = bfhi(v.z); kf[8 * i + 6] = bflo(v.w); kf[8 * i + 7] = bfhi(v.w); }
            float scv = 0.f;
            asm volatile("" ::: "memory");
#pragma unroll 1
            for (int h = 0; h < 8; ++h) { float d = 0.f;
#pragma unroll
                for (int i = 0; i < 64; ++i) d = fmaf(qf[h * 64 + i], kf[i], d);
                scv = fmaf(wq[h], fmaxf(d, 0.f), scv); }
            keys[k] = sortable(scv + 0.f);
        }
        __syncthreads();
        if (vis <= TOPK) { if (tid < 64) MASK[(size_t)t * 64 + tid] = (tid * 32 < vis) ? 0xffffffffu : 0u; }
        else {
            unsigned K = 0u;
            for (int bit = 31; bit >= 0; --bit) {
                const unsigned trial = K | (1u << bit); int c = 0;
                for (int k = tid; k < vis; k += 512) c += keys[k] >= trial ? 1 : 0;
                c = wave_sum_i(c); if (lane == 0 && c) atomicAdd(&lcnt[bit], (unsigned)c);
                __syncthreads();
                if (lcnt[bit] >= (unsigned)TOPK) K = trial;
            }
            { int c = 0; for (int k = tid; k < vis; k += 512) c += keys[k] > K ? 1 : 0; c = wave_sum_i(c); if (lane == 0 && c) atomicAdd(&lcnt[32], (unsigned)c); }
            __syncthreads();
            const int need = TOPK - (int)lcnt[32];
            for (int k = tid; k < vis; k += 512) {
                const unsigned kv = keys[k]; bool sel = kv > K;
                if (kv == K) { int r = 0; for (int j = 0; j < k; ++j) r += keys[j] == K ? 1 : 0; sel = r < need; }
                if (sel) atomicOr(&maskw[k >> 5], 1u << (k & 31));
            }
            __syncthreads();
            if (tid < 64) MASK[(size_t)t * 64 + tid] = maskw[tid];
        }
        __syncthreads();
    }
}
__device__ __forceinline__ float lam_value(const Args& a) {
    float s1 = 0.f, s2 = 0.f;
    for (int i = 0; i < 64; ++i) { s1 = fmaf(a.in[I_LQ1][i], a.in[I_LK1][i], s1); s2 = fmaf(a.in[I_LQ2][i], a.in[I_LK2][i], s2); }
    return expf(s1) - expf(s2) + 0.2f;
}
__device__ __forceinline__ void naive_diffattn(const Args& a, unsigned char* lds) {
    bf16* P = (bf16*)(a.ws + WS_PROJ);
    const int tid = threadIdx.x, lane = tid & 63, wv = tid >> 6;
    float* lg = (float*)(lds + wv * 16384);
    float* qs = (float*)(lds + 131072 + wv * 512);
    const float lam = lam_value(a);
    const int gw = blockIdx.x * 8 + wv, NW = gridDim.x * 8;
    for (int it = gw; it < T * 4; it += NW) {
        const int t = it >> 2, h = it & 3, b = t >> 11, s = t & 2047, vis = ((s >> 6) + 1) << 6;
        const float sl = SLOPE_A[h] * LOG2E;
        { const bf16* qr = P + (size_t)t * NP + C_AQ + h * 128; qs[lane] = bf2f(qr[lane]); qs[lane + 64] = bf2f(qr[lane + 64]); }
        LDS_WAIT();
        float m0 = -1e30f, m1 = -1e30f;
        for (int k = lane; k < vis; k += 64) {
            asm volatile("" ::: "memory");
            const v4u* kr = (const v4u*)(P + (size_t)(b * SEQ + k) * NP + C_AK + h * 128); float d0 = 0.f, d1 = 0.f;
#pragma unroll
            for (int i = 0; i < 8; ++i) { const v4u v = kr[i]; const float* q = qs + 8 * i;
                d0 = fmaf(q[0], bflo(v.x), d0); d0 = fmaf(q[1], bfhi(v.x), d0); d0 = fmaf(q[2], bflo(v.y), d0); d0 = fmaf(q[3], bfhi(v.y), d0);
                d0 = fmaf(q[4], bflo(v.z), d0); d0 = fmaf(q[5], bfhi(v.z), d0); d0 = fmaf(q[6], bflo(v.w), d0); d0 = fmaf(q[7], bfhi(v.w), d0); }
#pragma unroll
            for (int i = 0; i < 8; ++i) { const v4u v = kr[8 + i]; const float* q = qs + 64 + 8 * i;
                d1 = fmaf(q[0], bflo(v.x), d1); d1 = fmaf(q[1], bfhi(v.x), d1); d1 = fmaf(q[2], bflo(v.y), d1); d1 = fmaf(q[3], bfhi(v.y), d1);
                d1 = fmaf(q[4], bflo(v.z), d1); d1 = fmaf(q[5], bfhi(v.z), d1); d1 = fmaf(q[6], bflo(v.w), d1); d1 = fmaf(q[7], bfhi(v.w), d1); }
            const float bias = sl * fabsf((float)(s - k));
            d0 -= bias; d1 -= bias; lg[k] = d0; lg[2048 + k] = d1; m0 = fmaxf(m0, d0); m1 = fmaxf(m1, d1);
        }
        m0 = wave_max(m0); m1 = wave_max(m1);
        float l0 = 0.f, l1 = 0.f;
        for (int k = lane; k < vis; k += 64) { const float p0 = exp2f(lg[k] - m0), p1 = exp2f(lg[2048 + k] - m1); lg[k] = p0; lg[2048 + k] = p1; l0 += p0; l1 += p1; }
        l0 = wave_sum(l0); l1 = wave_sum(l1);
        LDS_WAIT();
        float o00 = 0.f, o01 = 0.f, o10 = 0.f, o11 = 0.f;
        const bf16* vb = P + (size_t)(b * SEQ) * NP + C_AV + h * 128 + lane;
        for (int k = 0; k < vis; ++k) { const float v0 = bf2f(vb[(size_t)k * NP]), v1 = bf2f(vb[(size_t)k * NP + 64]); const float p0 = lg[k], p1 = lg[2048 + k];
            o00 = fmaf(p0, v0, o00); o01 = fmaf(p0, v1, o01); o10 = fmaf(p1, v0, o10); o11 = fmaf(p1, v1, o11); }
        const float r0 = 1.f / l0, r1 = lam / l1;
        const float y0 = o00 * r0 - o10 * r1, y1 = o01 * r0 - o11 * r1;
        const float ss = wave_sum(y0 * y0 + y1 * y1); const float rn = 0.8f / sqrtf(ss * (1.f / 128.f) + RMS_EPS);
        bf16* yo = P + (size_t)t * NP + C_AQ + h * 128;
        yo[lane] = (bf16)f2bf(y0 * rn * a.in[I_SUBLN][lane]); yo[lane + 64] = (bf16)f2bf(y1 * rn * a.in[I_SUBLN][lane + 64]);
        LDS_WAIT();
    }
}
__device__ __forceinline__ void naive_battn(const Args& a, unsigned char* lds) {
    bf16* P = (bf16*)(a.ws + WS_PROJ); const bf16* KV = (const bf16*)(a.ws + WS_KV); const unsigned* MASK = (const unsigned*)(a.ws + WS_MASK);
    const int tid = threadIdx.x, lane = tid & 63, wv = tid >> 6;
    float* lg = (float*)(lds + wv * 16384); float* qs = (float*)(lds + 131072 + wv * 512);
    const int gw = blockIdx.x * 8 + wv, NW = gridDim.x * 8;
    for (int it = gw; it < T * 8; it += NW) {
        const int t = it >> 3, h = it & 7, b = t >> 11, s = t & 2047, vis = ((s >> 6) + 1) << 6;
        const float sl = SLOPE_B[h] * LOG2E;
        qs[lane] = bf2f(P[(size_t)t * NP + C_BQ + h * 64 + lane]);
        LDS_WAIT();
        float m0 = -1e30f;
        for (int k = lane; k < vis; k += 64) {
            const unsigned mw = MASK[(size_t)t * 64 + (k >> 5)]; float d0 = -INFINITY;
            asm volatile("" ::: "memory");
            if ((mw >> (k & 31)) & 1u) {
                const v4u* kr = (const v4u*)(KV + (size_t)(b * SEQ + k) * 1024 + h * 64); d0 = 0.f;
#pragma unroll
                for (int i = 0; i < 8; ++i) { const v4u v = kr[i]; const float* q = qs + 8 * i;
                    d0 = fmaf(q[0], bflo(v.x), d0); d0 = fmaf(q[1], bfhi(v.x), d0); d0 = fmaf(q[2], bflo(v.y), d0); d0 = fmaf(q[3], bfhi(v.y), d0);
                    d0 = fmaf(q[4], bflo(v.z), d0); d0 = fmaf(q[5], bfhi(v.z), d0); d0 = fmaf(q[6], bflo(v.w), d0); d0 = fmaf(q[7], bfhi(v.w), d0); }
                d0 -= sl * fabsf((float)(s - k));
            }
            lg[k] = d0; m0 = fmaxf(m0, d0);
        }
        m0 = wave_max(m0);
        float l0 = 0.f;
        for (int k = lane; k < vis; k += 64) { const float p0 = exp2f(lg[k] - m0); lg[k] = p0; l0 += p0; }
        l0 = wave_sum(l0);
        LDS_WAIT();
        float o = 0.f; const bf16* vb = KV + (size_t)(b * SEQ) * 1024 + 512 + h * 64 + lane;
        for (int k = 0; k < vis; ++k) o = fmaf(lg[k], bf2f(vb[(size_t)k * 1024]), o);
        P[(size_t)t * NP + C_BQ + h * 64 + lane] = (bf16)f2bf(o / l0);
        LDS_WAIT();
    }
}
struct Route { int bucket; float wi, wj; int pad; };
__device__ __forceinline__ void p7_ln_route(const Args& a, unsigned char* lds) {
    unsigned char* ws = a.ws; const int tid = threadIdx.x, lane = tid & 63, wv = tid >> 6, blk = blockIdx.x;
    float* rw = (float*)lds; int* cnt = (int*)(lds + 81920);
    const float* RW = (const float*)(ws + WS_RW); const float* MOD = (const float*)(ws + WS_MOD);
    bf16* U2 = (bf16*)(ws + WS_U2); Route* RT = (Route*)(ws + WS_ROUTE2); int* PERM = (int*)(ws + WS_ROUTE2 + 512 * 1024); int* CNT = (int*)(ws + WS_ROUTE2 + 1024 * 1024);
    for (int i = tid; i < 20 * 1024 / 4; i += 512) ((f32x4*)rw)[i] = ((const f32x4*)RW)[i];
    if (tid < 24) cnt[tid] = 0;
    for (int i = blk * 512 + tid; i < MAXSLOT; i += gridDim.x * 512) PERM[i] = -1;
    __syncthreads();
    const int b = blk >> 4;
    const float* sh2 = MOD + b * 6144 + 3072; const float* sc2 = MOD + b * 6144 + 4096;
    for (int i = 0; i < 16; ++i) {
        const int t = blk * 128 + wv * 16 + i; float* row = a.out + (size_t)t * 1024;
        f32x4 v[4]; float sm = 0.f;
#pragma unroll
        for (int j = 0; j < 4; ++j) { v[j] = *(const f32x4*)(row + j * 256 + lane * 4); sm += (v[j].x + v[j].y) + (v[j].z + v[j].w); }
        const float mean = wave_sum(sm) * (1.f / 1024.f); float sq = 0.f;
#pragma unroll
        for (int j = 0; j < 4; ++j) { v[j] = v[j] - mean; sq += (v[j].x * v[j].x + v[j].y * v[j].y) + (v[j].z * v[j].z + v[j].w * v[j].w); }
        const float rstd = 1.f / sqrtf(wave_sum(sq) * (1.f / 1024.f) + LN_EPS);
        f32x4 u[4];
#pragma unroll
        for (int j = 0; j < 4; ++j) { const int c = j * 256 + lane * 4; const f32x4 g = *(const f32x4*)(a.in[I_LN1G] + c), bb = *(const f32x4*)(a.in[I_LN1B] + c);
            const f32x4 x1 = v[j] * rstd * g + bb; *(f32x4*)(row + c) = x1;
            const f32x4 s2 = *(const f32x4*)(sc2 + c), h2 = *(const f32x4*)(sh2 + c); u[j] = x1 * (1.f + s2) + h2;
            v2u o; o.x = pk2(u[j].x, u[j].y); o.y = pk2(u[j].z, u[j].w); *(v2u*)(U2 + (size_t)t * 1024 + c) = o; }
        float lgt[20];
#pragma unroll
        for (int c = 0; c < 20; ++c) { float p = 0.f;
#pragma unroll
            for (int j = 0; j < 4; ++j) { const f32x4 w = *(const f32x4*)(rw + c * 1024 + j * 256 + lane * 4); p += (u[j].x * w.x + u[j].y * w.y) + (u[j].z * w.z + u[j].w * w.w); }
            lgt[c] = wave_sum(p); }
#pragma unroll
        for (int c = 0; c < 4; ++c) lgt[c] += a.in[I_BGRP][c];
#pragma unroll
        for (int c = 0; c < 16; ++c) lgt[4 + c] += a.in[I_BER][c];
        int g = 0; float gm = lgt[0];
#pragma unroll
        for (int c = 1; c < 4; ++c) if (lgt[c] > gm) { gm = lgt[c]; g = c; }
        float gs = 0.f;
#pragma unroll
        for (int c = 0; c < 4; ++c) gs += __expf(lgt[c] - gm);
        const float gp = 1.f / gs;
        float el[4];
#pragma unroll
        for (int e = 0; e < 4; ++e) el[e] = g == 0 ? lgt[4 + e] : (g == 1 ? lgt[8 + e] : (g == 2 ? lgt[12 + e] : lgt[16 + e]));
        int i1 = 0; float v1 = el[0];
#pragma unroll
        for (int e = 1; e < 4; ++e) if (el[e] > v1) { v1 = el[e]; i1 = e; }
        int i2 = -1; float v2 = -INFINITY;
#pragma unroll
        for (int e = 0; e < 4; ++e) if (e != i1 && el[e] > v2) { v2 = el[e]; i2 = e; }
        const float e2 = __expf(v2 - v1); const float w1 = gp / (1.f + e2), w2 = gp * e2 / (1.f + e2);
        const int lo = i1 < i2 ? i1 : i2, hi = i1 < i2 ? i2 : i1; const float wlo = i1 < i2 ? w1 : w2, whi = i1 < i2 ? w2 : w1;
        const int pi = lo == 0 ? hi - 1 : (lo == 1 ? hi + 1 : 5);
        const int bucket = g * 6 + pi;
        if (lane == 0) { Route r; r.bucket = bucket; r.wi = wlo; r.wj = whi; r.pad = 0; RT[t] = r; atomicAdd(&cnt[bucket], 1); }
    }
    __syncthreads();
    if (tid < 24) CNT[blk * 24 + tid] = cnt[tid];
    __syncthreads();
}
__device__ __forceinline__ void p8_sort(const Args& a, unsigned char* lds) {
    unsigned char* ws = a.ws; const int tid = threadIdx.x, blk = blockIdx.x;
    const Route* RT = (const Route*)(ws + WS_ROUTE2); int* PERM = (int*)(ws + WS_ROUTE2 + 512 * 1024); const int* CNT = (const int*)(ws + WS_ROUTE2 + 1024 * 1024);
    int* BASES = (int*)(ws + WS_ROUTE2 + 1024 * 1024 + 32768); float* SLOTW = (float*)(ws + WS_ROUTE2 + 1280 * 1024);
    const bf16* U2 = (const bf16*)(ws + WS_U2); bf16* XS = (bf16*)(ws + WS_XS);
    int* tot = (int*)lds; int* pre = tot + 32; int* base = pre + 32; int* bk = base + 32; int* slot = bk + 128;
    if (tid < 24) { int s = 0, p = 0; for (int bb = 0; bb < (int)gridDim.x; ++bb) { const int c = CNT[bb * 24 + tid]; if (bb < blk) p += c; s += c; } tot[tid] = s; pre[tid] = p; }
    __syncthreads();
    if (tid == 0) { int acc = 0; for (int p = 0; p < 24; ++p) { base[p] = acc; acc += (tot[p] + 255) & ~255; } base[24] = acc;
        if (blk == 0) { for (int p = 0; p <= 24; ++p) BASES[p] = base[p]; } }
    if (tid < 128) bk[tid] = RT[blk * 128 + tid].bucket;
    __syncthreads();
    if (tid < 128) { const int p = bk[tid]; int r = 0; for (int j = 0; j < tid; ++j) r += bk[j] == p ? 1 : 0; const int s = base[p] + pre[p] + r; slot[tid] = s;
        const int t = blk * 128 + tid; PERM[s] = t; SLOTW[2 * s] = RT[t].wi; SLOTW[2 * s + 1] = RT[t].wj; }
    __syncthreads();
    for (int i = tid; i < 128 * 128; i += 512) { const int r = i >> 7, c = i & 127; ((v4u*)(XS + (size_t)slot[r] * 1024))[c] = ((const v4u*)(U2 + (size_t)(blk * 128 + r) * 1024))[c]; }
    __syncthreads();
}
__device__ __forceinline__ int bucket_of_slot(const int* BASES, int s) { int p = 0; for (int q = 1; q < 24; ++q) if (s >= BASES[q]) p = q; return p; }
__device__ __forceinline__ void pair_experts(int p, int& ei, int& ej) { const int g = p / 6, pi = p % 6; ei = 4 * g + (pi < 3 ? 0 : (pi < 5 ? 1 : 2)); ej = 4 * g + (pi < 3 ? pi + 1 : (pi < 5 ? pi - 1 : 3)); }
__device__ __forceinline__ void naive_moe1(const Args& a, unsigned char* lds) {
    unsigned char* ws = a.ws; const int tid = threadIdx.x;
    const int* PERM = (const int*)(ws + WS_ROUTE2 + 512 * 1024); const int* BASES = (const int*)(ws + WS_ROUTE2 + 1024 * 1024 + 32768); const float* SLOTW = (const float*)(ws + WS_ROUTE2 + 1280 * 1024);
    const bf16* XS = (const bf16*)(ws + WS_XS); const bf16* W1 = (const bf16*)(ws + WS_W1); bf16* H = (bf16*)(ws + WS_H);
    float* xs = (float*)lds; const int nslot = BASES[24];
    for (int s = blockIdx.x; s < nslot; s += gridDim.x) {
        if (PERM[s] < 0) continue;
        const int p = bucket_of_slot(BASES, s); int ei, ej; pair_experts(p, ei, ej);
        __syncthreads();
        xs[tid] = bf2f(XS[(size_t)s * 1024 + tid]); xs[tid + 512] = bf2f(XS[(size_t)s * 1024 + 512 + tid]);
        __syncthreads();
        const int m = tid >> 8, c = tid & 255, e = m ? ej : ei; const int grow = (c >> 7) * 256 + (c & 127);
        const v4u* wg = (const v4u*)(W1 + ((size_t)e * 512 + grow) * 1024); const v4u* wu = (const v4u*)(W1 + ((size_t)e * 512 + grow + 128) * 1024);
        float dg = 0.f, du = 0.f;
        for (int i = 0; i < 128; ++i) { const v4u g = wg[i], u = wu[i]; const float* x = xs + 8 * i;
            dg = fmaf(x[0], bflo(g.x), dg); dg = fmaf(x[1], bfhi(g.x), dg); dg = fmaf(x[2], bflo(g.y), dg); dg = fmaf(x[3], bfhi(g.y), dg);
            dg = fmaf(x[4], bflo(g.z), dg); dg = fmaf(x[5], bfhi(g.z), dg); dg = fmaf(x[6], bflo(g.w), dg); dg = fmaf(x[7], bfhi(g.w), dg);
            du = fmaf(x[0], bflo(u.x), du); du = fmaf(x[1], bfhi(u.x), du); du = fmaf(x[2], bflo(u.y), du); du = fmaf(x[3], bfhi(u.y), du);
            du = fmaf(x[4], bflo(u.z), du); du = fmaf(x[5], bfhi(u.z), du); du = fmaf(x[6], bflo(u.w), du); du = fmaf(x[7], bfhi(u.w), du); }
        const float hv = dg / (1.f + __expf(-dg)) * du * SLOTW[2 * s + m];
        H[(size_t)s * 512 + tid] = (bf16)f2bf(hv);
    }
    __syncthreads();
}
__device__ __forceinline__ void naive_moe2(const Args& a, unsigned char* lds) {
    unsigned char* ws = a.ws; const int tid = threadIdx.x;
    const int* PERM = (const int*)(ws + WS_ROUTE2 + 512 * 1024); const int* BASES = (const int*)(ws + WS_ROUTE2 + 1024 * 1024 + 32768);
    const bf16* W2P = (const bf16*)(ws + WS_W2P); const bf16* H = (const bf16*)(ws + WS_H); const float* MOD = (const float*)(ws + WS_MOD);
    float* hs = (float*)lds; const int nslot = BASES[24];
    for (int s = blockIdx.x; s < nslot; s += gridDim.x) {
        const int t = PERM[s]; if (t < 0) continue;
        const int p = bucket_of_slot(BASES, s);
        __syncthreads();
        hs[tid] = bf2f(H[(size_t)s * 512 + tid]);
        __syncthreads();
        for (int j = tid; j < 1024; j += 512) {
            const v4u* w = (const v4u*)(W2P + ((size_t)p * 1024 + j) * 512); float y = 0.f;
            for (int i = 0; i < 64; ++i) { const v4u g = w[i]; const float* x = hs + 8 * i;
                y = fmaf(x[0], bflo(g.x), y); y = fmaf(x[1], bfhi(g.x), y); y = fmaf(x[2], bflo(g.y), y); y = fmaf(x[3], bfhi(g.y), y);
                y = fmaf(x[4], bflo(g.z), y); y = fmaf(x[5], bfhi(g.z), y); y = fmaf(x[6], bflo(g.w), y); y = fmaf(x[7], bfhi(g.w), y); }
            const size_t o = (size_t)t * 1024 + j; a.out[o] = ALPHA * a.out[o] + MOD[(t >> 11) * 6144 + 5120 + j] * y;
        }
    }
    __syncthreads();
}
__device__ __forceinline__ void p11_ln(const Args& a) {
    const int lane = threadIdx.x & 63, gw = blockIdx.x * 8 + (threadIdx.x >> 6), NW = gridDim.x * 8;
    for (int t = gw; t < T; t += NW) {
        float* row = a.out + (size_t)t * 1024; f32x4 v[4]; float sm = 0.f;
#pragma unroll
        for (int j = 0; j < 4; ++j) { v[j] = *(const f32x4*)(row + j * 256 + lane * 4); sm += (v[j].x + v[j].y) + (v[j].z + v[j].w); }
        const float mean = wave_sum(sm) * (1.f / 1024.f); float sq = 0.f;
#pragma unroll
        for (int j = 0; j < 4; ++j) { v[j] = v[j] - mean; sq += (v[j].x * v[j].x + v[j].y * v[j].y) + (v[j].z * v[j].z + v[j].w * v[j].w); }
        const float rstd = 1.f / sqrtf(wave_sum(sq) * (1.f / 1024.f) + LN_EPS);
#pragma unroll
        for (int j = 0; j < 4; ++j) { const int c = j * 256 + lane * 4; const f32x4 g = *(const f32x4*)(a.in[I_LN2G] + c), bb = *(const f32x4*)(a.in[I_LN2B] + c); *(f32x4*)(row + c) = v[j] * rstd * g + bb; }
    }
}

__global__ void __launch_bounds__(512, 2) fwd(Args a) {
    extern __shared__ __attribute__((aligned(16))) unsigned char lds[];
    const int tid = threadIdx.x;
    unsigned char* ws = a.ws;
    for (int u = tid; u < (LDS_BYTES - LDSCTL_OFF) / 4; u += 512) ((LAS unsigned*)((LAS unsigned char*)lds + LDSCTL_OFF))[u] = 0u;
    __syncthreads();
    XcdBarrier bar = xcd_barrier_post((unsigned*)(ws + WS_CTL) + CW_BAR, (volatile LAS unsigned*)((LAS unsigned char*)lds + MISC_OFF) + 8);
#define GRID_BAR() xcd_barrier(bar)
    bf16* PROJ = (bf16*)(ws + WS_PROJ); bf16* U = (bf16*)(ws + WS_U);

    p0_naive(a, lds);
    GRID_BAR();
    p1_modulate(a, lds);
    GRID_BAR();
    { EpiProj e{PROJ}; naive_gemm((float*)lds, U, 1024, (const bf16*)(ws + WS_WIN), 1024, T, NP, 1024, e); }
    GRID_BAR();
    naive_rms_rows(a);
    GRID_BAR();
    { EpiKV e{(bf16*)(ws + WS_KV), (const float*)(ws + WS_R)}; naive_gemm((float*)lds, PROJ + C_BKV, NP, (const bf16*)(ws + WS_WKV), 128, T, 1024, 128, e); }
    naive_indexer(a, lds);
    __syncthreads();
    naive_diffattn(a, lds);
    GRID_BAR();
    naive_battn(a, lds);
    GRID_BAR();
    { EpiMixA e{U, PROJ}; naive_gemm((float*)lds, PROJ + C_AQ, NP, (const bf16*)(ws + WS_WA), 512, T, 1024, 512, e); }
    __syncthreads();
    { EpiMixB e{U, PROJ}; naive_gemm((float*)lds, PROJ + C_BQ, NP, (const bf16*)(ws + WS_WB), 512, T, 1024, 512, e); }
    GRID_BAR();
    { EpiWo e{a.out, a.in[I_X], (const float*)(ws + WS_MOD)}; naive_gemm((float*)lds, U, 1024, (const bf16*)(ws + WS_WO), 1024, T, 1024, 1024, e); }
    GRID_BAR();
    p7_ln_route(a, lds);
    GRID_BAR();
    p8_sort(a, lds);
    GRID_BAR();
    naive_moe1(a, lds);
    GRID_BAR();
    naive_moe2(a, lds);
    GRID_BAR();
    p11_ln(a);
}

extern "C" void kernel_launch(void* const* d_in, const int* in_sizes, int n_in, void* d_out, int out_size, void* d_ws, size_t ws_size, hipStream_t stream) {
    static int grid = 0;
    if (grid == 0) {
        if (n_in != 27 || out_size != T * D || ws_size < WS_END) { fprintf(stderr, "kernel_launch: unexpected problem (n_in %d, out %d, ws %zu); nothing launched\n", n_in, out_size, ws_size); grid = -1; return; }
        int dev = 0, cus = 0;
        if (hipGetDevice(&dev) != hipSuccess || hipDeviceGetAttribute(&cus, hipDeviceAttributeMultiprocessorCount, dev) != hipSuccess) { grid = -1; return; }
        if (hipFuncSetAttribute((const void*)fwd, hipFuncAttributeMaxDynamicSharedMemorySize, LDS_BYTES) != hipSuccess) { fprintf(stderr, "kernel_launch: hipFuncSetAttribute failed\n"); grid = -1; return; }
        if (cus != 256) { fprintf(stderr, "kernel_launch: built for 256 CUs, device has %d; nothing launched\n", cus); grid = -1; return; }
        grid = cus;
    }
    if (grid < 0) return;
    if (hipMemsetAsync((char*)d_ws + WS_CTL, 0, CTL_ZERO_BYTES, stream) != hipSuccess) return;
    Args a{};
    for (int i = 0; i < 27; ++i) a.in[i] = (const float*)d_in[i];
    a.out = (float*)d_out; a.ws = (unsigned char*)d_ws;
    hipLaunchKernelGGL(fwd, dim3(grid), dim3(512), LDS_BYTES, stream, a);
}
```

```cpp
#include <hip/hip_runtime.h>
#include <hip/hip_bf16.h>
#include <cstdio>
#include <cstdint>

#define GAS __attribute__((address_space(1)))
#define LAS __attribute__((address_space(3)))
typedef unsigned short bf16;
typedef GAS unsigned gu32;
typedef unsigned v4u __attribute__((ext_vector_type(4)));
typedef unsigned v2u __attribute__((ext_vector_type(2)));
typedef float f32x4 __attribute__((ext_vector_type(4)));
#define RLX_AGENT __ATOMIC_RELAXED, __HIP_MEMORY_SCOPE_AGENT

#ifndef FAST_P2
#define FAST_P2 1
#endif
#ifndef FAST_KV
#define FAST_KV 1
#endif
#ifndef FAST_MIX
#define FAST_MIX 1
#endif
#ifndef FAST_WO
#define FAST_WO 1
#endif
#ifndef FAST_MOE
#define FAST_MOE 1
#endif
#ifndef FAST_DATT
#define FAST_DATT 1
#endif
#ifndef FAST_BATT
#define FAST_BATT 1
#endif
constexpr int BATCH = 16, SEQ = 2048, D = 1024, T = BATCH * SEQ;
constexpr int NP = 4864;
constexpr int C_AQ = 0, C_AK = 512, C_AV = 1024, C_BQ = 1536, C_BKV = 2048, C_IQ = 2176, C_IK = 2688, C_IW = 2752, C_PADB = 2760, C_G = 2816;
constexpr int IN_COLS = 4808;
constexpr float LOG2E = 1.4426950408889634f;
constexpr float QSCALE = 0.125f * LOG2E;
constexpr float ALPHA = 1.189207115002721f;
constexpr float LN_EPS = 1e-5f, RMS_EPS = 1e-5f;
constexpr int TOPK = 256;
constexpr int MAXSLOT = 40960;

__device__ __constant__ float SLOPE_A[4] = {0.6299605369567871f, 0.15749013423919678f, 0.039372533559799194f, 0.009843133389949799f};
__device__ __constant__ float SLOPE_B[8] = {0.39685025811195374f, 0.25f, 0.09921256452798843f, 0.0625f, 0.02480314113199711f, 0.015625f, 0.006200785282999277f, 0.00390625f};

constexpr size_t MiB = 1u << 20;
constexpr size_t WS_CTL = 0, CTL_ZERO_BYTES = 1 * MiB;
constexpr size_t WS_MOD = 1 * MiB;
constexpr size_t WS_R = WS_MOD + 512 * 1024;
constexpr size_t WS_ROUTE = WS_R + 128 * 1024;
constexpr size_t WS_WIN = 2 * MiB;
constexpr size_t WS_WA = 12 * MiB;
constexpr size_t WS_WB = 13 * MiB;
constexpr size_t WS_WO = 14 * MiB;
constexpr size_t WS_WKV = 16 * MiB;
constexpr size_t WS_W1 = 17 * MiB;
constexpr size_t WS_W2P = 33 * MiB;
constexpr size_t WS_ROUTE2 = 57 * MiB;
constexpr size_t WS_RW = 59 * MiB;
constexpr size_t WS_MODP = 59 * MiB + 128 * 1024;
constexpr size_t WS_MASK = 60 * MiB;
constexpr size_t WS_KV = 68 * MiB;
constexpr size_t WS_U = 132 * MiB;
constexpr size_t WS_PROJ = 196 * MiB;
constexpr size_t WS_U2 = 196 * MiB;
constexpr size_t WS_H = 260 * MiB;
constexpr size_t WS_XS = 300 * MiB;
constexpr size_t WS_MODPART = 500 * MiB;
constexpr size_t WS_END = 512 * MiB;

constexpr int CW_BAR = 4096;

constexpr int LDSCTL_OFF = 139264, MISC_OFF = LDSCTL_OFF + 320, LDS_BYTES = 147456;

__device__ __forceinline__ unsigned f2bf(float f) { unsigned u = __float_as_uint(f); return (u + 0x7fffu + ((u >> 16) & 1u)) >> 16; }
__device__ __forceinline__ float bf2f(unsigned h) { return __uint_as_float(h << 16); }
__device__ __forceinline__ float bflo(unsigned w) { return __uint_as_float(w << 16); }
__device__ __forceinline__ float bfhi(unsigned w) { return __uint_as_float(w & 0xffff0000u); }
__device__ __forceinline__ unsigned pk2(float lo, float hi) { return f2bf(lo) | (f2bf(hi) << 16); }
__device__ __forceinline__ float wave_sum(float v) {
#pragma unroll
    for (int o = 1; o < 64; o <<= 1) v += __shfl_xor(v, o);
    return v;
}
__device__ __forceinline__ float wave_max(float v) {
#pragma unroll
    for (int o = 1; o < 64; o <<= 1) v = fmaxf(v, __shfl_xor(v, o));
    return v;
}
__device__ __forceinline__ int wave_sum_i(int v) {
#pragma unroll
    for (int o = 1; o < 64; o <<= 1) v += __shfl_xor(v, o);
    return v;
}
#define LDS_WAIT() asm volatile("s_waitcnt lgkmcnt(0)" ::: "memory")
__device__ __forceinline__ int otid() { int t = threadIdx.x; asm volatile("" : "+v"(t)); return t; }

#define XB_TMO      128
#define XB_XCNT(j)  (256  + 64 * (j))
#define XB_XSUB(j)  (1280 + 64 * (j))
#define XB_XGEN(j)  (2304 + 64 * (j))
#define XB_TOP      3328
#define XB_TOPGEN   3392
#define XCD_BAR_WORDS 3456
#define XB_SPIN_CAP (1u << 22)
__device__ __forceinline__ unsigned xb_ld(unsigned* p)              { return __hip_atomic_load(p, __ATOMIC_RELAXED, __HIP_MEMORY_SCOPE_AGENT); }
__device__ __forceinline__ unsigned xb_add(unsigned* p, unsigned v) { return __hip_atomic_fetch_add(p, v, __ATOMIC_RELAXED, __HIP_MEMORY_SCOPE_AGENT); }
__device__ __forceinline__ unsigned xb_xcc_id() { return (unsigned)__builtin_amdgcn_s_getreg((3 << 11) | 20) & 0xFu; }
#define XB_SPIN(cond, bar) do { unsigned _sp = 0; while (cond) { __builtin_amdgcn_s_sleep(1); \
    if ((++_sp & 255u) == 0u) { if (xb_ld(&(bar)[XB_TMO])) break; if (_sp > XB_SPIN_CAP) { atomicAdd(&(bar)[XB_TMO], 1u); break; } } } } while (0)
struct XcdBarrier { unsigned* bar; unsigned x; volatile LAS unsigned* st; };
__device__ __forceinline__ XcdBarrier xcd_barrier_post(unsigned* bar, volatile LAS unsigned* st) {
    XcdBarrier b; b.bar = bar; b.x = xb_xcc_id(); b.st = st;
    if (threadIdx.x == 0) (void)xb_add(&bar[XB_XCNT(b.x)], 1u);
    return b;
}
__device__ __forceinline__ void xcd_barrier_complete(unsigned* bar, unsigned x, unsigned& nloc, unsigned& nx) {
    const unsigned G = gridDim.x * gridDim.y * gridDim.z;
    unsigned sum, cnt, mine, sp = 0u;
    for (;;) {
        sum = 0u; cnt = 0u; mine = 0u;
#pragma unroll
        for (unsigned j = 0; j < 16; ++j) { const unsigned c = xb_ld(&bar[XB_XCNT(j)]); sum += c; cnt += (c > 0u) ? 1u : 0u; mine = (j == x) ? c : mine; }
        if (sum == G) break;
        __builtin_amdgcn_s_sleep(1);
        if ((++sp & 255u) == 0u) { if (xb_ld(&bar[XB_TMO])) break; if (sp > XB_SPIN_CAP) { atomicAdd(&bar[XB_TMO], 1u); break; } }
    }
    nloc = mine > 0u ? mine : 1u; nx = cnt > 0u ? cnt : 1u;
}
__device__ __forceinline__ void xcd_barrier(const XcdBarrier& b) {
    asm volatile("s_waitcnt vmcnt(0)" ::: "memory");
    __syncthreads();
    if (threadIdx.x == 0) {
        unsigned* bar = b.bar;
        __builtin_amdgcn_s_waitcnt(0);
        unsigned nloc = b.st[0], nx = b.st[1];
        if (nloc == 0u) { xcd_barrier_complete(bar, b.x, nloc, nx); b.st[0] = nloc; b.st[1] = nx; }
        const unsigned old = xb_add(&bar[XB_XSUB(b.x)], 1u);
        const unsigned gen = old / nloc;
        if (old + 1u == (gen + 1u) * nloc) {
            __builtin_amdgcn_fence(__ATOMIC_RELEASE, "agent");
            asm volatile("s_waitcnt vmcnt(0)" ::: "memory");
            const unsigned og = xb_add(&bar[XB_TOP], 1u);
            const unsigned tg = og / nx;
            if (og + 1u == (tg + 1u) * nx) xb_add(&bar[XB_TOPGEN], 1u);
            else XB_SPIN(xb_ld(&bar[XB_TOPGEN]) == tg, bar);
            __builtin_amdgcn_fence(__ATOMIC_ACQUIRE, "agent");
            xb_add(&bar[XB_XGEN(b.x)], 1u);
            asm volatile("s_waitcnt vmcnt(0)" ::: "memory");
        } else {
            XB_SPIN(xb_ld(&bar[XB_XGEN(b.x)]) == gen, bar);
            __builtin_amdgcn_fence(__ATOMIC_ACQUIRE, "agent");
            asm volatile("s_waitcnt vmcnt(0)" ::: "memory");
        }
    }
    __syncthreads();
}

struct Args { const float* in[27]; float* out; unsigned char* ws; };
enum { I_X = 0, I_C, I_ADAW, I_ADAB, I_WIN, I_LQ1, I_LK1, I_LQ2, I_LK2, I_SUBLN, I_KVG, I_WUK, I_WUV, I_WA, I_WB, I_WO, I_LN1G, I_LN1B, I_WGRP, I_BGRP, I_WER, I_BER, I_WEG, I_WEU, I_WED, I_LN2G, I_LN2B };

template <class Epi>
__device__ __forceinline__ void naive_gemm(float* sm, const bf16* A, int lda, const bf16* Bt, int ldb, int M, int N, int K, const Epi& epi) {
    const int tid = otid(), ty = tid >> 5, tx = tid & 31;
    float* As = sm; float* Bs = sm + 16 * 132;
    const int ntn = N / 128, ntiles = (M / 128) * ntn;
    for (int tile = blockIdx.x; tile < ntiles; tile += gridDim.x) {
        const int m0 = (tile / ntn) * 128, n0 = (tile % ntn) * 128;
        float acc[8][4];
#pragma unroll
        for (int i = 0; i < 8; ++i)
#pragma unroll
            for (int j = 0; j < 4; ++j) acc[i][j] = 0.f;
        for (int k0 = 0; k0 < K; k0 += 16) {
            {
                const int row = tid >> 2, kq = (tid & 3) * 4;
                const v2u av = *(const v2u*)(A + (size_t)(m0 + row) * lda + k0 + kq);
                As[(kq + 0) * 132 + row] = bflo(av.x); As[(kq + 1) * 132 + row] = bfhi(av.x);
                As[(kq + 2) * 132 + row] = bflo(av.y); As[(kq + 3) * 132 + row] = bfhi(av.y);
                const v2u bv = *(const v2u*)(Bt + (size_t)(n0 + row) * ldb + k0 + kq);
                Bs[(kq + 0) * 132 + row] = bflo(bv.x); Bs[(kq + 1) * 132 + row] = bfhi(bv.x);
                Bs[(kq + 2) * 132 + row] = bflo(bv.y); Bs[(kq + 3) * 132 + row] = bfhi(bv.y);
            }
            __syncthreads();
#pragma unroll
            for (int kk = 0; kk < 16; ++kk) {
                float a[8], b[4];
#pragma unroll
                for (int i = 0; i < 8; ++i) a[i] = As[kk * 132 + ty * 8 + i];
#pragma unroll
                for (int j = 0; j < 4; ++j) b[j] = Bs[kk * 132 + tx * 4 + j];
#pragma unroll
                for (int i = 0; i < 8; ++i)
#pragma unroll
                    for (int j = 0; j < 4; ++j) acc[i][j] = fmaf(a[i], b[j], acc[i][j]);
            }
            __syncthreads();
        }
#pragma unroll
        for (int i = 0; i < 8; ++i)
#pragma unroll
            for (int j = 0; j < 4; ++j) epi(m0 + ty * 8 + i, n0 + tx * 4 + j, acc[i][j]);
    }
}

struct EpiProj {
    bf16* P;
    __device__ __forceinline__ void operator()(int r, int c, float v) const {
        if (c < C_AK || (c >= C_BQ && c < C_BKV)) v *= QSCALE;
        else if (c >= C_G) v = 1.f / (1.f + __expf(-v));
        P[(size_t)r * NP + c] = (bf16)f2bf(v);
    }
};
struct EpiKV { bf16* KV; const float* R; __device__ __forceinline__ void operator()(int r, int c, float v) const { KV[(size_t)r * 1024 + c] = (bf16)f2bf(v * R[r]); } };
struct EpiMixA { bf16* MX; const bf16* P; __device__ __forceinline__ void operator()(int r, int c, float v) const { MX[(size_t)r * 1024 + c] = (bf16)f2bf(v * bf2f(P[(size_t)r * NP + C_G + c])); } };
struct EpiMixB { bf16* MX; const bf16* P; __device__ __forceinline__ void operator()(int r, int c, float v) const { const size_t o = (size_t)r * 1024 + c; MX[o] = (bf16)f2bf(bf2f(MX[o]) + v * bf2f(P[(size_t)r * NP + C_G + 1024 + c])); } };
struct EpiWo { float* out; const float* x; const float* MOD; __device__ __forceinline__ void operator()(int r, int c, float v) const { const size_t o = (size_t)r * 1024 + c; out[o] = ALPHA * x[o] + MOD[(r >> 11) * 6144 + 2048 + c] * v; } };

__device__ __forceinline__ void p0_naive(const Args& a, unsigned char* lds) {
    unsigned char* ws = a.ws;
    const int tid = otid(); const size_t gt = (size_t)blockIdx.x * 512 + tid, NT = (size_t)gridDim.x * 512;
    bf16* WIN = (bf16*)(ws + WS_WIN); bf16* WA = (bf16*)(ws + WS_WA); bf16* WB = (bf16*)(ws + WS_WB); bf16* WO = (bf16*)(ws + WS_WO);
    bf16* WKV = (bf16*)(ws + WS_WKV); bf16* W1 = (bf16*)(ws + WS_W1); bf16* W2P = (bf16*)(ws + WS_W2P); float* RW = (float*)(ws + WS_RW);
    for (size_t i = gt; i < (size_t)NP * 1024; i += NT) { const int n = (int)(i >> 10), k = (int)(i & 1023); const int o = n < C_PADB ? n : (n >= C_G ? n - 56 : -1);
        WIN[i] = o >= 0 ? (bf16)f2bf(a.in[I_WIN][(size_t)k * IN_COLS + o]) : (bf16)0; }
    for (size_t i = gt; i < (size_t)1024 * 512; i += NT) { const int n = (int)(i >> 9), k = (int)(i & 511);
        WA[i] = (bf16)f2bf(a.in[I_WA][(size_t)k * 1024 + n]); WB[i] = (bf16)f2bf(a.in[I_WB][(size_t)k * 1024 + n]); }
    for (size_t i = gt; i < (size_t)1024 * 1024; i += NT) { const int n = (int)(i >> 10), k = (int)(i & 1023); WO[i] = (bf16)f2bf(a.in[I_WO][(size_t)k * 1024 + n]); }
    for (size_t i = gt; i < (size_t)1024 * 128; i += NT) { const int n = (int)(i >> 7), r = (int)(i & 127);
        const float g = a.in[I_KVG][r]; const float w = n < 512 ? a.in[I_WUK][r * 512 + n] : a.in[I_WUV][r * 512 + (n - 512)]; WKV[i] = (bf16)f2bf(g * w); }
    for (size_t i = gt; i < (size_t)16 * 512 * 1024; i += NT) { const int k = (int)(i & 1023), row = (int)((i >> 10) & 511), e = (int)(i >> 19);
        const int tile = row >> 8, half = (row >> 7) & 1, j = row & 127, col = tile * 128 + j;
        const float* src = half ? a.in[I_WEU] : a.in[I_WEG]; W1[i] = (bf16)f2bf(src[((size_t)e * 1024 + k) * 256 + col]); }
    for (size_t i = gt; i < (size_t)24 * 1024 * 512; i += NT) { const int kk = (int)(i & 511), n = (int)((i >> 9) & 1023), p = (int)(i >> 19);
        const int g = p / 6, pi = p % 6; const int ei = pi < 3 ? 0 : (pi < 5 ? 1 : 2); const int ej = pi < 3 ? pi + 1 : (pi < 5 ? pi - 1 : 3);
        const int e = 4 * g + (kk < 256 ? ei : ej); W2P[i] = (bf16)f2bf(a.in[I_WED][((size_t)e * 256 + (kk & 255)) * 1024 + n]); }
    for (size_t i = gt; i < (size_t)20 * 1024; i += NT) { const int c = (int)(i >> 10), k = (int)(i & 1023); RW[i] = c < 4 ? a.in[I_WGRP][k * 4 + c] : a.in[I_WER][k * 16 + (c - 4)]; }
    {
        float* sc = (float*)lds;
        const int kb = blockIdx.x >> 4, cb = blockIdx.x & 15;
        for (int i = tid; i < 16 * 64; i += 512) { const int b = i >> 6, kk = i & 63; const float cv = a.in[I_C][b * 1024 + kb * 64 + kk]; sc[i] = cv / (1.f + __expf(-cv)); }
        __syncthreads();
        if (tid < 384) {
            const int j = cb * 384 + tid; float acc[16];
#pragma unroll
            for (int b = 0; b < 16; ++b) acc[b] = 0.f;
            for (int kk = 0; kk < 64; ++kk) { const float w = a.in[I_ADAW][(size_t)(kb * 64 + kk) * 6144 + j];
#pragma unroll
                for (int b = 0; b < 16; ++b) acc[b] = fmaf(sc[b * 64 + kk], w, acc[b]); }
            float* MP = (float*)(ws + WS_MODPART);
#pragma unroll
            for (int b = 0; b < 16; ++b) MP[((size_t)kb * 16 + b) * 6144 + j] = acc[b];
        }
        __syncthreads();
    }
}
__device__ __forceinline__ float mod_sum(const float* MP, const float* adab, int b, int j) {
    float s = adab[j];
#pragma unroll
    for (int ks = 0; ks < 16; ++ks) s += MP[((size_t)ks * 16 + b) * 6144 + j];
    return s;
}
__device__ __forceinline__ void p1_modulate(const Args& a, unsigned char* lds) {
    unsigned char* ws = a.ws; const int tid = otid(), blk = blockIdx.x;
    const float* MP = (const float*)(ws + WS_MODPART); float* MOD = (float*)(ws + WS_MOD); bf16* U = (bf16*)(ws + WS_U);
    float* sh = (float*)lds; float* sc = sh + 1024;
    const int b = blk >> 4;
    for (int j = tid; j < 1024; j += 512) { sh[j] = mod_sum(MP, a.in[I_ADAB], b, j); sc[j] = 1.f + mod_sum(MP, a.in[I_ADAB], b, 1024 + j); }
    for (int e = tid; e < 384; e += 512) { const int flat = blk * 384 + e; MOD[flat] = mod_sum(MP, a.in[I_ADAB], flat / 6144, flat % 6144); }
    __syncthreads();
    const f32x4* X = (const f32x4*)(a.in[I_X] + (size_t)blk * 128 * 1024); v2u* Uo = (v2u*)(U + (size_t)blk * 128 * 1024);
    for (int i = tid; i < 128 * 256; i += 512) { const int c4 = (i & 255) * 4; const f32x4 x = X[i];
        v2u o; o.x = pk2(x.x * sc[c4] + sh[c4], x.y * sc[c4 + 1] + sh[c4 + 1]); o.y = pk2(x.z * sc[c4 + 2] + sh[c4 + 2], x.w * sc[c4 + 3] + sh[c4 + 3]); Uo[i] = o; }
    __syncthreads();
}
__device__ __forceinline__ void naive_rms_rows(const Args& a) {
    const bf16* P = (const bf16*)(a.ws + WS_PROJ); float* R = (float*)(a.ws + WS_R);
    const int tid = otid(); const int lane = tid & 63, gw = blockIdx.x * 8 + (tid >> 6), NW = gridDim.x * 8;
    for (int t = gw; t < T; t += NW) { const unsigned w = *(const unsigned*)(P + (size_t)t * NP + C_BKV + lane * 2); const float x0 = bflo(w), x1 = bfhi(w);
        const float ss = wave_sum(x0 * x0 + x1 * x1); if (lane == 0) R[t] = 1.f / sqrtf(ss * (1.f / 128.f) + RMS_EPS); }
}
__device__ __forceinline__ unsigned sortable(float s) { const unsigned u = __float_as_uint(s); return (u & 0x80000000u) ? ~u : (u | 0x80000000u); }
__device__ __forceinline__ void naive_indexer(const Args& a, unsigned char* lds) {
    const bf16* P = (const bf16*)(a.ws + WS_PROJ); unsigned* MASK = (unsigned*)(a.ws + WS_MASK);
    const int tid = otid(), lane = tid & 63;
    float* qf = (float*)lds; float* wq = (float*)(lds + 2048); unsigned* keys = (unsigned*)(lds + 4096); unsigned* lcnt = (unsigned*)(lds + 12288); unsigned* maskw = (unsigned*)(lds + 12544);
    for (int t = blockIdx.x; t < T; t += gridDim.x) {
        const int b = t >> 11, s = t & 2047, vis = ((s >> 6) + 1) << 6;
        { const bf16* qr = P + (size_t)t * NP + C_IQ; qf[tid] = bf2f(qr[tid]); if (tid < 8) wq[tid] = bf2f(P[(size_t)t * NP + C_IW + tid]); if (tid < 40) lcnt[tid] = 0u; if (tid < 64) maskw[tid] = 0u; }
        __syncthreads();
        for (int k = tid; k < vis; k += 512) {
            const v4u* kr = (const v4u*)(P + (size_t)(b * SEQ + k) * NP + C_IK); float kf[64];
#pragma unroll
            for (int i = 0; i < 8; ++i) { const v4u v = kr[i]; kf[8 * i] = bflo(v.x); kf[8 * i + 1] = bfhi(v.x); kf[8 * i + 2] = bflo(v.y); kf[8 * i + 3] = bfhi(v.y); kf[8 * i + 4] = bflo(v.z); kf[8 * i + 5] = bfhi(v.z); kf[8 * i + 6] = bflo(v.w); kf[8 * i + 7] = bfhi(v.w); }
            float scv = 0.f;
            asm volatile("" ::: "memory");
#pragma unroll 1
            for (int h = 0; h < 8; ++h) { float d = 0.f;
#pragma unroll
                for (int i = 0; i < 64; ++i) d = fmaf(qf[h * 64 + i], kf[i], d);
                scv = fmaf(wq[h], fmaxf(d, 0.f), scv); }
            keys[k] = sortable(scv + 0.f);
        }
        __syncthreads();
        if (vis <= TOPK) { if (tid < 64) MASK[(size_t)t * 64 + tid] = (tid * 32 < vis) ? 0xffffffffu : 0u; }
        else {
            unsigned K = 0u;
            for (int bit = 31; bit >= 0; --bit) {
                const unsigned trial = K | (1u << bit); int c = 0;
                for (int k = tid; k < vis; k += 512) c += keys[k] >= trial ? 1 : 0;
                c = wave_sum_i(c); if (lane == 0 && c) atomicAdd(&lcnt[bit], (unsigned)c);
                __syncthreads();
                if (lcnt[bit] >= (unsigned)TOPK) K = trial;
            }
            { int c = 0; for (int k = tid; k < vis; k += 512) c += keys[k] > K ? 1 : 0; c = wave_sum_i(c); if (lane == 0 && c) atomicAdd(&lcnt[32], (unsigned)c); }
            __syncthreads();
            const int need = TOPK - (int)lcnt[32];
            for (int k = tid; k < vis; k += 512) {
                const unsigned kv = keys[k]; bool sel = kv > K;
                if (kv == K) { int r = 0; for (int j = 0; j < k; ++j) r += keys[j] == K ? 1 : 0; sel = r < need; }
                if (sel) atomicOr(&maskw[k >> 5], 1u << (k & 31));
            }
            __syncthreads();
            if (tid < 64) MASK[(size_t)t * 64 + tid] = maskw[tid];
        }
        __syncthreads();
    }
}
__device__ __forceinline__ float lam_value(const Args& a) {
    float s1 = 0.f, s2 = 0.f;
    for (int i = 0; i < 64; ++i) { s1 = fmaf(a.in[I_LQ1][i], a.in[I_LK1][i], s1); s2 = fmaf(a.in[I_LQ2][i], a.in[I_LK2][i], s2); }
    return expf(s1) - expf(s2) + 0.2f;
}
__device__ __forceinline__ void naive_diffattn(const Args& a, unsigned char* lds) {
    bf16* P = (bf16*)(a.ws + WS_PROJ);
    const int tid = otid(), lane = tid & 63, wv = tid >> 6;
    float* lg = (float*)(lds + wv * 16384);
    float* qs = (float*)(lds + 131072 + wv * 512);
    const float lam = lam_value(a);
    const int gw = blockIdx.x * 8 + wv, NW = gridDim.x * 8;
    for (int it = gw; it < T * 4; it += NW) {
        const int t = it >> 2, h = it & 3, b = t >> 11, s = t & 2047, vis = ((s >> 6) + 1) << 6;
        const float sl = SLOPE_A[h] * LOG2E;
        { const bf16* qr = P + (size_t)t * NP + C_AQ + h * 128; qs[lane] = bf2f(qr[lane]); qs[lane + 64] = bf2f(qr[lane + 64]); }
        LDS_WAIT();
        float m0 = -1e30f, m1 = -1e30f;
        for (int k = lane; k < vis; k += 64) {
            asm volatile("" ::: "memory");
            const v4u* kr = (const v4u*)(P + (size_t)(b * SEQ + k) * NP + C_AK + h * 128); float d0 = 0.f, d1 = 0.f;
#pragma unroll
            for (int i = 0; i < 8; ++i) { const v4u v = kr[i]; const float* q = qs + 8 * i;
                d0 = fmaf(q[0], bflo(v.x), d0); d0 = fmaf(q[1], bfhi(v.x), d0); d0 = fmaf(q[2], bflo(v.y), d0); d0 = fmaf(q[3], bfhi(v.y), d0);
                d0 = fmaf(q[4], bflo(v.z), d0); d0 = fmaf(q[5], bfhi(v.z), d0); d0 = fmaf(q[6], bflo(v.w), d0); d0 = fmaf(q[7], bfhi(v.w), d0); }
#pragma unroll
            for (int i = 0; i < 8; ++i) { const v4u v = kr[8 + i]; const float* q = qs + 64 + 8 * i;
                d1 = fmaf(q[0], bflo(v.x), d1); d1 = fmaf(q[1], bfhi(v.x), d1); d1 = fmaf(q[2], bflo(v.y), d1); d1 = fmaf(q[3], bfhi(v.y), d1);
                d1 = fmaf(q[4], bflo(v.z), d1); d1 = fmaf(q[5], bfhi(v.z), d1); d1 = fmaf(q[6], bflo(v.w), d1); d1 = fmaf(q[7], bfhi(v.w), d1); }
            const float bias = sl * fabsf((float)(s - k));
            d0 -= bias; d1 -= bias; lg[k] = d0; lg[2048 + k] = d1; m0 = fmaxf(m0, d0); m1 = fmaxf(m1, d1);
        }
        m0 = wave_max(m0); m1 = wave_max(m1);
        float l0 = 0.f, l1 = 0.f;
        for (int k = lane; k < vis; k += 64) { const float p0 = exp2f(lg[k] - m0), p1 = exp2f(lg[2048 + k] - m1); lg[k] = p0; lg[2048 + k] = p1; l0 += p0; l1 += p1; }
        l0 = wave_sum(l0); l1 = wave_sum(l1);
        LDS_WAIT();
        float o00 = 0.f, o01 = 0.f, o10 = 0.f, o11 = 0.f;
        const bf16* vb = P + (size_t)(b * SEQ) * NP + C_AV + h * 128 + lane;
        for (int k = 0; k < vis; ++k) { const float v0 = bf2f(vb[(size_t)k * NP]), v1 = bf2f(vb[(size_t)k * NP + 64]); const float p0 = lg[k], p1 = lg[2048 + k];
            o00 = fmaf(p0, v0, o00); o01 = fmaf(p0, v1, o01); o10 = fmaf(p1, v0, o10); o11 = fmaf(p1, v1, o11); }
        const float r0 = 1.f / l0, r1 = lam / l1;
        const float y0 = o00 * r0 - o10 * r1, y1 = o01 * r0 - o11 * r1;
        const float ss = wave_sum(y0 * y0 + y1 * y1); const float rn = 0.8f / sqrtf(ss * (1.f / 128.f) + RMS_EPS);
        bf16* yo = P + (size_t)t * NP + C_AQ + h * 128;
        yo[lane] = (bf16)f2bf(y0 * rn * a.in[I_SUBLN][lane]); yo[lane + 64] = (bf16)f2bf(y1 * rn * a.in[I_SUBLN][lane + 64]);
        LDS_WAIT();
    }
}
__device__ __forceinline__ void naive_battn(const Args& a, unsigned char* lds) {
    bf16* P = (bf16*)(a.ws + WS_PROJ); const bf16* KV = (const bf16*)(a.ws + WS_KV); const unsigned* MASK = (const unsigned*)(a.ws + WS_MASK);
    const int tid = otid(), lane = tid & 63, wv = tid >> 6;
    float* lg = (float*)(lds + wv * 16384); float* qs = (float*)(lds + 131072 + wv * 512);
    const int gw = blockIdx.x * 8 + wv, NW = gridDim.x * 8;
    for (int it = gw; it < T * 8; it += NW) {
        const int t = it >> 3, h = it & 7, b = t >> 11, s = t & 2047, vis = ((s >> 6) + 1) << 6;
        const float sl = SLOPE_B[h] * LOG2E;
        qs[lane] = bf2f(P[(size_t)t * NP + C_BQ + h * 64 + lane]);
        LDS_WAIT();
        float m0 = -1e30f;
        for (int k = lane; k < vis; k += 64) {
            const unsigned mw = MASK[(size_t)t * 64 + (k >> 5)]; float d0 = -INFINITY;
            asm volatile("" ::: "memory");
            if ((mw >> (k & 31)) & 1u) {
                const v4u* kr = (const v4u*)(KV + (size_t)(b * SEQ + k) * 1024 + h * 64); d0 = 0.f;
#pragma unroll
                for (int i = 0; i < 8; ++i) { const v4u v = kr[i]; const float* q = qs + 8 * i;
                    d0 = fmaf(q[0], bflo(v.x), d0); d0 = fmaf(q[1], bfhi(v.x), d0); d0 = fmaf(q[2], bflo(v.y), d0); d0 = fmaf(q[3], bfhi(v.y), d0);
                    d0 = fmaf(q[4], bflo(v.z), d0); d0 = fmaf(q[5], bfhi(v.z), d0); d0 = fmaf(q[6], bflo(v.w), d0); d0 = fmaf(q[7], bfhi(v.w), d0); }
                d0 -= sl * fabsf((float)(s - k));
            }
            lg[k] = d0; m0 = fmaxf(m0, d0);
        }
        m0 = wave_max(m0);
        float l0 = 0.f;
        for (int k = lane; k < vis; k += 64) { const float p0 = exp2f(lg[k] - m0); lg[k] = p0; l0 += p0; }
        l0 = wave_sum(l0);
        LDS_WAIT();
        float o = 0.f; const bf16* vb = KV + (size_t)(b * SEQ) * 1024 + 512 + h * 64 + lane;
        for (int k = 0; k < vis; ++k) o = fmaf(lg[k], bf2f(vb[(size_t)k * 1024]), o);
        P[(size_t)t * NP + C_BQ + h * 64 + lane] = (bf16)f2bf(o / l0);
        LDS_WAIT();
    }
}
struct Route { int bucket; float wi, wj; int pad; };
__device__ __forceinline__ void p7_ln_route(const Args& a, unsigned char* lds) {
    unsigned char* ws = a.ws; const int tid = otid(), lane = tid & 63, wv = tid >> 6, blk = blockIdx.x;
    float* rw = (float*)lds; int* cnt = (int*)(lds + 81920);
    const float* RW = (const float*)(ws + WS_RW); const float* MOD = (const float*)(ws + WS_MOD);
    bf16* U2 = (bf16*)(ws + WS_U2); Route* RT = (Route*)(ws + WS_ROUTE2); int* PERM = (int*)(ws + WS_ROUTE2 + 512 * 1024); int* CNT = (int*)(ws + WS_ROUTE2 + 1024 * 1024);
    for (int i = tid; i < 20 * 1024 / 4; i += 512) ((f32x4*)rw)[i] = ((const f32x4*)RW)[i];
    if (tid < 24) cnt[tid] = 0;
    for (int i = blk * 512 + tid; i < MAXSLOT; i += gridDim.x * 512) PERM[i] = -1;
    __syncthreads();
    const int b = blk >> 4;
    const float* sh2 = MOD + b * 6144 + 3072; const float* sc2 = MOD + b * 6144 + 4096;
    for (int i = 0; i < 16; ++i) {
        const int t = blk * 128 + wv * 16 + i; float* row = a.out + (size_t)t * 1024;
        f32x4 v[4]; float sm = 0.f;
#pragma unroll
        for (int j = 0; j < 4; ++j) { v[j] = *(const f32x4*)(row + j * 256 + lane * 4); sm += (v[j].x + v[j].y) + (v[j].z + v[j].w); }
        const float mean = wave_sum(sm) * (1.f / 1024.f); float sq = 0.f;
#pragma unroll
        for (int j = 0; j < 4; ++j) { v[j] = v[j] - mean; sq += (v[j].x * v[j].x + v[j].y * v[j].y) + (v[j].z * v[j].z + v[j].w * v[j].w); }
        const float rstd = 1.f / sqrtf(wave_sum(sq) * (1.f / 1024.f) + LN_EPS);
        f32x4 u[4];
#pragma unroll
        for (int j = 0; j < 4; ++j) { const int c = j * 256 + lane * 4; const f32x4 g = *(const f32x4*)(a.in[I_LN1G] + c), bb = *(const f32x4*)(a.in[I_LN1B] + c);
            const f32x4 x1 = v[j] * rstd * g + bb; *(f32x4*)(row + c) = x1;
            const f32x4 s2 = *(const f32x4*)(sc2 + c), h2 = *(const f32x4*)(sh2 + c); u[j] = x1 * (1.f + s2) + h2;
            v2u o; o.x = pk2(u[j].x, u[j].y); o.y = pk2(u[j].z, u[j].w); *(v2u*)(U2 + (size_t)t * 1024 + c) = o; }
        float lgt[20];
#pragma unroll
        for (int c = 0; c < 20; ++c) { float p = 0.f;
#pragma unroll
            for (int j = 0; j < 4; ++j) { const f32x4 w = *(const f32x4*)(rw + c * 1024 + j * 256 + lane * 4); p += (u[j].x * w.x + u[j].y * w.y) + (u[j].z * w.z + u[j].w * w.w); }
            lgt[c] = wave_sum(p); }
#pragma unroll
        for (int c = 0; c < 4; ++c) lgt[c] += a.in[I_BGRP][c];
#pragma unroll
        for (int c = 0; c < 16; ++c) lgt[4 + c] += a.in[I_BER][c];
        int g = 0; float gm = lgt[0];
#pragma unroll
        for (int c = 1; c < 4; ++c) if (lgt[c] > gm) { gm = lgt[c]; g = c; }
        float gs = 0.f;
#pragma unroll
        for (int c = 0; c < 4; ++c) gs += __expf(lgt[c] - gm);
        const float gp = 1.f / gs;
        float el[4];
#pragma unroll
        for (int e = 0; e < 4; ++e) el[e] = g == 0 ? lgt[4 + e] : (g == 1 ? lgt[8 + e] : (g == 2 ? lgt[12 + e] : lgt[16 + e]));
        int i1 = 0; float v1 = el[0];
#pragma unroll
        for (int e = 1; e < 4; ++e) if (el[e] > v1) { v1 = el[e]; i1 = e; }
        int i2 = -1; float v2 = -INFINITY;
#pragma unroll
        for (int e = 0; e < 4; ++e) if (e != i1 && el[e] > v2) { v2 = el[e]; i2 = e; }
        const float e2 = __expf(v2 - v1); const float w1 = gp / (1.f + e2), w2 = gp * e2 / (1.f + e2);
        const int lo = i1 < i2 ? i1 : i2, hi = i1 < i2 ? i2 : i1; const float wlo = i1 < i2 ? w1 : w2, whi = i1 < i2 ? w2 : w1;
        const int pi = lo == 0 ? hi - 1 : (lo == 1 ? hi + 1 : 5);
        const int bucket = g * 6 + pi;
        if (lane == 0) { Route r; r.bucket = bucket; r.wi = wlo; r.wj = whi; r.pad = 0; RT[t] = r; atomicAdd(&cnt[bucket], 1); }
    }
    __syncthreads();
    if (tid < 24) CNT[blk * 24 + tid] = cnt[tid];
    __syncthreads();
}
__device__ __forceinline__ void p8_sort(const Args& a, unsigned char* lds) {
    unsigned char* ws = a.ws; const int tid = otid(), blk = blockIdx.x;
    const Route* RT = (const Route*)(ws + WS_ROUTE2); int* PERM = (int*)(ws + WS_ROUTE2 + 512 * 1024); const int* CNT = (const int*)(ws + WS_ROUTE2 + 1024 * 1024);
    int* BASES = (int*)(ws + WS_ROUTE2 + 1024 * 1024 + 32768); float* SLOTW = (float*)(ws + WS_ROUTE2 + 1280 * 1024);
    const bf16* U2 = (const bf16*)(ws + WS_U2); bf16* XS = (bf16*)(ws + WS_XS);
    int* tot = (int*)lds; int* pre = tot + 32; int* base = pre + 32; int* bk = base + 32; int* slot = bk + 128;
    if (tid < 24) { int s = 0, p = 0; for (int bb = 0; bb < (int)gridDim.x; ++bb) { const int c = CNT[bb * 24 + tid]; if (bb < blk) p += c; s += c; } tot[tid] = s; pre[tid] = p; }
    __syncthreads();
    if (tid == 0) { int acc = 0; for (int p = 0; p < 24; ++p) { base[p] = acc; acc += (tot[p] + 255) & ~255; } base[24] = acc;
        if (blk == 0) { for (int p = 0; p <= 24; ++p) BASES[p] = base[p]; } }
    if (tid < 128) bk[tid] = RT[blk * 128 + tid].bucket;
    __syncthreads();
    if (tid < 128) { const int p = bk[tid]; int r = 0; for (int j = 0; j < tid; ++j) r += bk[j] == p ? 1 : 0; const int s = base[p] + pre[p] + r; slot[tid] = s;
        const int t = blk * 128 + tid; PERM[s] = t; SLOTW[2 * s] = RT[t].wi; SLOTW[2 * s + 1] = RT[t].wj; }
    __syncthreads();
    for (int i = tid; i < 128 * 128; i += 512) { const int r = i >> 7, c = i & 127; ((v4u*)(XS + (size_t)slot[r] * 1024))[c] = ((const v4u*)(U2 + (size_t)(blk * 128 + r) * 1024))[c]; }
    __syncthreads();
}
__device__ __forceinline__ int bucket_of_slot(const int* BASES, int s) { int p = 0; for (int q = 1; q < 24; ++q) if (s >= BASES[q]) p = q; return p; }
__device__ __forceinline__ void pair_experts(int p, int& ei, int& ej) { const int g = p / 6, pi = p % 6; ei = 4 * g + (pi < 3 ? 0 : (pi < 5 ? 1 : 2)); ej = 4 * g + (pi < 3 ? pi + 1 : (pi < 5 ? pi - 1 : 3)); }
__device__ __forceinline__ void naive_moe1(const Args& a, unsigned char* lds) {
    unsigned char* ws = a.ws; const int tid = otid();
    const int* PERM = (const int*)(ws + WS_ROUTE2 + 512 * 1024); const int* BASES = (const int*)(ws + WS_ROUTE2 + 1024 * 1024 + 32768); const float* SLOTW = (const float*)(ws + WS_ROUTE2 + 1280 * 1024);
    const bf16* XS = (const bf16*)(ws + WS_XS); const bf16* W1 = (const bf16*)(ws + WS_W1); bf16* H = (bf16*)(ws + WS_H);
    float* xs = (float*)lds; const int nslot = BASES[24];
    for (int s = blockIdx.x; s < nslot; s += gridDim.x) {
        if (PERM[s] < 0) continue;
        const int p = bucket_of_slot(BASES, s); int ei, ej; pair_experts(p, ei, ej);
        __syncthreads();
        xs[tid] = bf2f(XS[(size_t)s * 1024 + tid]); xs[tid + 512] = bf2f(XS[(size_t)s * 1024 + 512 + tid]);
        __syncthreads();
        const int m = tid >> 8, c = tid & 255, e = m ? ej : ei; const int grow = (c >> 7) * 256 + (c & 127);
        const v4u* wg = (const v4u*)(W1 + ((size_t)e * 512 + grow) * 1024); const v4u* wu = (const v4u*)(W1 + ((size_t)e * 512 + grow + 128) * 1024);
        float dg = 0.f, du = 0.f;
        for (int i = 0; i < 128; ++i) { const v4u g = wg[i], u = wu[i]; const float* x = xs + 8 * i;
            dg = fmaf(x[0], bflo(g.x), dg); dg = fmaf(x[1], bfhi(g.x), dg); dg = fmaf(x[2], bflo(g.y), dg); dg = fmaf(x[3], bfhi(g.y), dg);
            dg = fmaf(x[4], bflo(g.z), dg); dg = fmaf(x[5], bfhi(g.z), dg); dg = fmaf(x[6], bflo(g.w), dg); dg = fmaf(x[7], bfhi(g.w), dg);
            du = fmaf(x[0], bflo(u.x), du); du = fmaf(x[1], bfhi(u.x), du); du = fmaf(x[2], bflo(u.y), du); du = fmaf(x[3], bfhi(u.y), du);
            du = fmaf(x[4], bflo(u.z), du); du = fmaf(x[5], bfhi(u.z), du); du = fmaf(x[6], bflo(u.w), du); du = fmaf(x[7], bfhi(u.w), du); }
        const float hv = dg / (1.f + __expf(-dg)) * du * SLOTW[2 * s + m];
        H[(size_t)s * 512 + tid] = (bf16)f2bf(hv);
    }
    __syncthreads();
}
__device__ __forceinline__ void naive_moe2(const Args& a, unsigned char* lds) {
    unsigned char* ws = a.ws; const int tid = otid();
    const int* PERM = (const int*)(ws + WS_ROUTE2 + 512 * 1024); const int* BASES = (const int*)(ws + WS_ROUTE2 + 1024 * 1024 + 32768);
    const bf16* W2P = (const bf16*)(ws + WS_W2P); const bf16* H = (const bf16*)(ws + WS_H); const float* MOD = (const float*)(ws + WS_MOD);
    float* hs = (float*)lds; const int nslot = BASES[24];
    for (int s = blockIdx.x; s < nslot; s += gridDim.x) {
        const int t = PERM[s]; if (t < 0) continue;
        const int p = bucket_of_slot(BASES, s);
        __syncthreads();
        hs[tid] = bf2f(H[(size_t)s * 512 + tid]);
        __syncthreads();
        for (int j = tid; j < 1024; j += 512) {
            const v4u* w = (const v4u*)(W2P + ((size_t)p * 1024 + j) * 512); float y = 0.f;
            for (int i = 0; i < 64; ++i) { const v4u g = w[i]; const float* x = hs + 8 * i;
                y = fmaf(x[0], bflo(g.x), y); y = fmaf(x[1], bfhi(g.x), y); y = fmaf(x[2], bflo(g.y), y); y = fmaf(x[3], bfhi(g.y), y);
                y = fmaf(x[4], bflo(g.z), y); y = fmaf(x[5], bfhi(g.z), y); y = fmaf(x[6], bflo(g.w), y); y = fmaf(x[7], bfhi(g.w), y); }
            const size_t o = (size_t)t * 1024 + j; a.out[o] = ALPHA * a.out[o] + MOD[(t >> 11) * 6144 + 5120 + j] * y;
        }
    }
    __syncthreads();
}
__device__ __forceinline__ void p11_ln(const Args& a) {
    const int tid = otid(); const int lane = tid & 63, gw = blockIdx.x * 8 + (tid >> 6), NW = gridDim.x * 8;
    for (int t = gw; t < T; t += NW) {
        float* row = a.out + (size_t)t * 1024; f32x4 v[4]; float sm = 0.f;
#pragma unroll
        for (int j = 0; j < 4; ++j) { v[j] = *(const f32x4*)(row + j * 256 + lane * 4); sm += (v[j].x + v[j].y) + (v[j].z + v[j].w); }
        const float mean = wave_sum(sm) * (1.f / 1024.f); float sq = 0.f;
#pragma unroll
        for (int j = 0; j < 4; ++j) { v[j] = v[j] - mean; sq += (v[j].x * v[j].x + v[j].y * v[j].y) + (v[j].z * v[j].z + v[j].w * v[j].w); }
        const float rstd = 1.f / sqrtf(wave_sum(sq) * (1.f / 1024.f) + LN_EPS);
#pragma unroll
        for (int j = 0; j < 4; ++j) { const int c = j * 256 + lane * 4; const f32x4 g = *(const f32x4*)(a.in[I_LN2G] + c), bb = *(const f32x4*)(a.in[I_LN2B] + c); *(f32x4*)(row + c) = v[j] * rstd * g + bb; }
    }
}

namespace pg8 {
#define PG8_LAS __attribute__((address_space(3)))
typedef unsigned short bf16_t;
typedef short bf16x8 __attribute__((ext_vector_type(8)));
typedef float f32x4 __attribute__((ext_vector_type(4)));
typedef unsigned u32x4 __attribute__((ext_vector_type(4)));
constexpr int BM = 256, BK = 64, HALF = 128, HTB = HALF * BK * 2  , STAGE_BYTES = 8 * HTB, NXCD = 8, WGM = 8;

__host__ __device__ __forceinline__ int lds_byte(int r, int c) { const int st = (r >> 4) * 2 + (c >> 5), rr = r & 15, cc = c & 31, ob = rr * 64 + cc * 2; return st * 1024 + (ob ^ (((ob >> 9) & 1) << 5)); }
__host__ __device__ __forceinline__ void stage_rc(int b, int& R, int& C) { const int st = b / 1024, sb = b % 1024, swz = sb ^ (((sb >> 9) & 1) << 5); R = (st >> 1) * 16 + swz / 64; C = (st & 1) * 32 + (swz % 64) / 2; }
__host__ __device__ __forceinline__ int perm32(int rho) { const int n = rho >> 4, i = rho & 15; return 8 * (i >> 2) + 4 * n + (i & 3); }

struct Unit { int pm, pn; };
struct Gemm { const bf16_t* A; const bf16_t* Bt; int M, N, K, lda, ldb; };

struct StaticOrder {
    int nM, nN, nwg, G, c;
    __host__ __device__ void init(int M, int N, int G_, int c_) { nM = M / BM; nN = N / BM; nwg = nM * nN; G = G_; c = c_; }
    __host__ __device__ bool next(int i, Unit& u) const {
        const long L = (long)i * G + c; if (L >= nwg) return false;
        int wgid = (int)L; { const int q = nwg / NXCD, r = nwg % NXCD, xcd = wgid % NXCD, off = wgid / NXCD; wgid = (xcd < r ? xcd * (q + 1) : r * (q + 1) + (xcd - r) * q) + off; }
        const int nig = WGM * nN, gid = wgid / nig, fm = gid * WGM, gsz = (nM - fm) < WGM ? (nM - fm) : WGM;
        u.pm = fm + ((wgid % nig) % gsz); u.pn = (wgid % nig) / gsz; return true;
    }
    __device__ __forceinline__ void a_ready(const Unit&) const {}
    __device__ __forceinline__ void done(const Unit&) const {}
    __device__ __forceinline__ const char* bbase(const Gemm& g, const Unit& u) const { return (const char*)g.Bt + (size_t)u.pn * ((size_t)BM * g.ldb * 2); }
};

template <class Epi, class Sched, bool ALIGN_EPI, bool SP2, int KK, int LDA, int LDB>
__device__ __forceinline__ void gemm_phase(PG8_LAS unsigned char* lds, const Gemm g, const Sched& S, const Epi& E) {
    int tid_ = threadIdx.x; asm volatile("" : "+v"(tid_));
    const int tid = tid_, wid = __builtin_amdgcn_readfirstlane(tid >> 6), lane = tid & 63, wr = wid >> 2, wc = wid & 3, fr = lane & 15, fq = lane >> 4;
    constexpr int K = KK, nt = K / BK;
    unsigned voffA[2], voffB[2];
#pragma unroll
    for (int i = 0; i < 2; ++i) { int R, C; stage_rc(tid * 16 + i * 8192, R, C); const int Rb = Epi::PERM ? ((R & ~31) + perm32(R & 31)) : R;
        voffA[i] = (unsigned)(R * LDA + C) * 2u; voffB[i] = (unsigned)(Rb * LDB + C) * 2u; }
    constexpr size_t kstep = (size_t)(BK * 2);
    constexpr size_t hstepA = (size_t)HALF * LDA * 2, hstepB = (size_t)HALF * LDB * 2;
    constexpr size_t tstepA = 2 * hstepA;
    const unsigned ldsw = (unsigned)wid * 1024u;
    const int aoff = lds_byte(wr * 64 + fr, fq * 8), boff = lds_byte(wc * 32 + fr, fq * 8);
#define PG8_SA(b, h) (((b) * 2 + (h)) * HTB)
#define PG8_SB(b, h) ((4 + (b) * 2 + (h)) * HTB)
#define PG8_STAGE(bufoff, gbase, voff) do { _Pragma("unroll") for (int _i = 0; _i < 2; ++_i) \
        __builtin_amdgcn_global_load_lds((const unsigned*)((const char*)(gbase) + (voff)[_i]), (PG8_LAS unsigned*)(lds + (bufoff) + ldsw + _i * 8192), 16, 0, 0); } while (0)
#define PG8_LDA(dst, b, h) do { _Pragma("unroll") for (int m = 0; m < 4; ++m) _Pragma("unroll") for (int k = 0; k < 2; ++k) dst[m][k] = *(const PG8_LAS bf16x8*)(lds + PG8_SA(b, h) + aoff + m * 2048 + k * 1024); } while (0)
#define PG8_LDB(dst, b, h) do { _Pragma("unroll") for (int n = 0; n < 2; ++n) _Pragma("unroll") for (int k = 0; k < 2; ++k) dst[n][k] = *(const PG8_LAS bf16x8*)(lds + PG8_SB(b, h) + boff + n * 2048 + k * 1024); } while (0)
#define PG8_MMA(ai, bj, At, Bt) do { __builtin_amdgcn_s_setprio(1); _Pragma("unroll") for (int m = 0; m < 4; ++m) _Pragma("unroll") for (int n = 0; n < 2; ++n) _Pragma("unroll") for (int k = 0; k < 2; ++k) \
        acc[ai][bj][m][n] = __builtin_amdgcn_mfma_f32_16x16x32_bf16(Bt[n][k], At[m][k], acc[ai][bj][m][n], 0, 0, 0); __builtin_amdgcn_s_setprio(0); } while (0)
#define PG8_WAIT_V(n) asm volatile("s_waitcnt vmcnt(" #n ")" ::: "memory")
#define PG8_WAIT_L(n) asm volatile("s_waitcnt lgkmcnt(" #n ")" ::: "memory")
#define PG8_BAR __builtin_amdgcn_s_barrier()
#define PG8_SCHED __builtin_amdgcn_sched_barrier(0)
    Unit cur, nxt; int ui = 0;
    if (!S.next(0, cur)) return;
    f32x4 acc[2][2][4][2];
#pragma unroll
    for (int a = 0; a < 2; ++a)
#pragma unroll
        for (int b = 0; b < 2; ++b)
#pragma unroll
            for (int m = 0; m < 4; ++m)
#pragma unroll
                for (int n = 0; n < 2; ++n) acc[a][b][m][n] = (f32x4){0.f, 0.f, 0.f, 0.f};
    bf16x8 At[4][2], B0[2][2], B1[2][2];
    const char* cA = (const char*)g.A + (size_t)cur.pm * tstepA; const char* cB = S.bbase(g, cur);
    S.a_ready(cur);
    if constexpr (SP2) {
        PG8_STAGE(PG8_SB(0, 0), cB, voffB); PG8_STAGE(PG8_SB(0, 1), cB + hstepB, voffB); PG8_STAGE(PG8_SA(0, 0), cA, voffA); PG8_STAGE(PG8_SA(0, 1), cA + hstepA, voffA);
        if (wr == 1) PG8_BAR;
        PG8_WAIT_V(2); PG8_BAR;
        PG8_STAGE(PG8_SB(1, 0), cB + kstep, voffB); PG8_STAGE(PG8_SA(1, 0), cA + kstep, voffA); PG8_STAGE(PG8_SB(1, 1), cB + hstepB + kstep, voffB);
        PG8_WAIT_V(6); PG8_BAR;
    } else {
        PG8_STAGE(PG8_SB(0, 0), cB, voffB); PG8_STAGE(PG8_SA(0, 0), cA, voffA); PG8_STAGE(PG8_SB(0, 1), cB + hstepB, voffB); PG8_STAGE(PG8_SA(0, 1), cA + hstepA, voffA);
        if (wr == 1) PG8_BAR;
        PG8_WAIT_V(4); PG8_BAR;
        PG8_STAGE(PG8_SB(1, 0), cB + kstep, voffB); PG8_STAGE(PG8_SA(1, 0), cA + kstep, voffA); PG8_STAGE(PG8_SB(1, 1), cB + hstepB + kstep, voffB);
        PG8_WAIT_V(6); PG8_BAR;
    }
    for (;;) {
        const bool has_next = S.next(ui + 1, nxt);
        const char* nA = has_next ? (const char*)g.A + (size_t)nxt.pm * tstepA : cA; const char* nB = has_next ? S.bbase(g, nxt) : cB;
        for (int t = 0; t < nt; t += 2) {
            const bool last = (t == nt - 2);
            const char* a1 = cA + (size_t)(t + 1) * kstep;
            const char* a2 = last ? nA : cA + (size_t)(t + 2) * kstep; const char* b2 = last ? nB : cB + (size_t)(t + 2) * kstep;
            const char* a3 = a2 + kstep; const char* b3 = b2 + kstep;
            if (last && has_next) S.a_ready(nxt);
            if constexpr (SP2) {
            PG8_LDB(B0, 0, 0); PG8_LDB(B1, 0, 1); PG8_SCHED; PG8_LDA(At, 0, 0); PG8_STAGE(PG8_SA(1, 1), a1 + hstepA, voffA);
            PG8_WAIT_V(8); PG8_WAIT_L(0); PG8_BAR; PG8_MMA(0, 0, At, B0); PG8_MMA(0, 1, At, B1); PG8_BAR; PG8_SCHED;
            PG8_LDA(At, 0, 1); PG8_STAGE(PG8_SB(0, 0), b2, voffB); PG8_STAGE(PG8_SB(0, 1), b2 + hstepB, voffB); PG8_STAGE(PG8_SA(0, 0), a2, voffA);
            PG8_WAIT_V(8); PG8_WAIT_L(0); PG8_BAR; PG8_MMA(1, 0, At, B0); PG8_MMA(1, 1, At, B1); PG8_BAR; PG8_SCHED;
            PG8_LDB(B0, 1, 0); PG8_LDB(B1, 1, 1); PG8_SCHED; PG8_LDA(At, 1, 0); PG8_STAGE(PG8_SA(0, 1), a2 + hstepA, voffA);
            PG8_WAIT_V(8); PG8_WAIT_L(0); PG8_BAR; PG8_MMA(0, 0, At, B0); PG8_MMA(0, 1, At, B1); PG8_BAR; PG8_SCHED;
            PG8_LDA(At, 1, 1); PG8_STAGE(PG8_SB(1, 0), b3, voffB); PG8_STAGE(PG8_SB(1, 1), b3 + hstepB, voffB); PG8_STAGE(PG8_SA(1, 0), a3, voffA);
            PG8_WAIT_V(8); PG8_WAIT_L(0); PG8_BAR; PG8_MMA(1, 0, At, B0); PG8_MMA(1, 1, At, B1); PG8_BAR; PG8_SCHED;
            } else {
            PG8_LDB(B0, 0, 0); PG8_SCHED; PG8_LDA(At, 0, 0); PG8_STAGE(PG8_SA(1, 1), a1 + hstepA, voffA);
            PG8_WAIT_L(8); PG8_BAR; PG8_WAIT_L(0); PG8_MMA(0, 0, At, B0); PG8_BAR; PG8_SCHED;
            PG8_LDB(B1, 0, 1); PG8_STAGE(PG8_SB(0, 0), b2, voffB);
            PG8_BAR; PG8_WAIT_L(0); PG8_MMA(0, 1, At, B1); PG8_BAR;
            PG8_LDA(At, 0, 1); PG8_STAGE(PG8_SA(0, 0), a2, voffA);
            PG8_BAR; PG8_WAIT_L(0); PG8_MMA(1, 0, At, B0); PG8_BAR; PG8_SCHED;
            PG8_STAGE(PG8_SB(0, 1), b2 + hstepB, voffB);
            PG8_WAIT_V(6); PG8_BAR; PG8_MMA(1, 1, At, B1); PG8_BAR;
            PG8_LDB(B0, 1, 0); PG8_SCHED; PG8_LDA(At, 1, 0); PG8_STAGE(PG8_SA(0, 1), a2 + hstepA, voffA);
            PG8_WAIT_L(8); PG8_BAR; PG8_WAIT_L(0); PG8_MMA(0, 0, At, B0); PG8_BAR; PG8_SCHED;
            PG8_LDB(B1, 1, 1); PG8_STAGE(PG8_SB(1, 0), b3, voffB);
            PG8_BAR; PG8_WAIT_L(0); PG8_MMA(0, 1, At, B1); PG8_BAR;
            PG8_LDA(At, 1, 1); PG8_STAGE(PG8_SA(1, 0), a3, voffA);
            PG8_BAR; PG8_WAIT_L(0); PG8_MMA(1, 0, At, B0); PG8_BAR; PG8_SCHED;
            PG8_STAGE(PG8_SB(1, 1), b3 + hstepB, voffB);
            PG8_WAIT_V(6); PG8_BAR; PG8_MMA(1, 1, At, B1); PG8_BAR;
            }
        }
        if constexpr (ALIGN_EPI) { if (wr == 0) PG8_BAR; }
        if constexpr (!Epi::AFTER_DRAIN) { E(acc, cur, wr, wc, fr, fq); S.done(cur); }
        if (!has_next) break;
#pragma unroll
        for (int a = 0; a < 2; ++a)
#pragma unroll
            for (int b = 0; b < 2; ++b)
#pragma unroll
                for (int m = 0; m < 4; ++m)
#pragma unroll
                    for (int n = 0; n < 2; ++n) acc[a][b][m][n] = (f32x4){0.f, 0.f, 0.f, 0.f};
        cur = nxt; cA = nA; cB = nB; ++ui;
        if constexpr (ALIGN_EPI) { if (wr == 1) PG8_BAR; }
    }
    PG8_WAIT_V(0);
    if constexpr (!ALIGN_EPI) { if (wr == 0) PG8_BAR; }
    PG8_BAR;
    if constexpr (Epi::AFTER_DRAIN) { E.fused(acc, cur, wr, wc, fr, fq, lds, wid, lane); S.done(cur); }
#undef PG8_SA
#undef PG8_SB
#undef PG8_STAGE
#undef PG8_LDA
#undef PG8_LDB
#undef PG8_MMA
#undef PG8_WAIT_V
#undef PG8_WAIT_L
#undef PG8_BAR
#undef PG8_SCHED
}

__device__ __forceinline__ unsigned cvt_pk_bf16(float lo, float hi) { unsigned r; asm volatile("v_cvt_pk_bf16_f32 %0, %1, %2" : "=v"(r) : "v"(lo), "v"(hi)); return r; }
__device__ __forceinline__ float blo(unsigned w) { return __uint_as_float(w << 16); }
__device__ __forceinline__ float bhi(unsigned w) { return __uint_as_float(w & 0xffff0000u); }
__device__ __forceinline__ float sigm(float v) { return __builtin_amdgcn_rcpf(1.f + __builtin_amdgcn_exp2f(-1.4426950408889634f * v)); }
struct EpiProjF {
    static constexpr bool PERM = true, AFTER_DRAIN = false;
    bf16_t* O; int ldc; float qs;
    __device__ __forceinline__ void operator()(const f32x4 (&acc)[2][2][4][2], const Unit& u, int wr, int wc, int fr, int fq) const {
        const int row0 = u.pm * BM + wr * 64 + fr, col0 = u.pn * BM + wc * 32 + 8 * fq;
        const int mode = (u.pn < 2 || u.pn == 6 || u.pn == 7) ? 1 : (u.pn >= 11 ? 2 : 0);
#pragma unroll
        for (int ai = 0; ai < 2; ++ai)
#pragma unroll
            for (int m = 0; m < 4; ++m) { bf16_t* rowp = O + (size_t)(row0 + ai * HALF + m * 16) * ldc + col0;
#pragma unroll
                for (int bj = 0; bj < 2; ++bj) { f32x4 v0 = acc[ai][bj][m][0], v1 = acc[ai][bj][m][1];
                    if (mode == 1) { v0 = v0 * qs; v1 = v1 * qs; }
                    else if (mode == 2) { v0 = (f32x4){sigm(v0[0]), sigm(v0[1]), sigm(v0[2]), sigm(v0[3])}; v1 = (f32x4){sigm(v1[0]), sigm(v1[1]), sigm(v1[2]), sigm(v1[3])}; }
                    u32x4 w; w.x = cvt_pk_bf16(v0[0], v0[1]); w.y = cvt_pk_bf16(v0[2], v0[3]); w.z = cvt_pk_bf16(v1[0], v1[1]); w.w = cvt_pk_bf16(v1[2], v1[3]);
                    *(u32x4*)(rowp + bj * HALF) = w; } }
    }
};
struct EpiRowScale {
    static constexpr bool PERM = true, AFTER_DRAIN = false;
    bf16_t* O; int ldc; const float* rs;
    __device__ __forceinline__ void operator()(const f32x4 (&acc)[2][2][4][2], const Unit& u, int wr, int wc, int fr, int fq) const {
        const int row0 = u.pm * BM + wr * 64 + fr, col0 = u.pn * BM + wc * 32 + 8 * fq;
#pragma unroll
        for (int ai = 0; ai < 2; ++ai)
#pragma unroll
            for (int m = 0; m < 4; ++m) { const int r = row0 + ai * HALF + m * 16; const float s = rs[r]; bf16_t* rowp = O + (size_t)r * ldc + col0;
#pragma unroll
                for (int bj = 0; bj < 2; ++bj) { const f32x4 v0 = acc[ai][bj][m][0] * s, v1 = acc[ai][bj][m][1] * s;
                    u32x4 w; w.x = cvt_pk_bf16(v0[0], v0[1]); w.y = cvt_pk_bf16(v0[2], v0[3]); w.z = cvt_pk_bf16(v1[0], v1[1]); w.w = cvt_pk_bf16(v1[2], v1[3]);
                    *(u32x4*)(rowp + bj * HALF) = w; } }
    }
};
template <bool FIRST> struct EpiMix {
    static constexpr bool PERM = true, AFTER_DRAIN = false;
    bf16_t* O; int ldc; const bf16_t* G; int ldg;
    __device__ __forceinline__ void operator()(const f32x4 (&acc)[2][2][4][2], const Unit& u, int wr, int wc, int fr, int fq) const {
        const int row0 = u.pm * BM + wr * 64 + fr, col0 = u.pn * BM + wc * 32 + 8 * fq;
#pragma unroll
        for (int ai = 0; ai < 2; ++ai)
#pragma unroll
            for (int m = 0; m < 4; ++m) { const int r = row0 + ai * HALF + m * 16; bf16_t* rowp = O + (size_t)r * ldc + col0; const bf16_t* gp = G + (size_t)r * ldg + col0;
#pragma unroll
                for (int bj = 0; bj < 2; ++bj) { const u32x4 gw = *(const u32x4*)(gp + bj * HALF); f32x4 v0 = acc[ai][bj][m][0], v1 = acc[ai][bj][m][1];
                    v0 = v0 * (f32x4){blo(gw.x), bhi(gw.x), blo(gw.y), bhi(gw.y)}; v1 = v1 * (f32x4){blo(gw.z), bhi(gw.z), blo(gw.w), bhi(gw.w)};
                    if (!FIRST) { const u32x4 ow = *(const u32x4*)(rowp + bj * HALF); v0 = v0 + (f32x4){blo(ow.x), bhi(ow.x), blo(ow.y), bhi(ow.y)}; v1 = v1 + (f32x4){blo(ow.z), bhi(ow.z), blo(ow.w), bhi(ow.w)}; }
                    u32x4 w; w.x = cvt_pk_bf16(v0[0], v0[1]); w.y = cvt_pk_bf16(v0[2], v0[3]); w.z = cvt_pk_bf16(v1[0], v1[1]); w.w = cvt_pk_bf16(v1[2], v1[3]);
                    *(u32x4*)(rowp + bj * HALF) = w; } }
    }
};
struct EpiResGate {
    static constexpr bool PERM = false, AFTER_DRAIN = false;
    float* out; const float* x; const float* gate; int gstride; float alpha;
    __device__ __forceinline__ void operator()(const f32x4 (&acc)[2][2][4][2], const Unit& u, int wr, int wc, int fr, int fq) const {
        const int col0 = u.pn * BM + wc * 32 + 4 * fq; const float* gb = gate + (size_t)((u.pm * BM) >> 11) * gstride + col0;
        f32x4 gv[2][2];
#pragma unroll
        for (int bj = 0; bj < 2; ++bj)
#pragma unroll
            for (int n = 0; n < 2; ++n) gv[bj][n] = *(const f32x4*)(gb + bj * HALF + n * 16);
#pragma unroll
        for (int ai = 0; ai < 2; ++ai)
#pragma unroll
            for (int m = 0; m < 4; ++m) { const size_t off = (size_t)(u.pm * BM + ai * HALF + wr * 64 + m * 16 + fr) * 1024 + col0;
#pragma unroll
                for (int bj = 0; bj < 2; ++bj)
#pragma unroll
                    for (int n = 0; n < 2; ++n) { const f32x4 xv = *(const f32x4*)(x + off + bj * HALF + n * 16); *(f32x4*)(out + off + bj * HALF + n * 16) = xv * alpha + gv[bj][n] * acc[ai][bj][m][n]; } }
    }
};
__device__ __forceinline__ int tile_bucket(const int* BASES, int pm) { const int s = pm * BM; int p = 0;
#pragma unroll
    for (int q = 1; q < 24; ++q) p = (s >= BASES[q]) ? q : p;
    return p; }
struct MoeOrder1 {
    StaticOrder so; const int* BASES; const bf16_t* W1;
    __device__ __forceinline__ bool next(int i, Unit& u) const { return so.next(i, u); }
    __device__ __forceinline__ void a_ready(const Unit&) const {}
    __device__ __forceinline__ void done(const Unit&) const {}
    __device__ __forceinline__ const char* bbase(const Gemm&, const Unit& u) const {
        const int p = tile_bucket(BASES, u.pm), g = p / 6, pi = p % 6;
        const int ei = 4 * g + (pi < 3 ? 0 : (pi < 5 ? 1 : 2)), ej = 4 * g + (pi < 3 ? pi + 1 : (pi < 5 ? pi - 1 : 3));
        const int e = u.pn < 2 ? ei : ej;
        return (const char*)(W1 + ((size_t)e * 512 + (size_t)(u.pn & 1) * 256) * 1024); }
};
struct MoeOrder2 {
    StaticOrder so; const int* BASES; const bf16_t* W2P;
    __device__ __forceinline__ bool next(int i, Unit& u) const { return so.next(i, u); }
    __device__ __forceinline__ void a_ready(const Unit&) const {}
    __device__ __forceinline__ void done(const Unit&) const {}
    __device__ __forceinline__ const char* bbase(const Gemm&, const Unit& u) const {
        const int p = tile_bucket(BASES, u.pm); return (const char*)(W2P + ((size_t)p * 1024 + (size_t)u.pn * 256) * 512); }
};
struct EpiMoe1 {
    static constexpr bool PERM = true, AFTER_DRAIN = false;
    bf16_t* H; const float* SLOTW;
    __device__ __forceinline__ void operator()(const f32x4 (&acc)[2][2][4][2], const Unit& u, int wr, int wc, int fr, int fq) const {
        const int row0 = u.pm * BM + wr * 64 + fr, col0 = (u.pn >> 1) * 256 + (u.pn & 1) * 128 + wc * 32 + 8 * fq, wsel = u.pn >> 1;
#pragma unroll
        for (int ai = 0; ai < 2; ++ai)
#pragma unroll
            for (int m = 0; m < 4; ++m) { const int r = row0 + ai * HALF + m * 16; const float w = SLOTW[2 * r + wsel];
                float o[8];
#pragma unroll
                for (int n = 0; n < 2; ++n)
#pragma unroll
                    for (int i = 0; i < 4; ++i) { const float g = acc[ai][0][m][n][i], up = acc[ai][1][m][n][i]; o[4 * n + i] = g * sigm(g) * up * w; }
                u32x4 wv; wv.x = cvt_pk_bf16(o[0], o[1]); wv.y = cvt_pk_bf16(o[2], o[3]); wv.z = cvt_pk_bf16(o[4], o[5]); wv.w = cvt_pk_bf16(o[6], o[7]);
                *(u32x4*)(H + (size_t)r * 512 + col0) = wv; }
    }
};
struct EpiMoe2 {
    static constexpr bool PERM = false, AFTER_DRAIN = false;
    float* out; const int* PERMV; const float* gate; int gstride; float alpha;
    __device__ __forceinline__ void operator()(const f32x4 (&acc)[2][2][4][2], const Unit& u, int wr, int wc, int fr, int fq) const {
        const int col0 = u.pn * BM + wc * 32 + 4 * fq;
#pragma unroll
        for (int ai = 0; ai < 2; ++ai)
#pragma unroll
            for (int m = 0; m < 4; ++m) { const int t = PERMV[u.pm * BM + ai * HALF + wr * 64 + m * 16 + fr];
                if (t >= 0) { const size_t off = (size_t)t * 1024 + col0; const float* gb = gate + (size_t)(t >> 11) * gstride + col0;
#pragma unroll
                    for (int bj = 0; bj < 2; ++bj)
#pragma unroll
                        for (int n = 0; n < 2; ++n) { const f32x4 xv = *(const f32x4*)(out + off + bj * HALF + n * 16); const f32x4 gv = *(const f32x4*)(gb + bj * HALF + n * 16);
                            *(f32x4*)(out + off + bj * HALF + n * 16) = xv * alpha + gv * acc[ai][bj][m][n]; } } }
    }
};
}


namespace att {
typedef short bf16x8 __attribute__((ext_vector_type(8)));
typedef short s16x4 __attribute__((ext_vector_type(4)));
typedef short v4i16_t __attribute__((ext_vector_type(4)));
typedef float f32x16 __attribute__((ext_vector_type(16)));
typedef unsigned u32x4 __attribute__((ext_vector_type(4)));
typedef float f32x2_t __attribute__((ext_vector_type(2))); typedef __bf16 bf16x2_t __attribute__((ext_vector_type(2)));
typedef LAS const char* lds_cptr;
constexpr float THR = 8.f;
__device__ __forceinline__ unsigned cvtpk(float lo, float hi) { f32x2_t v = {lo, hi}; bf16x2_t b = __builtin_convertvector(v, bf16x2_t); return __builtin_bit_cast(unsigned, b); }
__device__ __forceinline__ s16x4 vtr(lds_cptr p) { return __builtin_bit_cast(s16x4, __builtin_amdgcn_ds_read_tr16_b64_v4i16((LAS v4i16_t*)p)); }
__device__ __forceinline__ float swapmax(float m) { auto rr = __builtin_amdgcn_permlane32_swap(__float_as_uint(m), __float_as_uint(m), false, false); return fmaxf(__uint_as_float(rr[0]), __uint_as_float(rr[1])); }
__device__ __forceinline__ float swapsum(float m) { auto rr = __builtin_amdgcn_permlane32_swap(__float_as_uint(m), __float_as_uint(m), false, false); return __uint_as_float(rr[0]) + __uint_as_float(rr[1]); }
__device__ __forceinline__ void glds16(const void* g, LAS unsigned char* l) { __builtin_amdgcn_global_load_lds((const unsigned*)g, (LAS unsigned*)l, 16, 0, 0); }
__device__ __forceinline__ void qkt(f32x16& p0, f32x16& p1, lds_cptr kslot, const bf16x8 (&qr)[4], int r32, int hi) {
    lds_cptr kb = kslot + hi * 1024 + r32 * 16;
#pragma unroll
    for (int d0 = 0; d0 < 4; ++d0) {
        const bf16x8 b0 = *(const LAS bf16x8*)(kb + d0 * 2048), b1 = *(const LAS bf16x8*)(kb + d0 * 2048 + 512);
        p0 = __builtin_amdgcn_mfma_f32_32x32x16_bf16(b0, qr[d0], p0, 0, 0, 0);
        p1 = __builtin_amdgcn_mfma_f32_32x32x16_bf16(b1, qr[d0], p1, 0, 0, 0);
    }
}
template <int ND> __device__ __forceinline__ void pv(f32x16 (&o)[ND], lds_cptr vb, bf16x8 pa0, bf16x8 pa1, bf16x8 pa2, bf16x8 pa3) {
#pragma unroll
    for (int d0 = 0; d0 < ND; ++d0) {
        s16x4 lo[4], hi[4];
#pragma unroll
        for (int ks = 0; ks < 4; ++ks) { lo[ks] = vtr(vb + d0 * 4096 + ks * 1024); hi[ks] = vtr(vb + d0 * 4096 + ks * 1024 + 512); }
#define ATT_PK(k) (bf16x8){lo[k][0], lo[k][1], lo[k][2], lo[k][3], hi[k][0], hi[k][1], hi[k][2], hi[k][3]}
        o[d0] = __builtin_amdgcn_mfma_f32_32x32x16_bf16(pa0, ATT_PK(0), o[d0], 0, 0, 0);
        o[d0] = __builtin_amdgcn_mfma_f32_32x32x16_bf16(pa1, ATT_PK(1), o[d0], 0, 0, 0);
        o[d0] = __builtin_amdgcn_mfma_f32_32x32x16_bf16(pa2, ATT_PK(2), o[d0], 0, 0, 0);
        o[d0] = __builtin_amdgcn_mfma_f32_32x32x16_bf16(pa3, ATT_PK(3), o[d0], 0, 0, 0);
#undef ATT_PK
    }
}
__device__ __forceinline__ void alibi_cin(f32x16& p0, f32x16& p1, float qrel, float sl2, float m, bool past) {
    if (past) { const float bm = -sl2 * qrel - m;
#pragma unroll
        for (int r = 0; r < 16; ++r) { const float c = (float)((r & 3) + 8 * (r >> 2)); p0[r] = fmaf(sl2, c, bm); p1[r] = fmaf(sl2, c + 32.f, bm); }
    } else {
#pragma unroll
        for (int r = 0; r < 16; ++r) { const float c = (float)((r & 3) + 8 * (r >> 2)); p0[r] = -sl2 * fabsf(qrel - c) - m; p1[r] = -sl2 * fabsf(qrel - 32.f - c) - m; }
    }
}
template <int ND> __device__ __forceinline__ void softmax_step(f32x16& p0, f32x16& p1, float& m, float& l, f32x16 (&o)[ND], LAS float* wsf, int r32, int hi, bool first) {
    float mx = fmaxf(p0[0], p1[0]);
#pragma unroll
    for (int r = 1; r < 16; ++r) mx = fmaxf(mx, fmaxf(p0[r], p1[r]));
    mx = swapmax(mx);
    if (first) { const float dl = (mx == -INFINITY) ? 0.f : mx; m += dl;
#pragma unroll
        for (int r = 0; r < 16; ++r) { p0[r] -= dl; p1[r] -= dl; }
    } else if (__any(mx > THR)) {
        const float dl = fmaxf(mx, 0.f); m += dl;
#pragma unroll
        for (int r = 0; r < 16; ++r) { p0[r] -= dl; p1[r] -= dl; }
        const float f = __builtin_amdgcn_exp2f(-dl); l *= f; wsf[r32] = f;
        LDS_WAIT();
#pragma unroll
        for (int r = 0; r < 16; ++r) { const float fr = wsf[(r & 3) + 8 * (r >> 2) + 4 * hi];
#pragma unroll
            for (int d = 0; d < ND; ++d) o[d][r] *= fr; }
        LDS_WAIT();
    }
    float sacc = 0.f;
#pragma unroll
    for (int r = 0; r < 16; ++r) { p0[r] = __builtin_amdgcn_exp2f(p0[r]); p1[r] = __builtin_amdgcn_exp2f(p1[r]); sacc += p0[r] + p1[r]; }
    l += sacc;
}
#define ATT_PACK(P, B) (u32x4){cvtpk(P[B], P[B + 1]), cvtpk(P[B + 2], P[B + 3]), cvtpk(P[B + 4], P[B + 5]), cvtpk(P[B + 6], P[B + 7])}

__device__ __forceinline__ void battn_unit(LAS unsigned char* L, int b, int h, int qb, bf16* P, const bf16* KV, const unsigned* MASK) {
    const int tid = otid(), lane = tid & 63, wid = __builtin_amdgcn_readfirstlane(tid >> 6), r32 = lane & 31, hi = lane >> 5;
    const int q0 = qb * 256, qpos = q0 + wid * 32 + r32, cq = (q0 + wid * 32) >> 6, NT = (q0 + 256) >> 6;
    const size_t rowbase = (size_t)b * SEQ;
    const bf16* Kh = KV + rowbase * 1024 + h * 64;
    bf16* Qw = P + (rowbase + q0 + wid * 32) * NP + C_BQ + h * 64;
    const char* ksrc = (const char*)(Kh + (size_t)lane * 1024 + wid * 8);
    const char* vsrc = (const char*)(Kh + 512 + (size_t)(16 * (wid & 3) + (lane >> 2)) * 1024 + (wid >> 2) * 32 + (lane & 3) * 8);
    LAS unsigned char* kdst = L + wid * 1024; LAS unsigned char* vdst = L + 16384 + wid * 1024;
    LAS float* wsf = (LAS float*)(L + 32768 + wid * 256);
    bf16x8 qr[4];
#pragma unroll
    for (int d0 = 0; d0 < 4; ++d0) qr[d0] = *(const bf16x8*)(Qw + (size_t)r32 * NP + d0 * 16 + hi * 8);
    const float sl2 = SLOPE_B[h] * LOG2E;
    const unsigned* mrow = MASK + (rowbase + qpos) * 64;
    float m = 0.f, l = 0.f; f32x16 o[2]; o[0] = f32x16{}; o[1] = f32x16{};
    glds16(ksrc, kdst); glds16(vsrc, vdst);
    v2u mw = *(const v2u*)mrow;
    const lds_cptr vb0 = (lds_cptr)(L + 16384) + ((lane >> 4) & 1) * 32 + (lane & 3) * 8 + (4 * hi + ((lane & 15) >> 2)) * 64;
    for (int t = 0; t < NT; ++t) {
        asm volatile("s_waitcnt vmcnt(0)" ::: "memory"); __syncthreads();
        const v2u mcur = mw;
        if (t + 1 < NT) { const int s = (t + 1) & 1; glds16(ksrc + (size_t)(t + 1) * (64 * 1024 * 2), kdst + s * 8192); glds16(vsrc + (size_t)(t + 1) * (64 * 1024 * 2), vdst + s * 8192);
            if (t + 1 <= cq) mw = *(const v2u*)(mrow + 2 * (t + 1)); }
        if (t <= cq) {
            f32x16 p0, p1;
            alibi_cin(p0, p1, (float)(qpos - 64 * t - 4 * hi), sl2, m, t < cq);
            const unsigned mx0 = mcur.x >> (4 * hi), mx1 = mcur.y >> (4 * hi);
#pragma unroll
            for (int r = 0; r < 16; ++r) { const int c = (r & 3) + 8 * (r >> 2); p0[r] = ((mx0 >> c) & 1u) ? p0[r] : -INFINITY; p1[r] = ((mx1 >> c) & 1u) ? p1[r] : -INFINITY; }
            qkt(p0, p1, (lds_cptr)L + (t & 1) * 8192, qr, r32, hi);
            softmax_step<2>(p0, p1, m, l, o, wsf, r32, hi, t == 0);
            const u32x4 w0 = ATT_PACK(p0, 0), w1 = ATT_PACK(p0, 8), w2 = ATT_PACK(p1, 0), w3 = ATT_PACK(p1, 8);
            pv<2>(o, vb0 + (t & 1) * 8192, __builtin_bit_cast(bf16x8, w0), __builtin_bit_cast(bf16x8, w1), __builtin_bit_cast(bf16x8, w2), __builtin_bit_cast(bf16x8, w3));
        }
    }
    l = swapsum(l); wsf[32 + r32] = l; LDS_WAIT();
    LAS bf16* stg = (LAS bf16*)(L + 36864 + wid * 4096);
#pragma unroll
    for (int r = 0; r < 16; ++r) { const int orow = (r & 3) + 8 * (r >> 2) + 4 * hi; const float rl = 1.f / wsf[32 + orow];
        stg[orow * 64 + r32] = (bf16)f2bf(o[0][r] * rl); stg[orow * 64 + 32 + r32] = (bf16)f2bf(o[1][r] * rl); }
    LDS_WAIT();
#pragma unroll
    for (int i = 0; i < 4; ++i) { const int row = i * 8 + (lane >> 3), ch = lane & 7; const u32x4 v = *(const LAS u32x4*)(stg + row * 64 + ch * 8); *(u32x4*)(Qw + (size_t)row * NP + ch * 8) = v; }
    asm volatile("s_waitcnt lgkmcnt(0)" ::: "memory"); __syncthreads();
}
__device__ __forceinline__ void battn_phase(LAS unsigned char* L, const Args& a) {
    const int G = gridDim.x, bx = blockIdx.x, vcu = (bx % 8) * (G / 8) + bx / 8, bh = vcu >> 1, sel = vcu & 1;
    bf16* P = (bf16*)(a.ws + WS_PROJ); const bf16* KV = (const bf16*)(a.ws + WS_KV); const unsigned* MASK = (const unsigned*)(a.ws + WS_MASK);
    for (int i = 0; i < 4; ++i) { const int qb = i == 0 ? sel : (i == 1 ? 7 - sel : (i == 2 ? 2 + sel : 5 - sel)); battn_unit(L, bh >> 3, bh & 7, qb, P, KV, MASK); }
}

__device__ __forceinline__ void dattn_unit(LAS unsigned char* L, int b, int h, int qb, bf16* P, float lam, const float* subg) {
    const int tid = otid(), lane = tid & 63, wid = __builtin_amdgcn_readfirstlane(tid >> 6), r32 = lane & 31, hi = lane >> 5, rg = wid & 3, mp = wid >> 2;
    const int q0 = qb * 128, qpos = q0 + rg * 32 + r32, cq = (q0 + rg * 32) >> 6, NT = (q0 + 128) >> 6;
    const size_t rowbase = (size_t)b * SEQ;
    const bf16* Kb = P + rowbase * NP + C_AK + h * 128;
    const bf16* Vb = P + rowbase * NP + C_AV + h * 128;
    bf16* Qw = P + (rowbase + q0 + rg * 32) * NP + C_AQ + h * 128;
    const char* k0src = (const char*)(Kb + (size_t)lane * NP + wid * 8);
    const char* k1src = (const char*)(Kb + (size_t)lane * NP + 64 + wid * 8);
    const char* v0src = (const char*)(Vb + (size_t)(16 * (wid & 3) + (lane >> 2)) * NP + (wid >> 2) * 32 + (lane & 3) * 8);
    const char* v1src = v0src + 64 * 2;
    LAS unsigned char* dst = L + wid * 1024;
    LAS float* wsf = (LAS float*)(L + 65536 + wid * 256);
    bf16x8 qr[4];
#pragma unroll
    for (int d0 = 0; d0 < 4; ++d0) qr[d0] = *(const bf16x8*)(Qw + (size_t)r32 * NP + mp * 64 + d0 * 16 + hi * 8);
    const float sl2 = SLOPE_A[h] * LOG2E;
    float m = 0.f, l = 0.f; f32x16 o[4];
#pragma unroll
    for (int d = 0; d < 4; ++d) o[d] = f32x16{};
    constexpr size_t TS = (size_t)64 * NP * 2;
    glds16(k0src, dst); glds16(k1src, dst + 8192); glds16(v0src, dst + 16384); glds16(v1src, dst + 24576);
    const lds_cptr vb0 = (lds_cptr)(L + 16384) + ((lane >> 4) & 1) * 32 + (lane & 3) * 8 + (4 * hi + ((lane & 15) >> 2)) * 64;
    for (int t = 0; t < NT; ++t) {
        asm volatile("s_waitcnt vmcnt(0)" ::: "memory"); __syncthreads();
        if (t + 1 < NT) { LAS unsigned char* d2 = dst + ((t + 1) & 1) * 32768; const size_t go = (size_t)(t + 1) * TS;
            glds16(k0src + go, d2); glds16(k1src + go, d2 + 8192); glds16(v0src + go, d2 + 16384); glds16(v1src + go, d2 + 24576); }
        if (t <= cq) {
            f32x16 p0, p1;
            alibi_cin(p0, p1, (float)(qpos - 64 * t - 4 * hi), sl2, m, t < cq);
            qkt(p0, p1, (lds_cptr)L + (t & 1) * 32768 + mp * 8192, qr, r32, hi);
            softmax_step<4>(p0, p1, m, l, o, wsf, r32, hi, t == 0);
            const u32x4 w0 = ATT_PACK(p0, 0), w1 = ATT_PACK(p0, 8), w2 = ATT_PACK(p1, 0), w3 = ATT_PACK(p1, 8);
            pv<4>(o, vb0 + (t & 1) * 32768, __builtin_bit_cast(bf16x8, w0), __builtin_bit_cast(bf16x8, w1), __builtin_bit_cast(bf16x8, w2), __builtin_bit_cast(bf16x8, w3));
        }
    }
    l = swapsum(l); wsf[32 + r32] = l; LDS_WAIT();
    LAS float* X = (LAS float*)(L + 69632) + rg * (32 * 132);
    if (mp == 1) {
#pragma unroll
        for (int r = 0; r < 16; ++r) { const int orow = (r & 3) + 8 * (r >> 2) + 4 * hi; const float rl = lam / wsf[32 + orow];
#pragma unroll
            for (int d = 0; d < 4; ++d) X[orow * 132 + d * 32 + r32] = o[d][r] * rl; }
    }
    asm volatile("s_waitcnt lgkmcnt(0)" ::: "memory"); __syncthreads();
    if (mp == 0) {
#pragma unroll
        for (int r = 0; r < 16; ++r) { const int orow = (r & 3) + 8 * (r >> 2) + 4 * hi; const float rl = 1.f / wsf[32 + orow];
#pragma unroll
            for (int d = 0; d < 4; ++d) { LAS float* xp = X + orow * 132 + d * 32 + r32; *xp = o[d][r] * rl - *xp; } }
        LDS_WAIT();
        const int row = lane >> 1, half = lane & 1; const LAS f32x4* xr = (const LAS f32x4*)(X + row * 132 + half * 64);
        f32x4 y[16]; float ss = 0.f;
#pragma unroll
        for (int j = 0; j < 16; ++j) { y[j] = xr[j]; ss += (y[j].x * y[j].x + y[j].y * y[j].y) + (y[j].z * y[j].z + y[j].w * y[j].w); }
        ss += __shfl_xor(ss, 1);
        const float rn = 0.8f / sqrtf(ss * (1.f / 128.f) + RMS_EPS);
        bf16* op = Qw + (size_t)row * NP + half * 64; const f32x4* gp = (const f32x4*)(subg + half * 64);
#pragma unroll
        for (int j = 0; j < 8; ++j) { const f32x4 g0 = gp[2 * j], g1 = gp[2 * j + 1]; const f32x4 a0 = y[2 * j] * rn * g0, a1 = y[2 * j + 1] * rn * g1;
            u32x4 w; w.x = cvtpk(a0.x, a0.y); w.y = cvtpk(a0.z, a0.w); w.z = cvtpk(a1.x, a1.y); w.w = cvtpk(a1.z, a1.w); *(u32x4*)(op + j * 8) = w; }
    }
    asm volatile("s_waitcnt lgkmcnt(0)" ::: "memory"); __syncthreads();
}
__device__ __forceinline__ void dattn_phase(LAS unsigned char* L, const Args& a) {
    const int G = gridDim.x, bx = blockIdx.x, vcu = (bx % 8) * (G / 8) + bx / 8, bh = vcu >> 2, j = vcu & 3;
    bf16* P = (bf16*)(a.ws + WS_PROJ); const float lam = lam_value(a);
    for (int i = 0; i < 4; ++i) { const int qb = i == 0 ? j : (i == 1 ? 7 - j : (i == 2 ? 8 + j : 15 - j)); dattn_unit(L, bh >> 2, bh & 3, qb, P, lam, a.in[I_SUBLN]); }
}
#undef ATT_PACK
}

__global__ void __launch_bounds__(512, 2) fwd(Args a) {
    extern __shared__ __attribute__((aligned(16))) unsigned char lds[];
    const int tid = threadIdx.x;
    unsigned char* ws = a.ws;
    for (int u = tid; u < (LDS_BYTES - LDSCTL_OFF) / 4; u += 512) ((LAS unsigned*)((LAS unsigned char*)lds + LDSCTL_OFF))[u] = 0u;
    __syncthreads();
    XcdBarrier bar = xcd_barrier_post((unsigned*)(ws + WS_CTL) + CW_BAR, (volatile LAS unsigned*)((LAS unsigned char*)lds + MISC_OFF) + 8);
#define GRID_BAR() xcd_barrier(bar)
    bf16* PROJ = (bf16*)(ws + WS_PROJ); bf16* U = (bf16*)(ws + WS_U);
    LAS unsigned char* LL = (LAS unsigned char*)lds;

    p0_naive(a, lds);
    GRID_BAR();
    p1_modulate(a, lds);
    GRID_BAR();
#if FAST_P2
    { pg8::Gemm g{U, (const bf16*)(ws + WS_WIN), T, NP, 1024, 1024, 1024}; pg8::StaticOrder S; S.init(T, NP, (int)gridDim.x, (int)blockIdx.x);
      pg8::EpiProjF E{PROJ, NP, QSCALE}; pg8::gemm_phase<pg8::EpiProjF, pg8::StaticOrder, true, true, 1024, 1024, 1024>(LL, g, S, E); }
#else
    { EpiProj e{PROJ}; naive_gemm((float*)lds, U, 1024, (const bf16*)(ws + WS_WIN), 1024, T, NP, 1024, e); }
#endif
    GRID_BAR();
    naive_rms_rows(a);
    GRID_BAR();
#if FAST_KV
    { pg8::Gemm g{PROJ + C_BKV, (const bf16*)(ws + WS_WKV), T, 1024, 128, NP, 128}; pg8::StaticOrder S; S.init(T, 1024, (int)gridDim.x, (int)blockIdx.x);
      pg8::EpiRowScale E{(bf16*)(ws + WS_KV), 1024, (const float*)(ws + WS_R)}; pg8::gemm_phase<pg8::EpiRowScale, pg8::StaticOrder, true, true, 128, NP, 128>(LL, g, S, E); }
#else
    { EpiKV e{(bf16*)(ws + WS_KV), (const float*)(ws + WS_R)}; naive_gemm((float*)lds, PROJ + C_BKV, NP, (const bf16*)(ws + WS_WKV), 128, T, 1024, 128, e); }
#endif
    __syncthreads();
    naive_indexer(a, lds);
    __syncthreads();
#if FAST_DATT
    att::dattn_phase(LL, a);
#else
    naive_diffattn(a, lds);
#endif
    GRID_BAR();
#if FAST_BATT
    att::battn_phase(LL, a);
#else
    naive_battn(a, lds);
#endif
    GRID_BAR();
#if FAST_MIX
    { pg8::StaticOrder S; S.init(T, 1024, (int)gridDim.x, (int)blockIdx.x);
      { pg8::Gemm g{PROJ + C_AQ, (const bf16*)(ws + WS_WA), T, 1024, 512, NP, 512}; pg8::EpiMix<true> E{U, 1024, PROJ + C_G, NP};
        pg8::gemm_phase<pg8::EpiMix<true>, pg8::StaticOrder, true, true, 512, NP, 512>(LL, g, S, E); }
      asm volatile("s_waitcnt vmcnt(0)" ::: "memory"); __syncthreads();
      { pg8::Gemm g{PROJ + C_BQ, (const bf16*)(ws + WS_WB), T, 1024, 512, NP, 512}; pg8::EpiMix<false> E{U, 1024, PROJ + C_G + 1024, NP};
        pg8::gemm_phase<pg8::EpiMix<false>, pg8::StaticOrder, true, true, 512, NP, 512>(LL, g, S, E); } }
#else
    { EpiMixA e{U, PROJ}; naive_gemm((float*)lds, PROJ + C_AQ, NP, (const bf16*)(ws + WS_WA), 512, T, 1024, 512, e); }
    __syncthreads();
    { EpiMixB e{U, PROJ}; naive_gemm((float*)lds, PROJ + C_BQ, NP, (const bf16*)(ws + WS_WB), 512, T, 1024, 512, e); }
#endif
    GRID_BAR();
#if FAST_WO
    { pg8::Gemm g{U, (const bf16*)(ws + WS_WO), T, 1024, 1024, 1024, 1024}; pg8::StaticOrder S; S.init(T, 1024, (int)gridDim.x, (int)blockIdx.x);
      pg8::EpiResGate E{a.out, a.in[I_X], (const float*)(ws + WS_MOD) + 2048, 6144, ALPHA}; pg8::gemm_phase<pg8::EpiResGate, pg8::StaticOrder, true, true, 1024, 1024, 1024>(LL, g, S, E); }
#else
    { EpiWo e{a.out, a.in[I_X], (const float*)(ws + WS_MOD)}; naive_gemm((float*)lds, U, 1024, (const bf16*)(ws + WS_WO), 1024, T, 1024, 1024, e); }
#endif
    GRID_BAR();
    p7_ln_route(a, lds);
    GRID_BAR();
    p8_sort(a, lds);
    GRID_BAR();
#if FAST_MOE
    { const int* BASES = (const int*)(ws + WS_ROUTE2 + 1024 * 1024 + 32768); const int nslot = BASES[24];
      pg8::Gemm g{(const bf16*)(ws + WS_XS), (const bf16*)(ws + WS_W1), nslot, 1024, 1024, 1024, 1024};
      pg8::MoeOrder1 S; S.so.init(nslot, 1024, (int)gridDim.x, (int)blockIdx.x); S.BASES = BASES; S.W1 = (const bf16*)(ws + WS_W1);
      pg8::EpiMoe1 E{(bf16*)(ws + WS_H), (const float*)(ws + WS_ROUTE2 + 1280 * 1024)};
      pg8::gemm_phase<pg8::EpiMoe1, pg8::MoeOrder1, true, true, 1024, 1024, 1024>(LL, g, S, E); }
#else
    naive_moe1(a, lds);
#endif
    GRID_BAR();
#if FAST_MOE
    { const int* BASES = (const int*)(ws + WS_ROUTE2 + 1024 * 1024 + 32768); const int nslot = BASES[24];
      pg8::Gemm g{(const bf16*)(ws + WS_H), (const bf16*)(ws + WS_W2P), nslot, 1024, 512, 512, 512};
      pg8::MoeOrder2 S; S.so.init(nslot, 1024, (int)gridDim.x, (int)blockIdx.x); S.BASES = BASES; S.W2P = (const bf16*)(ws + WS_W2P);
      pg8::EpiMoe2 E{a.out, (const int*)(ws + WS_ROUTE2 + 512 * 1024), (const float*)(ws + WS_MOD) + 5120, 6144, ALPHA};
      pg8::gemm_phase<pg8::EpiMoe2, pg8::MoeOrder2, true, true, 512, 512, 512>(LL, g, S, E); }
#else
    naive_moe2(a, lds);
#endif
    GRID_BAR();
    p11_ln(a);
}

extern "C" void kernel_launch(void* const* d_in, const int* in_sizes, int n_in, void* d_out, int out_size, void* d_ws, size_t ws_size, hipStream_t stream) {
    static int grid = 0;
    if (grid == 0) {
        if (n_in != 27 || out_size != T * D || ws_size < WS_END) { fprintf(stderr, "kernel_launch: unexpected problem (n_in %d, out %d, ws %zu); nothing launched\n", n_in, out_size, ws_size); grid = -1; return; }
        int dev = 0, cus = 0;
        if (hipGetDevice(&dev) != hipSuccess || hipDeviceGetAttribute(&cus, hipDeviceAttributeMultiprocessorCount, dev) != hipSuccess) { grid = -1; return; }
        if (hipFuncSetAttribute((const void*)fwd, hipFuncAttributeMaxDynamicSharedMemorySize, LDS_BYTES) != hipSuccess) { fprintf(stderr, "kernel_launch: hipFuncSetAttribute failed\n"); grid = -1; return; }
        if (cus != 256) { fprintf(stderr, "kernel_launch: built for 256 CUs, device has %d; nothing launched\n", cus); grid = -1; return; }
        grid = cus;
    }
    if (grid < 0) return;
    if (hipMemsetAsync((char*)d_ws + WS_CTL, 0, CTL_ZERO_BYTES, stream) != hipSuccess) return;
    Args a{};
    for (int i = 0; i < 27; ++i) a.in[i] = (const float*)d_in[i];
    a.out = (float*)d_out; a.ws = (unsigned char*)d_ws;
    hipLaunchKernelGGL(fwd, dim3(grid), dim3(512), LDS_BYTES, stream, a);
}
```

```cpp
#include <hip/hip_runtime.h>
#include <hip/hip_bf16.h>
#include <cstdio>
#include <cstdint>

#define GAS __attribute__((address_space(1)))
#define LAS __attribute__((address_space(3)))
typedef unsigned short bf16;
typedef GAS unsigned gu32;
typedef unsigned v4u __attribute__((ext_vector_type(4)));
typedef unsigned v2u __attribute__((ext_vector_type(2)));
typedef float f32x4 __attribute__((ext_vector_type(4)));
#define RLX_AGENT __ATOMIC_RELAXED, __HIP_MEMORY_SCOPE_AGENT

#ifndef FAST_P2
#define FAST_P2 1
#endif
#ifndef FAST_KV
#define FAST_KV 1
#endif
#ifndef FAST_MIX
#define FAST_MIX 1
#endif
#ifndef FAST_WO
#define FAST_WO 1
#endif
#ifndef FAST_MOE
#define FAST_MOE 1
#endif
#ifndef FAST_DATT
#define FAST_DATT 1
#endif
#ifndef FAST_IDX
#define FAST_IDX 1
#endif
#ifndef FAST_BATT
#define FAST_BATT 1
#endif
constexpr int BATCH = 16, SEQ = 2048, D = 1024, T = BATCH * SEQ;
constexpr int NP = 4864;
constexpr int C_AQ = 0, C_AK = 512, C_AV = 1024, C_BQ = 1536, C_BKV = 2048, C_IQ = 2176, C_IK = 2688, C_IW = 2752, C_PADB = 2760, C_G = 2816;
constexpr int IN_COLS = 4808;
constexpr float LOG2E = 1.4426950408889634f;
constexpr float QSCALE = 0.125f * LOG2E;
constexpr float ALPHA = 1.189207115002721f;
constexpr float LN_EPS = 1e-5f, RMS_EPS = 1e-5f;
constexpr int TOPK = 256;
constexpr int MAXSLOT = 40960;

__device__ __constant__ float SLOPE_A[4] = {0.6299605369567871f, 0.15749013423919678f, 0.039372533559799194f, 0.009843133389949799f};
__device__ __constant__ float SLOPE_B[8] = {0.39685025811195374f, 0.25f, 0.09921256452798843f, 0.0625f, 0.02480314113199711f, 0.015625f, 0.006200785282999277f, 0.00390625f};

constexpr size_t MiB = 1u << 20;
constexpr size_t WS_CTL = 0, CTL_ZERO_BYTES = 1 * MiB;
constexpr size_t WS_MOD = 1 * MiB;
constexpr size_t WS_R = WS_MOD + 512 * 1024;
constexpr size_t WS_ROUTE = WS_R + 128 * 1024;
constexpr size_t WS_WIN = 2 * MiB;
constexpr size_t WS_WA = 12 * MiB;
constexpr size_t WS_WB = 13 * MiB;
constexpr size_t WS_WO = 14 * MiB;
constexpr size_t WS_WKV = 16 * MiB;
constexpr size_t WS_W1 = 17 * MiB;
constexpr size_t WS_W2P = 33 * MiB;
constexpr size_t WS_ROUTE2 = 57 * MiB;
constexpr size_t WS_RW = 59 * MiB;
constexpr size_t WS_MODP = 59 * MiB + 128 * 1024;
constexpr size_t WS_MASK = 60 * MiB;
constexpr size_t WS_KV = 68 * MiB;
constexpr size_t WS_U = 132 * MiB;
constexpr size_t WS_PROJ = 196 * MiB;
constexpr size_t WS_U2 = 196 * MiB;
constexpr size_t WS_H = 260 * MiB;
constexpr size_t WS_XS = 300 * MiB;
constexpr size_t WS_MODPART = 500 * MiB;
constexpr size_t WS_END = 512 * MiB;

constexpr int CW_BAR = 4096;

constexpr int LDSCTL_OFF = 139264, MISC_OFF = LDSCTL_OFF + 320, LDS_BYTES = 147456;

__device__ __forceinline__ unsigned f2bf(float f) { unsigned u = __float_as_uint(f); return (u + 0x7fffu + ((u >> 16) & 1u)) >> 16; }
__device__ __forceinline__ float bf2f(unsigned h) { return __uint_as_float(h << 16); }
__device__ __forceinline__ float bflo(unsigned w) { return __uint_as_float(w << 16); }
__device__ __forceinline__ float bfhi(unsigned w) { return __uint_as_float(w & 0xffff0000u); }
__device__ __forceinline__ unsigned pk2(float lo, float hi) { return f2bf(lo) | (f2bf(hi) << 16); }
__device__ __forceinline__ float wave_sum(float v) {
#pragma unroll
    for (int o = 1; o < 64; o <<= 1) v += __shfl_xor(v, o);
    return v;
}
__device__ __forceinline__ float wave_max(float v) {
#pragma unroll
    for (int o = 1; o < 64; o <<= 1) v = fmaxf(v, __shfl_xor(v, o));
    return v;
}
__device__ __forceinline__ int wave_sum_i(int v) {
#pragma unroll
    for (int o = 1; o < 64; o <<= 1) v += __shfl_xor(v, o);
    return v;
}
#define LDS_WAIT() asm volatile("s_waitcnt lgkmcnt(0)" ::: "memory")
__device__ __forceinline__ int otid() { int t = threadIdx.x; asm volatile("" : "+v"(t)); return t; }

#define XB_TMO      128
#define XB_XCNT(j)  (256  + 64 * (j))
#define XB_XSUB(j)  (1280 + 64 * (j))
#define XB_XGEN(j)  (2304 + 64 * (j))
#define XB_TOP      3328
#define XB_TOPGEN   3392
#define XCD_BAR_WORDS 3456
#define XB_SPIN_CAP (1u << 22)
__device__ __forceinline__ unsigned xb_ld(unsigned* p)              { return __hip_atomic_load(p, __ATOMIC_RELAXED, __HIP_MEMORY_SCOPE_AGENT); }
__device__ __forceinline__ unsigned xb_add(unsigned* p, unsigned v) { return __hip_atomic_fetch_add(p, v, __ATOMIC_RELAXED, __HIP_MEMORY_SCOPE_AGENT); }
__device__ __forceinline__ unsigned xb_xcc_id() { return (unsigned)__builtin_amdgcn_s_getreg((3 << 11) | 20) & 0xFu; }
#define XB_SPIN(cond, bar) do { unsigned _sp = 0; while (cond) { __builtin_amdgcn_s_sleep(1); \
    if ((++_sp & 255u) == 0u) { if (xb_ld(&(bar)[XB_TMO])) break; if (_sp > XB_SPIN_CAP) { atomicAdd(&(bar)[XB_TMO], 1u); break; } } } } while (0)
struct XcdBarrier { unsigned* bar; unsigned x; volatile LAS unsigned* st; };
__device__ __forceinline__ XcdBarrier xcd_barrier_post(unsigned* bar, volatile LAS unsigned* st) {
    XcdBarrier b; b.bar = bar; b.x = xb_xcc_id(); b.st = st;
    if (threadIdx.x == 0) (void)xb_add(&bar[XB_XCNT(b.x)], 1u);
    return b;
}
__device__ __forceinline__ void xcd_barrier_complete(unsigned* bar, unsigned x, unsigned& nloc, unsigned& nx) {
    const unsigned G = gridDim.x * gridDim.y * gridDim.z;
    unsigned sum, cnt, mine, sp = 0u;
    for (;;) {
        sum = 0u; cnt = 0u; mine = 0u;
#pragma unroll
        for (unsigned j = 0; j < 16; ++j) { const unsigned c = xb_ld(&bar[XB_XCNT(j)]); sum += c; cnt += (c > 0u) ? 1u : 0u; mine = (j == x) ? c : mine; }
        if (sum == G) break;
        __builtin_amdgcn_s_sleep(1);
        if ((++sp & 255u) == 0u) { if (xb_ld(&bar[XB_TMO])) break; if (sp > XB_SPIN_CAP) { atomicAdd(&bar[XB_TMO], 1u); break; } }
    }
    nloc = mine > 0u ? mine : 1u; nx = cnt > 0u ? cnt : 1u;
}
__device__ __forceinline__ void xcd_barrier(const XcdBarrier& b) {
    asm volatile("s_waitcnt vmcnt(0)" ::: "memory");
    __syncthreads();
    if (threadIdx.x == 0) {
        unsigned* bar = b.bar;
        __builtin_amdgcn_s_waitcnt(0);
        unsigned nloc = b.st[0], nx = b.st[1];
        if (nloc == 0u) { xcd_barrier_complete(bar, b.x, nloc, nx); b.st[0] = nloc; b.st[1] = nx; }
        const unsigned old = xb_add(&bar[XB_XSUB(b.x)], 1u);
        const unsigned gen = old / nloc;
        if (old + 1u == (gen + 1u) * nloc) {
            __builtin_amdgcn_fence(__ATOMIC_RELEASE, "agent");
            asm volatile("s_waitcnt vmcnt(0)" ::: "memory");
            const unsigned og = xb_add(&bar[XB_TOP], 1u);
            const unsigned tg = og / nx;
            if (og + 1u == (tg + 1u) * nx) xb_add(&bar[XB_TOPGEN], 1u);
            else XB_SPIN(xb_ld(&bar[XB_TOPGEN]) == tg, bar);
            __builtin_amdgcn_fence(__ATOMIC_ACQUIRE, "agent");
            xb_add(&bar[XB_XGEN(b.x)], 1u);
            asm volatile("s_waitcnt vmcnt(0)" ::: "memory");
        } else {
            XB_SPIN(xb_ld(&bar[XB_XGEN(b.x)]) == gen, bar);
            __builtin_amdgcn_fence(__ATOMIC_ACQUIRE, "agent");
            asm volatile("s_waitcnt vmcnt(0)" ::: "memory");
        }
    }
    __syncthreads();
}

struct Args { const float* in[27]; float* out; unsigned char* ws; };
enum { I_X = 0, I_C, I_ADAW, I_ADAB, I_WIN, I_LQ1, I_LK1, I_LQ2, I_LK2, I_SUBLN, I_KVG, I_WUK, I_WUV, I_WA, I_WB, I_WO, I_LN1G, I_LN1B, I_WGRP, I_BGRP, I_WER, I_BER, I_WEG, I_WEU, I_WED, I_LN2G, I_LN2B };

template <class Epi>
__device__ __forceinline__ void naive_gemm(float* sm, const bf16* A, int lda, const bf16* Bt, int ldb, int M, int N, int K, const Epi& epi) {
    const int tid = otid(), ty = tid >> 5, tx = tid & 31;
    float* As = sm; float* Bs = sm + 16 * 132;
    const int ntn = N / 128, ntiles = (M / 128) * ntn;
    for (int tile = blockIdx.x; tile < ntiles; tile += gridDim.x) {
        const int m0 = (tile / ntn) * 128, n0 = (tile % ntn) * 128;
        float acc[8][4];
#pragma unroll
        for (int i = 0; i < 8; ++i)
#pragma unroll
            for (int j = 0; j < 4; ++j) acc[i][j] = 0.f;
        for (int k0 = 0; k0 < K; k0 += 16) {
            {
                const int row = tid >> 2, kq = (tid & 3) * 4;
                const v2u av = *(const v2u*)(A + (size_t)(m0 + row) * lda + k0 + kq);
                As[(kq + 0) * 132 + row] = bflo(av.x); As[(kq + 1) * 132 + row] = bfhi(av.x);
                As[(kq + 2) * 132 + row] = bflo(av.y); As[(kq + 3) * 132 + row] = bfhi(av.y);
                const v2u bv = *(const v2u*)(Bt + (size_t)(n0 + row) * ldb + k0 + kq);
                Bs[(kq + 0) * 132 + row] = bflo(bv.x); Bs[(kq + 1) * 132 + row] = bfhi(bv.x);
                Bs[(kq + 2) * 132 + row] = bflo(bv.y); Bs[(kq + 3) * 132 + row] = bfhi(bv.y);
            }
            __syncthreads();
#pragma unroll
            for (int kk = 0; kk < 16; ++kk) {
                float a[8], b[4];
#pragma unroll
                for (int i = 0; i < 8; ++i) a[i] = As[kk * 132 + ty * 8 + i];
#pragma unroll
                for (int j = 0; j < 4; ++j) b[j] = Bs[kk * 132 + tx * 4 + j];
#pragma unroll
                for (int i = 0; i < 8; ++i)
#pragma unroll
                    for (int j = 0; j < 4; ++j) acc[i][j] = fmaf(a[i], b[j], acc[i][j]);
            }
            __syncthreads();
        }
#pragma unroll
        for (int i = 0; i < 8; ++i)
#pragma unroll
            for (int j = 0; j < 4; ++j) epi(m0 + ty * 8 + i, n0 + tx * 4 + j, acc[i][j]);
    }
}

struct EpiProj {
    bf16* P;
    __device__ __forceinline__ void operator()(int r, int c, float v) const {
        if (c < C_AK || (c >= C_BQ && c < C_BKV)) v *= QSCALE;
        else if (c >= C_G) v = 1.f / (1.f + __expf(-v));
        P[(size_t)r * NP + c] = (bf16)f2bf(v);
    }
};
struct EpiKV { bf16* KV; const float* R; __device__ __forceinline__ void operator()(int r, int c, float v) const { KV[(size_t)r * 1024 + c] = (bf16)f2bf(v * R[r]); } };
struct EpiMixA { bf16* MX; const bf16* P; __device__ __forceinline__ void operator()(int r, int c, float v) const { MX[(size_t)r * 1024 + c] = (bf16)f2bf(v * bf2f(P[(size_t)r * NP + C_G + c])); } };
struct EpiMixB { bf16* MX; const bf16* P; __device__ __forceinline__ void operator()(int r, int c, float v) const { const size_t o = (size_t)r * 1024 + c; MX[o] = (bf16)f2bf(bf2f(MX[o]) + v * bf2f(P[(size_t)r * NP + C_G + 1024 + c])); } };
struct EpiWo { float* out; const float* x; const float* MOD; __device__ __forceinline__ void operator()(int r, int c, float v) const { const size_t o = (size_t)r * 1024 + c; out[o] = ALPHA * x[o] + MOD[(r >> 11) * 6144 + 2048 + c] * v; } };

__device__ __forceinline__ void p0_naive(const Args& a, unsigned char* lds) {
    unsigned char* ws = a.ws;
    const int tid = otid(); const size_t gt = (size_t)blockIdx.x * 512 + tid, NT = (size_t)gridDim.x * 512;
    bf16* WIN = (bf16*)(ws + WS_WIN); bf16* WA = (bf16*)(ws + WS_WA); bf16* WB = (bf16*)(ws + WS_WB); bf16* WO = (bf16*)(ws + WS_WO);
    bf16* WKV = (bf16*)(ws + WS_WKV); bf16* W1 = (bf16*)(ws + WS_W1); bf16* W2P = (bf16*)(ws + WS_W2P); float* RW = (float*)(ws + WS_RW);
    for (size_t i = gt; i < (size_t)NP * 1024; i += NT) { const int n = (int)(i >> 10), k = (int)(i & 1023); const int o = n < C_PADB ? n : (n >= C_G ? n - 56 : -1);
        WIN[i] = o >= 0 ? (bf16)f2bf(a.in[I_WIN][(size_t)k * IN_COLS + o]) : (bf16)0; }
    for (size_t i = gt; i < (size_t)1024 * 512; i += NT) { const int n = (int)(i >> 9), k = (int)(i & 511);
        WA[i] = (bf16)f2bf(a.in[I_WA][(size_t)k * 1024 + n]); WB[i] = (bf16)f2bf(a.in[I_WB][(size_t)k * 1024 + n]); }
    for (size_t i = gt; i < (size_t)1024 * 1024; i += NT) { const int n = (int)(i >> 10), k = (int)(i & 1023); WO[i] = (bf16)f2bf(a.in[I_WO][(size_t)k * 1024 + n]); }
    for (size_t i = gt; i < (size_t)1024 * 128; i += NT) { const int n = (int)(i >> 7), r = (int)(i & 127);
        const float g = a.in[I_KVG][r]; const float w = n < 512 ? a.in[I_WUK][r * 512 + n] : a.in[I_WUV][r * 512 + (n - 512)]; WKV[i] = (bf16)f2bf(g * w); }
    for (size_t i = gt; i < (size_t)16 * 512 * 1024; i += NT) { const int k = (int)(i & 1023), row = (int)((i >> 10) & 511), e = (int)(i >> 19);
        const int tile = row >> 8, half = (row >> 7) & 1, j = row & 127, col = tile * 128 + j;
        const float* src = half ? a.in[I_WEU] : a.in[I_WEG]; W1[i] = (bf16)f2bf(src[((size_t)e * 1024 + k) * 256 + col]); }
    for (size_t i = gt; i < (size_t)24 * 1024 * 512; i += NT) { const int kk = (int)(i & 511), n = (int)((i >> 9) & 1023), p = (int)(i >> 19);
        const int g = p / 6, pi = p % 6; const int ei = pi < 3 ? 0 : (pi < 5 ? 1 : 2); const int ej = pi < 3 ? pi + 1 : (pi < 5 ? pi - 1 : 3);
        const int e = 4 * g + (kk < 256 ? ei : ej); W2P[i] = (bf16)f2bf(a.in[I_WED][((size_t)e * 256 + (kk & 255)) * 1024 + n]); }
    for (size_t i = gt; i < (size_t)20 * 1024; i += NT) { const int c = (int)(i >> 10), k = (int)(i & 1023); RW[i] = c < 4 ? a.in[I_WGRP][k * 4 + c] : a.in[I_WER][k * 16 + (c - 4)]; }
    {
        float* sc = (float*)lds;
        const int kb = blockIdx.x >> 4, cb = blockIdx.x & 15;
        for (int i = tid; i < 16 * 64; i += 512) { const int b = i >> 6, kk = i & 63; const float cv = a.in[I_C][b * 1024 + kb * 64 + kk]; sc[i] = cv / (1.f + __expf(-cv)); }
        __syncthreads();
        if (tid < 384) {
            const int j = cb * 384 + tid; float acc[16];
#pragma unroll
            for (int b = 0; b < 16; ++b) acc[b] = 0.f;
            for (int kk = 0; kk < 64; ++kk) { const float w = a.in[I_ADAW][(size_t)(kb * 64 + kk) * 6144 + j];
#pragma unroll
                for (int b = 0; b < 16; ++b) acc[b] = fmaf(sc[b * 64 + kk], w, acc[b]); }
            float* MP = (float*)(ws + WS_MODPART);
#pragma unroll
            for (int b = 0; b < 16; ++b) MP[((size_t)kb * 16 + b) * 6144 + j] = acc[b];
        }
        __syncthreads();
    }
}
__device__ __forceinline__ float mod_sum(const float* MP, const float* adab, int b, int j) {
    float s = adab[j];
#pragma unroll
    for (int ks = 0; ks < 16; ++ks) s += MP[((size_t)ks * 16 + b) * 6144 + j];
    return s;
}
__device__ __forceinline__ void p1_modulate(const Args& a, unsigned char* lds) {
    unsigned char* ws = a.ws; const int tid = otid(), blk = blockIdx.x;
    const float* MP = (const float*)(ws + WS_MODPART); float* MOD = (float*)(ws + WS_MOD); bf16* U = (bf16*)(ws + WS_U);
    float* sh = (float*)lds; float* sc = sh + 1024;
    const int b = blk >> 4;
    for (int j = tid; j < 1024; j += 512) { sh[j] = mod_sum(MP, a.in[I_ADAB], b, j); sc[j] = 1.f + mod_sum(MP, a.in[I_ADAB], b, 1024 + j); }
    for (int e = tid; e < 384; e += 512) { const int flat = blk * 384 + e; MOD[flat] = mod_sum(MP, a.in[I_ADAB], flat / 6144, flat % 6144); }
    __syncthreads();
    const f32x4* X = (const f32x4*)(a.in[I_X] + (size_t)blk * 128 * 1024); v2u* Uo = (v2u*)(U + (size_t)blk * 128 * 1024);
    for (int i = tid; i < 128 * 256; i += 512) { const int c4 = (i & 255) * 4; const f32x4 x = X[i];
        v2u o; o.x = pk2(x.x * sc[c4] + sh[c4], x.y * sc[c4 + 1] + sh[c4 + 1]); o.y = pk2(x.z * sc[c4 + 2] + sh[c4 + 2], x.w * sc[c4 + 3] + sh[c4 + 3]); Uo[i] = o; }
    __syncthreads();
}
__device__ __forceinline__ void naive_rms_rows(const Args& a) {
    const bf16* P = (const bf16*)(a.ws + WS_PROJ); float* R = (float*)(a.ws + WS_R);
    const int tid = otid(); const int lane = tid & 63, gw = blockIdx.x * 8 + (tid >> 6), NW = gridDim.x * 8;
    for (int t = gw; t < T; t += NW) { const unsigned w = *(const unsigned*)(P + (size_t)t * NP + C_BKV + lane * 2); const float x0 = bflo(w), x1 = bfhi(w);
        const float ss = wave_sum(x0 * x0 + x1 * x1); if (lane == 0) R[t] = 1.f / sqrtf(ss * (1.f / 128.f) + RMS_EPS); }
}
__device__ __forceinline__ unsigned sortable(float s) { const unsigned u = __float_as_uint(s); return (u & 0x80000000u) ? ~u : (u | 0x80000000u); }
__device__ __forceinline__ void naive_indexer(const Args& a, unsigned char* lds) {
    const bf16* P = (const bf16*)(a.ws + WS_PROJ); unsigned* MASK = (unsigned*)(a.ws + WS_MASK);
    const int tid = otid(), lane = tid & 63;
    float* qf = (float*)lds; float* wq = (float*)(lds + 2048); unsigned* keys = (unsigned*)(lds + 4096); unsigned* lcnt = (unsigned*)(lds + 12288); unsigned* maskw = (unsigned*)(lds + 12544);
    for (int t = blockIdx.x; t < T; t += gridDim.x) {
        const int b = t >> 11, s = t & 2047, vis = ((s >> 6) + 1) << 6;
        { const bf16* qr = P + (size_t)t * NP + C_IQ; qf[tid] = bf2f(qr[tid]); if (tid < 8) wq[tid] = bf2f(P[(size_t)t * NP + C_IW + tid]); if (tid < 40) lcnt[tid] = 0u; if (tid < 64) maskw[tid] = 0u; }
        __syncthreads();
        for (int k = tid; k < vis; k += 512) {
            const v4u* kr = (const v4u*)(P + (size_t)(b * SEQ + k) * NP + C_IK); float kf[64];
#pragma unroll
            for (int i = 0; i < 8; ++i) { const v4u v = kr[i]; kf[8 * i] = bflo(v.x); kf[8 * i + 1] = bfhi(v.x); kf[8 * i + 2] = bflo(v.y); kf[8 * i + 3] = bfhi(v.y); kf[8 * i + 4] = bflo(v.z); kf[8 * i + 5] = bfhi(v.z); kf[8 * i + 6] = bflo(v.w); kf[8 * i + 7] = bfhi(v.w); }
            float scv = 0.f;
            asm volatile("" ::: "memory");
#pragma unroll 1
            for (int h = 0; h < 8; ++h) { float d = 0.f;
#pragma unroll
                for (int i = 0; i < 64; ++i) d = fmaf(qf[h * 64 + i], kf[i], d);
                scv = fmaf(wq[h], fmaxf(d, 0.f), scv); }
            keys[k] = sortable(scv + 0.f);
        }
        __syncthreads();
        if (vis <= TOPK) { if (tid < 64) MASK[(size_t)t * 64 + tid] = (tid * 32 < vis) ? 0xffffffffu : 0u; }
        else {
            unsigned K = 0u;
            for (int bit = 31; bit >= 0; --bit) {
                const unsigned trial = K | (1u << bit); int c = 0;
                for (int k = tid; k < vis; k += 512) c += keys[k] >= trial ? 1 : 0;
                c = wave_sum_i(c); if (lane == 0 && c) atomicAdd(&lcnt[bit], (unsigned)c);
                __syncthreads();
                if (lcnt[bit] >= (unsigned)TOPK) K = trial;
            }
            { int c = 0; for (int k = tid; k < vis; k += 512) c += keys[k] > K ? 1 : 0; c = wave_sum_i(c); if (lane == 0 && c) atomicAdd(&lcnt[32], (unsigned)c); }
            __syncthreads();
            const int need = TOPK - (int)lcnt[32];
            for (int k = tid; k < vis; k += 512) {
                const unsigned kv = keys[k]; bool sel = kv > K;
                if (kv == K) { int r = 0; for (int j = 0; j < k; ++j) r += keys[j] == K ? 1 : 0; sel = r < need; }
                if (sel) atomicOr(&maskw[k >> 5], 1u << (k & 31));
            }
            __syncthreads();
            if (tid < 64) MASK[(size_t)t * 64 + tid] = maskw[tid];
        }
        __syncthreads();
    }
}
__device__ __forceinline__ float lam_value(const Args& a) {
    float s1 = 0.f, s2 = 0.f;
    for (int i = 0; i < 64; ++i) { s1 = fmaf(a.in[I_LQ1][i], a.in[I_LK1][i], s1); s2 = fmaf(a.in[I_LQ2][i], a.in[I_LK2][i], s2); }
    return expf(s1) - expf(s2) + 0.2f;
}
__device__ __forceinline__ void naive_diffattn(const Args& a, unsigned char* lds) {
    bf16* P = (bf16*)(a.ws + WS_PROJ);
    const int tid = otid(), lane = tid & 63, wv = tid >> 6;
    float* lg = (float*)(lds + wv * 16384);
    float* qs = (float*)(lds + 131072 + wv * 512);
    const float lam = lam_value(a);
    const int gw = blockIdx.x * 8 + wv, NW = gridDim.x * 8;
    for (int it = gw; it < T * 4; it += NW) {
        const int t = it >> 2, h = it & 3, b = t >> 11, s = t & 2047, vis = ((s >> 6) + 1) << 6;
        const float sl = SLOPE_A[h] * LOG2E;
        { const bf16* qr = P + (size_t)t * NP + C_AQ + h * 128; qs[lane] = bf2f(qr[lane]); qs[lane + 64] = bf2f(qr[lane + 64]); }
        LDS_WAIT();
        float m0 = -1e30f, m1 = -1e30f;
        for (int k = lane; k < vis; k += 64) {
            asm volatile("" ::: "memory");
            const v4u* kr = (const v4u*)(P + (size_t)(b * SEQ + k) * NP + C_AK + h * 128); float d0 = 0.f, d1 = 0.f;
#pragma unroll
            for (int i = 0; i < 8; ++i) { const v4u v = kr[i]; const float* q = qs + 8 * i;
                d0 = fmaf(q[0], bflo(v.x), d0); d0 = fmaf(q[1], bfhi(v.x), d0); d0 = fmaf(q[2], bflo(v.y), d0); d0 = fmaf(q[3], bfhi(v.y), d0);
                d0 = fmaf(q[4], bflo(v.z), d0); d0 = fmaf(q[5], bfhi(v.z), d0); d0 = fmaf(q[6], bflo(v.w), d0); d0 = fmaf(q[7], bfhi(v.w), d0); }
#pragma unroll
            for (int i = 0; i < 8; ++i) { const v4u v = kr[8 + i]; const float* q = qs + 64 + 8 * i;
                d1 = fmaf(q[0], bflo(v.x), d1); d1 = fmaf(q[1], bfhi(v.x), d1); d1 = fmaf(q[2], bflo(v.y), d1); d1 = fmaf(q[3], bfhi(v.y), d1);
                d1 = fmaf(q[4], bflo(v.z), d1); d1 = fmaf(q[5], bfhi(v.z), d1); d1 = fmaf(q[6], bflo(v.w), d1); d1 = fmaf(q[7], bfhi(v.w), d1); }
            const float bias = sl * fabsf((float)(s - k));
            d0 -= bias; d1 -= bias; lg[k] = d0; lg[2048 + k] = d1; m0 = fmaxf(m0, d0); m1 = fmaxf(m1, d1);
        }
        m0 = wave_max(m0); m1 = wave_max(m1);
        float l0 = 0.f, l1 = 0.f;
        for (int k = lane; k < vis; k += 64) { const float p0 = exp2f(lg[k] - m0), p1 = exp2f(lg[2048 + k] - m1); lg[k] = p0; lg[2048 + k] = p1; l0 += p0; l1 += p1; }
        l0 = wave_sum(l0); l1 = wave_sum(l1);
        LDS_WAIT();
        float o00 = 0.f, o01 = 0.f, o10 = 0.f, o11 = 0.f;
        const bf16* vb = P + (size_t)(b * SEQ) * NP + C_AV + h * 128 + lane;
        for (int k = 0; k < vis; ++k) { const float v0 = bf2f(vb[(size_t)k * NP]), v1 = bf2f(vb[(size_t)k * NP + 64]); const float p0 = lg[k], p1 = lg[2048 + k];
            o00 = fmaf(p0, v0, o00); o01 = fmaf(p0, v1, o01); o10 = fmaf(p1, v0, o10); o11 = fmaf(p1, v1, o11); }
        const float r0 = 1.f / l0, r1 = lam / l1;
        const float y0 = o00 * r0 - o10 * r1, y1 = o01 * r0 - o11 * r1;
        const float ss = wave_sum(y0 * y0 + y1 * y1); const float rn = 0.8f / sqrtf(ss * (1.f / 128.f) + RMS_EPS);
        bf16* yo = P + (size_t)t * NP + C_AQ + h * 128;
        yo[lane] = (bf16)f2bf(y0 * rn * a.in[I_SUBLN][lane]); yo[lane + 64] = (bf16)f2bf(y1 * rn * a.in[I_SUBLN][lane + 64]);
        LDS_WAIT();
    }
}
__device__ __forceinline__ void naive_battn(const Args& a, unsigned char* lds) {
    bf16* P = (bf16*)(a.ws + WS_PROJ); const bf16* KV = (const bf16*)(a.ws + WS_KV); const unsigned* MASK = (const unsigned*)(a.ws + WS_MASK);
    const int tid = otid(), lane = tid & 63, wv = tid >> 6;
    float* lg = (float*)(lds + wv * 16384); float* qs = (float*)(lds + 131072 + wv * 512);
    const int gw = blockIdx.x * 8 + wv, NW = gridDim.x * 8;
    for (int it = gw; it < T * 8; it += NW) {
        const int t = it >> 3, h = it & 7, b = t >> 11, s = t & 2047, vis = ((s >> 6) + 1) << 6;
        const float sl = SLOPE_B[h] * LOG2E;
        qs[lane] = bf2f(P[(size_t)t * NP + C_BQ + h * 64 + lane]);
        LDS_WAIT();
        float m0 = -1e30f;
        for (int k = lane; k < vis; k += 64) {
            const unsigned mw = MASK[(size_t)t * 64 + (k >> 5)]; float d0 = -INFINITY;
            asm volatile("" ::: "memory");
            if ((mw >> (k & 31)) & 1u) {
                const v4u* kr = (const v4u*)(KV + (size_t)(b * SEQ + k) * 1024 + h * 64); d0 = 0.f;
#pragma unroll
                for (int i = 0; i < 8; ++i) { const v4u v = kr[i]; const float* q = qs + 8 * i;
                    d0 = fmaf(q[0], bflo(v.x), d0); d0 = fmaf(q[1], bfhi(v.x), d0); d0 = fmaf(q[2], bflo(v.y), d0); d0 = fmaf(q[3], bfhi(v.y), d0);
                    d0 = fmaf(q[4], bflo(v.z), d0); d0 = fmaf(q[5], bfhi(v.z), d0); d0 = fmaf(q[6], bflo(v.w), d0); d0 = fmaf(q[7], bfhi(v.w), d0); }
                d0 -= sl * fabsf((float)(s - k));
            }
            lg[k] = d0; m0 = fmaxf(m0, d0);
        }
        m0 = wave_max(m0);
        float l0 = 0.f;
        for (int k = lane; k < vis; k += 64) { const float p0 = exp2f(lg[k] - m0); lg[k] = p0; l0 += p0; }
        l0 = wave_sum(l0);
        LDS_WAIT();
        float o = 0.f; const bf16* vb = KV + (size_t)(b * SEQ) * 1024 + 512 + h * 64 + lane;
        for (int k = 0; k < vis; ++k) o = fmaf(lg[k], bf2f(vb[(size_t)k * 1024]), o);
        P[(size_t)t * NP + C_BQ + h * 64 + lane] = (bf16)f2bf(o / l0);
        LDS_WAIT();
    }
}
struct Route { int bucket; float wi, wj; int pad; };
__device__ __forceinline__ void p7_ln_route(const Args& a, unsigned char* lds) {
    unsigned char* ws = a.ws; const int tid = otid(), lane = tid & 63, wv = tid >> 6, blk = blockIdx.x;
    float* rw = (float*)lds; int* cnt = (int*)(lds + 81920);
    const float* RW = (const float*)(ws + WS_RW); const float* MOD = (const float*)(ws + WS_MOD);
    bf16* U2 = (bf16*)(ws + WS_U2); Route* RT = (Route*)(ws + WS_ROUTE2); int* PERM = (int*)(ws + WS_ROUTE2 + 512 * 1024); int* CNT = (int*)(ws + WS_ROUTE2 + 1024 * 1024);
    for (int i = tid; i < 20 * 1024 / 4; i += 512) ((f32x4*)rw)[i] = ((const f32x4*)RW)[i];
    if (tid < 24) cnt[tid] = 0;
    for (int i = blk * 512 + tid; i < MAXSLOT; i += gridDim.x * 512) PERM[i] = -1;
    __syncthreads();
    const int b = blk >> 4;
    const float* sh2 = MOD + b * 6144 + 3072; const float* sc2 = MOD + b * 6144 + 4096;
    for (int i = 0; i < 16; ++i) {
        const int t = blk * 128 + wv * 16 + i; float* row = a.out + (size_t)t * 1024;
        f32x4 v[4]; float sm = 0.f;
#pragma unroll
        for (int j = 0; j < 4; ++j) { v[j] = *(const f32x4*)(row + j * 256 + lane * 4); sm += (v[j].x + v[j].y) + (v[j].z + v[j].w); }
        const float mean = wave_sum(sm) * (1.f / 1024.f); float sq = 0.f;
#pragma unroll
        for (int j = 0; j < 4; ++j) { v[j] = v[j] - mean; sq += (v[j].x * v[j].x + v[j].y * v[j].y) + (v[j].z * v[j].z + v[j].w * v[j].w); }
        const float rstd = 1.f / sqrtf(wave_sum(sq) * (1.f / 1024.f) + LN_EPS);
        f32x4 u[4];
#pragma unroll
        for (int j = 0; j < 4; ++j) { const int c = j * 256 + lane * 4; const f32x4 g = *(const f32x4*)(a.in[I_LN1G] + c), bb = *(const f32x4*)(a.in[I_LN1B] + c);
            const f32x4 x1 = v[j] * rstd * g + bb; *(f32x4*)(row + c) = x1;
            const f32x4 s2 = *(const f32x4*)(sc2 + c), h2 = *(const f32x4*)(sh2 + c); u[j] = x1 * (1.f + s2) + h2;
            v2u o; o.x = pk2(u[j].x, u[j].y); o.y = pk2(u[j].z, u[j].w); *(v2u*)(U2 + (size_t)t * 1024 + c) = o; }
        float lgt[20];
#pragma unroll
        for (int c = 0; c < 20; ++c) { float p = 0.f;
#pragma unroll
            for (int j = 0; j < 4; ++j) { const f32x4 w = *(const f32x4*)(rw + c * 1024 + j * 256 + lane * 4); p += (u[j].x * w.x + u[j].y * w.y) + (u[j].z * w.z + u[j].w * w.w); }
            lgt[c] = wave_sum(p); }
#pragma unroll
        for (int c = 0; c < 4; ++c) lgt[c] += a.in[I_BGRP][c];
#pragma unroll
        for (int c = 0; c < 16; ++c) lgt[4 + c] += a.in[I_BER][c];
        int g = 0; float gm = lgt[0];
#pragma unroll
        for (int c = 1; c < 4; ++c) if (lgt[c] > gm) { gm = lgt[c]; g = c; }
        float gs = 0.f;
#pragma unroll
        for (int c = 0; c < 4; ++c) gs += __expf(lgt[c] - gm);
        const float gp = 1.f / gs;
        float el[4];
#pragma unroll
        for (int e = 0; e < 4; ++e) el[e] = g == 0 ? lgt[4 + e] : (g == 1 ? lgt[8 + e] : (g == 2 ? lgt[12 + e] : lgt[16 + e]));
        int i1 = 0; float v1 = el[0];
#pragma unroll
        for (int e = 1; e < 4; ++e) if (el[e] > v1) { v1 = el[e]; i1 = e; }
        int i2 = -1; float v2 = -INFINITY;
#pragma unroll
        for (int e = 0; e < 4; ++e) if (e != i1 && el[e] > v2) { v2 = el[e]; i2 = e; }
        const float e2 = __expf(v2 - v1); const float w1 = gp / (1.f + e2), w2 = gp * e2 / (1.f + e2);
        const int lo = i1 < i2 ? i1 : i2, hi = i1 < i2 ? i2 : i1; const float wlo = i1 < i2 ? w1 : w2, whi = i1 < i2 ? w2 : w1;
        const int pi = lo == 0 ? hi - 1 : (lo == 1 ? hi + 1 : 5);
        const int bucket = g * 6 + pi;
        if (lane == 0) { Route r; r.bucket = bucket; r.wi = wlo; r.wj = whi; r.pad = 0; RT[t] = r; atomicAdd(&cnt[bucket], 1); }
    }
    __syncthreads();
    if (tid < 24) CNT[blk * 24 + tid] = cnt[tid];
    __syncthreads();
}
__device__ __forceinline__ void p8_sort(const Args& a, unsigned char* lds) {
    unsigned char* ws = a.ws; const int tid = otid(), blk = blockIdx.x;
    const Route* RT = (const Route*)(ws + WS_ROUTE2); int* PERM = (int*)(ws + WS_ROUTE2 + 512 * 1024); const int* CNT = (const int*)(ws + WS_ROUTE2 + 1024 * 1024);
    int* BASES = (int*)(ws + WS_ROUTE2 + 1024 * 1024 + 32768); float* SLOTW = (float*)(ws + WS_ROUTE2 + 1280 * 1024);
    const bf16* U2 = (const bf16*)(ws + WS_U2); bf16* XS = (bf16*)(ws + WS_XS);
    int* tot = (int*)lds; int* pre = tot + 32; int* base = pre + 32; int* bk = base + 32; int* slot = bk + 128;
    if (tid < 24) { int s = 0, p = 0; for (int bb = 0; bb < (int)gridDim.x; ++bb) { const int c = CNT[bb * 24 + tid]; if (bb < blk) p += c; s += c; } tot[tid] = s; pre[tid] = p; }
    __syncthreads();
    if (tid == 0) { int acc = 0; for (int p = 0; p < 24; ++p) { base[p] = acc; acc += (tot[p] + 255) & ~255; } base[24] = acc;
        if (blk == 0) { for (int p = 0; p <= 24; ++p) BASES[p] = base[p]; } }
    if (tid < 128) bk[tid] = RT[blk * 128 + tid].bucket;
    __syncthreads();
    if (tid < 128) { const int p = bk[tid]; int r = 0; for (int j = 0; j < tid; ++j) r += bk[j] == p ? 1 : 0; const int s = base[p] + pre[p] + r; slot[tid] = s;
        const int t = blk * 128 + tid; PERM[s] = t; SLOTW[2 * s] = RT[t].wi; SLOTW[2 * s + 1] = RT[t].wj; }
    __syncthreads();
    for (int i = tid; i < 128 * 128; i += 512) { const int r = i >> 7, c = i & 127; ((v4u*)(XS + (size_t)slot[r] * 1024))[c] = ((const v4u*)(U2 + (size_t)(blk * 128 + r) * 1024))[c]; }
    __syncthreads();
}
__device__ __forceinline__ int bucket_of_slot(const int* BASES, int s) { int p = 0; for (int q = 1; q < 24; ++q) if (s >= BASES[q]) p = q; return p; }
__device__ __forceinline__ void pair_experts(int p, int& ei, int& ej) { const int g = p / 6, pi = p % 6; ei = 4 * g + (pi < 3 ? 0 : (pi < 5 ? 1 : 2)); ej = 4 * g + (pi < 3 ? pi + 1 : (pi < 5 ? pi - 1 : 3)); }
__device__ __forceinline__ void naive_moe1(const Args& a, unsigned char* lds) {
    unsigned char* ws = a.ws; const int tid = otid();
    const int* PERM = (const int*)(ws + WS_ROUTE2 + 512 * 1024); const int* BASES = (const int*)(ws + WS_ROUTE2 + 1024 * 1024 + 32768); const float* SLOTW = (const float*)(ws + WS_ROUTE2 + 1280 * 1024);
    const bf16* XS = (const bf16*)(ws + WS_XS); const bf16* W1 = (const bf16*)(ws + WS_W1); bf16* H = (bf16*)(ws + WS_H);
    float* xs = (float*)lds; const int nslot = BASES[24];
    for (int s = blockIdx.x; s < nslot; s += gridDim.x) {
        if (PERM[s] < 0) continue;
        const int p = bucket_of_slot(BASES, s); int ei, ej; pair_experts(p, ei, ej);
        __syncthreads();
        xs[tid] = bf2f(XS[(size_t)s * 1024 + tid]); xs[tid + 512] = bf2f(XS[(size_t)s * 1024 + 512 + tid]);
        __syncthreads();
        const int m = tid >> 8, c = tid & 255, e = m ? ej : ei; const int grow = (c >> 7) * 256 + (c & 127);
        const v4u* wg = (const v4u*)(W1 + ((size_t)e * 512 + grow) * 1024); const v4u* wu = (const v4u*)(W1 + ((size_t)e * 512 + grow + 128) * 1024);
        float dg = 0.f, du = 0.f;
        for (int i = 0; i < 128; ++i) { const v4u g = wg[i], u = wu[i]; const float* x = xs + 8 * i;
            dg = fmaf(x[0], bflo(g.x), dg); dg = fmaf(x[1], bfhi(g.x), dg); dg = fmaf(x[2], bflo(g.y), dg); dg = fmaf(x[3], bfhi(g.y), dg);
            dg = fmaf(x[4], bflo(g.z), dg); dg = fmaf(x[5], bfhi(g.z), dg); dg = fmaf(x[6], bflo(g.w), dg); dg = fmaf(x[7], bfhi(g.w), dg);
            du = fmaf(x[0], bflo(u.x), du); du = fmaf(x[1], bfhi(u.x), du); du = fmaf(x[2], bflo(u.y), du); du = fmaf(x[3], bfhi(u.y), du);
            du = fmaf(x[4], bflo(u.z), du); du = fmaf(x[5], bfhi(u.z), du); du = fmaf(x[6], bflo(u.w), du); du = fmaf(x[7], bfhi(u.w), du); }
        const float hv = dg / (1.f + __expf(-dg)) * du * SLOTW[2 * s + m];
        H[(size_t)s * 512 + tid] = (bf16)f2bf(hv);
    }
    __syncthreads();
}
__device__ __forceinline__ void naive_moe2(const Args& a, unsigned char* lds) {
    unsigned char* ws = a.ws; const int tid = otid();
    const int* PERM = (const int*)(ws + WS_ROUTE2 + 512 * 1024); const int* BASES = (const int*)(ws + WS_ROUTE2 + 1024 * 1024 + 32768);
    const bf16* W2P = (const bf16*)(ws + WS_W2P); const bf16* H = (const bf16*)(ws + WS_H); const float* MOD = (const float*)(ws + WS_MOD);
    float* hs = (float*)lds; const int nslot = BASES[24];
    for (int s = blockIdx.x; s < nslot; s += gridDim.x) {
        const int t = PERM[s]; if (t < 0) continue;
        const int p = bucket_of_slot(BASES, s);
        __syncthreads();
        hs[tid] = bf2f(H[(size_t)s * 512 + tid]);
        __syncthreads();
        for (int j = tid; j < 1024; j += 512) {
            const v4u* w = (const v4u*)(W2P + ((size_t)p * 1024 + j) * 512); float y = 0.f;
            for (int i = 0; i < 64; ++i) { const v4u g = w[i]; const float* x = hs + 8 * i;
                y = fmaf(x[0], bflo(g.x), y); y = fmaf(x[1], bfhi(g.x), y); y = fmaf(x[2], bflo(g.y), y); y = fmaf(x[3], bfhi(g.y), y);
                y = fmaf(x[4], bflo(g.z), y); y = fmaf(x[5], bfhi(g.z), y); y = fmaf(x[6], bflo(g.w), y); y = fmaf(x[7], bfhi(g.w), y); }
            const size_t o = (size_t)t * 1024 + j; a.out[o] = ALPHA * a.out[o] + MOD[(t >> 11) * 6144 + 5120 + j] * y;
        }
    }
    __syncthreads();
}
__device__ __forceinline__ void p11_ln(const Args& a) {
    const int tid = otid(); const int lane = tid & 63, gw = blockIdx.x * 8 + (tid >> 6), NW = gridDim.x * 8;
    for (int t = gw; t < T; t += NW) {
        float* row = a.out + (size_t)t * 1024; f32x4 v[4]; float sm = 0.f;
#pragma unroll
        for (int j = 0; j < 4; ++j) { v[j] = *(const f32x4*)(row + j * 256 + lane * 4); sm += (v[j].x + v[j].y) + (v[j].z + v[j].w); }
        const float mean = wave_sum(sm) * (1.f / 1024.f); float sq = 0.f;
#pragma unroll
        for (int j = 0; j < 4; ++j) { v[j] = v[j] - mean; sq += (v[j].x * v[j].x + v[j].y * v[j].y) + (v[j].z * v[j].z + v[j].w * v[j].w); }
        const float rstd = 1.f / sqrtf(wave_sum(sq) * (1.f / 1024.f) + LN_EPS);
#pragma unroll
        for (int j = 0; j < 4; ++j) { const int c = j * 256 + lane * 4; const f32x4 g = *(const f32x4*)(a.in[I_LN2G] + c), bb = *(const f32x4*)(a.in[I_LN2B] + c); *(f32x4*)(row + c) = v[j] * rstd * g + bb; }
    }
}

namespace pg8 {
#define PG8_LAS __attribute__((address_space(3)))
typedef unsigned short bf16_t;
typedef short bf16x8 __attribute__((ext_vector_type(8)));
typedef float f32x4 __attribute__((ext_vector_type(4)));
typedef unsigned u32x4 __attribute__((ext_vector_type(4)));
constexpr int BM = 256, BK = 64, HALF = 128, HTB = HALF * BK * 2  , STAGE_BYTES = 8 * HTB, NXCD = 8, WGM = 8;

__host__ __device__ __forceinline__ int lds_byte(int r, int c) { const int st = (r >> 4) * 2 + (c >> 5), rr = r & 15, cc = c & 31, ob = rr * 64 + cc * 2; return st * 1024 + (ob ^ (((ob >> 9) & 1) << 5)); }
__host__ __device__ __forceinline__ void stage_rc(int b, int& R, int& C) { const int st = b / 1024, sb = b % 1024, swz = sb ^ (((sb >> 9) & 1) << 5); R = (st >> 1) * 16 + swz / 64; C = (st & 1) * 32 + (swz % 64) / 2; }
__host__ __device__ __forceinline__ int perm32(int rho) { const int n = rho >> 4, i = rho & 15; return 8 * (i >> 2) + 4 * n + (i & 3); }

struct Unit { int pm, pn; };
struct Gemm { const bf16_t* A; const bf16_t* Bt; int M, N, K, lda, ldb; };

struct StaticOrder {
    int nM, nN, nwg, G, c;
    __host__ __device__ void init(int M, int N, int G_, int c_) { nM = M / BM; nN = N / BM; nwg = nM * nN; G = G_; c = c_; }
    __host__ __device__ bool next(int i, Unit& u) const {
        const long L = (long)i * G + c; if (L >= nwg) return false;
        int wgid = (int)L; { const int q = nwg / NXCD, r = nwg % NXCD, xcd = wgid % NXCD, off = wgid / NXCD; wgid = (xcd < r ? xcd * (q + 1) : r * (q + 1) + (xcd - r) * q) + off; }
        const int nig = WGM * nN, gid = wgid / nig, fm = gid * WGM, gsz = (nM - fm) < WGM ? (nM - fm) : WGM;
        u.pm = fm + ((wgid % nig) % gsz); u.pn = (wgid % nig) / gsz; return true;
    }
    __device__ __forceinline__ void a_ready(const Unit&) const {}
    __device__ __forceinline__ void done(const Unit&) const {}
    __device__ __forceinline__ const char* bbase(const Gemm& g, const Unit& u) const { return (const char*)g.Bt + (size_t)u.pn * ((size_t)BM * g.ldb * 2); }
};

template <class Epi, class Sched, bool ALIGN_EPI, bool SP2, int KK, int LDA, int LDB>
__device__ __forceinline__ void gemm_phase(PG8_LAS unsigned char* lds, const Gemm g, const Sched& S, const Epi& E) {
    int tid_ = threadIdx.x; asm volatile("" : "+v"(tid_));
    const int tid = tid_, wid = __builtin_amdgcn_readfirstlane(tid >> 6), lane = tid & 63, wr = wid >> 2, wc = wid & 3, fr = lane & 15, fq = lane >> 4;
    constexpr int K = KK, nt = K / BK;
    unsigned voffA[2], voffB[2];
#pragma unroll
    for (int i = 0; i < 2; ++i) { int R, C; stage_rc(tid * 16 + i * 8192, R, C); const int Rb = Epi::PERM ? ((R & ~31) + perm32(R & 31)) : R;
        voffA[i] = (unsigned)(R * LDA + C) * 2u; voffB[i] = (unsigned)(Rb * LDB + C) * 2u; }
    constexpr size_t kstep = (size_t)(BK * 2);
    constexpr size_t hstepA = (size_t)HALF * LDA * 2, hstepB = (size_t)HALF * LDB * 2;
    constexpr size_t tstepA = 2 * hstepA;
    const unsigned ldsw = (unsigned)wid * 1024u;
    const int aoff = lds_byte(wr * 64 + fr, fq * 8), boff = lds_byte(wc * 32 + fr, fq * 8);
#define PG8_SA(b, h) (((b) * 2 + (h)) * HTB)
#define PG8_SB(b, h) ((4 + (b) * 2 + (h)) * HTB)
#define PG8_STAGE(bufoff, gbase, voff) do { _Pragma("unroll") for (int _i = 0; _i < 2; ++_i) \
        __builtin_amdgcn_global_load_lds((const unsigned*)((const char*)(gbase) + (voff)[_i]), (PG8_LAS unsigned*)(lds + (bufoff) + ldsw + _i * 8192), 16, 0, 0); } while (0)
#define PG8_LDA(dst, b, h) do { _Pragma("unroll") for (int m = 0; m < 4; ++m) _Pragma("unroll") for (int k = 0; k < 2; ++k) dst[m][k] = *(const PG8_LAS bf16x8*)(lds + PG8_SA(b, h) + aoff + m * 2048 + k * 1024); } while (0)
#define PG8_LDB(dst, b, h) do { _Pragma("unroll") for (int n = 0; n < 2; ++n) _Pragma("unroll") for (int k = 0; k < 2; ++k) dst[n][k] = *(const PG8_LAS bf16x8*)(lds + PG8_SB(b, h) + boff + n * 2048 + k * 1024); } while (0)
#define PG8_MMA(ai, bj, At, Bt) do { __builtin_amdgcn_s_setprio(1); _Pragma("unroll") for (int m = 0; m < 4; ++m) _Pragma("unroll") for (int n = 0; n < 2; ++n) _Pragma("unroll") for (int k = 0; k < 2; ++k) \
        acc[ai][bj][m][n] = __builtin_amdgcn_mfma_f32_16x16x32_bf16(Bt[n][k], At[m][k], acc[ai][bj][m][n], 0, 0, 0); __builtin_amdgcn_s_setprio(0); } while (0)
#define PG8_WAIT_V(n) asm volatile("s_waitcnt vmcnt(" #n ")" ::: "memory")
#define PG8_WAIT_L(n) asm volatile("s_waitcnt lgkmcnt(" #n ")" ::: "memory")
#define PG8_BAR __builtin_amdgcn_s_barrier()
#define PG8_SCHED __builtin_amdgcn_sched_barrier(0)
    Unit cur, nxt; int ui = 0;
    if (!S.next(0, cur)) return;
    f32x4 acc[2][2][4][2];
#pragma unroll
    for (int a = 0; a < 2; ++a)
#pragma unroll
        for (int b = 0; b < 2; ++b)
#pragma unroll
            for (int m = 0; m < 4; ++m)
#pragma unroll
                for (int n = 0; n < 2; ++n) acc[a][b][m][n] = (f32x4){0.f, 0.f, 0.f, 0.f};
    bf16x8 At[4][2], B0[2][2], B1[2][2];
    const char* cA = (const char*)g.A + (size_t)cur.pm * tstepA; const char* cB = S.bbase(g, cur);
    S.a_ready(cur);
    if constexpr (SP2) {
        PG8_STAGE(PG8_SB(0, 0), cB, voffB); PG8_STAGE(PG8_SB(0, 1), cB + hstepB, voffB); PG8_STAGE(PG8_SA(0, 0), cA, voffA); PG8_STAGE(PG8_SA(0, 1), cA + hstepA, voffA);
        if (wr == 1) PG8_BAR;
        PG8_WAIT_V(2); PG8_BAR;
        PG8_STAGE(PG8_SB(1, 0), cB + kstep, voffB); PG8_STAGE(PG8_SA(1, 0), cA + kstep, voffA); PG8_STAGE(PG8_SB(1, 1), cB + hstepB + kstep, voffB);
        PG8_WAIT_V(6); PG8_BAR;
    } else {
        PG8_STAGE(PG8_SB(0, 0), cB, voffB); PG8_STAGE(PG8_SA(0, 0), cA, voffA); PG8_STAGE(PG8_SB(0, 1), cB + hstepB, voffB); PG8_STAGE(PG8_SA(0, 1), cA + hstepA, voffA);
        if (wr == 1) PG8_BAR;
        PG8_WAIT_V(4); PG8_BAR;
        PG8_STAGE(PG8_SB(1, 0), cB + kstep, voffB); PG8_STAGE(PG8_SA(1, 0), cA + kstep, voffA); PG8_STAGE(PG8_SB(1, 1), cB + hstepB + kstep, voffB);
        PG8_WAIT_V(6); PG8_BAR;
    }
    for (;;) {
        const bool has_next = S.next(ui + 1, nxt);
        const char* nA = has_next ? (const char*)g.A + (size_t)nxt.pm * tstepA : cA; const char* nB = has_next ? S.bbase(g, nxt) : cB;
        for (int t = 0; t < nt; t += 2) {
            const bool last = (t == nt - 2);
            const char* a1 = cA + (size_t)(t + 1) * kstep;
            const char* a2 = last ? nA : cA + (size_t)(t + 2) * kstep; const char* b2 = last ? nB : cB + (size_t)(t + 2) * kstep;
            const char* a3 = a2 + kstep; const char* b3 = b2 + kstep;
            if (last && has_next) S.a_ready(nxt);
            if constexpr (SP2) {
            PG8_LDB(B0, 0, 0); PG8_LDB(B1, 0, 1); PG8_SCHED; PG8_LDA(At, 0, 0); PG8_STAGE(PG8_SA(1, 1), a1 + hstepA, voffA);
            PG8_WAIT_V(8); PG8_WAIT_L(0); PG8_BAR; PG8_MMA(0, 0, At, B0); PG8_MMA(0, 1, At, B1); PG8_BAR; PG8_SCHED;
            PG8_LDA(At, 0, 1); PG8_STAGE(PG8_SB(0, 0), b2, voffB); PG8_STAGE(PG8_SB(0, 1), b2 + hstepB, voffB); PG8_STAGE(PG8_SA(0, 0), a2, voffA);
            PG8_WAIT_V(8); PG8_WAIT_L(0); PG8_BAR; PG8_MMA(1, 0, At, B0); PG8_MMA(1, 1, At, B1); PG8_BAR; PG8_SCHED;
            PG8_LDB(B0, 1, 0); PG8_LDB(B1, 1, 1); PG8_SCHED; PG8_LDA(At, 1, 0); PG8_STAGE(PG8_SA(0, 1), a2 + hstepA, voffA);
            PG8_WAIT_V(8); PG8_WAIT_L(0); PG8_BAR; PG8_MMA(0, 0, At, B0); PG8_MMA(0, 1, At, B1); PG8_BAR; PG8_SCHED;
            PG8_LDA(At, 1, 1); PG8_STAGE(PG8_SB(1, 0), b3, voffB); PG8_STAGE(PG8_SB(1, 1), b3 + hstepB, voffB); PG8_STAGE(PG8_SA(1, 0), a3, voffA);
            PG8_WAIT_V(8); PG8_WAIT_L(0); PG8_BAR; PG8_MMA(1, 0, At, B0); PG8_MMA(1, 1, At, B1); PG8_BAR; PG8_SCHED;
            } else {
            PG8_LDB(B0, 0, 0); PG8_SCHED; PG8_LDA(At, 0, 0); PG8_STAGE(PG8_SA(1, 1), a1 + hstepA, voffA);
            PG8_WAIT_L(8); PG8_BAR; PG8_WAIT_L(0); PG8_MMA(0, 0, At, B0); PG8_BAR; PG8_SCHED;
            PG8_LDB(B1, 0, 1); PG8_STAGE(PG8_SB(0, 0), b2, voffB);
            PG8_BAR; PG8_WAIT_L(0); PG8_MMA(0, 1, At, B1); PG8_BAR;
            PG8_LDA(At, 0, 1); PG8_STAGE(PG8_SA(0, 0), a2, voffA);
            PG8_BAR; PG8_WAIT_L(0); PG8_MMA(1, 0, At, B0); PG8_BAR; PG8_SCHED;
            PG8_STAGE(PG8_SB(0, 1), b2 + hstepB, voffB);
            PG8_WAIT_V(6); PG8_BAR; PG8_MMA(1, 1, At, B1); PG8_BAR;
            PG8_LDB(B0, 1, 0); PG8_SCHED; PG8_LDA(At, 1, 0); PG8_STAGE(PG8_SA(0, 1), a2 + hstepA, voffA);
            PG8_WAIT_L(8); PG8_BAR; PG8_WAIT_L(0); PG8_MMA(0, 0, At, B0); PG8_BAR; PG8_SCHED;
            PG8_LDB(B1, 1, 1); PG8_STAGE(PG8_SB(1, 0), b3, voffB);
            PG8_BAR; PG8_WAIT_L(0); PG8_MMA(0, 1, At, B1); PG8_BAR;
            PG8_LDA(At, 1, 1); PG8_STAGE(PG8_SA(1, 0), a3, voffA);
            PG8_BAR; PG8_WAIT_L(0); PG8_MMA(1, 0, At, B0); PG8_BAR; PG8_SCHED;
            PG8_STAGE(PG8_SB(1, 1), b3 + hstepB, voffB);
            PG8_WAIT_V(6); PG8_BAR; PG8_MMA(1, 1, At, B1); PG8_BAR;
            }
        }
        if constexpr (ALIGN_EPI) { if (wr == 0) PG8_BAR; }
        if constexpr (!Epi::AFTER_DRAIN) { E(acc, cur, wr, wc, fr, fq); S.done(cur); }
        if (!has_next) break;
#pragma unroll
        for (int a = 0; a < 2; ++a)
#pragma unroll
            for (int b = 0; b < 2; ++b)
#pragma unroll
                for (int m = 0; m < 4; ++m)
#pragma unroll
                    for (int n = 0; n < 2; ++n) acc[a][b][m][n] = (f32x4){0.f, 0.f, 0.f, 0.f};
        cur = nxt; cA = nA; cB = nB; ++ui;
        if constexpr (ALIGN_EPI) { if (wr == 1) PG8_BAR; }
    }
    PG8_WAIT_V(0);
    if constexpr (!ALIGN_EPI) { if (wr == 0) PG8_BAR; }
    PG8_BAR;
    if constexpr (Epi::AFTER_DRAIN) { E.fused(acc, cur, wr, wc, fr, fq, lds, wid, lane); S.done(cur); }
#undef PG8_SA
#undef PG8_SB
#undef PG8_STAGE
#undef PG8_LDA
#undef PG8_LDB
#undef PG8_MMA
#undef PG8_WAIT_V
#undef PG8_WAIT_L
#undef PG8_BAR
#undef PG8_SCHED
}

__device__ __forceinline__ unsigned cvt_pk_bf16(float lo, float hi) { unsigned r; asm volatile("v_cvt_pk_bf16_f32 %0, %1, %2" : "=v"(r) : "v"(lo), "v"(hi)); return r; }
__device__ __forceinline__ float blo(unsigned w) { return __uint_as_float(w << 16); }
__device__ __forceinline__ float bhi(unsigned w) { return __uint_as_float(w & 0xffff0000u); }
__device__ __forceinline__ float sigm(float v) { return __builtin_amdgcn_rcpf(1.f + __builtin_amdgcn_exp2f(-1.4426950408889634f * v)); }
struct EpiProjF {
    static constexpr bool PERM = true, AFTER_DRAIN = false;
    bf16_t* O; int ldc; float qs;
    __device__ __forceinline__ void operator()(const f32x4 (&acc)[2][2][4][2], const Unit& u, int wr, int wc, int fr, int fq) const {
        const int row0 = u.pm * BM + wr * 64 + fr, col0 = u.pn * BM + wc * 32 + 8 * fq;
        const int mode = (u.pn < 2 || u.pn == 6 || u.pn == 7) ? 1 : (u.pn >= 11 ? 2 : 0);
#pragma unroll
        for (int ai = 0; ai < 2; ++ai)
#pragma unroll
            for (int m = 0; m < 4; ++m) { bf16_t* rowp = O + (size_t)(row0 + ai * HALF + m * 16) * ldc + col0;
#pragma unroll
                for (int bj = 0; bj < 2; ++bj) { f32x4 v0 = acc[ai][bj][m][0], v1 = acc[ai][bj][m][1];
                    if (mode == 1) { v0 = v0 * qs; v1 = v1 * qs; }
                    else if (mode == 2) { v0 = (f32x4){sigm(v0[0]), sigm(v0[1]), sigm(v0[2]), sigm(v0[3])}; v1 = (f32x4){sigm(v1[0]), sigm(v1[1]), sigm(v1[2]), sigm(v1[3])}; }
                    u32x4 w; w.x = cvt_pk_bf16(v0[0], v0[1]); w.y = cvt_pk_bf16(v0[2], v0[3]); w.z = cvt_pk_bf16(v1[0], v1[1]); w.w = cvt_pk_bf16(v1[2], v1[3]);
                    *(u32x4*)(rowp + bj * HALF) = w; } }
    }
};
struct EpiRowScale {
    static constexpr bool PERM = true, AFTER_DRAIN = false;
    bf16_t* O; int ldc; const float* rs;
    __device__ __forceinline__ void operator()(const f32x4 (&acc)[2][2][4][2], const Unit& u, int wr, int wc, int fr, int fq) const {
        const int row0 = u.pm * BM + wr * 64 + fr, col0 = u.pn * BM + wc * 32 + 8 * fq;
#pragma unroll
        for (int ai = 0; ai < 2; ++ai)
#pragma unroll
            for (int m = 0; m < 4; ++m) { const int r = row0 + ai * HALF + m * 16; const float s = rs[r]; bf16_t* rowp = O + (size_t)r * ldc + col0;
#pragma unroll
                for (int bj = 0; bj < 2; ++bj) { const f32x4 v0 = acc[ai][bj][m][0] * s, v1 = acc[ai][bj][m][1] * s;
                    u32x4 w; w.x = cvt_pk_bf16(v0[0], v0[1]); w.y = cvt_pk_bf16(v0[2], v0[3]); w.z = cvt_pk_bf16(v1[0], v1[1]); w.w = cvt_pk_bf16(v1[2], v1[3]);
                    *(u32x4*)(rowp + bj * HALF) = w; } }
    }
};
template <bool FIRST> struct EpiMix {
    static constexpr bool PERM = true, AFTER_DRAIN = false;
    bf16_t* O; int ldc; const bf16_t* G; int ldg;
    __device__ __forceinline__ void operator()(const f32x4 (&acc)[2][2][4][2], const Unit& u, int wr, int wc, int fr, int fq) const {
        const int row0 = u.pm * BM + wr * 64 + fr, col0 = u.pn * BM + wc * 32 + 8 * fq;
#pragma unroll
        for (int ai = 0; ai < 2; ++ai)
#pragma unroll
            for (int m = 0; m < 4; ++m) { const int r = row0 + ai * HALF + m * 16; bf16_t* rowp = O + (size_t)r * ldc + col0; const bf16_t* gp = G + (size_t)r * ldg + col0;
#pragma unroll
                for (int bj = 0; bj < 2; ++bj) { const u32x4 gw = *(const u32x4*)(gp + bj * HALF); f32x4 v0 = acc[ai][bj][m][0], v1 = acc[ai][bj][m][1];
                    v0 = v0 * (f32x4){blo(gw.x), bhi(gw.x), blo(gw.y), bhi(gw.y)}; v1 = v1 * (f32x4){blo(gw.z), bhi(gw.z), blo(gw.w), bhi(gw.w)};
                    if (!FIRST) { const u32x4 ow = *(const u32x4*)(rowp + bj * HALF); v0 = v0 + (f32x4){blo(ow.x), bhi(ow.x), blo(ow.y), bhi(ow.y)}; v1 = v1 + (f32x4){blo(ow.z), bhi(ow.z), blo(ow.w), bhi(ow.w)}; }
                    u32x4 w; w.x = cvt_pk_bf16(v0[0], v0[1]); w.y = cvt_pk_bf16(v0[2], v0[3]); w.z = cvt_pk_bf16(v1[0], v1[1]); w.w = cvt_pk_bf16(v1[2], v1[3]);
                    *(u32x4*)(rowp + bj * HALF) = w; } }
    }
};
struct EpiResGate {
    static constexpr bool PERM = false, AFTER_DRAIN = false;
    float* out; const float* x; const float* gate; int gstride; float alpha;
    __device__ __forceinline__ void operator()(const f32x4 (&acc)[2][2][4][2], const Unit& u, int wr, int wc, int fr, int fq) const {
        const int col0 = u.pn * BM + wc * 32 + 4 * fq; const float* gb = gate + (size_t)((u.pm * BM) >> 11) * gstride + col0;
        f32x4 gv[2][2];
#pragma unroll
        for (int bj = 0; bj < 2; ++bj)
#pragma unroll
            for (int n = 0; n < 2; ++n) gv[bj][n] = *(const f32x4*)(gb + bj * HALF + n * 16);
#pragma unroll
        for (int ai = 0; ai < 2; ++ai)
#pragma unroll
            for (int m = 0; m < 4; ++m) { const size_t off = (size_t)(u.pm * BM + ai * HALF + wr * 64 + m * 16 + fr) * 1024 + col0;
#pragma unroll
                for (int bj = 0; bj < 2; ++bj)
#pragma unroll
                    for (int n = 0; n < 2; ++n) { const f32x4 xv = *(const f32x4*)(x + off + bj * HALF + n * 16); *(f32x4*)(out + off + bj * HALF + n * 16) = xv * alpha + gv[bj][n] * acc[ai][bj][m][n]; } }
    }
};
__device__ __forceinline__ int tile_bucket(const int* BASES, int pm) { const int s = pm * BM; int p = 0;
#pragma unroll
    for (int q = 1; q < 24; ++q) p = (s >= BASES[q]) ? q : p;
    return p; }
struct MoeOrder1 {
    StaticOrder so; const int* BASES; const bf16_t* W1;
    __device__ __forceinline__ bool next(int i, Unit& u) const { return so.next(i, u); }
    __device__ __forceinline__ void a_ready(const Unit&) const {}
    __device__ __forceinline__ void done(const Unit&) const {}
    __device__ __forceinline__ const char* bbase(const Gemm&, const Unit& u) const {
        const int p = tile_bucket(BASES, u.pm), g = p / 6, pi = p % 6;
        const int ei = 4 * g + (pi < 3 ? 0 : (pi < 5 ? 1 : 2)), ej = 4 * g + (pi < 3 ? pi + 1 : (pi < 5 ? pi - 1 : 3));
        const int e = u.pn < 2 ? ei : ej;
        return (const char*)(W1 + ((size_t)e * 512 + (size_t)(u.pn & 1) * 256) * 1024); }
};
struct MoeOrder2 {
    StaticOrder so; const int* BASES; const bf16_t* W2P;
    __device__ __forceinline__ bool next(int i, Unit& u) const { return so.next(i, u); }
    __device__ __forceinline__ void a_ready(const Unit&) const {}
    __device__ __forceinline__ void done(const Unit&) const {}
    __device__ __forceinline__ const char* bbase(const Gemm&, const Unit& u) const {
        const int p = tile_bucket(BASES, u.pm); return (const char*)(W2P + ((size_t)p * 1024 + (size_t)u.pn * 256) * 512); }
};
struct EpiMoe1 {
    static constexpr bool PERM = true, AFTER_DRAIN = false;
    bf16_t* H; const float* SLOTW;
    __device__ __forceinline__ void operator()(const f32x4 (&acc)[2][2][4][2], const Unit& u, int wr, int wc, int fr, int fq) const {
        const int row0 = u.pm * BM + wr * 64 + fr, col0 = (u.pn >> 1) * 256 + (u.pn & 1) * 128 + wc * 32 + 8 * fq, wsel = u.pn >> 1;
#pragma unroll
        for (int ai = 0; ai < 2; ++ai)
#pragma unroll
            for (int m = 0; m < 4; ++m) { const int r = row0 + ai * HALF + m * 16; const float w = SLOTW[2 * r + wsel];
                float o[8];
#pragma unroll
                for (int n = 0; n < 2; ++n)
#pragma unroll
                    for (int i = 0; i < 4; ++i) { const float g = acc[ai][0][m][n][i], up = acc[ai][1][m][n][i]; o[4 * n + i] = g * sigm(g) * up * w; }
                u32x4 wv; wv.x = cvt_pk_bf16(o[0], o[1]); wv.y = cvt_pk_bf16(o[2], o[3]); wv.z = cvt_pk_bf16(o[4], o[5]); wv.w = cvt_pk_bf16(o[6], o[7]);
                *(u32x4*)(H + (size_t)r * 512 + col0) = wv; }
    }
};
struct EpiMoe2 {
    static constexpr bool PERM = false, AFTER_DRAIN = false;
    float* out; const int* PERMV; const float* gate; int gstride; float alpha;
    __device__ __forceinline__ void operator()(const f32x4 (&acc)[2][2][4][2], const Unit& u, int wr, int wc, int fr, int fq) const {
        const int col0 = u.pn * BM + wc * 32 + 4 * fq;
#pragma unroll
        for (int ai = 0; ai < 2; ++ai)
#pragma unroll
            for (int m = 0; m < 4; ++m) { const int t = PERMV[u.pm * BM + ai * HALF + wr * 64 + m * 16 + fr];
                if (t >= 0) { const size_t off = (size_t)t * 1024 + col0; const float* gb = gate + (size_t)(t >> 11) * gstride + col0;
#pragma unroll
                    for (int bj = 0; bj < 2; ++bj)
#pragma unroll
                        for (int n = 0; n < 2; ++n) { const f32x4 xv = *(const f32x4*)(out + off + bj * HALF + n * 16); const f32x4 gv = *(const f32x4*)(gb + bj * HALF + n * 16);
                            *(f32x4*)(out + off + bj * HALF + n * 16) = xv * alpha + gv * acc[ai][bj][m][n]; } } }
    }
};
}


namespace att {
typedef short bf16x8 __attribute__((ext_vector_type(8)));
typedef short s16x4 __attribute__((ext_vector_type(4)));
typedef short v4i16_t __attribute__((ext_vector_type(4)));
typedef float f32x16 __attribute__((ext_vector_type(16)));
typedef unsigned u32x4 __attribute__((ext_vector_type(4)));
typedef float f32x2_t __attribute__((ext_vector_type(2))); typedef __bf16 bf16x2_t __attribute__((ext_vector_type(2)));
typedef LAS const char* lds_cptr;
constexpr float THR = 8.f;
__device__ __forceinline__ unsigned cvtpk(float lo, float hi) { f32x2_t v = {lo, hi}; bf16x2_t b = __builtin_convertvector(v, bf16x2_t); return __builtin_bit_cast(unsigned, b); }
__device__ __forceinline__ s16x4 vtr(lds_cptr p) { return __builtin_bit_cast(s16x4, __builtin_amdgcn_ds_read_tr16_b64_v4i16((LAS v4i16_t*)p)); }
__device__ __forceinline__ float swapmax(float m) { auto rr = __builtin_amdgcn_permlane32_swap(__float_as_uint(m), __float_as_uint(m), false, false); return fmaxf(__uint_as_float(rr[0]), __uint_as_float(rr[1])); }
__device__ __forceinline__ float swapsum(float m) { auto rr = __builtin_amdgcn_permlane32_swap(__float_as_uint(m), __float_as_uint(m), false, false); return __uint_as_float(rr[0]) + __uint_as_float(rr[1]); }
__device__ __forceinline__ void glds16(const void* g, LAS unsigned char* l) { __builtin_amdgcn_global_load_lds((const unsigned*)g, (LAS unsigned*)l, 16, 0, 0); }
__device__ __forceinline__ void qkt(f32x16& p0, f32x16& p1, lds_cptr kslot, const bf16x8 (&qr)[4], int r32, int hi) {
    lds_cptr kb = kslot + hi * 1024 + r32 * 16;
#pragma unroll
    for (int d0 = 0; d0 < 4; ++d0) {
        const bf16x8 b0 = *(const LAS bf16x8*)(kb + d0 * 2048), b1 = *(const LAS bf16x8*)(kb + d0 * 2048 + 512);
        p0 = __builtin_amdgcn_mfma_f32_32x32x16_bf16(b0, qr[d0], p0, 0, 0, 0);
        p1 = __builtin_amdgcn_mfma_f32_32x32x16_bf16(b1, qr[d0], p1, 0, 0, 0);
    }
}
template <int ND> __device__ __forceinline__ void pv(f32x16 (&o)[ND], lds_cptr vb, bf16x8 pa0, bf16x8 pa1, bf16x8 pa2, bf16x8 pa3) {
#pragma unroll
    for (int d0 = 0; d0 < ND; ++d0) {
        s16x4 lo[4], hi[4];
#pragma unroll
        for (int ks = 0; ks < 4; ++ks) { lo[ks] = vtr(vb + d0 * 4096 + ks * 1024); hi[ks] = vtr(vb + d0 * 4096 + ks * 1024 + 512); }
#define ATT_PK(k) (bf16x8){lo[k][0], lo[k][1], lo[k][2], lo[k][3], hi[k][0], hi[k][1], hi[k][2], hi[k][3]}
        o[d0] = __builtin_amdgcn_mfma_f32_32x32x16_bf16(pa0, ATT_PK(0), o[d0], 0, 0, 0);
        o[d0] = __builtin_amdgcn_mfma_f32_32x32x16_bf16(pa1, ATT_PK(1), o[d0], 0, 0, 0);
        o[d0] = __builtin_amdgcn_mfma_f32_32x32x16_bf16(pa2, ATT_PK(2), o[d0], 0, 0, 0);
        o[d0] = __builtin_amdgcn_mfma_f32_32x32x16_bf16(pa3, ATT_PK(3), o[d0], 0, 0, 0);
#undef ATT_PK
    }
}
__device__ __forceinline__ void alibi_cin(f32x16& p0, f32x16& p1, float qrel, float sl2, float m, bool past) {
    if (past) { const float bm = -sl2 * qrel - m;
#pragma unroll
        for (int r = 0; r < 16; ++r) { const float c = (float)((r & 3) + 8 * (r >> 2)); p0[r] = fmaf(sl2, c, bm); p1[r] = fmaf(sl2, c + 32.f, bm); }
    } else {
#pragma unroll
        for (int r = 0; r < 16; ++r) { const float c = (float)((r & 3) + 8 * (r >> 2)); p0[r] = -sl2 * fabsf(qrel - c) - m; p1[r] = -sl2 * fabsf(qrel - 32.f - c) - m; }
    }
}
template <int ND> __device__ __forceinline__ void softmax_step(f32x16& p0, f32x16& p1, float& m, float& l, f32x16 (&o)[ND], LAS float* wsf, int r32, int hi, bool first) {
    float mx = fmaxf(p0[0], p1[0]);
#pragma unroll
    for (int r = 1; r < 16; ++r) mx = fmaxf(mx, fmaxf(p0[r], p1[r]));
    mx = swapmax(mx);
    if (first) { const float dl = (mx == -INFINITY) ? 0.f : mx; m += dl;
#pragma unroll
        for (int r = 0; r < 16; ++r) { p0[r] -= dl; p1[r] -= dl; }
    } else if (__any(mx > THR)) {
        const float dl = fmaxf(mx, 0.f); m += dl;
#pragma unroll
        for (int r = 0; r < 16; ++r) { p0[r] -= dl; p1[r] -= dl; }
        const float f = __builtin_amdgcn_exp2f(-dl); l *= f; wsf[r32] = f;
        LDS_WAIT();
#pragma unroll
        for (int r = 0; r < 16; ++r) { const float fr = wsf[(r & 3) + 8 * (r >> 2) + 4 * hi];
#pragma unroll
            for (int d = 0; d < ND; ++d) o[d][r] *= fr; }
        LDS_WAIT();
    }
    float sacc = 0.f;
#pragma unroll
    for (int r = 0; r < 16; ++r) { p0[r] = __builtin_amdgcn_exp2f(p0[r]); p1[r] = __builtin_amdgcn_exp2f(p1[r]); sacc += p0[r] + p1[r]; }
    l += sacc;
}
#define ATT_PACK(P, B) (u32x4){cvtpk(P[B], P[B + 1]), cvtpk(P[B + 2], P[B + 3]), cvtpk(P[B + 4], P[B + 5]), cvtpk(P[B + 6], P[B + 7])}

__device__ __forceinline__ void battn_unit(LAS unsigned char* L, int b, int h, int qb, bf16* P, const bf16* KV, const unsigned* MASK) {
    const int tid = otid(), lane = tid & 63, wid = __builtin_amdgcn_readfirstlane(tid >> 6), r32 = lane & 31, hi = lane >> 5;
    const int q0 = qb * 256, qpos = q0 + wid * 32 + r32, cq = (q0 + wid * 32) >> 6, NT = (q0 + 256) >> 6;
    const size_t rowbase = (size_t)b * SEQ;
    const bf16* Kh = KV + rowbase * 1024 + h * 64;
    bf16* Qw = P + (rowbase + q0 + wid * 32) * NP + C_BQ + h * 64;
    const char* ksrc = (const char*)(Kh + (size_t)lane * 1024 + wid * 8);
    const char* vsrc = (const char*)(Kh + 512 + (size_t)(16 * (wid & 3) + (lane >> 2)) * 1024 + (wid >> 2) * 32 + (lane & 3) * 8);
    LAS unsigned char* kdst = L + wid * 1024; LAS unsigned char* vdst = L + 16384 + wid * 1024;
    LAS float* wsf = (LAS float*)(L + 32768 + wid * 256);
    bf16x8 qr[4];
#pragma unroll
    for (int d0 = 0; d0 < 4; ++d0) qr[d0] = *(const bf16x8*)(Qw + (size_t)r32 * NP + d0 * 16 + hi * 8);
    const float sl2 = SLOPE_B[h] * LOG2E;
    const unsigned* mrow = MASK + (rowbase + qpos) * 64;
    float m = 0.f, l = 0.f; f32x16 o[2]; o[0] = f32x16{}; o[1] = f32x16{};
    glds16(ksrc, kdst); glds16(vsrc, vdst);
    v2u mw = *(const v2u*)mrow;
    const lds_cptr vb0 = (lds_cptr)(L + 16384) + ((lane >> 4) & 1) * 32 + (lane & 3) * 8 + (4 * hi + ((lane & 15) >> 2)) * 64;
    for (int t = 0; t < NT; ++t) {
        asm volatile("s_waitcnt vmcnt(0)" ::: "memory"); __syncthreads();
        const v2u mcur = mw;
        if (t + 1 < NT) { const int s = (t + 1) & 1; glds16(ksrc + (size_t)(t + 1) * (64 * 1024 * 2), kdst + s * 8192); glds16(vsrc + (size_t)(t + 1) * (64 * 1024 * 2), vdst + s * 8192);
            if (t + 1 <= cq) mw = *(const v2u*)(mrow + 2 * (t + 1)); }
        if (t <= cq) {
            f32x16 p0, p1;
            alibi_cin(p0, p1, (float)(qpos - 64 * t - 4 * hi), sl2, m, t < cq);
            const unsigned mx0 = mcur.x >> (4 * hi), mx1 = mcur.y >> (4 * hi);
#pragma unroll
            for (int r = 0; r < 16; ++r) { const int c = (r & 3) + 8 * (r >> 2); p0[r] = ((mx0 >> c) & 1u) ? p0[r] : -INFINITY; p1[r] = ((mx1 >> c) & 1u) ? p1[r] : -INFINITY; }
            qkt(p0, p1, (lds_cptr)L + (t & 1) * 8192, qr, r32, hi);
            softmax_step<2>(p0, p1, m, l, o, wsf, r32, hi, t == 0);
            const u32x4 w0 = ATT_PACK(p0, 0), w1 = ATT_PACK(p0, 8), w2 = ATT_PACK(p1, 0), w3 = ATT_PACK(p1, 8);
            pv<2>(o, vb0 + (t & 1) * 8192, __builtin_bit_cast(bf16x8, w0), __builtin_bit_cast(bf16x8, w1), __builtin_bit_cast(bf16x8, w2), __builtin_bit_cast(bf16x8, w3));
        }
    }
    l = swapsum(l); wsf[32 + r32] = l; LDS_WAIT();
    LAS bf16* stg = (LAS bf16*)(L + 36864 + wid * 4096);
#pragma unroll
    for (int r = 0; r < 16; ++r) { const int orow = (r & 3) + 8 * (r >> 2) + 4 * hi; const float rl = 1.f / wsf[32 + orow];
        stg[orow * 64 + r32] = (bf16)f2bf(o[0][r] * rl); stg[orow * 64 + 32 + r32] = (bf16)f2bf(o[1][r] * rl); }
    LDS_WAIT();
#pragma unroll
    for (int i = 0; i < 4; ++i) { const int row = i * 8 + (lane >> 3), ch = lane & 7; const u32x4 v = *(const LAS u32x4*)(stg + row * 64 + ch * 8); *(u32x4*)(Qw + (size_t)row * NP + ch * 8) = v; }
    asm volatile("s_waitcnt lgkmcnt(0)" ::: "memory"); __syncthreads();
}
__device__ __forceinline__ void battn_phase(LAS unsigned char* L, const Args& a) {
    const int G = gridDim.x, bx = blockIdx.x, vcu = (bx % 8) * (G / 8) + bx / 8, bh = vcu >> 1, sel = vcu & 1;
    bf16* P = (bf16*)(a.ws + WS_PROJ); const bf16* KV = (const bf16*)(a.ws + WS_KV); const unsigned* MASK = (const unsigned*)(a.ws + WS_MASK);
    for (int i = 0; i < 4; ++i) { const int qb = i == 0 ? sel : (i == 1 ? 7 - sel : (i == 2 ? 2 + sel : 5 - sel)); battn_unit(L, bh >> 3, bh & 7, qb, P, KV, MASK); }
}

__device__ __forceinline__ void dattn_unit(LAS unsigned char* L, int b, int h, int qb, bf16* P, float lam, const float* subg) {
    const int tid = otid(), lane = tid & 63, wid = __builtin_amdgcn_readfirstlane(tid >> 6), r32 = lane & 31, hi = lane >> 5, rg = wid & 3, mp = wid >> 2;
    const int q0 = qb * 128, qpos = q0 + rg * 32 + r32, cq = (q0 + rg * 32) >> 6, NT = (q0 + 128) >> 6;
    const size_t rowbase = (size_t)b * SEQ;
    const bf16* Kb = P + rowbase * NP + C_AK + h * 128;
    const bf16* Vb = P + rowbase * NP + C_AV + h * 128;
    bf16* Qw = P + (rowbase + q0 + rg * 32) * NP + C_AQ + h * 128;
    const char* k0src = (const char*)(Kb + (size_t)lane * NP + wid * 8);
    const char* k1src = (const char*)(Kb + (size_t)lane * NP + 64 + wid * 8);
    const char* v0src = (const char*)(Vb + (size_t)(16 * (wid & 3) + (lane >> 2)) * NP + (wid >> 2) * 32 + (lane & 3) * 8);
    const char* v1src = v0src + 64 * 2;
    LAS unsigned char* dst = L + wid * 1024;
    LAS float* wsf = (LAS float*)(L + 65536 + wid * 256);
    bf16x8 qr[4];
#pragma unroll
    for (int d0 = 0; d0 < 4; ++d0) qr[d0] = *(const bf16x8*)(Qw + (size_t)r32 * NP + mp * 64 + d0 * 16 + hi * 8);
    const float sl2 = SLOPE_A[h] * LOG2E;
    float m = 0.f, l = 0.f; f32x16 o[4];
#pragma unroll
    for (int d = 0; d < 4; ++d) o[d] = f32x16{};
    constexpr size_t TS = (size_t)64 * NP * 2;
    glds16(k0src, dst); glds16(k1src, dst + 8192); glds16(v0src, dst + 16384); glds16(v1src, dst + 24576);
    const lds_cptr vb0 = (lds_cptr)(L + 16384) + ((lane >> 4) & 1) * 32 + (lane & 3) * 8 + (4 * hi + ((lane & 15) >> 2)) * 64;
    for (int t = 0; t < NT; ++t) {
        asm volatile("s_waitcnt vmcnt(0)" ::: "memory"); __syncthreads();
        if (t + 1 < NT) { LAS unsigned char* d2 = dst + ((t + 1) & 1) * 32768; const size_t go = (size_t)(t + 1) * TS;
            glds16(k0src + go, d2); glds16(k1src + go, d2 + 8192); glds16(v0src + go, d2 + 16384); glds16(v1src + go, d2 + 24576); }
        if (t <= cq) {
            f32x16 p0, p1;
            alibi_cin(p0, p1, (float)(qpos - 64 * t - 4 * hi), sl2, m, t < cq);
            qkt(p0, p1, (lds_cptr)L + (t & 1) * 32768 + mp * 8192, qr, r32, hi);
            softmax_step<4>(p0, p1, m, l, o, wsf, r32, hi, t == 0);
            const u32x4 w0 = ATT_PACK(p0, 0), w1 = ATT_PACK(p0, 8), w2 = ATT_PACK(p1, 0), w3 = ATT_PACK(p1, 8);
            pv<4>(o, vb0 + (t & 1) * 32768, __builtin_bit_cast(bf16x8, w0), __builtin_bit_cast(bf16x8, w1), __builtin_bit_cast(bf16x8, w2), __builtin_bit_cast(bf16x8, w3));
        }
    }
    l = swapsum(l); wsf[32 + r32] = l; LDS_WAIT();
    LAS float* X = (LAS float*)(L + 69632) + rg * (32 * 132);
    if (mp == 1) {
#pragma unroll
        for (int r = 0; r < 16; ++r) { const int orow = (r & 3) + 8 * (r >> 2) + 4 * hi; const float rl = lam / wsf[32 + orow];
#pragma unroll
            for (int d = 0; d < 4; ++d) X[orow * 132 + d * 32 + r32] = o[d][r] * rl; }
    }
    asm volatile("s_waitcnt lgkmcnt(0)" ::: "memory"); __syncthreads();
    if (mp == 0) {
#pragma unroll
        for (int r = 0; r < 16; ++r) { const int orow = (r & 3) + 8 * (r >> 2) + 4 * hi; const float rl = 1.f / wsf[32 + orow];
#pragma unroll
            for (int d = 0; d < 4; ++d) { LAS float* xp = X + orow * 132 + d * 32 + r32; *xp = o[d][r] * rl - *xp; } }
        LDS_WAIT();
        const int row = lane >> 1, half = lane & 1; const LAS f32x4* xr = (const LAS f32x4*)(X + row * 132 + half * 64);
        f32x4 y[16]; float ss = 0.f;
#pragma unroll
        for (int j = 0; j < 16; ++j) { y[j] = xr[j]; ss += (y[j].x * y[j].x + y[j].y * y[j].y) + (y[j].z * y[j].z + y[j].w * y[j].w); }
        ss += __shfl_xor(ss, 1);
        const float rn = 0.8f / sqrtf(ss * (1.f / 128.f) + RMS_EPS);
        bf16* op = Qw + (size_t)row * NP + half * 64; const f32x4* gp = (const f32x4*)(subg + half * 64);
#pragma unroll
        for (int j = 0; j < 8; ++j) { const f32x4 g0 = gp[2 * j], g1 = gp[2 * j + 1]; const f32x4 a0 = y[2 * j] * rn * g0, a1 = y[2 * j + 1] * rn * g1;
            u32x4 w; w.x = cvtpk(a0.x, a0.y); w.y = cvtpk(a0.z, a0.w); w.z = cvtpk(a1.x, a1.y); w.w = cvtpk(a1.z, a1.w); *(u32x4*)(op + j * 8) = w; }
    }
    asm volatile("s_waitcnt lgkmcnt(0)" ::: "memory"); __syncthreads();
}
__device__ __forceinline__ void dattn_phase(LAS unsigned char* L, const Args& a) {
    const int G = gridDim.x, bx = blockIdx.x, vcu = (bx % 8) * (G / 8) + bx / 8, bh = vcu >> 2, j = vcu & 3;
    bf16* P = (bf16*)(a.ws + WS_PROJ); const float lam = lam_value(a);
    for (int i = 0; i < 4; ++i) { const int qb = i == 0 ? j : (i == 1 ? 7 - j : (i == 2 ? 8 + j : 15 - j)); dattn_unit(L, bh >> 2, bh & 3, qb, P, lam, a.in[I_SUBLN]); }
}
#undef ATT_PACK
}


namespace idx {
typedef short bf16x8 __attribute__((ext_vector_type(8)));
typedef float f32x16 __attribute__((ext_vector_type(16)));
typedef unsigned u32x4 __attribute__((ext_vector_type(4)));
__device__ __forceinline__ void cnt_ge(int& c, unsigned key, unsigned t) { asm("v_cmp_ge_u32_e32 vcc, %1, %2\n\tv_addc_co_u32_e32 %0, vcc, 0, %0, vcc" : "+v"(c) : "v"(key), "v"(t) : "vcc"); }
__device__ __forceinline__ void cnt_gt(int& c, unsigned key, unsigned t) { asm("v_cmp_gt_u32_e32 vcc, %1, %2\n\tv_addc_co_u32_e32 %0, vcc, 0, %0, vcc" : "+v"(c) : "v"(key), "v"(t) : "vcc"); }
__device__ __forceinline__ int row16_sum(int x) {
    x += __builtin_amdgcn_update_dpp(0, x, 0xB1, 0xF, 0xF, true);
    x += __builtin_amdgcn_update_dpp(0, x, 0x4E, 0xF, 0xF, true);
    x += __builtin_amdgcn_update_dpp(0, x, 0x141, 0xF, 0xF, true);
    x += __builtin_amdgcn_update_dpp(0, x, 0x140, 0xF, 0xF, true);
    return x;
}
__device__ __forceinline__ int half_sum(int x, int hi) {
    x = row16_sum(x);
    const int s0 = __builtin_amdgcn_readlane(x, 0) + __builtin_amdgcn_readlane(x, 16), s1 = __builtin_amdgcn_readlane(x, 32) + __builtin_amdgcn_readlane(x, 48);
    return hi ? s1 : s0;
}
template <int NS> __device__ __forceinline__ void idx_unit_t(LAS unsigned char* L, int b, int g, const bf16* P, unsigned* MASK) {
    const int tid = otid(), lane = tid & 63, wid = __builtin_amdgcn_readfirstlane(tid >> 6), r32 = lane & 31, hi = lane >> 5;
    const int nblk = 2 * ((g >> 1) + 1);
    const size_t rowbase = (size_t)b * SEQ; const int tq0 = g * 32 + wid * 4;
    unsigned* mrow0 = MASK + (rowbase + tq0 + 2 * hi) * 64;
    const int qsel = 2 * ((r32 >> 2) & 1) + (r32 >> 4), hsel = ((r32 >> 3) & 1) * 4 + (r32 & 3);
    const bf16* qp = P + (rowbase + tq0 + qsel) * NP + C_IQ + hsel * 64 + hi * 8;
    bf16x8 qa[4];
#pragma unroll
    for (int ks = 0; ks < 4; ++ks) qa[ks] = *(const bf16x8*)(qp + ks * 16);
    float w[2][8];
#pragma unroll
    for (int q2 = 0; q2 < 2; ++q2) { const u32x4 wv = *(const u32x4*)(P + (rowbase + tq0 + 2 * hi + q2) * NP + C_IW);
        w[q2][0] = bflo(wv.x); w[q2][1] = bfhi(wv.x); w[q2][2] = bflo(wv.y); w[q2][3] = bfhi(wv.y); w[q2][4] = bflo(wv.z); w[q2][5] = bfhi(wv.z); w[q2][6] = bflo(wv.w); w[q2][7] = bfhi(wv.w); }
    const char* ksrc = (const char*)(P + (rowbase + lane) * NP + C_IK + wid * 8);
    LAS unsigned char* kdst = L + wid * 1024;
    const char* kp = ksrc;
#define IDX_DMA(s_) do { _Pragma("unroll") for (int sub = 0; sub < 4; ++sub) \
        __builtin_amdgcn_global_load_lds((const unsigned*)(kp + (size_t)(64 * sub) * (NP * 2)), (LAS unsigned*)(kdst + ((s_) & 1) * 32768 + sub * 8192), 16, 0, 0); \
        kp += (size_t)256 * (NP * 2); asm volatile("" : "+v"(kp)); } while (0)
    unsigned key[2][8 * NS];
    IDX_DMA(0);
#pragma unroll
    for (int s_ = 0; s_ < NS; ++s_) {
        asm volatile("s_waitcnt vmcnt(0)" ::: "memory"); __syncthreads();
        if (s_ + 1 < NS) IDX_DMA(s_ + 1);
#pragma unroll
        for (int j = 0; j < 8; ++j) {
            const int blk = 8 * s_ + j;
            const LAS unsigned char* kb = L + (s_ & 1) * 32768 + (j >> 1) * 8192 + hi * 1024 + ((j & 1) * 32 + r32) * 16;
            f32x16 acc = f32x16{};
#pragma unroll
            for (int ks = 0; ks < 4; ++ks) { const bf16x8 kf = *(const LAS bf16x8*)(kb + ks * 2048); acc = __builtin_amdgcn_mfma_f32_32x32x16_bf16(qa[ks], kf, acc, 0, 0, 0); }
            const bool vis = blk < nblk;
#pragma unroll
            for (int q2 = 0; q2 < 2; ++q2) { float sc = 0.f;
#pragma unroll
                for (int h = 0; h < 8; ++h) sc = fmaf(w[q2][h], fmaxf(acc[8 * q2 + h], 0.f), sc);
                key[q2][blk] = vis ? sortable(sc + 0.f) : 0u; asm volatile("" : "+v"(key[q2][blk])); }
        }
    }
#undef IDX_DMA
    unsigned K0 = 0u, K1 = 0u; int g0 = 0x7fffffff, g1 = 0x7fffffff;
    for (int bit = 31; bit >= 0; --bit) {
        const unsigned t0 = K0 | (1u << bit), t1 = K1 | (1u << bit);
        int c0 = 0, c1 = 0;
#pragma unroll
        for (int i = 0; i < 8 * NS; ++i) { cnt_ge(c0, key[0][i], t0); cnt_ge(c1, key[1][i], t1); }
        c0 = half_sum(c0, hi); c1 = half_sum(c1, hi);
        if (c0 >= TOPK) { K0 = t0; g0 = c0; }
        if (c1 >= TOPK) { K1 = t1; g1 = c1; }
        if (__all(g0 == TOPK && g1 == TOPK)) break;
    }
    unsigned m00 = 0u, m01 = 0u, m10 = 0u, m11 = 0u;
    if (__all(g0 == TOPK && g1 == TOPK)) {
#pragma unroll
        for (int blk = 0; blk < 8 * NS; ++blk) {
            const unsigned long long b0 = __ballot(key[0][blk] >= K0), b1 = __ballot(key[1][blk] >= K1);
            const unsigned w0 = hi ? (unsigned)(b0 >> 32) : (unsigned)b0, w1 = hi ? (unsigned)(b1 >> 32) : (unsigned)b1;
            if (r32 == (blk & 31)) { if (blk < 32) { m00 = w0; m10 = w1; } else { m01 = w0; m11 = w1; } } }
    } else {
        int c0 = 0, c1 = 0;
#pragma unroll
        for (int i = 0; i < 8 * NS; ++i) { cnt_gt(c0, key[0][i], K0); cnt_gt(c1, key[1][i], K1); }
        const int need0 = TOPK - half_sum(c0, hi), need1 = TOPK - half_sum(c1, hi);
        int tk0 = 0, tk1 = 0; const unsigned lt = (1u << r32) - 1u;
#pragma unroll
        for (int blk = 0; blk < 8 * NS; ++blk) {
            const unsigned long long e0b = __ballot(key[0][blk] == K0), e1b = __ballot(key[1][blk] == K1);
            const unsigned e0 = hi ? (unsigned)(e0b >> 32) : (unsigned)e0b, e1 = hi ? (unsigned)(e1b >> 32) : (unsigned)e1b;
            const bool s0 = key[0][blk] > K0 || (key[0][blk] == K0 && tk0 + __popc(e0 & lt) < need0);
            const bool s1 = key[1][blk] > K1 || (key[1][blk] == K1 && tk1 + __popc(e1 & lt) < need1);
            tk0 += __popc(e0); tk1 += __popc(e1);
            const unsigned long long b0 = __ballot(s0), b1 = __ballot(s1);
            const unsigned w0 = hi ? (unsigned)(b0 >> 32) : (unsigned)b0, w1 = hi ? (unsigned)(b1 >> 32) : (unsigned)b1;
            if (r32 == (blk & 31)) { if (blk < 32) { m00 = w0; m10 = w1; } else { m01 = w0; m11 = w1; } } }
    }
    mrow0[r32] = m00; mrow0[32 + r32] = m01; mrow0[64 + r32] = m10; mrow0[96 + r32] = m11;
}
__device__ __forceinline__ void idx_unit(LAS unsigned char* L, int b, int g, const bf16* P, unsigned* MASK) {
    const int nblk = 2 * ((g >> 1) + 1), ns = (nblk + 7) >> 3;
    if (ns <= 1) {
        const int tid = otid(), lane = tid & 63, wid = __builtin_amdgcn_readfirstlane(tid >> 6), r32 = lane & 31, hi = lane >> 5;
        unsigned* mrow0 = MASK + ((size_t)b * SEQ + g * 32 + wid * 4 + 2 * hi) * 64;
        const unsigned wlo = r32 < nblk ? 0xffffffffu : 0u;
        mrow0[r32] = wlo; mrow0[32 + r32] = 0u; mrow0[64 + r32] = wlo; mrow0[96 + r32] = 0u;
    }
    else if (ns == 2) idx_unit_t<2>(L, b, g, P, MASK);
    else if (ns == 3) idx_unit_t<3>(L, b, g, P, MASK);
    else if (ns == 4) idx_unit_t<4>(L, b, g, P, MASK);
    else if (ns == 5) idx_unit_t<5>(L, b, g, P, MASK);
    else if (ns == 6) idx_unit_t<6>(L, b, g, P, MASK);
    else if (ns == 7) idx_unit_t<7>(L, b, g, P, MASK);
    else idx_unit_t<8>(L, b, g, P, MASK);
}
__device__ __forceinline__ void idx_phase(LAS unsigned char* L, const Args& a) {
    const int G = gridDim.x, bx = blockIdx.x, vcu = (bx % 8) * (G / 8) + bx / 8, b = vcu >> 4, j = vcu & 15;
    const bf16* P = (const bf16*)(a.ws + WS_PROJ); unsigned* MASK = (unsigned*)(a.ws + WS_MASK);
    for (int i = 0; i < 4; ++i) { const int g = i == 0 ? j : (i == 1 ? 31 - j : (i == 2 ? 32 + j : 63 - j)); idx_unit(L, b, g, P, MASK);
        asm volatile("s_waitcnt lgkmcnt(0)" ::: "memory"); __syncthreads(); }
}
}

__global__ void __launch_bounds__(512, 2) fwd(Args a) {
    extern __shared__ __attribute__((aligned(16))) unsigned char lds[];
    const int tid = threadIdx.x;
    unsigned char* ws = a.ws;
    for (int u = tid; u < (LDS_BYTES - LDSCTL_OFF) / 4; u += 512) ((LAS unsigned*)((LAS unsigned char*)lds + LDSCTL_OFF))[u] = 0u;
    __syncthreads();
    XcdBarrier bar = xcd_barrier_post((unsigned*)(ws + WS_CTL) + CW_BAR, (volatile LAS unsigned*)((LAS unsigned char*)lds + MISC_OFF) + 8);
#define GRID_BAR() xcd_barrier(bar)
    bf16* PROJ = (bf16*)(ws + WS_PROJ); bf16* U = (bf16*)(ws + WS_U);
    LAS unsigned char* LL = (LAS unsigned char*)lds;

    p0_naive(a, lds);
    GRID_BAR();
    p1_modulate(a, lds);
    GRID_BAR();
#if FAST_P2
    { pg8::Gemm g{U, (const bf16*)(ws + WS_WIN), T, NP, 1024, 1024, 1024}; pg8::StaticOrder S; S.init(T, NP, (int)gridDim.x, (int)blockIdx.x);
      pg8::EpiProjF E{PROJ, NP, QSCALE}; pg8::gemm_phase<pg8::EpiProjF, pg8::StaticOrder, true, true, 1024, 1024, 1024>(LL, g, S, E); }
#else
    { EpiProj e{PROJ}; naive_gemm((float*)lds, U, 1024, (const bf16*)(ws + WS_WIN), 1024, T, NP, 1024, e); }
#endif
    GRID_BAR();
    naive_rms_rows(a);
    GRID_BAR();
#if FAST_KV
    { pg8::Gemm g{PROJ + C_BKV, (const bf16*)(ws + WS_WKV), T, 1024, 128, NP, 128}; pg8::StaticOrder S; S.init(T, 1024, (int)gridDim.x, (int)blockIdx.x);
      pg8::EpiRowScale E{(bf16*)(ws + WS_KV), 1024, (const float*)(ws + WS_R)}; pg8::gemm_phase<pg8::EpiRowScale, pg8::StaticOrder, true, true, 128, NP, 128>(LL, g, S, E); }
#else
    { EpiKV e{(bf16*)(ws + WS_KV), (const float*)(ws + WS_R)}; naive_gemm((float*)lds, PROJ + C_BKV, NP, (const bf16*)(ws + WS_WKV), 128, T, 1024, 128, e); }
#endif
    __syncthreads();
#if FAST_IDX
    idx::idx_phase(LL, a);
#else
    naive_indexer(a, lds);
#endif
    __syncthreads();
#if FAST_DATT
    att::dattn_phase(LL, a);
#else
    naive_diffattn(a, lds);
#endif
    GRID_BAR();
#if FAST_BATT
    att::battn_phase(LL, a);
#else
    naive_battn(a, lds);
#endif
    GRID_BAR();
#if FAST_MIX
    { pg8::StaticOrder S; S.init(T, 1024, (int)gridDim.x, (int)blockIdx.x);
      { pg8::Gemm g{PROJ + C_AQ, (const bf16*)(ws + WS_WA), T, 1024, 512, NP, 512}; pg8::EpiMix<true> E{U, 1024, PROJ + C_G, NP};
        pg8::gemm_phase<pg8::EpiMix<true>, pg8::StaticOrder, true, true, 512, NP, 512>(LL, g, S, E); }
      asm volatile("s_waitcnt vmcnt(0)" ::: "memory"); __syncthreads();
      { pg8::Gemm g{PROJ + C_BQ, (const bf16*)(ws + WS_WB), T, 1024, 512, NP, 512}; pg8::EpiMix<false> E{U, 1024, PROJ + C_G + 1024, NP};
        pg8::gemm_phase<pg8::EpiMix<false>, pg8::StaticOrder, true, true, 512, NP, 512>(LL, g, S, E); } }
#else
    { EpiMixA e{U, PROJ}; naive_gemm((float*)lds, PROJ + C_AQ, NP, (const bf16*)(ws + WS_WA), 512, T, 1024, 512, e); }
    __syncthreads();
    { EpiMixB e{U, PROJ}; naive_gemm((float*)lds, PROJ + C_BQ, NP, (const bf16*)(ws + WS_WB), 512, T, 1024, 512, e); }
#endif
    GRID_BAR();
#if FAST_WO
    { pg8::Gemm g{U, (const bf16*)(ws + WS_WO), T, 1024, 1024, 1024, 1024}; pg8::StaticOrder S; S.init(T, 1024, (int)gridDim.x, (int)blockIdx.x);
      pg8::EpiResGate E{a.out, a.in[I_X], (const float*)(ws + WS_MOD) + 2048, 6144, ALPHA}; pg8::gemm_phase<pg8::EpiResGate, pg8::StaticOrder, true, true, 1024, 1024, 1024>(LL, g, S, E); }
#else
    { EpiWo e{a.out, a.in[I_X], (const float*)(ws + WS_MOD)}; naive_gemm((float*)lds, U, 1024, (const bf16*)(ws + WS_WO), 1024, T, 1024, 1024, e); }
#endif
    GRID_BAR();
    p7_ln_route(a, lds);
    GRID_BAR();
    p8_sort(a, lds);
    GRID_BAR();
#if FAST_MOE
    { const int* BASES = (const int*)(ws + WS_ROUTE2 + 1024 * 1024 + 32768); const int nslot = BASES[24];
      pg8::Gemm g{(const bf16*)(ws + WS_XS), (const bf16*)(ws + WS_W1), nslot, 1024, 1024, 1024, 1024};
      pg8::MoeOrder1 S; S.so.init(nslot, 1024, (int)gridDim.x, (int)blockIdx.x); S.BASES = BASES; S.W1 = (const bf16*)(ws + WS_W1);
      pg8::EpiMoe1 E{(bf16*)(ws + WS_H), (const float*)(ws + WS_ROUTE2 + 1280 * 1024)};
      pg8::gemm_phase<pg8::EpiMoe1, pg8::MoeOrder1, true, true, 1024, 1024, 1024>(LL, g, S, E); }
#else
    naive_moe1(a, lds);
#endif
    GRID_BAR();
#if FAST_MOE
    { const int* BASES = (const int*)(ws + WS_ROUTE2 + 1024 * 1024 + 32768); const int nslot = BASES[24];
      pg8::Gemm g{(const bf16*)(ws + WS_H), (const bf16*)(ws + WS_W2P), nslot, 1024, 512, 512, 512};
      pg8::MoeOrder2 S; S.so.init(nslot, 1024, (int)gridDim.x, (int)blockIdx.x); S.BASES = BASES; S.W2P = (const bf16*)(ws + WS_W2P);
      pg8::EpiMoe2 E{a.out, (const int*)(ws + WS_ROUTE2 + 512 * 1024), (const float*)(ws + WS_MOD) + 5120, 6144, ALPHA};
      pg8::gemm_phase<pg8::EpiMoe2, pg8::MoeOrder2, true, true, 512, 512, 512>(LL, g, S, E); }
#else
    naive_moe2(a, lds);
#endif
    GRID_BAR();
    p11_ln(a);
}

extern "C" void kernel_launch(void* const* d_in, const int* in_sizes, int n_in, void* d_out, int out_size, void* d_ws, size_t ws_size, hipStream_t stream) {
    static int grid = 0;
    if (grid == 0) {
        if (n_in != 27 || out_size != T * D || ws_size < WS_END) { fprintf(stderr, "kernel_launch: unexpected problem (n_in %d, out %d, ws %zu); nothing launched\n", n_in, out_size, ws_size); grid = -1; return; }
        int dev = 0, cus = 0;
        if (hipGetDevice(&dev) != hipSuccess || hipDeviceGetAttribute(&cus, hipDeviceAttributeMultiprocessorCount, dev) != hipSuccess) { grid = -1; return; }
        if (hipFuncSetAttribute((const void*)fwd, hipFuncAttributeMaxDynamicSharedMemorySize, LDS_BYTES) != hipSuccess) { fprintf(stderr, "kernel_launch: hipFuncSetAttribute failed\n"); grid = -1; return; }
        if (cus != 256) { fprintf(stderr, "kernel_launch: built for 256 CUs, device has %d; nothing launched\n", cus); grid = -1; return; }
        grid = cus;
    }
    if (grid < 0) return;
    if (hipMemsetAsync((char*)d_ws + WS_CTL, 0, CTL_ZERO_BYTES, stream) != hipSuccess) return;
    Args a{};
    for (int i = 0; i < 27; ++i) a.in[i] = (const float*)d_in[i];
    a.out = (float*)d_out; a.ws = (unsigned char*)d_ws;
    hipLaunchKernelGGL(fwd, dim3(grid), dim3(512), LDS_BYTES, stream, a);
}
```

```cpp
#include <hip/hip_runtime.h>
#include <hip/hip_bf16.h>
#include <cstdio>
#include <cstdint>

#define GAS __attribute__((address_space(1)))
#define LAS __attribute__((address_space(3)))
typedef unsigned short bf16;
typedef GAS unsigned gu32;
typedef unsigned v4u __attribute__((ext_vector_type(4)));
typedef unsigned v2u __attribute__((ext_vector_type(2)));
typedef float f32x4 __attribute__((ext_vector_type(4)));
#define RLX_AGENT __ATOMIC_RELAXED, __HIP_MEMORY_SCOPE_AGENT

#ifndef FAST_P0
#define FAST_P0 1
#endif
#ifndef FAST_P2
#define FAST_P2 1
#endif
#ifndef FAST_KV
#define FAST_KV 1
#endif
#ifndef FAST_MIX
#define FAST_MIX 1
#endif
#ifndef FAST_WO
#define FAST_WO 1
#endif
#ifndef FAST_MOE
#define FAST_MOE 1
#endif
#ifndef FAST_DATT
#define FAST_DATT 1
#endif
#ifndef FAST_IDX
#define FAST_IDX 1
#endif
#ifndef FAST_BATT
#define FAST_BATT 1
#endif
#ifndef PROBE_P0P1
#define PROBE_P0P1 1
#endif
#ifndef PROBE_P2
#define PROBE_P2 1
#endif
#ifndef PROBE_KVIDX
#define PROBE_KVIDX 1
#endif
#ifndef PROBE_DATT
#define PROBE_DATT 1
#endif
#ifndef PROBE_BATT
#define PROBE_BATT 1
#endif
#ifndef PROBE_MIXWO
#define PROBE_MIXWO 1
#endif
#ifndef PROBE_MOE
#define PROBE_MOE 1
#endif
#ifndef PROBE_ROWS
#define PROBE_ROWS 1
#endif
#ifndef PROBE_P7
#define PROBE_P7 1
#endif
#ifndef PROBE_P8
#define PROBE_P8 1
#endif
#ifndef PROBE_P11
#define PROBE_P11 1
#endif
#ifndef PROBE_BAR
#define PROBE_BAR 1
#endif
#ifndef PROBE_MOE1
#define PROBE_MOE1 1
#endif
#ifndef PROBE_MOE2
#define PROBE_MOE2 1
#endif
#ifndef PROBE_P0
#define PROBE_P0 1
#endif
#ifndef PROBE_P1
#define PROBE_P1 1
#endif
#ifndef PROBE_KV
#define PROBE_KV 1
#endif
#ifndef PROBE_IDX
#define PROBE_IDX 1
#endif
#ifndef PROBE_MIX
#define PROBE_MIX 1
#endif
#ifndef PROBE_WO
#define PROBE_WO 1
#endif
constexpr int BATCH = 16, SEQ = 2048, D = 1024, T = BATCH * SEQ;
constexpr int NP = 4864;
constexpr int C_AQ = 0, C_AK = 512, C_AV = 1024, C_BQ = 1536, C_BKV = 2048, C_IQ = 2176, C_IK = 2688, C_IW = 2752, C_PADB = 2760, C_G = 2816;
constexpr int IN_COLS = 4808;
constexpr float LOG2E = 1.4426950408889634f;
constexpr float QSCALE = 0.125f * LOG2E;
constexpr float ALPHA = 1.189207115002721f;
constexpr float LN_EPS = 1e-5f, RMS_EPS = 1e-5f;
constexpr int TOPK = 256;
constexpr int MAXSLOT = 40960;

__device__ __constant__ float SLOPE_A[4] = {0.6299605369567871f, 0.15749013423919678f, 0.039372533559799194f, 0.009843133389949799f};
__device__ __constant__ float SLOPE_B[8] = {0.39685025811195374f, 0.25f, 0.09921256452798843f, 0.0625f, 0.02480314113199711f, 0.015625f, 0.006200785282999277f, 0.00390625f};

constexpr size_t MiB = 1u << 20;
constexpr size_t WS_CTL = 0, CTL_ZERO_BYTES = 1 * MiB;
constexpr size_t WS_MOD = 1 * MiB;
constexpr size_t WS_R = WS_MOD + 512 * 1024;
constexpr size_t WS_ROUTE = WS_R + 128 * 1024;
constexpr size_t WS_SMALL = WS_R + 128 * 1024;
constexpr int SM_LN1G = 0, SM_LN1B = 1024, SM_LN2G = 2048, SM_LN2B = 3072, SM_SUBLN = 4096, SM_BGRP = 4224, SM_BER = 4228, SM_LAM = 4244, SM_ADAB = 4352;
constexpr size_t WS_WIN = 2 * MiB;
constexpr size_t WS_WA = 12 * MiB;
constexpr size_t WS_WB = 13 * MiB;
constexpr size_t WS_WO = 14 * MiB;
constexpr size_t WS_WKV = 16 * MiB;
constexpr size_t WS_W1 = 17 * MiB;
constexpr size_t WS_W2P = 33 * MiB;
constexpr size_t WS_ROUTE2 = 57 * MiB;
constexpr size_t WS_RW = 59 * MiB;
constexpr size_t WS_MODP = 59 * MiB + 128 * 1024;
constexpr size_t WS_MASK = 60 * MiB;
constexpr size_t WS_KV = 68 * MiB;
constexpr size_t WS_U = 132 * MiB;
constexpr size_t WS_PROJ = 196 * MiB;
constexpr size_t WS_U2 = 196 * MiB;
constexpr size_t WS_H = 260 * MiB;
constexpr size_t WS_XS = 300 * MiB;
constexpr size_t WS_MODPART = 500 * MiB;
constexpr size_t WS_END = 512 * MiB;

constexpr int CW_BAR = 4096;

constexpr int LDSCTL_OFF = 139264, MISC_OFF = LDSCTL_OFF + 320, LDS_BYTES = 147456;

__device__ __forceinline__ unsigned f2bf(float f) { unsigned u = __float_as_uint(f); return (u + 0x7fffu + ((u >> 16) & 1u)) >> 16; }
__device__ __forceinline__ float bf2f(unsigned h) { return __uint_as_float(h << 16); }
__device__ __forceinline__ float bflo(unsigned w) { return __uint_as_float(w << 16); }
__device__ __forceinline__ float bfhi(unsigned w) { return __uint_as_float(w & 0xffff0000u); }
__device__ __forceinline__ unsigned pk2(float lo, float hi) { return f2bf(lo) | (f2bf(hi) << 16); }
#define DPP_ADD(x, ctrl) x += __builtin_bit_cast(float, __builtin_amdgcn_update_dpp(0, __builtin_bit_cast(int, x), ctrl, 0xF, 0xF, true))
__device__ __forceinline__ float wave_sum(float v) {
    DPP_ADD(v, 0xB1); DPP_ADD(v, 0x4E); DPP_ADD(v, 0x141); DPP_ADD(v, 0x140);
    const int iv = __builtin_bit_cast(int, v);
    const float s0 = __builtin_bit_cast(float, __builtin_amdgcn_readlane(iv, 0)), s1 = __builtin_bit_cast(float, __builtin_amdgcn_readlane(iv, 16));
    const float s2 = __builtin_bit_cast(float, __builtin_amdgcn_readlane(iv, 32)), s3 = __builtin_bit_cast(float, __builtin_amdgcn_readlane(iv, 48));
    return (s0 + s1) + (s2 + s3);
}
__device__ __forceinline__ float wave_max(float v) {
#pragma unroll
    for (int o = 1; o < 64; o <<= 1) v = fmaxf(v, __shfl_xor(v, o));
    return v;
}
__device__ __forceinline__ int wave_sum_i(int v) {
#pragma unroll
    for (int o = 1; o < 64; o <<= 1) v += __shfl_xor(v, o);
    return v;
}
#define LDS_WAIT() asm volatile("s_waitcnt lgkmcnt(0)" ::: "memory")
__device__ __forceinline__ int otid(int wid) { unsigned z; asm volatile("v_mov_b32 %0, 0" : "=v"(z)); return wid * 64 + (int)__builtin_amdgcn_mbcnt_hi(~0u, __builtin_amdgcn_mbcnt_lo(~0u, z)); }

#define XB_TMO      128
#define XB_XCNT(j)  (256  + 64 * (j))
#define XB_XSUB(j)  (1280 + 64 * (j))
#define XB_XGEN(j)  (2304 + 64 * (j))
#define XB_TOP      3328
#define XB_TOPGEN   3392
#define XCD_BAR_WORDS 3456
#define XB_SPIN_CAP (1u << 22)
__device__ __forceinline__ unsigned xb_ld(unsigned* p)              { return __hip_atomic_load(p, __ATOMIC_RELAXED, __HIP_MEMORY_SCOPE_AGENT); }
__device__ __forceinline__ unsigned xb_add(unsigned* p, unsigned v) { return __hip_atomic_fetch_add(p, v, __ATOMIC_RELAXED, __HIP_MEMORY_SCOPE_AGENT); }
__device__ __forceinline__ unsigned xb_xcc_id() { return (unsigned)__builtin_amdgcn_s_getreg((3 << 11) | 20) & 0xFu; }
#define XB_SPIN(cond, bar) do { unsigned _sp = 0; while (cond) { __builtin_amdgcn_s_sleep(1); \
    if ((++_sp & 255u) == 0u) { if (xb_ld(&(bar)[XB_TMO])) break; if (_sp > XB_SPIN_CAP) { atomicAdd(&(bar)[XB_TMO], 1u); break; } } } } while (0)
struct XcdBarrier { unsigned* bar; unsigned x; volatile LAS unsigned* st; };
__device__ __forceinline__ XcdBarrier xcd_barrier_post(unsigned* bar, volatile LAS unsigned* st) {
    XcdBarrier b; b.bar = bar; b.x = xb_xcc_id(); b.st = st;
    if (threadIdx.x == 0) (void)xb_add(&bar[XB_XCNT(b.x)], 1u);
    return b;
}
__device__ __forceinline__ void xcd_barrier_complete(unsigned* bar, unsigned x, unsigned& nloc, unsigned& nx) {
    const unsigned G = gridDim.x * gridDim.y * gridDim.z;
    unsigned sum, cnt, mine, sp = 0u;
    for (;;) {
        sum = 0u; cnt = 0u; mine = 0u;
#pragma unroll
        for (unsigned j = 0; j < 16; ++j) { const unsigned c = xb_ld(&bar[XB_XCNT(j)]); sum += c; cnt += (c > 0u) ? 1u : 0u; mine = (j == x) ? c : mine; }
        if (sum == G) break;
        __builtin_amdgcn_s_sleep(1);
        if ((++sp & 255u) == 0u) { if (xb_ld(&bar[XB_TMO])) break; if (sp > XB_SPIN_CAP) { atomicAdd(&bar[XB_TMO], 1u); break; } }
    }
    nloc = mine > 0u ? mine : 1u; nx = cnt > 0u ? cnt : 1u;
}
__device__ __forceinline__ void xcd_barrier(const XcdBarrier& b) {
    asm volatile("s_waitcnt vmcnt(0)" ::: "memory");
    __syncthreads();
    if (threadIdx.x == 0) {
        unsigned* bar = b.bar;
        __builtin_amdgcn_s_waitcnt(0);
        unsigned nloc = b.st[0], nx = b.st[1];
        if (nloc == 0u) { xcd_barrier_complete(bar, b.x, nloc, nx); b.st[0] = nloc; b.st[1] = nx; }
        const unsigned old = xb_add(&bar[XB_XSUB(b.x)], 1u);
        const unsigned gen = old / nloc;
        if (old + 1u == (gen + 1u) * nloc) {
            __builtin_amdgcn_fence(__ATOMIC_RELEASE, "agent");
            asm volatile("s_waitcnt vmcnt(0)" ::: "memory");
            const unsigned og = xb_add(&bar[XB_TOP], 1u);
            const unsigned tg = og / nx;
            if (og + 1u == (tg + 1u) * nx) xb_add(&bar[XB_TOPGEN], 1u);
            else XB_SPIN(xb_ld(&bar[XB_TOPGEN]) == tg, bar);
            __builtin_amdgcn_fence(__ATOMIC_ACQUIRE, "agent");
            xb_add(&bar[XB_XGEN(b.x)], 1u);
            asm volatile("s_waitcnt vmcnt(0)" ::: "memory");
        } else {
            XB_SPIN(xb_ld(&bar[XB_XGEN(b.x)]) == gen, bar);
            __builtin_amdgcn_fence(__ATOMIC_ACQUIRE, "agent");
            asm volatile("s_waitcnt vmcnt(0)" ::: "memory");
        }
    }
    __syncthreads();
}

struct Args { const float* in[27]; float* out; unsigned char* ws; };
__device__ __forceinline__ const Args& kargs() { const Args* p = (const Args*)__builtin_amdgcn_kernarg_segment_ptr(); asm volatile("" : "+s"(p)); return *p; }
struct Ctx {
    LAS const unsigned long long* tab;
    __device__ __forceinline__ unsigned long long get(int i) const { const unsigned long long v = tab[i];
        const unsigned lo = __builtin_amdgcn_readfirstlane((unsigned)v), hi = __builtin_amdgcn_readfirstlane((unsigned)(v >> 32)); return ((unsigned long long)hi << 32) | lo; }
    __device__ __forceinline__ const float* in(int i) const { return (const float*)get(i); }
    __device__ __forceinline__ float* out() const { return (float*)get(27); }
    __device__ __forceinline__ unsigned char* ws() const { return (unsigned char*)get(28); }
};
enum { I_X = 0, I_C, I_ADAW, I_ADAB, I_WIN, I_LQ1, I_LK1, I_LQ2, I_LK2, I_SUBLN, I_KVG, I_WUK, I_WUV, I_WA, I_WB, I_WO, I_LN1G, I_LN1B, I_WGRP, I_BGRP, I_WER, I_BER, I_WEG, I_WEU, I_WED, I_LN2G, I_LN2B };

template <class Epi>
__device__ __forceinline__ void naive_gemm(float* sm, const bf16* A, int lda, const bf16* Bt, int ldb, int M, int N, int K, const Epi& epi, int WID_) {
    const int tid = otid(WID_), ty = tid >> 5, tx = tid & 31;
    float* As = sm; float* Bs = sm + 16 * 132;
    const int ntn = N / 128, ntiles = (M / 128) * ntn;
    for (int tile = blockIdx.x; tile < ntiles; tile += gridDim.x) {
        const int m0 = (tile / ntn) * 128, n0 = (tile % ntn) * 128;
        float acc[8][4];
#pragma unroll
        for (int i = 0; i < 8; ++i)
#pragma unroll
            for (int j = 0; j < 4; ++j) acc[i][j] = 0.f;
        for (int k0 = 0; k0 < K; k0 += 16) {
            {
                const int row = tid >> 2, kq = (tid & 3) * 4;
                const v2u av = *(const v2u*)(A + (size_t)(m0 + row) * lda + k0 + kq);
                As[(kq + 0) * 132 + row] = bflo(av.x); As[(kq + 1) * 132 + row] = bfhi(av.x);
                As[(kq + 2) * 132 + row] = bflo(av.y); As[(kq + 3) * 132 + row] = bfhi(av.y);
                const v2u bv = *(const v2u*)(Bt + (size_t)(n0 + row) * ldb + k0 + kq);
                Bs[(kq + 0) * 132 + row] = bflo(bv.x); Bs[(kq + 1) * 132 + row] = bfhi(bv.x);
                Bs[(kq + 2) * 132 + row] = bflo(bv.y); Bs[(kq + 3) * 132 + row] = bfhi(bv.y);
            }
            __syncthreads();
#pragma unroll
            for (int kk = 0; kk < 16; ++kk) {
                float a[8], b[4];
#pragma unroll
                for (int i = 0; i < 8; ++i) a[i] = As[kk * 132 + ty * 8 + i];
#pragma unroll
                for (int j = 0; j < 4; ++j) b[j] = Bs[kk * 132 + tx * 4 + j];
#pragma unroll
                for (int i = 0; i < 8; ++i)
#pragma unroll
                    for (int j = 0; j < 4; ++j) acc[i][j] = fmaf(a[i], b[j], acc[i][j]);
            }
            __syncthreads();
        }
#pragma unroll
        for (int i = 0; i < 8; ++i)
#pragma unroll
            for (int j = 0; j < 4; ++j) epi(m0 + ty * 8 + i, n0 + tx * 4 + j, acc[i][j]);
    }
}

struct EpiProj {
    bf16* P;
    __device__ __forceinline__ void operator()(int r, int c, float v) const {
        if (c < C_AK || (c >= C_BQ && c < C_BKV)) v *= QSCALE;
        else if (c >= C_G) v = 1.f / (1.f + __expf(-v));
        P[(size_t)r * NP + c] = (bf16)f2bf(v);
    }
};
struct EpiKV { bf16* KV; const float* R; __device__ __forceinline__ void operator()(int r, int c, float v) const { KV[(size_t)r * 1024 + c] = (bf16)f2bf(v * R[r]); } };
struct EpiMixA { bf16* MX; const bf16* P; __device__ __forceinline__ void operator()(int r, int c, float v) const { MX[(size_t)r * 1024 + c] = (bf16)f2bf(v * bf2f(P[(size_t)r * NP + C_G + c])); } };
struct EpiMixB { bf16* MX; const bf16* P; __device__ __forceinline__ void operator()(int r, int c, float v) const { const size_t o = (size_t)r * 1024 + c; MX[o] = (bf16)f2bf(bf2f(MX[o]) + v * bf2f(P[(size_t)r * NP + C_G + 1024 + c])); } };
struct EpiWo { float* out; const float* x; const float* MOD; __device__ __forceinline__ void operator()(int r, int c, float v) const { const size_t o = (size_t)r * 1024 + c; out[o] = ALPHA * x[o] + MOD[(r >> 11) * 6144 + 2048 + c] * v; } };

__device__ __forceinline__ void p0_naive(const Ctx& a, unsigned char* lds, int WID_) {
    unsigned char* ws = a.ws();
    const int tid = otid(WID_); const size_t gt = (size_t)blockIdx.x * 512 + tid, NT = (size_t)gridDim.x * 512;
    bf16* WIN = (bf16*)(ws + WS_WIN); bf16* WA = (bf16*)(ws + WS_WA); bf16* WB = (bf16*)(ws + WS_WB); bf16* WO = (bf16*)(ws + WS_WO);
    bf16* WKV = (bf16*)(ws + WS_WKV); bf16* W1 = (bf16*)(ws + WS_W1); bf16* W2P = (bf16*)(ws + WS_W2P); float* RW = (float*)(ws + WS_RW);
    for (size_t i = gt; i < (size_t)NP * 1024; i += NT) { const int n = (int)(i >> 10), k = (int)(i & 1023); const int o = n < C_PADB ? n : (n >= C_G ? n - 56 : -1);
        WIN[i] = o >= 0 ? (bf16)f2bf(a.in(I_WIN)[(size_t)k * IN_COLS + o]) : (bf16)0; }
    for (size_t i = gt; i < (size_t)1024 * 512; i += NT) { const int n = (int)(i >> 9), k = (int)(i & 511);
        WA[i] = (bf16)f2bf(a.in(I_WA)[(size_t)k * 1024 + n]); WB[i] = (bf16)f2bf(a.in(I_WB)[(size_t)k * 1024 + n]); }
    for (size_t i = gt; i < (size_t)1024 * 1024; i += NT) { const int n = (int)(i >> 10), k = (int)(i & 1023); WO[i] = (bf16)f2bf(a.in(I_WO)[(size_t)k * 1024 + n]); }
    for (size_t i = gt; i < (size_t)1024 * 128; i += NT) { const int n = (int)(i >> 7), r = (int)(i & 127);
        const float g = a.in(I_KVG)[r]; const float w = n < 512 ? a.in(I_WUK)[r * 512 + n] : a.in(I_WUV)[r * 512 + (n - 512)]; WKV[i] = (bf16)f2bf(g * w); }
    for (size_t i = gt; i < (size_t)16 * 512 * 1024; i += NT) { const int k = (int)(i & 1023), row = (int)((i >> 10) & 511), e = (int)(i >> 19);
        const int tile = row >> 8, half = (row >> 7) & 1, j = row & 127, col = tile * 128 + j;
        const float* src = half ? a.in(I_WEU) : a.in(I_WEG); W1[i] = (bf16)f2bf(src[((size_t)e * 1024 + k) * 256 + col]); }
    for (size_t i = gt; i < (size_t)24 * 1024 * 512; i += NT) { const int kk = (int)(i & 511), n = (int)((i >> 9) & 1023), p = (int)(i >> 19);
        const int g = p / 6, pi = p % 6; const int ei = pi < 3 ? 0 : (pi < 5 ? 1 : 2); const int ej = pi < 3 ? pi + 1 : (pi < 5 ? pi - 1 : 3);
        const int e = 4 * g + (kk < 256 ? ei : ej); W2P[i] = (bf16)f2bf(a.in(I_WED)[((size_t)e * 256 + (kk & 255)) * 1024 + n]); }
    for (size_t i = gt; i < (size_t)20 * 1024; i += NT) { const int c = (int)(i >> 10), k = (int)(i & 1023); RW[i] = c < 4 ? a.in(I_WGRP)[k * 4 + c] : a.in(I_WER)[k * 16 + (c - 4)]; }
    {
        float* sc = (float*)lds;
        const int kb = blockIdx.x >> 4, cb = blockIdx.x & 15;
        for (int i = tid; i < 16 * 64; i += 512) { const int b = i >> 6, kk = i & 63; const float cv = a.in(I_C)[b * 1024 + kb * 64 + kk]; sc[i] = cv / (1.f + __expf(-cv)); }
        __syncthreads();
        if (tid < 384) {
            const int j = cb * 384 + tid; float acc[16];
#pragma unroll
            for (int b = 0; b < 16; ++b) acc[b] = 0.f;
            for (int kk = 0; kk < 64; ++kk) { const float w = a.in(I_ADAW)[(size_t)(kb * 64 + kk) * 6144 + j];
#pragma unroll
                for (int b = 0; b < 16; ++b) acc[b] = fmaf(sc[b * 64 + kk], w, acc[b]); }
            float* MP = (float*)(ws + WS_MODPART);
#pragma unroll
            for (int b = 0; b < 16; ++b) MP[((size_t)kb * 16 + b) * 6144 + j] = acc[b];
        }
        __syncthreads();
    }
}
__device__ __forceinline__ float lam_value(const Ctx& a);
__device__ __forceinline__ void tr_item(const float* src, int ld, bf16* dst, int dld, LAS float* scr, int lane, int nvalid, const float* kscale) {
    const int n_ = lane & 31; const float* sp0 = src + (size_t)(lane >> 5) * ld + n_; const bool ok = n_ < nvalid;
#pragma unroll 1
    for (int h = 0; h < 2; ++h) {
        float tv[16];
#pragma unroll
        for (int i = 0; i < 16; ++i) tv[i] = ok ? sp0[(size_t)(2 * (16 * h + i)) * ld] : 0.f;
#pragma unroll
        for (int i = 0; i < 16; ++i) { const int kk = 2 * (16 * h + i) + (lane >> 5); float v = tv[i]; if (kscale) v *= kscale[kk]; scr[kk * 33 + n_] = v; }
    }
    LDS_WAIT();
    const int c = lane & 7;
#pragma unroll
    for (int j = 0; j < 4; ++j) { const int n = (lane >> 3) + 8 * j; const LAS float* sp = scr + (8 * c) * 33 + n;
        v4u o; o.x = pk2(sp[0 * 33], sp[1 * 33]); o.y = pk2(sp[2 * 33], sp[3 * 33]); o.z = pk2(sp[4 * 33], sp[5 * 33]); o.w = pk2(sp[6 * 33], sp[7 * 33]);
        *(v4u*)(dst + (size_t)n * dld + 8 * c) = o; }
    LDS_WAIT();
}
__device__ __forceinline__ void p0_fast(const Ctx& a, LAS unsigned char* L, int WID_) {
    unsigned char* ws = a.ws();
    const int tid = otid(WID_), lane = tid & 63, wv = tid >> 6;
    bf16* WIN = (bf16*)(ws + WS_WIN); bf16* WA = (bf16*)(ws + WS_WA); bf16* WB = (bf16*)(ws + WS_WB); bf16* WO = (bf16*)(ws + WS_WO);
    bf16* WKV = (bf16*)(ws + WS_WKV); bf16* W1 = (bf16*)(ws + WS_W1); bf16* W2P = (bf16*)(ws + WS_W2P); float* RW = (float*)(ws + WS_RW);
    LAS float* scr = (LAS float*)(L + 8192 + wv * 8448);
    const int gw = blockIdx.x * 8 + wv, NW = gridDim.x * 8;
    constexpr int I_WINn = 16 * 152, I_WAn = 8 * 32, I_WOn = 16 * 32, I_KVn = 2 * 16 * 2, I_W1n = 16 * 2 * 16 * 8, I_W2n = 48 * 4 * 32;
    constexpr int NITEMS = I_WINn + 2 * I_WAn + I_WOn + I_KVn + I_W1n + I_W2n;
    for (int it = gw; it < NITEMS; it += NW) {
        int r = it;
        if (r < I_WINn) { const int kb = r / 152, nb = r % 152, n0 = nb * 32; const int o0 = n0 < C_PADB ? n0 : n0 - 56;
            const int nvalid = nb < 86 ? 32 : (nb == 86 ? 8 : (nb == 87 ? 0 : 32));
            tr_item(a.in(I_WIN) + (size_t)(kb * 64) * IN_COLS + (nb == 87 ? 0 : o0), IN_COLS, WIN + (size_t)n0 * 1024 + kb * 64, 1024, scr, lane, nvalid, nullptr); continue; }
        r -= I_WINn;
        if (r < I_WAn) { const int kb = r / 32, nb = r % 32; tr_item(a.in(I_WA) + (size_t)(kb * 64) * 1024 + nb * 32, 1024, WA + (size_t)(nb * 32) * 512 + kb * 64, 512, scr, lane, 32, nullptr); continue; }
        r -= I_WAn;
        if (r < I_WAn) { const int kb = r / 32, nb = r % 32; tr_item(a.in(I_WB) + (size_t)(kb * 64) * 1024 + nb * 32, 1024, WB + (size_t)(nb * 32) * 512 + kb * 64, 512, scr, lane, 32, nullptr); continue; }
        r -= I_WAn;
        if (r < I_WOn) { const int kb = r / 32, nb = r % 32; tr_item(a.in(I_WO) + (size_t)(kb * 64) * 1024 + nb * 32, 1024, WO + (size_t)(nb * 32) * 1024 + kb * 64, 1024, scr, lane, 32, nullptr); continue; }
        r -= I_WOn;
        if (r < I_KVn) { const int which = r / 32, rr = r % 32, kb = rr / 16, nb = rr % 16; const float* src = which ? a.in(I_WUV) : a.in(I_WUK);
            tr_item(src + (size_t)(kb * 64) * 512 + nb * 32, 512, WKV + (size_t)(which * 512 + nb * 32) * 128 + kb * 64, 128, scr, lane, 32, a.in(I_KVG) + kb * 64); continue; }
        r -= I_KVn;
        if (r < I_W1n) { const int e = r / 256, rr = r % 256, half = rr / 128, r2 = rr % 128, kb = r2 / 8, nb = r2 % 8, col = nb * 32; const float* src = half ? a.in(I_WEU) : a.in(I_WEG);
            const int row = (col >> 7) * 256 + half * 128 + (col & 127);
            tr_item(src + ((size_t)e * 1024 + kb * 64) * 256 + col, 256, W1 + ((size_t)e * 512 + row) * 1024 + kb * 64, 1024, scr, lane, 32, nullptr); continue; }
        r -= I_W1n;
        { const int ph = r / 128, r2 = r % 128, kb = r2 / 32, nb = r2 % 32, p = ph >> 1, half = ph & 1; const int g = p / 6, pi = p % 6;
            const int ei = pi < 3 ? 0 : (pi < 5 ? 1 : 2), ej = pi < 3 ? pi + 1 : (pi < 5 ? pi - 1 : 3); const int e = 4 * g + (half ? ej : ei);
            tr_item(a.in(I_WED) + ((size_t)e * 256 + kb * 64) * 1024 + nb * 32, 1024, W2P + ((size_t)p * 1024 + nb * 32) * 512 + half * 256 + kb * 64, 512, scr, lane, 32, nullptr); }
    }
    for (size_t i = (size_t)blockIdx.x * 512 + tid; i < (size_t)20 * 1024; i += (size_t)gridDim.x * 512) { const int c = (int)(i >> 10), k = (int)(i & 1023); RW[i] = c < 4 ? a.in(I_WGRP)[k * 4 + c] : a.in(I_WER)[k * 16 + (c - 4)]; }
    if (blockIdx.x == 0) { float* SM = (float*)(ws + WS_SMALL);
        for (int i = tid; i < 1024; i += 512) { SM[SM_LN1G + i] = a.in(I_LN1G)[i]; SM[SM_LN1B + i] = a.in(I_LN1B)[i]; SM[SM_LN2G + i] = a.in(I_LN2G)[i]; SM[SM_LN2B + i] = a.in(I_LN2B)[i]; }
        for (int i = tid; i < 6144; i += 512) SM[SM_ADAB + i] = a.in(I_ADAB)[i];
        if (tid < 128) SM[SM_SUBLN + tid] = a.in(I_SUBLN)[tid];
        if (tid < 4) SM[SM_BGRP + tid] = a.in(I_BGRP)[tid];
        if (tid < 16) SM[SM_BER + tid] = a.in(I_BER)[tid];
        if (tid == 0) SM[SM_LAM] = lam_value(a); }
    {
        LAS float* sc = (LAS float*)L;
        const int kb = blockIdx.x >> 4, cb = blockIdx.x & 15;
        for (int i = tid; i < 16 * 64; i += 512) { const int b = i >> 6, kk = i & 63; const float cv = a.in(I_C)[b * 1024 + kb * 64 + kk]; sc[i] = cv / (1.f + __expf(-cv)); }
        __syncthreads();
        if (tid < 384) {
            const int j = cb * 384 + tid; float acc[16];
#pragma unroll
            for (int b = 0; b < 16; ++b) acc[b] = 0.f;
#pragma unroll 8
            for (int kk = 0; kk < 64; ++kk) { const float w = a.in(I_ADAW)[(size_t)(kb * 64 + kk) * 6144 + j];
#pragma unroll
                for (int b = 0; b < 16; ++b) acc[b] = fmaf(sc[b * 64 + kk], w, acc[b]); }
            float* MP = (float*)(ws + WS_MODPART);
#pragma unroll
            for (int b = 0; b < 16; ++b) MP[((size_t)kb * 16 + b) * 6144 + j] = acc[b];
        }
        __syncthreads();
    }
}
__device__ __forceinline__ float mod_sum(const float* MP, const float* adab, int b, int j) {
    float s = adab[j];
#pragma unroll
    for (int ks = 0; ks < 16; ++ks) s += MP[((size_t)ks * 16 + b) * 6144 + j];
    return s;
}
__device__ __forceinline__ void p1_modulate(const Ctx& a, unsigned char* lds, int WID_) {
    unsigned char* ws = a.ws(); const int tid = otid(WID_), blk = blockIdx.x;
    const float* MP = (const float*)(ws + WS_MODPART); float* MOD = (float*)(ws + WS_MOD); bf16* U = (bf16*)(ws + WS_U);
    float* sh = (float*)lds; float* sc = sh + 1024; const float* SMv = (const float*)(ws + WS_SMALL);
    const int b = blk >> 4;
    for (int j = tid; j < 1024; j += 512) { sh[j] = mod_sum(MP, SMv + SM_ADAB, b, j); sc[j] = 1.f + mod_sum(MP, SMv + SM_ADAB, b, 1024 + j); }
    for (int e = tid; e < 384; e += 512) { const int flat = blk * 384 + e; MOD[flat] = mod_sum(MP, SMv + SM_ADAB, flat / 6144, flat % 6144); }
    __syncthreads();
    const f32x4* X = (const f32x4*)(a.in(I_X) + (size_t)blk * 128 * 1024); v2u* Uo = (v2u*)(U + (size_t)blk * 128 * 1024);
    for (int i0 = tid; i0 < 128 * 256; i0 += 512 * 8) {
        f32x4 xv[8];
#pragma unroll
        for (int j = 0; j < 8; ++j) xv[j] = X[i0 + j * 512];
#pragma unroll
        for (int j = 0; j < 8; ++j) { const int i = i0 + j * 512, c4 = (i & 255) * 4; const f32x4 x = xv[j];
            v2u o; o.x = pk2(x.x * sc[c4] + sh[c4], x.y * sc[c4 + 1] + sh[c4 + 1]); o.y = pk2(x.z * sc[c4 + 2] + sh[c4 + 2], x.w * sc[c4 + 3] + sh[c4 + 3]); Uo[i] = o; } }
    __syncthreads();
}
__device__ __forceinline__ void naive_rms_rows(const Ctx& a, int WID_) {
    const bf16* P = (const bf16*)(a.ws() + WS_PROJ); float* R = (float*)(a.ws() + WS_R);
    const int tid = otid(WID_); const int lane = tid & 63, gw = blockIdx.x * 8 + (tid >> 6), NW = gridDim.x * 8;
    for (int t0 = gw; t0 < T; t0 += NW * 8) {
        unsigned wv_[8];
#pragma unroll
        for (int j = 0; j < 8; ++j) wv_[j] = *(const unsigned*)(P + (size_t)(t0 + j * NW) * NP + C_BKV + lane * 2);
#pragma unroll
        for (int j = 0; j < 8; ++j) { const float x0 = bflo(wv_[j]), x1 = bfhi(wv_[j]); const float ss = wave_sum(x0 * x0 + x1 * x1); if (lane == 0) R[t0 + j * NW] = 1.f / sqrtf(ss * (1.f / 128.f) + RMS_EPS); } }
}
__device__ __forceinline__ unsigned sortable(float s) { const unsigned u = __float_as_uint(s); return (u & 0x80000000u) ? ~u : (u | 0x80000000u); }
__device__ __forceinline__ void naive_indexer(const Ctx& a, unsigned char* lds, int WID_) {
    const bf16* P = (const bf16*)(a.ws() + WS_PROJ); unsigned* MASK = (unsigned*)(a.ws() + WS_MASK);
    const int tid = otid(WID_), lane = tid & 63;
    float* qf = (float*)lds; float* wq = (float*)(lds + 2048); unsigned* keys = (unsigned*)(lds + 4096); unsigned* lcnt = (unsigned*)(lds + 12288); unsigned* maskw = (unsigned*)(lds + 12544);
    for (int t = blockIdx.x; t < T; t += gridDim.x) {
        const int b = t >> 11, s = t & 2047, vis = ((s >> 6) + 1) << 6;
        { const bf16* qr = P + (size_t)t * NP + C_IQ; qf[tid] = bf2f(qr[tid]); if (tid < 8) wq[tid] = bf2f(P[(size_t)t * NP + C_IW + tid]); if (tid < 40) lcnt[tid] = 0u; if (tid < 64) maskw[tid] = 0u; }
        __syncthreads();
        for (int k = tid; k < vis; k += 512) {
            const v4u* kr = (const v4u*)(P + (size_t)(b * SEQ + k) * NP + C_IK); float kf[64];
#pragma unroll
            for (int i = 0; i < 8; ++i) { const v4u v = kr[i]; kf[8 * i] = bflo(v.x); kf[8 * i + 1] = bfhi(v.x); kf[8 * i + 2] = bflo(v.y); kf[8 * i + 3] = bfhi(v.y); kf[8 * i + 4] = bflo(v.z); kf[8 * i + 5] = bfhi(v.z); kf[8 * i + 6] = bflo(v.w); kf[8 * i + 7] = bfhi(v.w); }
            float scv = 0.f;
            asm volatile("" ::: "memory");
#pragma unroll 1
            for (int h = 0; h < 8; ++h) { float d = 0.f;
#pragma unroll
                for (int i = 0; i < 64; ++i) d = fmaf(qf[h * 64 + i], kf[i], d);
                scv = fmaf(wq[h], fmaxf(d, 0.f), scv); }
            keys[k] = sortable(scv + 0.f);
        }
        __syncthreads();
        if (vis <= TOPK) { if (tid < 64) MASK[(size_t)t * 64 + tid] = (tid * 32 < vis) ? 0xffffffffu : 0u; }
        else {
            unsigned K = 0u;
            for (int bit = 31; bit >= 0; --bit) {
                const unsigned trial = K | (1u << bit); int c = 0;
                for (int k = tid; k < vis; k += 512) c += keys[k] >= trial ? 1 : 0;
                c = wave_sum_i(c); if (lane == 0 && c) atomicAdd(&lcnt[bit], (unsigned)c);
                __syncthreads();
                if (lcnt[bit] >= (unsigned)TOPK) K = trial;
            }
            { int c = 0; for (int k = tid; k < vis; k += 512) c += keys[k] > K ? 1 : 0; c = wave_sum_i(c); if (lane == 0 && c) atomicAdd(&lcnt[32], (unsigned)c); }
            __syncthreads();
            const int need = TOPK - (int)lcnt[32];
            for (int k = tid; k < vis; k += 512) {
                const unsigned kv = keys[k]; bool sel = kv > K;
                if (kv == K) { int r = 0; for (int j = 0; j < k; ++j) r += keys[j] == K ? 1 : 0; sel = r < need; }
                if (sel) atomicOr(&maskw[k >> 5], 1u << (k & 31));
            }
            __syncthreads();
            if (tid < 64) MASK[(size_t)t * 64 + tid] = maskw[tid];
        }
        __syncthreads();
    }
}
__device__ __forceinline__ float lam_value(const Ctx& a) {
    float s1 = 0.f, s2 = 0.f;
    for (int i = 0; i < 64; ++i) { s1 = fmaf(a.in(I_LQ1)[i], a.in(I_LK1)[i], s1); s2 = fmaf(a.in(I_LQ2)[i], a.in(I_LK2)[i], s2); }
    return expf(s1) - expf(s2) + 0.2f;
}
__device__ __forceinline__ void naive_diffattn(const Ctx& a, unsigned char* lds, int WID_) {
    bf16* P = (bf16*)(a.ws() + WS_PROJ);
    const int tid = otid(WID_), lane = tid & 63, wv = tid >> 6;
    float* lg = (float*)(lds + wv * 16384);
    float* qs = (float*)(lds + 131072 + wv * 512);
    const float lam = lam_value(a);
    const int gw = blockIdx.x * 8 + wv, NW = gridDim.x * 8;
    for (int it = gw; it < T * 4; it += NW) {
        const int t = it >> 2, h = it & 3, b = t >> 11, s = t & 2047, vis = ((s >> 6) + 1) << 6;
        const float sl = SLOPE_A[h] * LOG2E;
        { const bf16* qr = P + (size_t)t * NP + C_AQ + h * 128; qs[lane] = bf2f(qr[lane]); qs[lane + 64] = bf2f(qr[lane + 64]); }
        LDS_WAIT();
        float m0 = -1e30f, m1 = -1e30f;
        for (int k = lane; k < vis; k += 64) {
            asm volatile("" ::: "memory");
            const v4u* kr = (const v4u*)(P + (size_t)(b * SEQ + k) * NP + C_AK + h * 128); float d0 = 0.f, d1 = 0.f;
#pragma unroll
            for (int i = 0; i < 8; ++i) { const v4u v = kr[i]; const float* q = qs + 8 * i;
                d0 = fmaf(q[0], bflo(v.x), d0); d0 = fmaf(q[1], bfhi(v.x), d0); d0 = fmaf(q[2], bflo(v.y), d0); d0 = fmaf(q[3], bfhi(v.y), d0);
                d0 = fmaf(q[4], bflo(v.z), d0); d0 = fmaf(q[5], bfhi(v.z), d0); d0 = fmaf(q[6], bflo(v.w), d0); d0 = fmaf(q[7], bfhi(v.w), d0); }
#pragma unroll
            for (int i = 0; i < 8; ++i) { const v4u v = kr[8 + i]; const float* q = qs + 64 + 8 * i;
                d1 = fmaf(q[0], bflo(v.x), d1); d1 = fmaf(q[1], bfhi(v.x), d1); d1 = fmaf(q[2], bflo(v.y), d1); d1 = fmaf(q[3], bfhi(v.y), d1);
                d1 = fmaf(q[4], bflo(v.z), d1); d1 = fmaf(q[5], bfhi(v.z), d1); d1 = fmaf(q[6], bflo(v.w), d1); d1 = fmaf(q[7], bfhi(v.w), d1); }
            const float bias = sl * fabsf((float)(s - k));
            d0 -= bias; d1 -= bias; lg[k] = d0; lg[2048 + k] = d1; m0 = fmaxf(m0, d0); m1 = fmaxf(m1, d1);
        }
        m0 = wave_max(m0); m1 = wave_max(m1);
        float l0 = 0.f, l1 = 0.f;
        for (int k = lane; k < vis; k += 64) { const float p0 = exp2f(lg[k] - m0), p1 = exp2f(lg[2048 + k] - m1); lg[k] = p0; lg[2048 + k] = p1; l0 += p0; l1 += p1; }
        l0 = wave_sum(l0); l1 = wave_sum(l1);
        LDS_WAIT();
        float o00 = 0.f, o01 = 0.f, o10 = 0.f, o11 = 0.f;
        const bf16* vb = P + (size_t)(b * SEQ) * NP + C_AV + h * 128 + lane;
        for (int k = 0; k < vis; ++k) { const float v0 = bf2f(vb[(size_t)k * NP]), v1 = bf2f(vb[(size_t)k * NP + 64]); const float p0 = lg[k], p1 = lg[2048 + k];
            o00 = fmaf(p0, v0, o00); o01 = fmaf(p0, v1, o01); o10 = fmaf(p1, v0, o10); o11 = fmaf(p1, v1, o11); }
        const float r0 = 1.f / l0, r1 = lam / l1;
        const float y0 = o00 * r0 - o10 * r1, y1 = o01 * r0 - o11 * r1;
        const float ss = wave_sum(y0 * y0 + y1 * y1); const float rn = 0.8f / sqrtf(ss * (1.f / 128.f) + RMS_EPS);
        bf16* yo = P + (size_t)t * NP + C_AQ + h * 128;
        yo[lane] = (bf16)f2bf(y0 * rn * a.in(I_SUBLN)[lane]); yo[lane + 64] = (bf16)f2bf(y1 * rn * a.in(I_SUBLN)[lane + 64]);
        LDS_WAIT();
    }
}
__device__ __forceinline__ void naive_battn(const Ctx& a, unsigned char* lds, int WID_) {
    bf16* P = (bf16*)(a.ws() + WS_PROJ); const bf16* KV = (const bf16*)(a.ws() + WS_KV); const unsigned* MASK = (const unsigned*)(a.ws() + WS_MASK);
    const int tid = otid(WID_), lane = tid & 63, wv = tid >> 6;
    float* lg = (float*)(lds + wv * 16384); float* qs = (float*)(lds + 131072 + wv * 512);
    const int gw = blockIdx.x * 8 + wv, NW = gridDim.x * 8;
    for (int it = gw; it < T * 8; it += NW) {
        const int t = it >> 3, h = it & 7, b = t >> 11, s = t & 2047, vis = ((s >> 6) + 1) << 6;
        const float sl = SLOPE_B[h] * LOG2E;
        qs[lane] = bf2f(P[(size_t)t * NP + C_BQ + h * 64 + lane]);
        LDS_WAIT();
        float m0 = -1e30f;
        for (int k = lane; k < vis; k += 64) {
            const unsigned mw = MASK[(size_t)t * 64 + (k >> 5)]; float d0 = -INFINITY;
            asm volatile("" ::: "memory");
            if ((mw >> (k & 31)) & 1u) {
                const v4u* kr = (const v4u*)(KV + (size_t)(b * SEQ + k) * 1024 + h * 64); d0 = 0.f;
#pragma unroll
                for (int i = 0; i < 8; ++i) { const v4u v = kr[i]; const float* q = qs + 8 * i;
                    d0 = fmaf(q[0], bflo(v.x), d0); d0 = fmaf(q[1], bfhi(v.x), d0); d0 = fmaf(q[2], bflo(v.y), d0); d0 = fmaf(q[3], bfhi(v.y), d0);
                    d0 = fmaf(q[4], bflo(v.z), d0); d0 = fmaf(q[5], bfhi(v.z), d0); d0 = fmaf(q[6], bflo(v.w), d0); d0 = fmaf(q[7], bfhi(v.w), d0); }
                d0 -= sl * fabsf((float)(s - k));
            }
            lg[k] = d0; m0 = fmaxf(m0, d0);
        }
        m0 = wave_max(m0);
        float l0 = 0.f;
        for (int k = lane; k < vis; k += 64) { const float p0 = exp2f(lg[k] - m0); lg[k] = p0; l0 += p0; }
        l0 = wave_sum(l0);
        LDS_WAIT();
        float o = 0.f; const bf16* vb = KV + (size_t)(b * SEQ) * 1024 + 512 + h * 64 + lane;
        for (int k = 0; k < vis; ++k) o = fmaf(lg[k], bf2f(vb[(size_t)k * 1024]), o);
        P[(size_t)t * NP + C_BQ + h * 64 + lane] = (bf16)f2bf(o / l0);
        LDS_WAIT();
    }
}
struct Route { int bucket; float wi, wj; int pad; };
__device__ __forceinline__ void p7_ln_route(const Ctx& a, unsigned char* lds, bool dry, int WID_) {
    unsigned char* ws = a.ws(); const int tid = otid(WID_), lane = tid & 63, wv = tid >> 6, blk = blockIdx.x;
    float* rw = (float*)lds; int* cnt = (int*)(lds + 81920); const float* SMv = (const float*)(a.ws() + WS_SMALL);
    const float* RW = (const float*)(ws + WS_RW); const float* MOD = (const float*)(ws + WS_MOD);
    bf16* U2 = (bf16*)(ws + WS_U2); Route* RT = (Route*)(ws + WS_ROUTE2); int* PERM = (int*)(ws + WS_ROUTE2 + 512 * 1024); int* CNT = (int*)(ws + WS_ROUTE2 + 1024 * 1024);
    for (int i = tid; i < 20 * 1024 / 4; i += 512) ((f32x4*)rw)[i] = ((const f32x4*)RW)[i];
    if (tid < 24) cnt[tid] = 0;
    for (int i = blk * 512 + tid; i < MAXSLOT; i += gridDim.x * 512) PERM[i] = -1;
    __syncthreads();
    const int b = blk >> 4;
    const float* sh2 = MOD + b * 6144 + 3072; const float* sc2 = MOD + b * 6144 + 4096;
    float* const outp = a.out();
    f32x4 nx[4];
#pragma unroll
    for (int j = 0; j < 4; ++j) nx[j] = *(const f32x4*)(outp + (size_t)(blk * 128 + wv * 16) * 1024 + j * 256 + lane * 4);
    for (int i = 0; i < 16; ++i) {
        const int t = blk * 128 + wv * 16 + i; float* row = outp + (size_t)t * 1024;
        f32x4 v[4]; float sm = 0.f;
#pragma unroll
        for (int j = 0; j < 4; ++j) { v[j] = nx[j]; sm += (v[j].x + v[j].y) + (v[j].z + v[j].w); }
        if (i + 1 < 16) {
#pragma unroll
            for (int j = 0; j < 4; ++j) nx[j] = *(const f32x4*)(row + 1024 + j * 256 + lane * 4); }
        const float mean = wave_sum(sm) * (1.f / 1024.f); float sq = 0.f;
#pragma unroll
        for (int j = 0; j < 4; ++j) { v[j] = v[j] - mean; sq += (v[j].x * v[j].x + v[j].y * v[j].y) + (v[j].z * v[j].z + v[j].w * v[j].w); }
        const float rstd = 1.f / sqrtf(wave_sum(sq) * (1.f / 1024.f) + LN_EPS);
        f32x4 u[4];
#pragma unroll
        for (int j = 0; j < 4; ++j) { const int c = j * 256 + lane * 4; const f32x4 g = *(const f32x4*)(SMv + SM_LN1G + c), bb = *(const f32x4*)(SMv + SM_LN1B + c);
            const f32x4 x1 = v[j] * rstd * g + bb; *(f32x4*)((dry ? (float*)(ws + 300 * MiB) + (size_t)t * 1024 : row) + c) = x1;
            const f32x4 s2 = *(const f32x4*)(sc2 + c), h2 = *(const f32x4*)(sh2 + c); u[j] = x1 * (1.f + s2) + h2;
            v2u o; o.x = pk2(u[j].x, u[j].y); o.y = pk2(u[j].z, u[j].w); *(v2u*)((dry ? (bf16*)(ws + 428 * MiB) : U2) + (size_t)t * 1024 + c) = o; }
        float lgt[20];
#pragma unroll
        for (int c = 0; c < 20; ++c) { float p = 0.f;
#pragma unroll
            for (int j = 0; j < 4; ++j) { const f32x4 w = *(const f32x4*)(rw + c * 1024 + j * 256 + lane * 4); p += (u[j].x * w.x + u[j].y * w.y) + (u[j].z * w.z + u[j].w * w.w); }
            lgt[c] = wave_sum(p); }
#pragma unroll
        for (int c = 0; c < 4; ++c) lgt[c] += SMv[SM_BGRP + c];
#pragma unroll
        for (int c = 0; c < 16; ++c) lgt[4 + c] += SMv[SM_BER + c];
        int g = 0; float gm = lgt[0];
#pragma unroll
        for (int c = 1; c < 4; ++c) if (lgt[c] > gm) { gm = lgt[c]; g = c; }
        float gs = 0.f;
#pragma unroll
        for (int c = 0; c < 4; ++c) gs += __expf(lgt[c] - gm);
        const float gp = 1.f / gs;
        float el[4];
#pragma unroll
        for (int e = 0; e < 4; ++e) el[e] = g == 0 ? lgt[4 + e] : (g == 1 ? lgt[8 + e] : (g == 2 ? lgt[12 + e] : lgt[16 + e]));
        int i1 = 0; float v1 = el[0];
#pragma unroll
        for (int e = 1; e < 4; ++e) if (el[e] > v1) { v1 = el[e]; i1 = e; }
        int i2 = -1; float v2 = -INFINITY;
#pragma unroll
        for (int e = 0; e < 4; ++e) if (e != i1 && el[e] > v2) { v2 = el[e]; i2 = e; }
        const float e2 = __expf(v2 - v1); const float w1 = gp / (1.f + e2), w2 = gp * e2 / (1.f + e2);
        const int lo = i1 < i2 ? i1 : i2, hi = i1 < i2 ? i2 : i1; const float wlo = i1 < i2 ? w1 : w2, whi = i1 < i2 ? w2 : w1;
        const int pi = lo == 0 ? hi - 1 : (lo == 1 ? hi + 1 : 5);
        const int bucket = g * 6 + pi;
        if (lane == 0 && !dry) { Route r; r.bucket = bucket; r.wi = wlo; r.wj = whi; r.pad = 0; RT[t] = r; atomicAdd(&cnt[bucket], 1); }
    }
    __syncthreads();
    if (tid < 24 && !dry) CNT[blk * 24 + tid] = cnt[tid];
    __syncthreads();
}
__device__ __forceinline__ void p8_sort(const Ctx& a, unsigned char* lds, int WID_) {
    unsigned char* ws = a.ws(); const int tid = otid(WID_), blk = blockIdx.x;
    const Route* RT = (const Route*)(ws + WS_ROUTE2); int* PERM = (int*)(ws + WS_ROUTE2 + 512 * 1024); const int* CNT = (const int*)(ws + WS_ROUTE2 + 1024 * 1024);
    int* BASES = (int*)(ws + WS_ROUTE2 + 1024 * 1024 + 32768); float* SLOTW = (float*)(ws + WS_ROUTE2 + 1280 * 1024);
    const bf16* U2 = (const bf16*)(ws + WS_U2); bf16* XS = (bf16*)(ws + WS_XS);
    int* tot = (int*)lds; int* pre = tot + 32; int* base = pre + 32; int* bk = base + 32; int* slot = bk + 128;
    if (tid < 64) tot[tid] = 0;
    __syncthreads();
    if (tid < 384) { const int p = tid >> 4, sg = tid & 15; int sa = 0, sp = 0;
#pragma unroll
        for (int i = 0; i < 16; ++i) { const int bb = sg * 16 + i; const int c = CNT[bb * 24 + p]; sa += c; sp += bb < blk ? c : 0; }
        atomicAdd(&tot[p], sa); atomicAdd(&pre[p], sp); }
    __syncthreads();
    if (tid == 0) { int acc = 0; for (int p = 0; p < 24; ++p) { base[p] = acc; acc += (tot[p] + 255) & ~255; } base[24] = acc;
        if (blk == 0) { for (int p = 0; p <= 24; ++p) BASES[p] = base[p]; } }
    if (tid < 128) bk[tid] = RT[blk * 128 + tid].bucket;
    __syncthreads();
    if (tid < 128) { const int p = bk[tid]; int r = 0; for (int j = 0; j < tid; ++j) r += bk[j] == p ? 1 : 0; const int s = base[p] + pre[p] + r; slot[tid] = s;
        const int t = blk * 128 + tid; PERM[s] = t; SLOTW[2 * s] = RT[t].wi; SLOTW[2 * s + 1] = RT[t].wj; }
    __syncthreads();
    for (int i0 = tid; i0 < 128 * 128; i0 += 512 * 8) {
        v4u cv[8];
#pragma unroll
        for (int j = 0; j < 8; ++j) { const int i = i0 + j * 512, r = i >> 7, c = i & 127; cv[j] = ((const v4u*)(U2 + (size_t)(blk * 128 + r) * 1024))[c]; }
#pragma unroll
        for (int j = 0; j < 8; ++j) { const int i = i0 + j * 512, r = i >> 7, c = i & 127; ((v4u*)(XS + (size_t)slot[r] * 1024))[c] = cv[j]; } }
    __syncthreads();
}
__device__ __forceinline__ int bucket_of_slot(const int* BASES, int s) { int p = 0; for (int q = 1; q < 24; ++q) if (s >= BASES[q]) p = q; return p; }
__device__ __forceinline__ void pair_experts(int p, int& ei, int& ej) { const int g = p / 6, pi = p % 6; ei = 4 * g + (pi < 3 ? 0 : (pi < 5 ? 1 : 2)); ej = 4 * g + (pi < 3 ? pi + 1 : (pi < 5 ? pi - 1 : 3)); }
__device__ __forceinline__ void naive_moe1(const Ctx& a, unsigned char* lds, int WID_) {
    unsigned char* ws = a.ws(); const int tid = otid(WID_);
    const int* PERM = (const int*)(ws + WS_ROUTE2 + 512 * 1024); const int* BASES = (const int*)(ws + WS_ROUTE2 + 1024 * 1024 + 32768); const float* SLOTW = (const float*)(ws + WS_ROUTE2 + 1280 * 1024);
    const bf16* XS = (const bf16*)(ws + WS_XS); const bf16* W1 = (const bf16*)(ws + WS_W1); bf16* H = (bf16*)(ws + WS_H);
    float* xs = (float*)lds; const int nslot = BASES[24];
    for (int s = blockIdx.x; s < nslot; s += gridDim.x) {
        if (PERM[s] < 0) continue;
        const int p = bucket_of_slot(BASES, s); int ei, ej; pair_experts(p, ei, ej);
        __syncthreads();
        xs[tid] = bf2f(XS[(size_t)s * 1024 + tid]); xs[tid + 512] = bf2f(XS[(size_t)s * 1024 + 512 + tid]);
        __syncthreads();
        const int m = tid >> 8, c = tid & 255, e = m ? ej : ei; const int grow = (c >> 7) * 256 + (c & 127);
        const v4u* wg = (const v4u*)(W1 + ((size_t)e * 512 + grow) * 1024); const v4u* wu = (const v4u*)(W1 + ((size_t)e * 512 + grow + 128) * 1024);
        float dg = 0.f, du = 0.f;
        for (int i = 0; i < 128; ++i) { const v4u g = wg[i], u = wu[i]; const float* x = xs + 8 * i;
            dg = fmaf(x[0], bflo(g.x), dg); dg = fmaf(x[1], bfhi(g.x), dg); dg = fmaf(x[2], bflo(g.y), dg); dg = fmaf(x[3], bfhi(g.y), dg);
            dg = fmaf(x[4], bflo(g.z), dg); dg = fmaf(x[5], bfhi(g.z), dg); dg = fmaf(x[6], bflo(g.w), dg); dg = fmaf(x[7], bfhi(g.w), dg);
            du = fmaf(x[0], bflo(u.x), du); du = fmaf(x[1], bfhi(u.x), du); du = fmaf(x[2], bflo(u.y), du); du = fmaf(x[3], bfhi(u.y), du);
            du = fmaf(x[4], bflo(u.z), du); du = fmaf(x[5], bfhi(u.z), du); du = fmaf(x[6], bflo(u.w), du); du = fmaf(x[7], bfhi(u.w), du); }
        const float hv = dg / (1.f + __expf(-dg)) * du * SLOTW[2 * s + m];
        H[(size_t)s * 512 + tid] = (bf16)f2bf(hv);
    }
    __syncthreads();
}
__device__ __forceinline__ void naive_moe2(const Ctx& a, unsigned char* lds, int WID_) {
    unsigned char* ws = a.ws(); const int tid = otid(WID_);
    const int* PERM = (const int*)(ws + WS_ROUTE2 + 512 * 1024); const int* BASES = (const int*)(ws + WS_ROUTE2 + 1024 * 1024 + 32768);
    const bf16* W2P = (const bf16*)(ws + WS_W2P); const bf16* H = (const bf16*)(ws + WS_H); const float* MOD = (const float*)(ws + WS_MOD);
    float* hs = (float*)lds; const int nslot = BASES[24];
    for (int s = blockIdx.x; s < nslot; s += gridDim.x) {
        const int t = PERM[s]; if (t < 0) continue;
        const int p = bucket_of_slot(BASES, s);
        __syncthreads();
        hs[tid] = bf2f(H[(size_t)s * 512 + tid]);
        __syncthreads();
        for (int j = tid; j < 1024; j += 512) {
            const v4u* w = (const v4u*)(W2P + ((size_t)p * 1024 + j) * 512); float y = 0.f;
            for (int i = 0; i < 64; ++i) { const v4u g = w[i]; const float* x = hs + 8 * i;
                y = fmaf(x[0], bflo(g.x), y); y = fmaf(x[1], bfhi(g.x), y); y = fmaf(x[2], bflo(g.y), y); y = fmaf(x[3], bfhi(g.y), y);
                y = fmaf(x[4], bflo(g.z), y); y = fmaf(x[5], bfhi(g.z), y); y = fmaf(x[6], bflo(g.w), y); y = fmaf(x[7], bfhi(g.w), y); }
            const size_t o = (size_t)t * 1024 + j; a.out()[o] = ALPHA * a.out()[o] + MOD[(t >> 11) * 6144 + 5120 + j] * y;
        }
    }
    __syncthreads();
}
__device__ __forceinline__ void p11_ln(const Ctx& a, bool dry, int WID_) {
    const float* SMv = (const float*)(a.ws() + WS_SMALL);
    const int tid = otid(WID_); const int lane = tid & 63, gw = blockIdx.x * 8 + (tid >> 6), NW = gridDim.x * 8;
    float* const outp = a.out();
    f32x4 nx[4];
#pragma unroll
    for (int j = 0; j < 4; ++j) nx[j] = *(const f32x4*)(outp + (size_t)gw * 1024 + j * 256 + lane * 4);
    for (int t = gw; t < T; t += NW) {
        float* row = outp + (size_t)t * 1024; f32x4 v[4]; float sm = 0.f;
#pragma unroll
        for (int j = 0; j < 4; ++j) { v[j] = nx[j]; sm += (v[j].x + v[j].y) + (v[j].z + v[j].w); }
        if (t + NW < T) {
#pragma unroll
            for (int j = 0; j < 4; ++j) nx[j] = *(const f32x4*)(row + (size_t)NW * 1024 + j * 256 + lane * 4); }
        const float mean = wave_sum(sm) * (1.f / 1024.f); float sq = 0.f;
#pragma unroll
        for (int j = 0; j < 4; ++j) { v[j] = v[j] - mean; sq += (v[j].x * v[j].x + v[j].y * v[j].y) + (v[j].z * v[j].z + v[j].w * v[j].w); }
        const float rstd = 1.f / sqrtf(wave_sum(sq) * (1.f / 1024.f) + LN_EPS);
#pragma unroll
        for (int j = 0; j < 4; ++j) { const int c = j * 256 + lane * 4; const f32x4 g = *(const f32x4*)(SMv + SM_LN2G + c), bb = *(const f32x4*)(SMv + SM_LN2B + c); *(f32x4*)((dry ? (float*)(a.ws() + 60 * MiB) + (size_t)t * 1024 : row) + c) = v[j] * rstd * g + bb; }
    }
}

namespace pg8 {
#define PG8_LAS __attribute__((address_space(3)))
typedef unsigned short bf16_t;
typedef short bf16x8 __attribute__((ext_vector_type(8)));
typedef float f32x4 __attribute__((ext_vector_type(4)));
typedef unsigned u32x4 __attribute__((ext_vector_type(4)));
constexpr int BM = 256, BK = 64, HALF = 128, HTB = HALF * BK * 2  , STAGE_BYTES = 8 * HTB, NXCD = 8, WGM = 8;

__host__ __device__ __forceinline__ int lds_byte(int r, int c) { const int st = (r >> 4) * 2 + (c >> 5), rr = r & 15, cc = c & 31, ob = rr * 64 + cc * 2; return st * 1024 + (ob ^ (((ob >> 9) & 1) << 5)); }
__host__ __device__ __forceinline__ void stage_rc(int b, int& R, int& C) { const int st = b / 1024, sb = b % 1024, swz = sb ^ (((sb >> 9) & 1) << 5); R = (st >> 1) * 16 + swz / 64; C = (st & 1) * 32 + (swz % 64) / 2; }
__host__ __device__ __forceinline__ int perm32(int rho) { const int n = rho >> 4, i = rho & 15; return 8 * (i >> 2) + 4 * n + (i & 3); }

struct Unit { int pm, pn; };
struct Gemm { const bf16_t* A; const bf16_t* Bt; int M, N, K, lda, ldb; };

struct StaticOrder {
    int nM, nN, nwg, G, c;
    __host__ __device__ void init(int M, int N, int G_, int c_) { nM = M / BM; nN = N / BM; nwg = nM * nN; G = G_; c = c_; }
    __host__ __device__ bool next(int i, Unit& u) const {
        const long L = (long)i * G + c; if (L >= nwg) return false;
        int wgid = (int)L; { const int q = nwg / NXCD, r = nwg % NXCD, xcd = wgid % NXCD, off = wgid / NXCD; wgid = (xcd < r ? xcd * (q + 1) : r * (q + 1) + (xcd - r) * q) + off; }
        const int nig = WGM * nN, gid = wgid / nig, fm = gid * WGM, gsz = (nM - fm) < WGM ? (nM - fm) : WGM;
        u.pm = fm + ((wgid % nig) % gsz); u.pn = (wgid % nig) / gsz; return true;
    }
    __device__ __forceinline__ void a_ready(const Unit&) const {}
    __device__ __forceinline__ void done(const Unit&) const {}
    __device__ __forceinline__ const char* bbase(const Gemm& g, const Unit& u) const { return (const char*)g.Bt + (size_t)u.pn * ((size_t)BM * g.ldb * 2); }
};

template <class Epi, class Sched, bool ALIGN_EPI, bool SP2, int KK, int LDA, int LDB>
__device__ __forceinline__ void gemm_phase(PG8_LAS unsigned char* lds, const Gemm g, const Sched& S, const Epi& E, int WID_) {
    int tid_ = otid(WID_);
    const int tid = tid_, wid = __builtin_amdgcn_readfirstlane(tid >> 6), lane = tid & 63, wr = wid >> 2, wc = wid & 3, fr = lane & 15, fq = lane >> 4;
    constexpr int K = KK, nt = K / BK;
    unsigned voffA[2], voffB[2];
#pragma unroll
    for (int i = 0; i < 2; ++i) { int R, C; stage_rc(tid * 16 + i * 8192, R, C); const int Rb = Epi::PERM ? ((R & ~31) + perm32(R & 31)) : R;
        voffA[i] = (unsigned)(R * LDA + C) * 2u; voffB[i] = (unsigned)(Rb * LDB + C) * 2u; }
    constexpr size_t kstep = (size_t)(BK * 2);
    constexpr size_t hstepA = (size_t)HALF * LDA * 2, hstepB = (size_t)HALF * LDB * 2;
    constexpr size_t tstepA = 2 * hstepA;
    const unsigned ldsw = (unsigned)wid * 1024u;
    const int aoff = lds_byte(wr * 64 + fr, fq * 8), boff = lds_byte(wc * 32 + fr, fq * 8);
#define PG8_SA(b, h) (((b) * 2 + (h)) * HTB)
#define PG8_SB(b, h) ((4 + (b) * 2 + (h)) * HTB)
#define PG8_STAGE(bufoff, gbase, voff) do { _Pragma("unroll") for (int _i = 0; _i < 2; ++_i) \
        __builtin_amdgcn_global_load_lds((const unsigned*)((const char*)(gbase) + (voff)[_i]), (PG8_LAS unsigned*)(lds + (bufoff) + ldsw + _i * 8192), 16, 0, 0); } while (0)
#define PG8_LDA(dst, b, h) do { _Pragma("unroll") for (int m = 0; m < 4; ++m) _Pragma("unroll") for (int k = 0; k < 2; ++k) dst[m][k] = *(const PG8_LAS bf16x8*)(lds + PG8_SA(b, h) + aoff + m * 2048 + k * 1024); } while (0)
#define PG8_LDB(dst, b, h) do { _Pragma("unroll") for (int n = 0; n < 2; ++n) _Pragma("unroll") for (int k = 0; k < 2; ++k) dst[n][k] = *(const PG8_LAS bf16x8*)(lds + PG8_SB(b, h) + boff + n * 2048 + k * 1024); } while (0)
#define PG8_MMA(ai, bj, At, Bt) do { __builtin_amdgcn_s_setprio(1); _Pragma("unroll") for (int m = 0; m < 4; ++m) _Pragma("unroll") for (int n = 0; n < 2; ++n) _Pragma("unroll") for (int k = 0; k < 2; ++k) \
        acc[ai][bj][m][n] = __builtin_amdgcn_mfma_f32_16x16x32_bf16(Bt[n][k], At[m][k], acc[ai][bj][m][n], 0, 0, 0); __builtin_amdgcn_s_setprio(0); } while (0)
#define PG8_WAIT_V(n) asm volatile("s_waitcnt vmcnt(" #n ")" ::: "memory")
#define PG8_WAIT_L(n) asm volatile("s_waitcnt lgkmcnt(" #n ")" ::: "memory")
#define PG8_BAR __builtin_amdgcn_s_barrier()
#define PG8_SCHED __builtin_amdgcn_sched_barrier(0)
    Unit cur, nxt; int ui = 0;
    if (!S.next(0, cur)) return;
    f32x4 acc[2][2][4][2];
#pragma unroll
    for (int a = 0; a < 2; ++a)
#pragma unroll
        for (int b = 0; b < 2; ++b)
#pragma unroll
            for (int m = 0; m < 4; ++m)
#pragma unroll
                for (int n = 0; n < 2; ++n) acc[a][b][m][n] = (f32x4){0.f, 0.f, 0.f, 0.f};
    bf16x8 At[4][2], B0[2][2], B1[2][2];
    const char* cA = (const char*)g.A + (size_t)cur.pm * tstepA; const char* cB = S.bbase(g, cur);
    S.a_ready(cur);
    if constexpr (SP2) {
        PG8_STAGE(PG8_SB(0, 0), cB, voffB); PG8_STAGE(PG8_SB(0, 1), cB + hstepB, voffB); PG8_STAGE(PG8_SA(0, 0), cA, voffA); PG8_STAGE(PG8_SA(0, 1), cA + hstepA, voffA);
        if (wr == 1) PG8_BAR;
        PG8_WAIT_V(2); PG8_BAR;
        PG8_STAGE(PG8_SB(1, 0), cB + kstep, voffB); PG8_STAGE(PG8_SA(1, 0), cA + kstep, voffA); PG8_STAGE(PG8_SB(1, 1), cB + hstepB + kstep, voffB);
        PG8_WAIT_V(6); PG8_BAR;
    } else {
        PG8_STAGE(PG8_SB(0, 0), cB, voffB); PG8_STAGE(PG8_SA(0, 0), cA, voffA); PG8_STAGE(PG8_SB(0, 1), cB + hstepB, voffB); PG8_STAGE(PG8_SA(0, 1), cA + hstepA, voffA);
        if (wr == 1) PG8_BAR;
        PG8_WAIT_V(4); PG8_BAR;
        PG8_STAGE(PG8_SB(1, 0), cB + kstep, voffB); PG8_STAGE(PG8_SA(1, 0), cA + kstep, voffA); PG8_STAGE(PG8_SB(1, 1), cB + hstepB + kstep, voffB);
        PG8_WAIT_V(6); PG8_BAR;
    }
    for (;;) {
        const bool has_next = S.next(ui + 1, nxt);
        const char* nA = has_next ? (const char*)g.A + (size_t)nxt.pm * tstepA : cA; const char* nB = has_next ? S.bbase(g, nxt) : cB;
        for (int t = 0; t < nt; t += 2) {
            const bool last = (t == nt - 2);
            const char* a1 = cA + (size_t)(t + 1) * kstep;
            const char* a2 = last ? nA : cA + (size_t)(t + 2) * kstep; const char* b2 = last ? nB : cB + (size_t)(t + 2) * kstep;
            const char* a3 = a2 + kstep; const char* b3 = b2 + kstep;
            if (last && has_next) S.a_ready(nxt);
            if constexpr (SP2) {
            PG8_LDB(B0, 0, 0); PG8_LDB(B1, 0, 1); PG8_SCHED; PG8_LDA(At, 0, 0); PG8_STAGE(PG8_SA(1, 1), a1 + hstepA, voffA);
            PG8_WAIT_V(8); PG8_WAIT_L(0); PG8_BAR; PG8_MMA(0, 0, At, B0); PG8_MMA(0, 1, At, B1); PG8_BAR; PG8_SCHED;
            PG8_LDA(At, 0, 1); PG8_STAGE(PG8_SB(0, 0), b2, voffB); PG8_STAGE(PG8_SB(0, 1), b2 + hstepB, voffB); PG8_STAGE(PG8_SA(0, 0), a2, voffA);
            PG8_WAIT_V(8); PG8_WAIT_L(0); PG8_BAR; PG8_MMA(1, 0, At, B0); PG8_MMA(1, 1, At, B1); PG8_BAR; PG8_SCHED;
            PG8_LDB(B0, 1, 0); PG8_LDB(B1, 1, 1); PG8_SCHED; PG8_LDA(At, 1, 0); PG8_STAGE(PG8_SA(0, 1), a2 + hstepA, voffA);
            PG8_WAIT_V(8); PG8_WAIT_L(0); PG8_BAR; PG8_MMA(0, 0, At, B0); PG8_MMA(0, 1, At, B1); PG8_BAR; PG8_SCHED;
            PG8_LDA(At, 1, 1); PG8_STAGE(PG8_SB(1, 0), b3, voffB); PG8_STAGE(PG8_SB(1, 1), b3 + hstepB, voffB); PG8_STAGE(PG8_SA(1, 0), a3, voffA);
            PG8_WAIT_V(8); PG8_WAIT_L(0); PG8_BAR; PG8_MMA(1, 0, At, B0); PG8_MMA(1, 1, At, B1); PG8_BAR; PG8_SCHED;
            } else {
            PG8_LDB(B0, 0, 0); PG8_SCHED; PG8_LDA(At, 0, 0); PG8_STAGE(PG8_SA(1, 1), a1 + hstepA, voffA);
            PG8_WAIT_L(8); PG8_BAR; PG8_WAIT_L(0); PG8_MMA(0, 0, At, B0); PG8_BAR; PG8_SCHED;
            PG8_LDB(B1, 0, 1); PG8_STAGE(PG8_SB(0, 0), b2, voffB);
            PG8_BAR; PG8_WAIT_L(0); PG8_MMA(0, 1, At, B1); PG8_BAR;
            PG8_LDA(At, 0, 1); PG8_STAGE(PG8_SA(0, 0), a2, voffA);
            PG8_BAR; PG8_WAIT_L(0); PG8_MMA(1, 0, At, B0); PG8_BAR; PG8_SCHED;
            PG8_STAGE(PG8_SB(0, 1), b2 + hstepB, voffB);
            PG8_WAIT_V(6); PG8_BAR; PG8_MMA(1, 1, At, B1); PG8_BAR;
            PG8_LDB(B0, 1, 0); PG8_SCHED; PG8_LDA(At, 1, 0); PG8_STAGE(PG8_SA(0, 1), a2 + hstepA, voffA);
            PG8_WAIT_L(8); PG8_BAR; PG8_WAIT_L(0); PG8_MMA(0, 0, At, B0); PG8_BAR; PG8_SCHED;
            PG8_LDB(B1, 1, 1); PG8_STAGE(PG8_SB(1, 0), b3, voffB);
            PG8_BAR; PG8_WAIT_L(0); PG8_MMA(0, 1, At, B1); PG8_BAR;
            PG8_LDA(At, 1, 1); PG8_STAGE(PG8_SA(1, 0), a3, voffA);
            PG8_BAR; PG8_WAIT_L(0); PG8_MMA(1, 0, At, B0); PG8_BAR; PG8_SCHED;
            PG8_STAGE(PG8_SB(1, 1), b3 + hstepB, voffB);
            PG8_WAIT_V(6); PG8_BAR; PG8_MMA(1, 1, At, B1); PG8_BAR;
            }
        }
        if constexpr (ALIGN_EPI) { if (wr == 0) PG8_BAR; }
        if constexpr (!Epi::AFTER_DRAIN) { E(acc, cur, wr, wc, fr, fq); S.done(cur); }
        if (!has_next) break;
#pragma unroll
        for (int a = 0; a < 2; ++a)
#pragma unroll
            for (int b = 0; b < 2; ++b)
#pragma unroll
                for (int m = 0; m < 4; ++m)
#pragma unroll
                    for (int n = 0; n < 2; ++n) acc[a][b][m][n] = (f32x4){0.f, 0.f, 0.f, 0.f};
        cur = nxt; cA = nA; cB = nB; ++ui;
        if constexpr (ALIGN_EPI) { if (wr == 1) PG8_BAR; }
    }
    PG8_WAIT_V(0);
    if constexpr (!ALIGN_EPI) { if (wr == 0) PG8_BAR; }
    PG8_BAR;
    if constexpr (Epi::AFTER_DRAIN) { E.fused(acc, cur, wr, wc, fr, fq, lds, wid, lane); S.done(cur); }
#undef PG8_SA
#undef PG8_SB
#undef PG8_STAGE
#undef PG8_LDA
#undef PG8_LDB
#undef PG8_MMA
#undef PG8_WAIT_V
#undef PG8_WAIT_L
#undef PG8_BAR
#undef PG8_SCHED
}

__device__ __forceinline__ unsigned cvt_pk_bf16(float lo, float hi) { unsigned r; asm volatile("v_cvt_pk_bf16_f32 %0, %1, %2" : "=v"(r) : "v"(lo), "v"(hi)); return r; }
__device__ __forceinline__ float blo(unsigned w) { return __uint_as_float(w << 16); }
__device__ __forceinline__ float bhi(unsigned w) { return __uint_as_float(w & 0xffff0000u); }
__device__ __forceinline__ float sigm(float v) { return __builtin_amdgcn_rcpf(1.f + __builtin_amdgcn_exp2f(-1.4426950408889634f * v)); }
struct EpiProjF {
    static constexpr bool PERM = true, AFTER_DRAIN = false;
    bf16_t* O; int ldc; float qs;
    __device__ __forceinline__ void operator()(const f32x4 (&acc)[2][2][4][2], const Unit& u, int wr, int wc, int fr, int fq) const {
        const int row0 = u.pm * BM + wr * 64 + fr, col0 = u.pn * BM + wc * 32 + 8 * fq;
        const int mode = (u.pn < 2 || u.pn == 6 || u.pn == 7) ? 1 : (u.pn >= 11 ? 2 : 0);
#pragma unroll
        for (int ai = 0; ai < 2; ++ai)
#pragma unroll
            for (int m = 0; m < 4; ++m) { bf16_t* rowp = O + (size_t)(row0 + ai * HALF + m * 16) * ldc + col0;
#pragma unroll
                for (int bj = 0; bj < 2; ++bj) { f32x4 v0 = acc[ai][bj][m][0], v1 = acc[ai][bj][m][1];
                    if (mode == 1) { v0 = v0 * qs; v1 = v1 * qs; }
                    else if (mode == 2) { v0 = (f32x4){sigm(v0[0]), sigm(v0[1]), sigm(v0[2]), sigm(v0[3])}; v1 = (f32x4){sigm(v1[0]), sigm(v1[1]), sigm(v1[2]), sigm(v1[3])}; }
                    u32x4 w; w.x = cvt_pk_bf16(v0[0], v0[1]); w.y = cvt_pk_bf16(v0[2], v0[3]); w.z = cvt_pk_bf16(v1[0], v1[1]); w.w = cvt_pk_bf16(v1[2], v1[3]);
                    *(u32x4*)(rowp + bj * HALF) = w; } }
    }
};
struct EpiRowScale {
    static constexpr bool PERM = true, AFTER_DRAIN = false;
    bf16_t* O; int ldc; const float* rs;
    __device__ __forceinline__ void operator()(const f32x4 (&acc)[2][2][4][2], const Unit& u, int wr, int wc, int fr, int fq) const {
        const int row0 = u.pm * BM + wr * 64 + fr, col0 = u.pn * BM + wc * 32 + 8 * fq;
#pragma unroll
        for (int ai = 0; ai < 2; ++ai)
#pragma unroll
            for (int m = 0; m < 4; ++m) { const int r = row0 + ai * HALF + m * 16; const float s = rs[r]; bf16_t* rowp = O + (size_t)r * ldc + col0;
#pragma unroll
                for (int bj = 0; bj < 2; ++bj) { const f32x4 v0 = acc[ai][bj][m][0] * s, v1 = acc[ai][bj][m][1] * s;
                    u32x4 w; w.x = cvt_pk_bf16(v0[0], v0[1]); w.y = cvt_pk_bf16(v0[2], v0[3]); w.z = cvt_pk_bf16(v1[0], v1[1]); w.w = cvt_pk_bf16(v1[2], v1[3]);
                    *(u32x4*)(rowp + bj * HALF) = w; } }
    }
};
template <bool FIRST> struct EpiMix {
    static constexpr bool PERM = true, AFTER_DRAIN = false;
    bf16_t* O; int ldc; const bf16_t* G; int ldg;
    __device__ __forceinline__ void operator()(const f32x4 (&acc)[2][2][4][2], const Unit& u, int wr, int wc, int fr, int fq) const {
        const int row0 = u.pm * BM + wr * 64 + fr, col0 = u.pn * BM + wc * 32 + 8 * fq;
#pragma unroll
        for (int ai = 0; ai < 2; ++ai)
#pragma unroll
            for (int m = 0; m < 4; ++m) { const int r = row0 + ai * HALF + m * 16; bf16_t* rowp = O + (size_t)r * ldc + col0; const bf16_t* gp = G + (size_t)r * ldg + col0;
#pragma unroll
                for (int bj = 0; bj < 2; ++bj) { const u32x4 gw = *(const u32x4*)(gp + bj * HALF); f32x4 v0 = acc[ai][bj][m][0], v1 = acc[ai][bj][m][1];
                    v0 = v0 * (f32x4){blo(gw.x), bhi(gw.x), blo(gw.y), bhi(gw.y)}; v1 = v1 * (f32x4){blo(gw.z), bhi(gw.z), blo(gw.w), bhi(gw.w)};
                    if (!FIRST) { const u32x4 ow = *(const u32x4*)(rowp + bj * HALF); v0 = v0 + (f32x4){blo(ow.x), bhi(ow.x), blo(ow.y), bhi(ow.y)}; v1 = v1 + (f32x4){blo(ow.z), bhi(ow.z), blo(ow.w), bhi(ow.w)}; }
                    u32x4 w; w.x = cvt_pk_bf16(v0[0], v0[1]); w.y = cvt_pk_bf16(v0[2], v0[3]); w.z = cvt_pk_bf16(v1[0], v1[1]); w.w = cvt_pk_bf16(v1[2], v1[3]);
                    *(u32x4*)(rowp + bj * HALF) = w; } }
    }
};
struct EpiResGate {
    static constexpr bool PERM = false, AFTER_DRAIN = false;
    float* out; const float* x; const float* gate; int gstride; float alpha;
    __device__ __forceinline__ void operator()(const f32x4 (&acc)[2][2][4][2], const Unit& u, int wr, int wc, int fr, int fq) const {
        const int col0 = u.pn * BM + wc * 32 + 4 * fq; const float* gb = gate + (size_t)((u.pm * BM) >> 11) * gstride + col0;
        f32x4 gv[2][2];
#pragma unroll
        for (int bj = 0; bj < 2; ++bj)
#pragma unroll
            for (int n = 0; n < 2; ++n) gv[bj][n] = *(const f32x4*)(gb + bj * HALF + n * 16);
#pragma unroll
        for (int ai = 0; ai < 2; ++ai)
#pragma unroll
            for (int m = 0; m < 4; ++m) { const size_t off = (size_t)(u.pm * BM + ai * HALF + wr * 64 + m * 16 + fr) * 1024 + col0;
#pragma unroll
                for (int bj = 0; bj < 2; ++bj)
#pragma unroll
                    for (int n = 0; n < 2; ++n) { const f32x4 xv = *(const f32x4*)(x + off + bj * HALF + n * 16); *(f32x4*)(out + off + bj * HALF + n * 16) = xv * alpha + gv[bj][n] * acc[ai][bj][m][n]; } }
    }
};
__device__ __forceinline__ int tile_bucket(const int* BASES, int pm) { const int s = pm * BM; int p = 0;
#pragma unroll
    for (int q = 1; q < 24; ++q) p = (s >= BASES[q]) ? q : p;
    return p; }
struct MoeOrder1 {
    StaticOrder so; const int* BASES; const bf16_t* W1;
    __device__ __forceinline__ bool next(int i, Unit& u) const { return so.next(i, u); }
    __device__ __forceinline__ void a_ready(const Unit&) const {}
    __device__ __forceinline__ void done(const Unit&) const {}
    __device__ __forceinline__ const char* bbase(const Gemm&, const Unit& u) const {
        const int p = tile_bucket(BASES, u.pm), g = p / 6, pi = p % 6;
        const int ei = 4 * g + (pi < 3 ? 0 : (pi < 5 ? 1 : 2)), ej = 4 * g + (pi < 3 ? pi + 1 : (pi < 5 ? pi - 1 : 3));
        const int e = u.pn < 2 ? ei : ej;
        return (const char*)(W1 + ((size_t)e * 512 + (size_t)(u.pn & 1) * 256) * 1024); }
};
struct MoeOrder2 {
    StaticOrder so; const int* BASES; const bf16_t* W2P;
    __device__ __forceinline__ bool next(int i, Unit& u) const { return so.next(i, u); }
    __device__ __forceinline__ void a_ready(const Unit&) const {}
    __device__ __forceinline__ void done(const Unit&) const {}
    __device__ __forceinline__ const char* bbase(const Gemm&, const Unit& u) const {
        const int p = tile_bucket(BASES, u.pm); return (const char*)(W2P + ((size_t)p * 1024 + (size_t)u.pn * 256) * 512); }
};
struct EpiMoe1 {
    static constexpr bool PERM = true, AFTER_DRAIN = false;
    bf16_t* H; const float* SLOTW;
    __device__ __forceinline__ void operator()(const f32x4 (&acc)[2][2][4][2], const Unit& u, int wr, int wc, int fr, int fq) const {
        const int row0 = u.pm * BM + wr * 64 + fr, col0 = (u.pn >> 1) * 256 + (u.pn & 1) * 128 + wc * 32 + 8 * fq, wsel = u.pn >> 1;
#pragma unroll
        for (int ai = 0; ai < 2; ++ai)
#pragma unroll
            for (int m = 0; m < 4; ++m) { const int r = row0 + ai * HALF + m * 16; const float w = SLOTW[2 * r + wsel];
                float o[8];
#pragma unroll
                for (int n = 0; n < 2; ++n)
#pragma unroll
                    for (int i = 0; i < 4; ++i) { const float g = acc[ai][0][m][n][i], up = acc[ai][1][m][n][i]; o[4 * n + i] = g * sigm(g) * up * w; }
                u32x4 wv; wv.x = cvt_pk_bf16(o[0], o[1]); wv.y = cvt_pk_bf16(o[2], o[3]); wv.z = cvt_pk_bf16(o[4], o[5]); wv.w = cvt_pk_bf16(o[6], o[7]);
                *(u32x4*)(H + (size_t)r * 512 + col0) = wv; }
    }
};
struct EpiMoe2 {
    static constexpr bool PERM = false, AFTER_DRAIN = false;
    float* out; const int* PERMV; const float* gate; int gstride; float alpha; float* wout;
    __device__ __forceinline__ void operator()(const f32x4 (&acc)[2][2][4][2], const Unit& u, int wr, int wc, int fr, int fq) const {
        const int col0 = u.pn * BM + wc * 32 + 4 * fq;
#pragma unroll
        for (int ai = 0; ai < 2; ++ai)
#pragma unroll
            for (int m = 0; m < 4; ++m) { const int t = PERMV[u.pm * BM + ai * HALF + wr * 64 + m * 16 + fr];
                if (t >= 0) { const size_t off = (size_t)t * 1024 + col0; const float* gb = gate + (size_t)(t >> 11) * gstride + col0;
#pragma unroll
                    for (int bj = 0; bj < 2; ++bj)
#pragma unroll
                        for (int n = 0; n < 2; ++n) { const f32x4 xv = *(const f32x4*)(out + off + bj * HALF + n * 16); const f32x4 gv = *(const f32x4*)(gb + bj * HALF + n * 16);
                            *(f32x4*)(wout + off + bj * HALF + n * 16) = xv * alpha + gv * acc[ai][bj][m][n]; } } }
    }
};
}


namespace att {
typedef short bf16x8 __attribute__((ext_vector_type(8)));
typedef short s16x4 __attribute__((ext_vector_type(4)));
typedef short v4i16_t __attribute__((ext_vector_type(4)));
typedef float f32x16 __attribute__((ext_vector_type(16)));
typedef unsigned u32x4 __attribute__((ext_vector_type(4)));
typedef float f32x2_t __attribute__((ext_vector_type(2))); typedef __bf16 bf16x2_t __attribute__((ext_vector_type(2)));
typedef LAS const char* lds_cptr;
constexpr float THR = 8.f;
__device__ __forceinline__ unsigned cvtpk(float lo, float hi) { f32x2_t v = {lo, hi}; bf16x2_t b = __builtin_convertvector(v, bf16x2_t); return __builtin_bit_cast(unsigned, b); }
__device__ __forceinline__ s16x4 vtr(lds_cptr p) { return __builtin_bit_cast(s16x4, __builtin_amdgcn_ds_read_tr16_b64_v4i16((LAS v4i16_t*)p)); }
__device__ __forceinline__ float swapmax(float m) { auto rr = __builtin_amdgcn_permlane32_swap(__float_as_uint(m), __float_as_uint(m), false, false); return fmaxf(__uint_as_float(rr[0]), __uint_as_float(rr[1])); }
__device__ __forceinline__ float swapsum(float m) { auto rr = __builtin_amdgcn_permlane32_swap(__float_as_uint(m), __float_as_uint(m), false, false); return __uint_as_float(rr[0]) + __uint_as_float(rr[1]); }
__device__ __forceinline__ void glds16(const void* g, LAS unsigned char* l) { __builtin_amdgcn_global_load_lds((const unsigned*)g, (LAS unsigned*)l, 16, 0, 0); }
__device__ __forceinline__ void qkt(f32x16& p0, f32x16& p1, lds_cptr kslot, const bf16x8 (&qr)[4], int r32, int hi) {
    lds_cptr kb = kslot + hi * 1024 + r32 * 16;
#pragma unroll
    for (int d0 = 0; d0 < 4; ++d0) {
        const bf16x8 b0 = *(const LAS bf16x8*)(kb + d0 * 2048), b1 = *(const LAS bf16x8*)(kb + d0 * 2048 + 512);
        p0 = __builtin_amdgcn_mfma_f32_32x32x16_bf16(b0, qr[d0], p0, 0, 0, 0);
        p1 = __builtin_amdgcn_mfma_f32_32x32x16_bf16(b1, qr[d0], p1, 0, 0, 0);
    }
}
template <int ND, bool LM> __device__ __forceinline__ void pv(f32x16 (&o)[ND + (LM ? 1 : 0)], int vb, bf16x8 pa0, bf16x8 pa1, bf16x8 pa2, bf16x8 pa3) {
    if constexpr (LM) {
        const bf16x8 ones = (bf16x8){0x3F80, 0x3F80, 0x3F80, 0x3F80, 0x3F80, 0x3F80, 0x3F80, 0x3F80};
        o[ND] = __builtin_amdgcn_mfma_f32_32x32x16_bf16(pa0, ones, o[ND], 0, 0, 0); o[ND] = __builtin_amdgcn_mfma_f32_32x32x16_bf16(pa1, ones, o[ND], 0, 0, 0);
        o[ND] = __builtin_amdgcn_mfma_f32_32x32x16_bf16(pa2, ones, o[ND], 0, 0, 0); o[ND] = __builtin_amdgcn_mfma_f32_32x32x16_bf16(pa3, ones, o[ND], 0, 0, 0);
    }
#pragma unroll
    for (int d0 = 0; d0 < ND; ++d0) {
        s16x4 lo[4], hi[4];
#pragma unroll
        for (int ks = 0; ks < 4; ++ks) {
            asm volatile("ds_read_b64_tr_b16 %0, %1 offset:%c2" : "=&v"(lo[ks]) : "v"(vb), "i"(d0 * 4096 + ks * 1024) : "memory");
            asm volatile("ds_read_b64_tr_b16 %0, %1 offset:%c2" : "=&v"(hi[ks]) : "v"(vb), "i"(d0 * 4096 + ks * 1024 + 512) : "memory"); }
        asm volatile("s_waitcnt lgkmcnt(0)" ::: "memory"); __builtin_amdgcn_sched_barrier(0);
#define ATT_PK(k) (bf16x8){lo[k][0], lo[k][1], lo[k][2], lo[k][3], hi[k][0], hi[k][1], hi[k][2], hi[k][3]}
        o[d0] = __builtin_amdgcn_mfma_f32_32x32x16_bf16(pa0, ATT_PK(0), o[d0], 0, 0, 0);
        o[d0] = __builtin_amdgcn_mfma_f32_32x32x16_bf16(pa1, ATT_PK(1), o[d0], 0, 0, 0);
        o[d0] = __builtin_amdgcn_mfma_f32_32x32x16_bf16(pa2, ATT_PK(2), o[d0], 0, 0, 0);
        o[d0] = __builtin_amdgcn_mfma_f32_32x32x16_bf16(pa3, ATT_PK(3), o[d0], 0, 0, 0);
#undef ATT_PK
    }
}
__device__ __forceinline__ void alibi_cin(f32x16& p0, f32x16& p1, float qrel, float sl2, float m, bool past) {
    if (past) { const float bm = -sl2 * qrel - m;
#pragma unroll
        for (int r = 0; r < 16; ++r) { const float c = (float)((r & 3) + 8 * (r >> 2)); p0[r] = fmaf(sl2, c, bm); p1[r] = fmaf(sl2, c + 32.f, bm); }
    } else {
#pragma unroll
        for (int r = 0; r < 16; ++r) { const float c = (float)((r & 3) + 8 * (r >> 2)); p0[r] = -sl2 * fabsf(qrel - c) - m; p1[r] = -sl2 * fabsf(qrel - 32.f - c) - m; }
    }
}
template <int ND, bool LM> __device__ __forceinline__ bool softmax_step(f32x16& p0, f32x16& p1, float& m, float& l, f32x16 (&o)[ND + (LM ? 1 : 0)], LAS float* wsf, int r32, int hi, bool first) {
    float mxa = fmaxf(fmaxf(p0[0], p0[1]), p1[0]), mxb = fmaxf(fmaxf(p0[2], p0[3]), p1[1]);
    mxa = fmaxf(fmaxf(mxa, p1[2]), p1[3]);
#pragma unroll
    for (int r = 4; r < 16; r += 4) { mxa = fmaxf(fmaxf(mxa, p0[r]), p0[r + 1]); mxb = fmaxf(fmaxf(mxb, p0[r + 2]), p0[r + 3]); mxa = fmaxf(fmaxf(mxa, p1[r]), p1[r + 1]); mxb = fmaxf(fmaxf(mxb, p1[r + 2]), p1[r + 3]); }
    float mx = swapmax(fmaxf(mxa, mxb));
    if (!first && __all(mx < -160.f)) return false;
    if (first) { const float dl = (mx == -INFINITY) ? 0.f : mx; m += dl;
#pragma unroll
        for (int r = 0; r < 16; ++r) { p0[r] -= dl; p1[r] -= dl; }
    } else if (__any(mx > THR)) {
        const float dl = fmaxf(mx, 0.f); m += dl;
#pragma unroll
        for (int r = 0; r < 16; ++r) { p0[r] -= dl; p1[r] -= dl; }
        const float f = __builtin_amdgcn_exp2f(-dl); if constexpr (!LM) l *= f; wsf[r32] = f;
        LDS_WAIT();
#pragma unroll
        for (int r = 0; r < 16; ++r) { const float fr = wsf[(r & 3) + 8 * (r >> 2) + 4 * hi];
#pragma unroll
            for (int d = 0; d < ND + (LM ? 1 : 0); ++d) o[d][r] *= fr; }
        LDS_WAIT();
    }
    float sacc = 0.f;
#pragma unroll
    for (int r = 0; r < 16; ++r) { p0[r] = __builtin_amdgcn_exp2f(p0[r]); p1[r] = __builtin_amdgcn_exp2f(p1[r]); if constexpr (!LM) sacc += p0[r] + p1[r]; }
    if constexpr (!LM) l += sacc;
    return true;
}
#define ATT_PACK(P, B) (u32x4){cvtpk(P[B], P[B + 1]), cvtpk(P[B + 2], P[B + 3]), cvtpk(P[B + 4], P[B + 5]), cvtpk(P[B + 6], P[B + 7])}

#define ATT_WAITBAR(N) do { asm volatile("s_waitcnt vmcnt(" #N ") lgkmcnt(0)" ::: "memory"); __builtin_amdgcn_s_barrier(); asm volatile("" ::: "memory"); } while (0)
__device__ __forceinline__ void battn_unit(LAS unsigned char* L, int b, int h, int qb, bf16* P, const bf16* KV, const unsigned* MASK, bool dry, int WID_) {
    const int tid = otid(WID_), lane = tid & 63, wid = __builtin_amdgcn_readfirstlane(tid >> 6), r32 = lane & 31, hi = lane >> 5;
    const int q0 = qb * 256, qpos = q0 + wid * 32 + r32, cq = (q0 + wid * 32) >> 6, NT = (q0 + 256) >> 6;
    const size_t rowbase = (size_t)b * SEQ;
    const bf16* Kh = KV + rowbase * 1024 + h * 64;
    bf16* Qw = P + (rowbase + q0 + wid * 32) * NP + C_BQ + h * 64;
    const char* ksrc = (const char*)(Kh + (size_t)lane * 1024 + wid * 8);
    const char* vsrc = (const char*)(Kh + 512 + (size_t)(16 * (wid & 3) + (lane >> 2)) * 1024 + (wid >> 2) * 32 + (lane & 3) * 8);
    const char* msrc = (const char*)(MASK + (rowbase + q0 + wid * 32 + (lane >> 1)) * 64 + (lane & 1));
    LAS unsigned char* kdst = L + wid * 1024; LAS unsigned char* vdst = L + 8192 + wid * 1024; LAS unsigned char* mdst = L + 65536 + wid * 256;
    LAS float* wsf = (LAS float*)(L + 73728 + wid * 256);
    bf16x8 qr[4];
#pragma unroll
    for (int d0 = 0; d0 < 4; ++d0) qr[d0] = *(const bf16x8*)(Qw + (size_t)r32 * NP + d0 * 16 + hi * 8);
    __builtin_amdgcn_s_waitcnt(0x0F70);
    const float sl2 = SLOPE_B[h] * LOG2E;
    float m = 0.f; f32x16 o[3]; o[0] = f32x16{}; o[1] = f32x16{}; o[2] = f32x16{};
#define B_DMA(it_) do { const int t_ = NT - 1 - (it_) > 0 ? NT - 1 - (it_) : 0; const int s_ = (it_) & 3; \
        glds16(ksrc + (size_t)t_ * (64 * 1024 * 2), kdst + s_ * 16384); glds16(vsrc + (size_t)t_ * (64 * 1024 * 2), vdst + s_ * 16384); \
        __builtin_amdgcn_global_load_lds((const unsigned*)(msrc + t_ * 8), (LAS unsigned*)(mdst + s_ * 2048), 4, 0, 0); } while (0)
    B_DMA(0); B_DMA(1); B_DMA(2);
    const int vb0 = (int)(unsigned)(size_t)(L + 8192) + ((lane >> 4) & 1) * 32 + (lane & 3) * 8 + (4 * hi + ((lane & 15) >> 2)) * 64;
    for (int it = 0; it < NT; ++it) {
        const int t = NT - 1 - it, sl = it & 3;
        ATT_WAITBAR(6);
        B_DMA(it + 3);
        if (t <= cq) {
            f32x16 p0, p1;
            alibi_cin(p0, p1, (float)(qpos - 64 * t - 4 * hi), sl2, m, t < cq);
            const v2u mcur = *(const LAS v2u*)(mdst + sl * 2048 + r32 * 8);
            const unsigned mx0 = mcur.x >> (4 * hi), mx1 = mcur.y >> (4 * hi);
#pragma unroll
            for (int r = 0; r < 16; ++r) { const int c = (r & 3) + 8 * (r >> 2); p0[r] = ((mx0 >> c) & 1u) ? p0[r] : -INFINITY; p1[r] = ((mx1 >> c) & 1u) ? p1[r] : -INFINITY; }
            qkt(p0, p1, (lds_cptr)L + sl * 16384, qr, r32, hi);
            if (softmax_step<2, true>(p0, p1, m, m  , o, wsf, r32, hi, t == cq)) {
                const u32x4 w0 = ATT_PACK(p0, 0), w1 = ATT_PACK(p0, 8), w2 = ATT_PACK(p1, 0), w3 = ATT_PACK(p1, 8);
                pv<2, true>(o, vb0 + sl * 16384, __builtin_bit_cast(bf16x8, w0), __builtin_bit_cast(bf16x8, w1), __builtin_bit_cast(bf16x8, w2), __builtin_bit_cast(bf16x8, w3)); }
        }
    }
#undef B_DMA
    LAS bf16* stg = (LAS bf16*)(L + 75776 + wid * 4096);
#pragma unroll
    for (int r = 0; r < 16; ++r) { const int orow = (r & 3) + 8 * (r >> 2) + 4 * hi; const float rl = 1.f / o[2][r];
        stg[orow * 64 + r32] = (bf16)f2bf(o[0][r] * rl); stg[orow * 64 + 32 + r32] = (bf16)f2bf(o[1][r] * rl); }
    LDS_WAIT();
#pragma unroll
    for (int i = 0; i < 4; ++i) { const int row = i * 8 + (lane >> 3), ch = lane & 7; const u32x4 v = *(const LAS u32x4*)(stg + row * 64 + ch * 8); if (!dry) *(u32x4*)(Qw + (size_t)row * NP + ch * 8) = v; }
    ATT_WAITBAR(0);
}
__device__ __forceinline__ void battn_phase(LAS unsigned char* L, const Ctx& a, bool dry, int WID_) {
    const int bx = blockIdx.x, x = bx & 7, c = (bx >> 3) & 31, b = 2 * x + (c >> 4), cc = c & 15, hpar = cc & 1, sel = (cc >> 1) & 1, rot = cc >> 2;
    bf16* P = (bf16*)(a.ws() + WS_PROJ); const bf16* KV = (const bf16*)(a.ws() + WS_KV); const unsigned* MASK = (const unsigned*)(a.ws() + WS_MASK);
    for (int i = 0; i < 4; ++i) { const int qb = i == 0 ? sel : (i == 1 ? 7 - sel : (i == 2 ? 2 + sel : 5 - sel)); const int h = 2 * ((i + rot) & 3) + hpar; battn_unit(L, b, h, qb, P, KV, MASK, dry, WID_); }
}

__device__ __forceinline__ void dattn_unit(LAS unsigned char* L, int b, int h, int qb, bf16* P, float lam, const float* subg, bool dry, int WID_) {
    const int tid = otid(WID_), lane = tid & 63, wid = __builtin_amdgcn_readfirstlane(tid >> 6), r32 = lane & 31, hi = lane >> 5, rg = wid & 3, mp = wid >> 2;
    const int q0 = qb * 128, qpos = q0 + rg * 32 + r32, cq = (q0 + rg * 32) >> 6, NT = (q0 + 128) >> 6;
    const size_t rowbase = (size_t)b * SEQ;
    const bf16* Kb = P + rowbase * NP + C_AK + h * 128;
    const bf16* Vb = P + rowbase * NP + C_AV + h * 128;
    bf16* Qw = P + (rowbase + q0 + rg * 32) * NP + C_AQ + h * 128;
    const char* k0src = (const char*)(Kb + (size_t)lane * NP + wid * 8);
    const char* k1src = (const char*)(Kb + (size_t)lane * NP + 64 + wid * 8);
    const char* v0src = (const char*)(Vb + (size_t)(16 * (wid & 3) + (lane >> 2)) * NP + (wid >> 2) * 32 + (lane & 3) * 8);
    const char* v1src = v0src + 64 * 2;
    LAS unsigned char* dst = L + wid * 1024;
    LAS float* wsf = (LAS float*)(L + 131072 + wid * 256);
    bf16x8 qr[4];
#pragma unroll
    for (int d0 = 0; d0 < 4; ++d0) qr[d0] = *(const bf16x8*)(Qw + (size_t)r32 * NP + mp * 64 + d0 * 16 + hi * 8);
    __builtin_amdgcn_s_waitcnt(0x0F70);
    const float sl2 = SLOPE_A[h] * LOG2E;
    float m = 0.f, l = 0.f; f32x16 o[4];
#pragma unroll
    for (int d = 0; d < 4; ++d) o[d] = f32x16{};
    constexpr size_t TS = (size_t)64 * NP * 2;
#define D_DMA(it_) do { const int t_ = NT - 1 - (it_) > 0 ? NT - 1 - (it_) : 0; LAS unsigned char* d2 = dst + ((it_) & 3) * 32768; const size_t go = (size_t)t_ * TS; \
        glds16(k0src + go, d2); glds16(k1src + go, d2 + 8192); glds16(v0src + go, d2 + 16384); glds16(v1src + go, d2 + 24576); } while (0)
    D_DMA(0); D_DMA(1); D_DMA(2);
    const int vb0 = (int)(unsigned)(size_t)(L + 16384) + ((lane >> 4) & 1) * 32 + (lane & 3) * 8 + (4 * hi + ((lane & 15) >> 2)) * 64;
    for (int it = 0; it < NT; ++it) {
        const int t = NT - 1 - it, sl = it & 3;
        ATT_WAITBAR(8);
        D_DMA(it + 3);
        if (t <= cq) {
            f32x16 p0, p1;
            alibi_cin(p0, p1, (float)(qpos - 64 * t - 4 * hi), sl2, m, t < cq);
            qkt(p0, p1, (lds_cptr)L + sl * 32768 + mp * 8192, qr, r32, hi);
            if (softmax_step<4, false>(p0, p1, m, l, o, wsf, r32, hi, t == cq)) {
                const u32x4 w0 = ATT_PACK(p0, 0), w1 = ATT_PACK(p0, 8), w2 = ATT_PACK(p1, 0), w3 = ATT_PACK(p1, 8);
                pv<4, false>(o, vb0 + sl * 32768, __builtin_bit_cast(bf16x8, w0), __builtin_bit_cast(bf16x8, w1), __builtin_bit_cast(bf16x8, w2), __builtin_bit_cast(bf16x8, w3)); }
        }
    }
#undef D_DMA
    ATT_WAITBAR(0);
    l = swapsum(l); wsf[32 + r32] = l; LDS_WAIT();
    LAS float* X = (LAS float*)L + rg * (32 * 132);
    if (mp == 1) {
#pragma unroll
        for (int r = 0; r < 16; ++r) { const int orow = (r & 3) + 8 * (r >> 2) + 4 * hi; const float rl = lam / wsf[32 + orow];
#pragma unroll
            for (int d = 0; d < 4; ++d) X[orow * 132 + d * 32 + r32] = o[d][r] * rl; }
    }
    asm volatile("s_waitcnt lgkmcnt(0)" ::: "memory"); __syncthreads();
    if (mp == 0) {
#pragma unroll
        for (int r = 0; r < 16; ++r) { const int orow = (r & 3) + 8 * (r >> 2) + 4 * hi; const float rl = 1.f / wsf[32 + orow];
#pragma unroll
            for (int d = 0; d < 4; ++d) { LAS float* xp = X + orow * 132 + d * 32 + r32; *xp = o[d][r] * rl - *xp; } }
        LDS_WAIT();
        const int row = lane >> 1, half = lane & 1; const LAS f32x4* xr = (const LAS f32x4*)(X + row * 132 + half * 64);
        f32x4 y[16]; float ss = 0.f;
#pragma unroll
        for (int j = 0; j < 16; ++j) { y[j] = xr[j]; ss += (y[j].x * y[j].x + y[j].y * y[j].y) + (y[j].z * y[j].z + y[j].w * y[j].w); }
        ss += __shfl_xor(ss, 1);
        const float rn = 0.8f / sqrtf(ss * (1.f / 128.f) + RMS_EPS);
        bf16* op = Qw + (size_t)row * NP + half * 64; const f32x4* gp = (const f32x4*)(subg + half * 64);
#pragma unroll
        for (int j = 0; j < 8; ++j) { const f32x4 g0 = gp[2 * j], g1 = gp[2 * j + 1]; const f32x4 a0 = y[2 * j] * rn * g0, a1 = y[2 * j + 1] * rn * g1;
            u32x4 w; w.x = cvtpk(a0.x, a0.y); w.y = cvtpk(a0.z, a0.w); w.z = cvtpk(a1.x, a1.y); w.w = cvtpk(a1.z, a1.w); if (!dry) *(u32x4*)(op + j * 8) = w; }
    }
    asm volatile("s_waitcnt lgkmcnt(0)" ::: "memory"); __syncthreads();
}
__device__ __forceinline__ void dattn_phase(LAS unsigned char* L, const Ctx& a, bool dry, int WID_) {
    const int bx = blockIdx.x, x = bx & 7, c = (bx >> 3) & 31, b = 2 * x + (c >> 4), cc = c & 15, rot = cc & 3, j = cc >> 2;
    bf16* P = (bf16*)(a.ws() + WS_PROJ); const float* SMv = (const float*)(a.ws() + WS_SMALL); const float lam = SMv[SM_LAM];
    for (int i = 0; i < 4; ++i) { const int qb = i == 0 ? j : (i == 1 ? 7 - j : (i == 2 ? 8 + j : 15 - j)); const int h = (i + rot) & 3; dattn_unit(L, b, h, qb, P, lam, SMv + SM_SUBLN, dry, WID_); }
}
#undef ATT_PACK
}


namespace idx {
typedef short bf16x8 __attribute__((ext_vector_type(8)));
typedef float f32x16 __attribute__((ext_vector_type(16)));
typedef unsigned u32x4 __attribute__((ext_vector_type(4)));
__device__ __forceinline__ void cnt_ge(int& c, unsigned key, unsigned t) { asm("v_cmp_ge_u32_e32 vcc, %1, %2\n\tv_addc_co_u32_e32 %0, vcc, 0, %0, vcc" : "+v"(c) : "v"(key), "v"(t) : "vcc"); }
__device__ __forceinline__ void cnt_gt(int& c, unsigned key, unsigned t) { asm("v_cmp_gt_u32_e32 vcc, %1, %2\n\tv_addc_co_u32_e32 %0, vcc, 0, %0, vcc" : "+v"(c) : "v"(key), "v"(t) : "vcc"); }
__device__ __forceinline__ int row16_sum(int x) {
    x += __builtin_amdgcn_update_dpp(0, x, 0xB1, 0xF, 0xF, true);
    x += __builtin_amdgcn_update_dpp(0, x, 0x4E, 0xF, 0xF, true);
    x += __builtin_amdgcn_update_dpp(0, x, 0x141, 0xF, 0xF, true);
    x += __builtin_amdgcn_update_dpp(0, x, 0x140, 0xF, 0xF, true);
    return x;
}
__device__ __forceinline__ int half_sum(int x, int hi) {
    x = row16_sum(x);
    const int s0 = __builtin_amdgcn_readlane(x, 0) + __builtin_amdgcn_readlane(x, 16), s1 = __builtin_amdgcn_readlane(x, 32) + __builtin_amdgcn_readlane(x, 48);
    return hi ? s1 : s0;
}
__device__ __forceinline__ float relu1(float x) { return __builtin_amdgcn_fmed3f(x, 0.f, __builtin_inff()); }
template <int NS> __device__ __forceinline__ void idx_unit_t(LAS unsigned char* L, int b, int g, const bf16* P, unsigned* MASK, int WID_) {
    const int tid = otid(WID_), lane = tid & 63, wid = __builtin_amdgcn_readfirstlane(tid >> 6), r32 = lane & 31, hi = lane >> 5;
    const int nblk = 2 * ((g >> 1) + 1);
    const size_t rowbase = (size_t)b * SEQ; const int tq0 = g * 32 + wid * 4;
    unsigned* mrow0 = MASK + (rowbase + tq0 + 2 * hi) * 64;
    const int qsel = 2 * ((r32 >> 2) & 1) + (r32 >> 4), hsel = ((r32 >> 3) & 1) * 4 + (r32 & 3);
    const bf16* qp = P + (rowbase + tq0 + qsel) * NP + C_IQ + hsel * 64 + hi * 8;
    bf16x8 qa[4];
#pragma unroll
    for (int ks = 0; ks < 4; ++ks) qa[ks] = *(const bf16x8*)(qp + ks * 16);
    float w[2][8];
#pragma unroll
    for (int q2 = 0; q2 < 2; ++q2) { const u32x4 wv = *(const u32x4*)(P + (rowbase + tq0 + 2 * hi + q2) * NP + C_IW);
        w[q2][0] = bflo(wv.x); w[q2][1] = bfhi(wv.x); w[q2][2] = bflo(wv.y); w[q2][3] = bfhi(wv.y); w[q2][4] = bflo(wv.z); w[q2][5] = bfhi(wv.z); w[q2][6] = bflo(wv.w); w[q2][7] = bfhi(wv.w); }
    const char* ksrc = (const char*)(P + (rowbase + lane) * NP + C_IK + wid * 8);
    LAS unsigned char* kdst = L + wid * 1024;
    const char* kp = ksrc;
#define IDX_DMA(s_) do { _Pragma("unroll") for (int sub = 0; sub < 4; ++sub) \
        __builtin_amdgcn_global_load_lds((const unsigned*)(kp + (size_t)(64 * sub) * (NP * 2)), (LAS unsigned*)(kdst + ((s_) & 1) * 32768 + sub * 8192), 16, 0, 0); \
        kp += (size_t)256 * (NP * 2); asm volatile("" : "+v"(kp)); } while (0)
    unsigned key[2][8 * NS];
    IDX_DMA(0);
#pragma unroll
    for (int s_ = 0; s_ < NS; ++s_) {
        asm volatile("s_waitcnt vmcnt(0)" ::: "memory"); __syncthreads();
        if (s_ + 1 < NS) IDX_DMA(s_ + 1);
#pragma unroll
        for (int j = 0; j < 8; ++j) {
            const int blk = 8 * s_ + j;
            const LAS unsigned char* kb = L + (s_ & 1) * 32768 + (j >> 1) * 8192 + hi * 1024 + ((j & 1) * 32 + r32) * 16;
            f32x16 acc = f32x16{};
#pragma unroll
            for (int ks = 0; ks < 4; ++ks) { const bf16x8 kf = *(const LAS bf16x8*)(kb + ks * 2048); acc = __builtin_amdgcn_mfma_f32_32x32x16_bf16(qa[ks], kf, acc, 0, 0, 0); }
            const bool vis = blk < nblk;
#pragma unroll
            for (int q2 = 0; q2 < 2; ++q2) { float sc = 0.f;
#pragma unroll
                for (int h = 0; h < 8; ++h) sc = fmaf(w[q2][h], relu1(acc[8 * q2 + h]), sc);
                key[q2][blk] = vis ? sortable(sc + 0.f) : 0u; asm volatile("" : "+v"(key[q2][blk])); }
        }
    }
#undef IDX_DMA
    unsigned K0 = 0u, K1 = 0u; int g0 = 0x7fffffff, g1 = 0x7fffffff;
    for (int bit = 31; bit >= 0; --bit) {
        const unsigned t0 = K0 | (1u << bit), t1 = K1 | (1u << bit);
        int c0 = 0, c1 = 0;
#pragma unroll
        for (int i = 0; i < 8 * NS; ++i) { cnt_ge(c0, key[0][i], t0); cnt_ge(c1, key[1][i], t1); }
        c0 = half_sum(c0, hi); c1 = half_sum(c1, hi);
        if (c0 >= TOPK) { K0 = t0; g0 = c0; }
        if (c1 >= TOPK) { K1 = t1; g1 = c1; }
        if (__all(g0 == TOPK && g1 == TOPK)) break;
    }
    unsigned m00 = 0u, m01 = 0u, m10 = 0u, m11 = 0u;
    if (__all(g0 == TOPK && g1 == TOPK)) {
#pragma unroll
        for (int blk = 0; blk < 8 * NS; ++blk) {
            const unsigned long long b0 = __ballot(key[0][blk] >= K0), b1 = __ballot(key[1][blk] >= K1);
            const unsigned w0 = hi ? (unsigned)(b0 >> 32) : (unsigned)b0, w1 = hi ? (unsigned)(b1 >> 32) : (unsigned)b1;
            if (r32 == (blk & 31)) { if (blk < 32) { m00 = w0; m10 = w1; } else { m01 = w0; m11 = w1; } }
            __builtin_amdgcn_sched_barrier(0); }
    } else {
        int c0 = 0, c1 = 0;
#pragma unroll
        for (int i = 0; i < 8 * NS; ++i) { cnt_gt(c0, key[0][i], K0); cnt_gt(c1, key[1][i], K1); }
        const int need0 = TOPK - half_sum(c0, hi), need1 = TOPK - half_sum(c1, hi);
        int tk0 = 0, tk1 = 0; const unsigned lt = (1u << r32) - 1u;
#pragma unroll
        for (int blk = 0; blk < 8 * NS; ++blk) {
            const unsigned long long e0b = __ballot(key[0][blk] == K0), e1b = __ballot(key[1][blk] == K1);
            const unsigned e0 = hi ? (unsigned)(e0b >> 32) : (unsigned)e0b, e1 = hi ? (unsigned)(e1b >> 32) : (unsigned)e1b;
            const bool s0 = key[0][blk] > K0 || (key[0][blk] == K0 && tk0 + __popc(e0 & lt) < need0);
            const bool s1 = key[1][blk] > K1 || (key[1][blk] == K1 && tk1 + __popc(e1 & lt) < need1);
            tk0 += __popc(e0); tk1 += __popc(e1);
            const unsigned long long b0 = __ballot(s0), b1 = __ballot(s1);
            const unsigned w0 = hi ? (unsigned)(b0 >> 32) : (unsigned)b0, w1 = hi ? (unsigned)(b1 >> 32) : (unsigned)b1;
            if (r32 == (blk & 31)) { if (blk < 32) { m00 = w0; m10 = w1; } else { m01 = w0; m11 = w1; } }
            __builtin_amdgcn_sched_barrier(0); }
    }
    mrow0[r32] = m00; mrow0[32 + r32] = m01; mrow0[64 + r32] = m10; mrow0[96 + r32] = m11;
}
__device__ __forceinline__ void idx_unit(LAS unsigned char* L, int b, int g, const bf16* P, unsigned* MASK, int WID_) {
    const int nblk = 2 * ((g >> 1) + 1), ns = (nblk + 7) >> 3;
    if (ns <= 1) {
        const int tid = otid(WID_), lane = tid & 63, wid = __builtin_amdgcn_readfirstlane(tid >> 6), r32 = lane & 31, hi = lane >> 5;
        unsigned* mrow0 = MASK + ((size_t)b * SEQ + g * 32 + wid * 4 + 2 * hi) * 64;
        const unsigned wlo = r32 < nblk ? 0xffffffffu : 0u;
        mrow0[r32] = wlo; mrow0[32 + r32] = 0u; mrow0[64 + r32] = wlo; mrow0[96 + r32] = 0u;
    }
    else if (ns == 2) idx_unit_t<2>(L, b, g, P, MASK, WID_);
    else if (ns == 3) idx_unit_t<3>(L, b, g, P, MASK, WID_);
    else if (ns == 4) idx_unit_t<4>(L, b, g, P, MASK, WID_);
    else if (ns == 5) idx_unit_t<5>(L, b, g, P, MASK, WID_);
    else if (ns == 6) idx_unit_t<6>(L, b, g, P, MASK, WID_);
    else if (ns == 7) idx_unit_t<7>(L, b, g, P, MASK, WID_);
    else idx_unit_t<8>(L, b, g, P, MASK, WID_);
}
__device__ __forceinline__ void idx_phase(LAS unsigned char* L, const Ctx& a, int WID_) {
    const int G = gridDim.x, bx = blockIdx.x, vcu = (bx % 8) * (G / 8) + bx / 8, b = vcu >> 4, j = vcu & 15;
    const bf16* P = (const bf16*)(a.ws() + WS_PROJ); unsigned* MASK = (unsigned*)(a.ws() + WS_MASK);
    for (int i = 0; i < 4; ++i) { const int g = i == 0 ? j : (i == 1 ? 31 - j : (i == 2 ? 32 + j : 63 - j)); idx_unit(L, b, g, P, MASK, WID_);
        asm volatile("s_waitcnt lgkmcnt(0)" ::: "memory"); __syncthreads(); }
}
}

__global__ void __launch_bounds__(512, 2) fwd(Args karg) {
    extern __shared__ __attribute__((aligned(16))) unsigned char lds[];
    const int tid = threadIdx.x; const int WID_ = __builtin_amdgcn_readfirstlane(tid >> 6);
    if (tid < 27) ((LAS unsigned long long*)((LAS unsigned char*)lds + LDSCTL_OFF + 512))[tid] = (unsigned long long)karg.in[tid];
    if (tid == 27) ((LAS unsigned long long*)((LAS unsigned char*)lds + LDSCTL_OFF + 512))[27] = (unsigned long long)karg.out;
    if (tid == 28) ((LAS unsigned long long*)((LAS unsigned char*)lds + LDSCTL_OFF + 512))[28] = (unsigned long long)karg.ws;
    unsigned char* ws = karg.ws;
    Ctx a; a.tab = (LAS const unsigned long long*)((LAS unsigned char*)lds + LDSCTL_OFF + 512);
    if (tid < 128) ((LAS unsigned*)((LAS unsigned char*)lds + LDSCTL_OFF))[tid] = 0u;
    __syncthreads();
    XcdBarrier bar = xcd_barrier_post((unsigned*)(ws + WS_CTL) + CW_BAR, (volatile LAS unsigned*)((LAS unsigned char*)lds + MISC_OFF) + 8);
#define GRID_BAR() do { for (int br_ = 0; br_ < PROBE_BAR; ++br_) xcd_barrier(bar); } while (0)
    bf16* PROJ = (bf16*)(ws + WS_PROJ); bf16* U = (bf16*)(ws + WS_U);
    LAS unsigned char* LL = (LAS unsigned char*)lds;

    for (int rep = 0; rep < PROBE_P0P1; ++rep) {
    for (int r2 = 0; r2 < PROBE_P0; ++r2) {
#if FAST_P0
    p0_fast(a, LL, WID_);
#else
    p0_naive(a, lds, WID_);
#endif
    __syncthreads(); }
    GRID_BAR();
    for (int r2 = 0; r2 < PROBE_P1; ++r2) { p1_modulate(a, lds, WID_); __syncthreads(); }
    GRID_BAR();
    }
    for (int rep = 0; rep < PROBE_P2; ++rep) {
#if FAST_P2
    { pg8::Gemm g{U, (const bf16*)(ws + WS_WIN), T, NP, 1024, 1024, 1024}; pg8::StaticOrder S; S.init(T, NP, (int)gridDim.x, (int)blockIdx.x);
      pg8::EpiProjF E{PROJ, NP, QSCALE}; pg8::gemm_phase<pg8::EpiProjF, pg8::StaticOrder, true, true, 1024, 1024, 1024>(LL, g, S, E, WID_); }
#else
    { EpiProj e{PROJ}; naive_gemm((float*)lds, U, 1024, (const bf16*)(ws + WS_WIN), 1024, T, NP, 1024, e, WID_); }
#endif
    GRID_BAR();
    }
    naive_rms_rows(a, WID_);
    GRID_BAR();
    for (int rep = 0; rep < PROBE_KVIDX; ++rep) {
    for (int r2 = 0; r2 < PROBE_KV; ++r2) {
#if FAST_KV
    { pg8::Gemm g{PROJ + C_BKV, (const bf16*)(ws + WS_WKV), T, 1024, 128, NP, 128}; pg8::StaticOrder S; S.init(T, 1024, (int)gridDim.x, (int)blockIdx.x);
      pg8::EpiRowScale E{(bf16*)(ws + WS_KV), 1024, (const float*)(ws + WS_R)}; pg8::gemm_phase<pg8::EpiRowScale, pg8::StaticOrder, true, true, 128, NP, 128>(LL, g, S, E, WID_); }
#else
    { EpiKV e{(bf16*)(ws + WS_KV), (const float*)(ws + WS_R)}; naive_gemm((float*)lds, PROJ + C_BKV, NP, (const bf16*)(ws + WS_WKV), 128, T, 1024, 128, e, WID_); }
#endif
    __syncthreads(); }
    for (int r2 = 0; r2 < PROBE_IDX; ++r2) {
#if FAST_IDX
    idx::idx_phase(LL, a, WID_);
#else
    naive_indexer(a, lds, WID_);
#endif
    __syncthreads(); }
    }
#if FAST_DATT
    for (int rep = PROBE_DATT - 1; rep >= 0; --rep) { att::dattn_phase(LL, a, rep > 0, WID_); __syncthreads(); }
#else
    naive_diffattn(a, lds, WID_);
#endif
    GRID_BAR();
#if FAST_BATT
    for (int rep = PROBE_BATT - 1; rep >= 0; --rep) { att::battn_phase(LL, a, rep > 0, WID_); __syncthreads(); }
#else
    naive_battn(a, lds, WID_);
#endif
    GRID_BAR();
    for (int rep = 0; rep < PROBE_MIXWO; ++rep) {
    for (int r2 = 0; r2 < PROBE_MIX; ++r2) {
#if FAST_MIX
    { pg8::StaticOrder S; S.init(T, 1024, (int)gridDim.x, (int)blockIdx.x);
      { pg8::Gemm g{PROJ + C_AQ, (const bf16*)(ws + WS_WA), T, 1024, 512, NP, 512}; pg8::EpiMix<true> E{U, 1024, PROJ + C_G, NP};
        pg8::gemm_phase<pg8::EpiMix<true>, pg8::StaticOrder, true, true, 512, NP, 512>(LL, g, S, E, WID_); }
      asm volatile("s_waitcnt vmcnt(0)" ::: "memory"); __syncthreads();
      { pg8::Gemm g{PROJ + C_BQ, (const bf16*)(ws + WS_WB), T, 1024, 512, NP, 512}; pg8::EpiMix<false> E{U, 1024, PROJ + C_G + 1024, NP};
        pg8::gemm_phase<pg8::EpiMix<false>, pg8::StaticOrder, true, true, 512, NP, 512>(LL, g, S, E, WID_); } }
#else
    { EpiMixA e{U, PROJ}; naive_gemm((float*)lds, PROJ + C_AQ, NP, (const bf16*)(ws + WS_WA), 512, T, 1024, 512, e, WID_); }
    __syncthreads();
    { EpiMixB e{U, PROJ}; naive_gemm((float*)lds, PROJ + C_BQ, NP, (const bf16*)(ws + WS_WB), 512, T, 1024, 512, e, WID_); }
#endif
    asm volatile("s_waitcnt vmcnt(0)" ::: "memory"); __syncthreads(); }
    GRID_BAR();
    for (int r2 = 0; r2 < PROBE_WO; ++r2) {
#if FAST_WO
    { pg8::Gemm g{U, (const bf16*)(ws + WS_WO), T, 1024, 1024, 1024, 1024}; pg8::StaticOrder S; S.init(T, 1024, (int)gridDim.x, (int)blockIdx.x);
      pg8::EpiResGate E{a.out(), a.in(I_X), (const float*)(ws + WS_MOD) + 2048, 6144, ALPHA}; pg8::gemm_phase<pg8::EpiResGate, pg8::StaticOrder, true, true, 1024, 1024, 1024>(LL, g, S, E, WID_); }
#else
    { EpiWo e{a.out(), a.in(I_X), (const float*)(ws + WS_MOD)}; naive_gemm((float*)lds, U, 1024, (const bf16*)(ws + WS_WO), 1024, T, 1024, 1024, e, WID_); }
#endif
    __syncthreads(); }
    GRID_BAR();
    }
    for (int rep = PROBE_ROWS * PROBE_P7 - 1; rep >= 0; --rep) p7_ln_route(a, lds, rep > 0, WID_);
    GRID_BAR();
    for (int rep = 0; rep < PROBE_ROWS * PROBE_P8; ++rep) { p8_sort(a, lds, WID_);
    GRID_BAR(); }
    for (int rep = 0; rep < PROBE_MOE * PROBE_MOE1; ++rep) {
#if FAST_MOE
    { const int* BASES = (const int*)(ws + WS_ROUTE2 + 1024 * 1024 + 32768); const int nslot = BASES[24];
      pg8::Gemm g{(const bf16*)(ws + WS_XS), (const bf16*)(ws + WS_W1), nslot, 1024, 1024, 1024, 1024};
      pg8::MoeOrder1 S; S.so.init(nslot, 1024, (int)gridDim.x, (int)blockIdx.x); S.BASES = BASES; S.W1 = (const bf16*)(ws + WS_W1);
      pg8::EpiMoe1 E{(bf16*)(ws + WS_H), (const float*)(ws + WS_ROUTE2 + 1280 * 1024)};
      pg8::gemm_phase<pg8::EpiMoe1, pg8::MoeOrder1, true, true, 1024, 1024, 1024>(LL, g, S, E, WID_); }
#else
    naive_moe1(a, lds, WID_);
#endif
    GRID_BAR();
    }
    for (int rep = PROBE_MOE * PROBE_MOE2 - 1; rep >= 0; --rep) {
#if FAST_MOE
    { const int* BASES = (const int*)(ws + WS_ROUTE2 + 1024 * 1024 + 32768); const int nslot = BASES[24];
      pg8::Gemm g{(const bf16*)(ws + WS_H), (const bf16*)(ws + WS_W2P), nslot, 1024, 512, 512, 512};
      pg8::MoeOrder2 S; S.so.init(nslot, 1024, (int)gridDim.x, (int)blockIdx.x); S.BASES = BASES; S.W2P = (const bf16*)(ws + WS_W2P);
      pg8::EpiMoe2 E{a.out(), (const int*)(ws + WS_ROUTE2 + 512 * 1024), (const float*)(ws + WS_MOD) + 5120, 6144, ALPHA, rep > 0 ? (float*)(ws + 60 * MiB) : a.out()};
      pg8::gemm_phase<pg8::EpiMoe2, pg8::MoeOrder2, true, true, 512, 512, 512>(LL, g, S, E, WID_); }
#else
    naive_moe2(a, lds, WID_);
#endif
    GRID_BAR();
    }
    for (int rep = PROBE_ROWS * PROBE_P11 - 1; rep >= 0; --rep) p11_ln(a, rep > 0, WID_);
}

extern "C" void kernel_launch(void* const* d_in, const int* in_sizes, int n_in, void* d_out, int out_size, void* d_ws, size_t ws_size, hipStream_t stream) {
    static int grid = 0;
    if (grid == 0) {
        if (n_in != 27 || out_size != T * D || ws_size < WS_END) { fprintf(stderr, "kernel_launch: unexpected problem (n_in %d, out %d, ws %zu); nothing launched\n", n_in, out_size, ws_size); grid = -1; return; }
        int dev = 0, cus = 0;
        if (hipGetDevice(&dev) != hipSuccess || hipDeviceGetAttribute(&cus, hipDeviceAttributeMultiprocessorCount, dev) != hipSuccess) { grid = -1; return; }
        if (hipFuncSetAttribute((const void*)fwd, hipFuncAttributeMaxDynamicSharedMemorySize, LDS_BYTES) != hipSuccess) { fprintf(stderr, "kernel_launch: hipFuncSetAttribute failed\n"); grid = -1; return; }
        if (cus != 256) { fprintf(stderr, "kernel_launch: built for 256 CUs, device has %d; nothing launched\n", cus); grid = -1; return; }
        grid = cus;
    }
    if (grid < 0) return;
    if (hipMemsetAsync((char*)d_ws + WS_CTL, 0, CTL_ZERO_BYTES, stream) != hipSuccess) return;
    Args a{};
    for (int i = 0; i < 27; ++i) a.in[i] = (const float*)d_in[i];
    a.out = (float*)d_out; a.ws = (unsigned char*)d_ws;
    hipLaunchKernelGGL(fwd, dim3(grid), dim3(512), LDS_BYTES, stream, a);
}
```

```cpp
#include <hip/hip_runtime.h>
#include <hip/hip_bf16.h>
#include <cstdio>
#include <cstdint>

#define GAS __attribute__((address_space(1)))
#define LAS __attribute__((address_space(3)))
typedef unsigned short bf16;
typedef GAS unsigned gu32;
typedef unsigned v4u __attribute__((ext_vector_type(4)));
typedef unsigned v2u __attribute__((ext_vector_type(2)));
typedef float f32x4 __attribute__((ext_vector_type(4)));
#define RLX_AGENT __ATOMIC_RELAXED, __HIP_MEMORY_SCOPE_AGENT

#ifndef FAST_P0
#define FAST_P0 1
#endif
#ifndef FAST_P2
#define FAST_P2 1
#endif
#ifndef FAST_KV
#define FAST_KV 1
#endif
#ifndef FAST_MIX
#define FAST_MIX 1
#endif
#ifndef FAST_WO
#define FAST_WO 1
#endif
#ifndef FAST_MOE
#define FAST_MOE 1
#endif
#ifndef FAST_DATT
#define FAST_DATT 1
#endif
#ifndef FAST_IDX
#define FAST_IDX 1
#endif
#ifndef FAST_BATT
#define FAST_BATT 1
#endif
#ifndef PROBE_P0P1
#define PROBE_P0P1 1
#endif
#ifndef PROBE_P2
#define PROBE_P2 1
#endif
#ifndef PROBE_KVIDX
#define PROBE_KVIDX 1
#endif
#ifndef PROBE_DATT
#define PROBE_DATT 1
#endif
#ifndef PROBE_BATT
#define PROBE_BATT 1
#endif
#ifndef PROBE_MIXWO
#define PROBE_MIXWO 1
#endif
#ifndef PROBE_MOE
#define PROBE_MOE 1
#endif
#ifndef PROBE_ROWS
#define PROBE_ROWS 1
#endif
#ifndef PROBE_P7
#define PROBE_P7 1
#endif
#ifndef PROBE_P8
#define PROBE_P8 1
#endif
#ifndef PROBE_P11
#define PROBE_P11 1
#endif
#ifndef PROBE_BAR
#define PROBE_BAR 1
#endif
#ifndef PROBE_MOE1
#define PROBE_MOE1 1
#endif
#ifndef PROBE_MOE2
#define PROBE_MOE2 1
#endif
#ifndef PROBE_P0
#define PROBE_P0 1
#endif
#ifndef PROBE_P1
#define PROBE_P1 1
#endif
#ifndef PROBE_KV
#define PROBE_KV 1
#endif
#ifndef PROBE_IDX
#define PROBE_IDX 1
#endif
#ifndef PROBE_MIX
#define PROBE_MIX 1
#endif
#ifndef PROBE_WO
#define PROBE_WO 1
#endif
constexpr int BATCH = 16, SEQ = 2048, D = 1024, T = BATCH * SEQ;
constexpr int NP = 4864;
constexpr int C_AQ = 0, C_AK = 512, C_AV = 1024, C_BQ = 1536, C_BKV = 2048, C_IQ = 2176, C_IK = 2688, C_IW = 2752, C_PADB = 2760, C_G = 2816;
constexpr int IN_COLS = 4808;
constexpr float LOG2E = 1.4426950408889634f;
constexpr float QSCALE = 0.125f * LOG2E;
constexpr float ALPHA = 1.189207115002721f;
constexpr float LN_EPS = 1e-5f, RMS_EPS = 1e-5f;
constexpr int TOPK = 256;
constexpr int MAXSLOT = 40960;

__device__ __constant__ float SLOPE_A[4] = {0.6299605369567871f, 0.15749013423919678f, 0.039372533559799194f, 0.009843133389949799f};
__device__ __constant__ float SLOPE_B[8] = {0.39685025811195374f, 0.25f, 0.09921256452798843f, 0.0625f, 0.02480314113199711f, 0.015625f, 0.006200785282999277f, 0.00390625f};

constexpr size_t MiB = 1u << 20;
constexpr size_t WS_CTL = 0, CTL_ZERO_BYTES = 1 * MiB;
constexpr size_t WS_MOD = 1 * MiB;
constexpr size_t WS_R = WS_MOD + 512 * 1024;
constexpr size_t WS_ROUTE = WS_R + 128 * 1024;
constexpr size_t WS_SMALL = WS_R + 128 * 1024;
constexpr int SM_LN1G = 0, SM_LN1B = 1024, SM_LN2G = 2048, SM_LN2B = 3072, SM_SUBLN = 4096, SM_BGRP = 4224, SM_BER = 4228, SM_LAM = 4244, SM_ADAB = 4352;
constexpr size_t WS_WIN = 2 * MiB;
constexpr size_t WS_WA = 12 * MiB;
constexpr size_t WS_WB = 13 * MiB;
constexpr size_t WS_WO = 14 * MiB;
constexpr size_t WS_WKV = 16 * MiB;
constexpr size_t WS_W1 = 17 * MiB;
constexpr size_t WS_W2P = 33 * MiB;
constexpr size_t WS_ROUTE2 = 57 * MiB;
constexpr size_t WS_RW = 59 * MiB;
constexpr size_t WS_MODP = 59 * MiB + 128 * 1024;
constexpr size_t WS_MASK = 60 * MiB;
constexpr size_t WS_KV = 68 * MiB;
constexpr size_t WS_U = 132 * MiB;
constexpr size_t WS_PROJ = 196 * MiB;
constexpr size_t WS_U2 = 196 * MiB;
constexpr size_t WS_H = 260 * MiB;
constexpr size_t WS_XS = 300 * MiB;
constexpr size_t WS_MODPART = 500 * MiB;
constexpr size_t WS_END = 512 * MiB;

constexpr int CW_BAR = 4096;

constexpr int LDSCTL_OFF = 139264, MISC_OFF = LDSCTL_OFF + 320, LDS_BYTES = 147456;

__device__ __forceinline__ unsigned f2bf(float f) { unsigned u = __float_as_uint(f); return (u + 0x7fffu + ((u >> 16) & 1u)) >> 16; }
__device__ __forceinline__ float bf2f(unsigned h) { return __uint_as_float(h << 16); }
__device__ __forceinline__ float bflo(unsigned w) { return __uint_as_float(w << 16); }
__device__ __forceinline__ float bfhi(unsigned w) { return __uint_as_float(w & 0xffff0000u); }
__device__ __forceinline__ unsigned pk2(float lo, float hi) { return f2bf(lo) | (f2bf(hi) << 16); }
#define DPP_ADD(x, ctrl) x += __builtin_bit_cast(float, __builtin_amdgcn_update_dpp(0, __builtin_bit_cast(int, x), ctrl, 0xF, 0xF, true))
__device__ __forceinline__ float wave_sum(float v) {
    DPP_ADD(v, 0xB1); DPP_ADD(v, 0x4E); DPP_ADD(v, 0x141); DPP_ADD(v, 0x140);
    const int iv = __builtin_bit_cast(int, v);
    const float s0 = __builtin_bit_cast(float, __builtin_amdgcn_readlane(iv, 0)), s1 = __builtin_bit_cast(float, __builtin_amdgcn_readlane(iv, 16));
    const float s2 = __builtin_bit_cast(float, __builtin_amdgcn_readlane(iv, 32)), s3 = __builtin_bit_cast(float, __builtin_amdgcn_readlane(iv, 48));
    return (s0 + s1) + (s2 + s3);
}
__device__ __forceinline__ float wave_max(float v) {
#pragma unroll
    for (int o = 1; o < 64; o <<= 1) v = fmaxf(v, __shfl_xor(v, o));
    return v;
}
__device__ __forceinline__ int wave_sum_i(int v) {
#pragma unroll
    for (int o = 1; o < 64; o <<= 1) v += __shfl_xor(v, o);
    return v;
}
#define LDS_WAIT() asm volatile("s_waitcnt lgkmcnt(0)" ::: "memory")
__device__ __forceinline__ int otid(int wid) { unsigned z; asm volatile("v_mov_b32 %0, 0" : "=v"(z)); return wid * 64 + (int)__builtin_amdgcn_mbcnt_hi(~0u, __builtin_amdgcn_mbcnt_lo(~0u, z)); }

#define XB_TMO      128
#define XB_XCNT(j)  (256  + 64 * (j))
#define XB_XSUB(j)  (1280 + 64 * (j))
#define XB_XGEN(j)  (2304 + 64 * (j))
#define XB_TOP      3328
#define XB_TOPGEN   3392
#define XCD_BAR_WORDS 3456
#define XB_SPIN_CAP (1u << 22)
__device__ __forceinline__ unsigned xb_ld(unsigned* p)              { return __hip_atomic_load(p, __ATOMIC_RELAXED, __HIP_MEMORY_SCOPE_AGENT); }
__device__ __forceinline__ unsigned xb_add(unsigned* p, unsigned v) { return __hip_atomic_fetch_add(p, v, __ATOMIC_RELAXED, __HIP_MEMORY_SCOPE_AGENT); }
__device__ __forceinline__ unsigned xb_xcc_id() { return (unsigned)__builtin_amdgcn_s_getreg((3 << 11) | 20) & 0xFu; }
#define XB_SPIN(cond, bar) do { unsigned _sp = 0; while (cond) { __builtin_amdgcn_s_sleep(1); \
    if ((++_sp & 255u) == 0u) { if (xb_ld(&(bar)[XB_TMO])) break; if (_sp > XB_SPIN_CAP) { atomicAdd(&(bar)[XB_TMO], 1u); break; } } } } while (0)
struct XcdBarrier { unsigned* bar; unsigned x; volatile LAS unsigned* st; };
__device__ __forceinline__ XcdBarrier xcd_barrier_post(unsigned* bar, volatile LAS unsigned* st) {
    XcdBarrier b; b.bar = bar; b.x = xb_xcc_id(); b.st = st;
    if (threadIdx.x == 0) (void)xb_add(&bar[XB_XCNT(b.x)], 1u);
    return b;
}
__device__ __forceinline__ void xcd_barrier_complete(unsigned* bar, unsigned x, unsigned& nloc, unsigned& nx) {
    const unsigned G = gridDim.x * gridDim.y * gridDim.z;
    unsigned sum, cnt, mine, sp = 0u;
    for (;;) {
        sum = 0u; cnt = 0u; mine = 0u;
#pragma unroll
        for (unsigned j = 0; j < 16; ++j) { const unsigned c = xb_ld(&bar[XB_XCNT(j)]); sum += c; cnt += (c > 0u) ? 1u : 0u; mine = (j == x) ? c : mine; }
        if (sum == G) break;
        __builtin_amdgcn_s_sleep(1);
        if ((++sp & 255u) == 0u) { if (xb_ld(&bar[XB_TMO])) break; if (sp > XB_SPIN_CAP) { atomicAdd(&bar[XB_TMO], 1u); break; } }
    }
    nloc = mine > 0u ? mine : 1u; nx = cnt > 0u ? cnt : 1u;
}
__device__ __forceinline__ void xcd_barrier(const XcdBarrier& b) {
    asm volatile("s_waitcnt vmcnt(0)" ::: "memory");
    __syncthreads();
    if (threadIdx.x == 0) {
        unsigned* bar = b.bar;
        __builtin_amdgcn_s_waitcnt(0);
        unsigned nloc = b.st[0], nx = b.st[1];
        if (nloc == 0u) { xcd_barrier_complete(bar, b.x, nloc, nx); b.st[0] = nloc; b.st[1] = nx; }
        const unsigned old = xb_add(&bar[XB_XSUB(b.x)], 1u);
        const unsigned gen = old / nloc;
        if (old + 1u == (gen + 1u) * nloc) {
            __builtin_amdgcn_fence(__ATOMIC_RELEASE, "agent");
            asm volatile("s_waitcnt vmcnt(0)" ::: "memory");
            const unsigned og = xb_add(&bar[XB_TOP], 1u);
            const unsigned tg = og / nx;
            if (og + 1u == (tg + 1u) * nx) xb_add(&bar[XB_TOPGEN], 1u);
            else XB_SPIN(xb_ld(&bar[XB_TOPGEN]) == tg, bar);
            __builtin_amdgcn_fence(__ATOMIC_ACQUIRE, "agent");
            xb_add(&bar[XB_XGEN(b.x)], 1u);
            asm volatile("s_waitcnt vmcnt(0)" ::: "memory");
        } else {
            XB_SPIN(xb_ld(&bar[XB_XGEN(b.x)]) == gen, bar);
            __builtin_amdgcn_fence(__ATOMIC_ACQUIRE, "agent");
            asm volatile("s_waitcnt vmcnt(0)" ::: "memory");
        }
    }
    __syncthreads();
}

struct Args { const float* in[27]; float* out; unsigned char* ws; };
__device__ __forceinline__ const Args& kargs() { const Args* p = (const Args*)__builtin_amdgcn_kernarg_segment_ptr(); asm volatile("" : "+s"(p)); return *p; }
struct Ctx {
    LAS const unsigned long long* tab;
    __device__ __forceinline__ unsigned long long get(int i) const { const unsigned long long v = tab[i];
        const unsigned lo = __builtin_amdgcn_readfirstlane((unsigned)v), hi = __builtin_amdgcn_readfirstlane((unsigned)(v >> 32)); return ((unsigned long long)hi << 32) | lo; }
    __device__ __forceinline__ const float* in(int i) const { return (const float*)get(i); }
    __device__ __forceinline__ float* out() const { return (float*)get(27); }
    __device__ __forceinline__ unsigned char* ws() const { return (unsigned char*)get(28); }
};
enum { I_X = 0, I_C, I_ADAW, I_ADAB, I_WIN, I_LQ1, I_LK1, I_LQ2, I_LK2, I_SUBLN, I_KVG, I_WUK, I_WUV, I_WA, I_WB, I_WO, I_LN1G, I_LN1B, I_WGRP, I_BGRP, I_WER, I_BER, I_WEG, I_WEU, I_WED, I_LN2G, I_LN2B };

template <class Epi>
__device__ __forceinline__ void naive_gemm(float* sm, const bf16* A, int lda, const bf16* Bt, int ldb, int M, int N, int K, const Epi& epi, int WID_) {
    const int tid = otid(WID_), ty = tid >> 5, tx = tid & 31;
    float* As = sm; float* Bs = sm + 16 * 132;
    const int ntn = N / 128, ntiles = (M / 128) * ntn;
    for (int tile = blockIdx.x; tile < ntiles; tile += gridDim.x) {
        const int m0 = (tile / ntn) * 128, n0 = (tile % ntn) * 128;
        float acc[8][4];
#pragma unroll
        for (int i = 0; i < 8; ++i)
#pragma unroll
            for (int j = 0; j < 4; ++j) acc[i][j] = 0.f;
        for (int k0 = 0; k0 < K; k0 += 16) {
            {
                const int row = tid >> 2, kq = (tid & 3) * 4;
                const v2u av = *(const v2u*)(A + (size_t)(m0 + row) * lda + k0 + kq);
                As[(kq + 0) * 132 + row] = bflo(av.x); As[(kq + 1) * 132 + row] = bfhi(av.x);
                As[(kq + 2) * 132 + row] = bflo(av.y); As[(kq + 3) * 132 + row] = bfhi(av.y);
                const v2u bv = *(const v2u*)(Bt + (size_t)(n0 + row) * ldb + k0 + kq);
                Bs[(kq + 0) * 132 + row] = bflo(bv.x); Bs[(kq + 1) * 132 + row] = bfhi(bv.x);
                Bs[(kq + 2) * 132 + row] = bflo(bv.y); Bs[(kq + 3) * 132 + row] = bfhi(bv.y);
            }
            __syncthreads();
#pragma unroll
            for (int kk = 0; kk < 16; ++kk) {
                float a[8], b[4];
#pragma unroll
                for (int i = 0; i < 8; ++i) a[i] = As[kk * 132 + ty * 8 + i];
#pragma unroll
                for (int j = 0; j < 4; ++j) b[j] = Bs[kk * 132 + tx * 4 + j];
#pragma unroll
                for (int i = 0; i < 8; ++i)
#pragma unroll
                    for (int j = 0; j < 4; ++j) acc[i][j] = fmaf(a[i], b[j], acc[i][j]);
            }
            __syncthreads();
        }
#pragma unroll
        for (int i = 0; i < 8; ++i)
#pragma unroll
            for (int j = 0; j < 4; ++j) epi(m0 + ty * 8 + i, n0 + tx * 4 + j, acc[i][j]);
    }
}

struct EpiProj {
    bf16* P;
    __device__ __forceinline__ void operator()(int r, int c, float v) const {
        if (c < C_AK || (c >= C_BQ && c < C_BKV)) v *= QSCALE;
        else if (c >= C_G) v = 1.f / (1.f + __expf(-v));
        P[(size_t)r * NP + c] = (bf16)f2bf(v);
    }
};
struct EpiKV { bf16* KV; const float* R; __device__ __forceinline__ void operator()(int r, int c, float v) const { KV[(size_t)r * 1024 + c] = (bf16)f2bf(v * R[r]); } };
struct EpiMixA { bf16* MX; const bf16* P; __device__ __forceinline__ void operator()(int r, int c, float v) const { MX[(size_t)r * 1024 + c] = (bf16)f2bf(v * bf2f(P[(size_t)r * NP + C_G + c])); } };
struct EpiMixB { bf16* MX; const bf16* P; __device__ __forceinline__ void operator()(int r, int c, float v) const { const size_t o = (size_t)r * 1024 + c; MX[o] = (bf16)f2bf(bf2f(MX[o]) + v * bf2f(P[(size_t)r * NP + C_G + 1024 + c])); } };
struct EpiWo { float* out; const float* x; const float* MOD; __device__ __forceinline__ void operator()(int r, int c, float v) const { const size_t o = (size_t)r * 1024 + c; out[o] = ALPHA * x[o] + MOD[(r >> 11) * 6144 + 2048 + c] * v; } };

__device__ __forceinline__ void p0_naive(const Ctx& a, unsigned char* lds, int WID_) {
    unsigned char* ws = a.ws();
    const int tid = otid(WID_); const size_t gt = (size_t)blockIdx.x * 512 + tid, NT = (size_t)gridDim.x * 512;
    bf16* WIN = (bf16*)(ws + WS_WIN); bf16* WA = (bf16*)(ws + WS_WA); bf16* WB = (bf16*)(ws + WS_WB); bf16* WO = (bf16*)(ws + WS_WO);
    bf16* WKV = (bf16*)(ws + WS_WKV); bf16* W1 = (bf16*)(ws + WS_W1); bf16* W2P = (bf16*)(ws + WS_W2P); float* RW = (float*)(ws + WS_RW);
    for (size_t i = gt; i < (size_t)NP * 1024; i += NT) { const int n = (int)(i >> 10), k = (int)(i & 1023); const int o = n < C_PADB ? n : (n >= C_G ? n - 56 : -1);
        WIN[i] = o >= 0 ? (bf16)f2bf(a.in(I_WIN)[(size_t)k * IN_COLS + o]) : (bf16)0; }
    for (size_t i = gt; i < (size_t)1024 * 512; i += NT) { const int n = (int)(i >> 9), k = (int)(i & 511);
        WA[i] = (bf16)f2bf(a.in(I_WA)[(size_t)k * 1024 + n]); WB[i] = (bf16)f2bf(a.in(I_WB)[(size_t)k * 1024 + n]); }
    for (size_t i = gt; i < (size_t)1024 * 1024; i += NT) { const int n = (int)(i >> 10), k = (int)(i & 1023); WO[i] = (bf16)f2bf(a.in(I_WO)[(size_t)k * 1024 + n]); }
    for (size_t i = gt; i < (size_t)1024 * 128; i += NT) { const int n = (int)(i >> 7), r = (int)(i & 127);
        const float g = a.in(I_KVG)[r]; const float w = n < 512 ? a.in(I_WUK)[r * 512 + n] : a.in(I_WUV)[r * 512 + (n - 512)]; WKV[i] = (bf16)f2bf(g * w); }
    for (size_t i = gt; i < (size_t)16 * 512 * 1024; i += NT) { const int k = (int)(i & 1023), row = (int)((i >> 10) & 511), e = (int)(i >> 19);
        const int tile = row >> 8, half = (row >> 7) & 1, j = row & 127, col = tile * 128 + j;
        const float* src = half ? a.in(I_WEU) : a.in(I_WEG); W1[i] = (bf16)f2bf(src[((size_t)e * 1024 + k) * 256 + col]); }
    for (size_t i = gt; i < (size_t)24 * 1024 * 512; i += NT) { const int kk = (int)(i & 511), n = (int)((i >> 9) & 1023), p = (int)(i >> 19);
        const int g = p / 6, pi = p % 6; const int ei = pi < 3 ? 0 : (pi < 5 ? 1 : 2); const int ej = pi < 3 ? pi + 1 : (pi < 5 ? pi - 1 : 3);
        const int e = 4 * g + (kk < 256 ? ei : ej); W2P[i] = (bf16)f2bf(a.in(I_WED)[((size_t)e * 256 + (kk & 255)) * 1024 + n]); }
    for (size_t i = gt; i < (size_t)20 * 1024; i += NT) { const int c = (int)(i >> 10), k = (int)(i & 1023); RW[i] = c < 4 ? a.in(I_WGRP)[k * 4 + c] : a.in(I_WER)[k * 16 + (c - 4)]; }
    {
        float* sc = (float*)lds;
        const int kb = blockIdx.x >> 4, cb = blockIdx.x & 15;
        for (int i = tid; i < 16 * 64; i += 512) { const int b = i >> 6, kk = i & 63; const float cv = a.in(I_C)[b * 1024 + kb * 64 + kk]; sc[i] = cv / (1.f + __expf(-cv)); }
        __syncthreads();
        if (tid < 384) {
            const int j = cb * 384 + tid; float acc[16];
#pragma unroll
            for (int b = 0; b < 16; ++b) acc[b] = 0.f;
            for (int kk = 0; kk < 64; ++kk) { const float w = a.in(I_ADAW)[(size_t)(kb * 64 + kk) * 6144 + j];
#pragma unroll
                for (int b = 0; b < 16; ++b) acc[b] = fmaf(sc[b * 64 + kk], w, acc[b]); }
            float* MP = (float*)(ws + WS_MODPART);
#pragma unroll
            for (int b = 0; b < 16; ++b) MP[((size_t)kb * 16 + b) * 6144 + j] = acc[b];
        }
        __syncthreads();
    }
}
__device__ __forceinline__ float lam_value(const Ctx& a);
__device__ __forceinline__ void tr_item(const float* src, int ld, bf16* dst, int dld, LAS float* scr, int lane, int nvalid, const float* kscale) {
    const int n_ = lane & 31; const float* sp0 = src + (size_t)(lane >> 5) * ld + n_; const bool ok = n_ < nvalid;
#pragma unroll 1
    for (int h = 0; h < 2; ++h) {
        float tv[16];
#pragma unroll
        for (int i = 0; i < 16; ++i) tv[i] = ok ? sp0[(size_t)(2 * (16 * h + i)) * ld] : 0.f;
#pragma unroll
        for (int i = 0; i < 16; ++i) { const int kk = 2 * (16 * h + i) + (lane >> 5); float v = tv[i]; if (kscale) v *= kscale[kk]; scr[kk * 33 + n_] = v; }
    }
    LDS_WAIT();
    const int c = lane & 7;
#pragma unroll
    for (int j = 0; j < 4; ++j) { const int n = (lane >> 3) + 8 * j; const LAS float* sp = scr + (8 * c) * 33 + n;
        v4u o; o.x = pk2(sp[0 * 33], sp[1 * 33]); o.y = pk2(sp[2 * 33], sp[3 * 33]); o.z = pk2(sp[4 * 33], sp[5 * 33]); o.w = pk2(sp[6 * 33], sp[7 * 33]);
        *(v4u*)(dst + (size_t)n * dld + 8 * c) = o; }
    LDS_WAIT();
}
__device__ __forceinline__ void p0_fast(const Ctx& a, LAS unsigned char* L, int WID_) {
    unsigned char* ws = a.ws();
    const int tid = otid(WID_), lane = tid & 63, wv = tid >> 6;
    bf16* WIN = (bf16*)(ws + WS_WIN); bf16* WA = (bf16*)(ws + WS_WA); bf16* WB = (bf16*)(ws + WS_WB); bf16* WO = (bf16*)(ws + WS_WO);
    bf16* WKV = (bf16*)(ws + WS_WKV); bf16* W1 = (bf16*)(ws + WS_W1); bf16* W2P = (bf16*)(ws + WS_W2P); float* RW = (float*)(ws + WS_RW);
    LAS float* scr = (LAS float*)(L + 8192 + wv * 8448);
    const int gw = blockIdx.x * 8 + wv, NW = gridDim.x * 8;
    constexpr int I_WINn = 16 * 152, I_WAn = 8 * 32, I_WOn = 16 * 32, I_KVn = 2 * 16 * 2, I_W1n = 16 * 2 * 16 * 8, I_W2n = 48 * 4 * 32;
    constexpr int NITEMS = I_WINn + 2 * I_WAn + I_WOn + I_KVn + I_W1n + I_W2n;
    for (int it = gw; it < NITEMS; it += NW) {
        int r = it;
        if (r < I_WINn) { const int kb = r / 152, nb = r % 152, n0 = nb * 32; const int o0 = n0 < C_PADB ? n0 : n0 - 56;
            const int nvalid = nb < 86 ? 32 : (nb == 86 ? 8 : (nb == 87 ? 0 : 32));
            tr_item(a.in(I_WIN) + (size_t)(kb * 64) * IN_COLS + (nb == 87 ? 0 : o0), IN_COLS, WIN + (size_t)n0 * 1024 + kb * 64, 1024, scr, lane, nvalid, nullptr); continue; }
        r -= I_WINn;
        if (r < I_WAn) { const int kb = r / 32, nb = r % 32; tr_item(a.in(I_WA) + (size_t)(kb * 64) * 1024 + nb * 32, 1024, WA + (size_t)(nb * 32) * 1024 + kb * 64, 1024, scr, lane, 32, nullptr); continue; }
        r -= I_WAn;
        if (r < I_WAn) { const int kb = r / 32, nb = r % 32; tr_item(a.in(I_WB) + (size_t)(kb * 64) * 1024 + nb * 32, 1024, WA + (size_t)(nb * 32) * 1024 + 512 + kb * 64, 1024, scr, lane, 32, nullptr); continue; }
        r -= I_WAn;
        if (r < I_WOn) { const int kb = r / 32, nb = r % 32; tr_item(a.in(I_WO) + (size_t)(kb * 64) * 1024 + nb * 32, 1024, WO + (size_t)(nb * 32) * 1024 + kb * 64, 1024, scr, lane, 32, nullptr); continue; }
        r -= I_WOn;
        if (r < I_KVn) { const int which = r / 32, rr = r % 32, kb = rr / 16, nb = rr % 16; const float* src = which ? a.in(I_WUV) : a.in(I_WUK);
            tr_item(src + (size_t)(kb * 64) * 512 + nb * 32, 512, WKV + (size_t)(which * 512 + nb * 32) * 128 + kb * 64, 128, scr, lane, 32, a.in(I_KVG) + kb * 64); continue; }
        r -= I_KVn;
        if (r < I_W1n) { const int e = r / 256, rr = r % 256, half = rr / 128, r2 = rr % 128, kb = r2 / 8, nb = r2 % 8, col = nb * 32; const float* src = half ? a.in(I_WEU) : a.in(I_WEG);
            const int row = (col >> 7) * 256 + half * 128 + (col & 127);
            tr_item(src + ((size_t)e * 1024 + kb * 64) * 256 + col, 256, W1 + ((size_t)e * 512 + row) * 1024 + kb * 64, 1024, scr, lane, 32, nullptr); continue; }
        r -= I_W1n;
        { const int ph = r / 128, r2 = r % 128, kb = r2 / 32, nb = r2 % 32, p = ph >> 1, half = ph & 1; const int g = p / 6, pi = p % 6;
            const int ei = pi < 3 ? 0 : (pi < 5 ? 1 : 2), ej = pi < 3 ? pi + 1 : (pi < 5 ? pi - 1 : 3); const int e = 4 * g + (half ? ej : ei);
            tr_item(a.in(I_WED) + ((size_t)e * 256 + kb * 64) * 1024 + nb * 32, 1024, W2P + ((size_t)p * 1024 + nb * 32) * 512 + half * 256 + kb * 64, 512, scr, lane, 32, nullptr); }
    }
    for (size_t i = (size_t)blockIdx.x * 512 + tid; i < (size_t)20 * 1024; i += (size_t)gridDim.x * 512) { const int c = (int)(i >> 10), k = (int)(i & 1023); RW[i] = c < 4 ? a.in(I_WGRP)[k * 4 + c] : a.in(I_WER)[k * 16 + (c - 4)]; }
    { float* SM = (float*)(ws + WS_SMALL); const int bx = blockIdx.x;
        if (bx < 2) { const int i = bx * 512 + tid; SM[SM_LN1G + i] = a.in(I_LN1G)[i]; SM[SM_LN1B + i] = a.in(I_LN1B)[i]; }
        else if (bx < 4) { const int i = (bx - 2) * 512 + tid; SM[SM_LN2G + i] = a.in(I_LN2G)[i]; SM[SM_LN2B + i] = a.in(I_LN2B)[i]; }
        else if (bx < 16) { const int i = (bx - 4) * 512 + tid; SM[SM_ADAB + i] = a.in(I_ADAB)[i]; }
        else if (bx == 16) { if (tid < 128) SM[SM_SUBLN + tid] = a.in(I_SUBLN)[tid];
            if (tid < 4) SM[SM_BGRP + tid] = a.in(I_BGRP)[tid];
            if (tid < 16) SM[SM_BER + tid] = a.in(I_BER)[tid];
            if (tid == 0) SM[SM_LAM] = lam_value(a); } }
    {
        LAS float* sc = (LAS float*)L;
        const int kb = blockIdx.x >> 4, cb = blockIdx.x & 15;
        for (int i = tid; i < 16 * 64; i += 512) { const int b = i >> 6, kk = i & 63; const float cv = a.in(I_C)[b * 1024 + kb * 64 + kk]; sc[i] = cv / (1.f + __expf(-cv)); }
        __syncthreads();
        if (tid < 384) {
            const int j = cb * 384 + tid; float acc[16];
#pragma unroll
            for (int b = 0; b < 16; ++b) acc[b] = 0.f;
#pragma unroll 8
            for (int kk = 0; kk < 64; ++kk) { const float w = a.in(I_ADAW)[(size_t)(kb * 64 + kk) * 6144 + j];
#pragma unroll
                for (int b = 0; b < 16; ++b) acc[b] = fmaf(sc[b * 64 + kk], w, acc[b]); }
            float* MP = (float*)(ws + WS_MODPART);
#pragma unroll
            for (int b = 0; b < 16; ++b) MP[((size_t)kb * 16 + b) * 6144 + j] = acc[b];
        }
        __syncthreads();
    }
}
__device__ __forceinline__ float mod_sum(const float* MP, const float* adab, int b, int j) {
    float s = adab[j];
#pragma unroll
    for (int ks = 0; ks < 16; ++ks) s += MP[((size_t)ks * 16 + b) * 6144 + j];
    return s;
}
__device__ __forceinline__ void p1_modulate(const Ctx& a, unsigned char* lds, int WID_) {
    unsigned char* ws = a.ws(); const int tid = otid(WID_), blk = blockIdx.x;
    const float* MP = (const float*)(ws + WS_MODPART); float* MOD = (float*)(ws + WS_MOD); bf16* U = (bf16*)(ws + WS_U);
    float* sh = (float*)lds; float* sc = sh + 1024; const float* SMv = (const float*)(ws + WS_SMALL);
    const int b = blk >> 4;
    for (int j = tid; j < 1024; j += 512) { sh[j] = mod_sum(MP, SMv + SM_ADAB, b, j); sc[j] = 1.f + mod_sum(MP, SMv + SM_ADAB, b, 1024 + j); }
    for (int e = tid; e < 384; e += 512) { const int flat = blk * 384 + e; MOD[flat] = mod_sum(MP, SMv + SM_ADAB, flat / 6144, flat % 6144); }
    __syncthreads();
    const f32x4* X = (const f32x4*)(a.in(I_X) + (size_t)blk * 128 * 1024); v2u* Uo = (v2u*)(U + (size_t)blk * 128 * 1024);
    for (int i0 = tid; i0 < 128 * 256; i0 += 512 * 8) {
        f32x4 xv[8];
#pragma unroll
        for (int j = 0; j < 8; ++j) xv[j] = X[i0 + j * 512];
#pragma unroll
        for (int j = 0; j < 8; ++j) { const int i = i0 + j * 512, c4 = (i & 255) * 4; const f32x4 x = xv[j];
            v2u o; o.x = pk2(x.x * sc[c4] + sh[c4], x.y * sc[c4 + 1] + sh[c4 + 1]); o.y = pk2(x.z * sc[c4 + 2] + sh[c4 + 2], x.w * sc[c4 + 3] + sh[c4 + 3]); Uo[i] = o; } }
    __syncthreads();
}
__device__ __forceinline__ void naive_rms_rows(const Ctx& a, int WID_) {
    const bf16* P = (const bf16*)(a.ws() + WS_PROJ); float* R = (float*)(a.ws() + WS_R);
    const int tid = otid(WID_); const int lane = tid & 63, gw = blockIdx.x * 8 + (tid >> 6), NW = gridDim.x * 8;
    for (int t0 = gw; t0 < T; t0 += NW * 8) {
        unsigned wv_[8];
#pragma unroll
        for (int j = 0; j < 8; ++j) wv_[j] = *(const unsigned*)(P + (size_t)(t0 + j * NW) * NP + C_BKV + lane * 2);
#pragma unroll
        for (int j = 0; j < 8; ++j) { const float x0 = bflo(wv_[j]), x1 = bfhi(wv_[j]); const float ss = wave_sum(x0 * x0 + x1 * x1); if (lane == 0) R[t0 + j * NW] = 1.f / sqrtf(ss * (1.f / 128.f) + RMS_EPS); } }
}
__device__ __forceinline__ unsigned sortable(float s) { const unsigned u = __float_as_uint(s); return (u & 0x80000000u) ? ~u : (u | 0x80000000u); }
__device__ __forceinline__ void naive_indexer(const Ctx& a, unsigned char* lds, int WID_) {
    const bf16* P = (const bf16*)(a.ws() + WS_PROJ); unsigned* MASK = (unsigned*)(a.ws() + WS_MASK);
    const int tid = otid(WID_), lane = tid & 63;
    float* qf = (float*)lds; float* wq = (float*)(lds + 2048); unsigned* keys = (unsigned*)(lds + 4096); unsigned* lcnt = (unsigned*)(lds + 12288); unsigned* maskw = (unsigned*)(lds + 12544);
    for (int t = blockIdx.x; t < T; t += gridDim.x) {
        const int b = t >> 11, s = t & 2047, vis = ((s >> 6) + 1) << 6;
        { const bf16* qr = P + (size_t)t * NP + C_IQ; qf[tid] = bf2f(qr[tid]); if (tid < 8) wq[tid] = bf2f(P[(size_t)t * NP + C_IW + tid]); if (tid < 40) lcnt[tid] = 0u; if (tid < 64) maskw[tid] = 0u; }
        __syncthreads();
        for (int k = tid; k < vis; k += 512) {
            const v4u* kr = (const v4u*)(P + (size_t)(b * SEQ + k) * NP + C_IK); float kf[64];
#pragma unroll
            for (int i = 0; i < 8; ++i) { const v4u v = kr[i]; kf[8 * i] = bflo(v.x); kf[8 * i + 1] = bfhi(v.x); kf[8 * i + 2] = bflo(v.y); kf[8 * i + 3] = bfhi(v.y); kf[8 * i + 4] = bflo(v.z); kf[8 * i + 5] = bfhi(v.z); kf[8 * i + 6] = bflo(v.w); kf[8 * i + 7] = bfhi(v.w); }
            float scv = 0.f;
            asm volatile("" ::: "memory");
#pragma unroll 1
            for (int h = 0; h < 8; ++h) { float d = 0.f;
#pragma unroll
                for (int i = 0; i < 64; ++i) d = fmaf(qf[h * 64 + i], kf[i], d);
                scv = fmaf(wq[h], fmaxf(d, 0.f), scv); }
            keys[k] = sortable(scv + 0.f);
        }
        __syncthreads();
        if (vis <= TOPK) { if (tid < 64) MASK[(size_t)t * 64 + tid] = (tid * 32 < vis) ? 0xffffffffu : 0u; }
        else {
            unsigned K = 0u;
            for (int bit = 31; bit >= 0; --bit) {
                const unsigned trial = K | (1u << bit); int c = 0;
                for (int k = tid; k < vis; k += 512) c += keys[k] >= trial ? 1 : 0;
                c = wave_sum_i(c); if (lane == 0 && c) atomicAdd(&lcnt[bit], (unsigned)c);
                __syncthreads();
                if (lcnt[bit] >= (unsigned)TOPK) K = trial;
            }
            { int c = 0; for (int k = tid; k < vis; k += 512) c += keys[k] > K ? 1 : 0; c = wave_sum_i(c); if (lane == 0 && c) atomicAdd(&lcnt[32], (unsigned)c); }
            __syncthreads();
            const int need = TOPK - (int)lcnt[32];
            for (int k = tid; k < vis; k += 512) {
                const unsigned kv = keys[k]; bool sel = kv > K;
                if (kv == K) { int r = 0; for (int j = 0; j < k; ++j) r += keys[j] == K ? 1 : 0; sel = r < need; }
                if (sel) atomicOr(&maskw[k >> 5], 1u << (k & 31));
            }
            __syncthreads();
            if (tid < 64) MASK[(size_t)t * 64 + tid] = maskw[tid];
        }
        __syncthreads();
    }
}
__device__ __forceinline__ float lam_value(const Ctx& a) {
    float s1 = 0.f, s2 = 0.f;
    for (int i = 0; i < 64; ++i) { s1 = fmaf(a.in(I_LQ1)[i], a.in(I_LK1)[i], s1); s2 = fmaf(a.in(I_LQ2)[i], a.in(I_LK2)[i], s2); }
    return expf(s1) - expf(s2) + 0.2f;
}
__device__ __forceinline__ void naive_diffattn(const Ctx& a, unsigned char* lds, int WID_) {
    bf16* P = (bf16*)(a.ws() + WS_PROJ);
    const int tid = otid(WID_), lane = tid & 63, wv = tid >> 6;
    float* lg = (float*)(lds + wv * 16384);
    float* qs = (float*)(lds + 131072 + wv * 512);
    const float lam = lam_value(a);
    const int gw = blockIdx.x * 8 + wv, NW = gridDim.x * 8;
    for (int it = gw; it < T * 4; it += NW) {
        const int t = it >> 2, h = it & 3, b = t >> 11, s = t & 2047, vis = ((s >> 6) + 1) << 6;
        const float sl = SLOPE_A[h] * LOG2E;
        { const bf16* qr = P + (size_t)t * NP + C_AQ + h * 128; qs[lane] = bf2f(qr[lane]); qs[lane + 64] = bf2f(qr[lane + 64]); }
        LDS_WAIT();
        float m0 = -1e30f, m1 = -1e30f;
        for (int k = lane; k < vis; k += 64) {
            asm volatile("" ::: "memory");
            const v4u* kr = (const v4u*)(P + (size_t)(b * SEQ + k) * NP + C_AK + h * 128); float d0 = 0.f, d1 = 0.f;
#pragma unroll
            for (int i = 0; i < 8; ++i) { const v4u v = kr[i]; const float* q = qs + 8 * i;
                d0 = fmaf(q[0], bflo(v.x), d0); d0 = fmaf(q[1], bfhi(v.x), d0); d0 = fmaf(q[2], bflo(v.y), d0); d0 = fmaf(q[3], bfhi(v.y), d0);
                d0 = fmaf(q[4], bflo(v.z), d0); d0 = fmaf(q[5], bfhi(v.z), d0); d0 = fmaf(q[6], bflo(v.w), d0); d0 = fmaf(q[7], bfhi(v.w), d0); }
#pragma unroll
            for (int i = 0; i < 8; ++i) { const v4u v = kr[8 + i]; const float* q = qs + 64 + 8 * i;
                d1 = fmaf(q[0], bflo(v.x), d1); d1 = fmaf(q[1], bfhi(v.x), d1); d1 = fmaf(q[2], bflo(v.y), d1); d1 = fmaf(q[3], bfhi(v.y), d1);
                d1 = fmaf(q[4], bflo(v.z), d1); d1 = fmaf(q[5], bfhi(v.z), d1); d1 = fmaf(q[6], bflo(v.w), d1); d1 = fmaf(q[7], bfhi(v.w), d1); }
            const float bias = sl * fabsf((float)(s - k));
            d0 -= bias; d1 -= bias; lg[k] = d0; lg[2048 + k] = d1; m0 = fmaxf(m0, d0); m1 = fmaxf(m1, d1);
        }
        m0 = wave_max(m0); m1 = wave_max(m1);
        float l0 = 0.f, l1 = 0.f;
        for (int k = lane; k < vis; k += 64) { const float p0 = exp2f(lg[k] - m0), p1 = exp2f(lg[2048 + k] - m1); lg[k] = p0; lg[2048 + k] = p1; l0 += p0; l1 += p1; }
        l0 = wave_sum(l0); l1 = wave_sum(l1);
        LDS_WAIT();
        float o00 = 0.f, o01 = 0.f, o10 = 0.f, o11 = 0.f;
        const bf16* vb = P + (size_t)(b * SEQ) * NP + C_AV + h * 128 + lane;
        for (int k = 0; k < vis; ++k) { const float v0 = bf2f(vb[(size_t)k * NP]), v1 = bf2f(vb[(size_t)k * NP + 64]); const float p0 = lg[k], p1 = lg[2048 + k];
            o00 = fmaf(p0, v0, o00); o01 = fmaf(p0, v1, o01); o10 = fmaf(p1, v0, o10); o11 = fmaf(p1, v1, o11); }
        const float r0 = 1.f / l0, r1 = lam / l1;
        const float y0 = o00 * r0 - o10 * r1, y1 = o01 * r0 - o11 * r1;
        const float ss = wave_sum(y0 * y0 + y1 * y1); const float rn = 0.8f / sqrtf(ss * (1.f / 128.f) + RMS_EPS);
        bf16* yo = P + (size_t)t * NP + C_AQ + h * 128;
        yo[lane] = (bf16)f2bf(y0 * rn * a.in(I_SUBLN)[lane]); yo[lane + 64] = (bf16)f2bf(y1 * rn * a.in(I_SUBLN)[lane + 64]);
        LDS_WAIT();
    }
}
__device__ __forceinline__ void naive_battn(const Ctx& a, unsigned char* lds, int WID_) {
    bf16* P = (bf16*)(a.ws() + WS_PROJ); const bf16* KV = (const bf16*)(a.ws() + WS_KV); const unsigned* MASK = (const unsigned*)(a.ws() + WS_MASK);
    const int tid = otid(WID_), lane = tid & 63, wv = tid >> 6;
    float* lg = (float*)(lds + wv * 16384); float* qs = (float*)(lds + 131072 + wv * 512);
    const int gw = blockIdx.x * 8 + wv, NW = gridDim.x * 8;
    for (int it = gw; it < T * 8; it += NW) {
        const int t = it >> 3, h = it & 7, b = t >> 11, s = t & 2047, vis = ((s >> 6) + 1) << 6;
        const float sl = SLOPE_B[h] * LOG2E;
        qs[lane] = bf2f(P[(size_t)t * NP + C_BQ + h * 64 + lane]);
        LDS_WAIT();
        float m0 = -1e30f;
        for (int k = lane; k < vis; k += 64) {
            const unsigned mw = MASK[(size_t)t * 64 + (k >> 5)]; float d0 = -INFINITY;
            asm volatile("" ::: "memory");
            if ((mw >> (k & 31)) & 1u) {
                const v4u* kr = (const v4u*)(KV + (size_t)(b * SEQ + k) * 1024 + h * 64); d0 = 0.f;
#pragma unroll
                for (int i = 0; i < 8; ++i) { const v4u v = kr[i]; const float* q = qs + 8 * i;
                    d0 = fmaf(q[0], bflo(v.x), d0); d0 = fmaf(q[1], bfhi(v.x), d0); d0 = fmaf(q[2], bflo(v.y), d0); d0 = fmaf(q[3], bfhi(v.y), d0);
                    d0 = fmaf(q[4], bflo(v.z), d0); d0 = fmaf(q[5], bfhi(v.z), d0); d0 = fmaf(q[6], bflo(v.w), d0); d0 = fmaf(q[7], bfhi(v.w), d0); }
                d0 -= sl * fabsf((float)(s - k));
            }
            lg[k] = d0; m0 = fmaxf(m0, d0);
        }
        m0 = wave_max(m0);
        float l0 = 0.f;
        for (int k = lane; k < vis; k += 64) { const float p0 = exp2f(lg[k] - m0); lg[k] = p0; l0 += p0; }
        l0 = wave_sum(l0);
        LDS_WAIT();
        float o = 0.f; const bf16* vb = KV + (size_t)(b * SEQ) * 1024 + 512 + h * 64 + lane;
        for (int k = 0; k < vis; ++k) o = fmaf(lg[k], bf2f(vb[(size_t)k * 1024]), o);
        P[(size_t)t * NP + C_BQ + h * 64 + lane] = (bf16)f2bf(o / l0);
        LDS_WAIT();
    }
}
struct Route { int bucket; float wi, wj; int pad; };
__device__ __forceinline__ float wave_total(float v) {
    DPP_ADD(v, 0xB1); DPP_ADD(v, 0x4E); DPP_ADD(v, 0x141); DPP_ADD(v, 0x140);
    v += __builtin_bit_cast(float, __builtin_amdgcn_update_dpp(0, __builtin_bit_cast(int, v), 0x142, 0xA, 0xF, false));
    v += __builtin_bit_cast(float, __builtin_amdgcn_update_dpp(0, __builtin_bit_cast(int, v), 0x143, 0xC, 0xF, false));
    return __builtin_bit_cast(float, __builtin_amdgcn_readlane(__builtin_bit_cast(int, v), 63));
}
__device__ __forceinline__ void route_decide(const float (&lgt)[20], int& bucket, float& wlo, float& whi) {
    int g = 0; float gm = lgt[0];
#pragma unroll
    for (int c = 1; c < 4; ++c) if (lgt[c] > gm) { gm = lgt[c]; g = c; }
    float gs = 0.f;
#pragma unroll
    for (int c = 0; c < 4; ++c) gs += __expf(lgt[c] - gm);
    const float gp = 1.f / gs;
    float el[4];
#pragma unroll
    for (int e = 0; e < 4; ++e) el[e] = g == 0 ? lgt[4 + e] : (g == 1 ? lgt[8 + e] : (g == 2 ? lgt[12 + e] : lgt[16 + e]));
    int i1 = 0; float v1 = el[0];
#pragma unroll
    for (int e = 1; e < 4; ++e) if (el[e] > v1) { v1 = el[e]; i1 = e; }
    int i2 = -1; float v2 = -INFINITY;
#pragma unroll
    for (int e = 0; e < 4; ++e) if (e != i1 && el[e] > v2) { v2 = el[e]; i2 = e; }
    const float e2 = __expf(v2 - v1); const float w1 = gp / (1.f + e2), w2 = gp * e2 / (1.f + e2);
    const int lo = i1 < i2 ? i1 : i2, hi = i1 < i2 ? i2 : i1; wlo = i1 < i2 ? w1 : w2; whi = i1 < i2 ? w2 : w1;
    const int pi = lo == 0 ? hi - 1 : (lo == 1 ? hi + 1 : 5);
    bucket = g * 6 + pi;
}
__device__ __forceinline__ void p7_ln_route(const Ctx& a, unsigned char* lds, bool dry, int WID_) {
    unsigned char* ws = a.ws(); const int tid = otid(WID_), lane = tid & 63, wv = tid >> 6, blk = blockIdx.x;
    float* rw = (float*)lds; int* cnt = (int*)(lds + 81920); const float* SMv = (const float*)(a.ws() + WS_SMALL);
    const float* RW = (const float*)(ws + WS_RW); const float* MOD = (const float*)(ws + WS_MOD);
    bf16* U2 = (bf16*)(ws + WS_U2); Route* RT = (Route*)(ws + WS_ROUTE2); int* PERM = (int*)(ws + WS_ROUTE2 + 512 * 1024); int* CNT = (int*)(ws + WS_ROUTE2 + 1024 * 1024);
    for (int i = tid; i < 20 * 1024 / 4; i += 512) ((f32x4*)rw)[i] = ((const f32x4*)RW)[i];
    if (tid < 24) cnt[tid] = 0;
    for (int i = blk * 512 + tid; i < MAXSLOT; i += gridDim.x * 512) PERM[i] = -1;
    __syncthreads();
    const int b = blk >> 4;
    const float* sh2 = MOD + b * 6144 + 3072; const float* sc2 = MOD + b * 6144 + 4096;
    float* const outp = a.out();
    float* const xo = dry ? (float*)(ws + 300 * MiB) : outp; bf16* const uo = dry ? (bf16*)(ws + 428 * MiB) : U2;
    const float* const xin = a.in(I_X); const bf16* const brn = (const bf16*)(ws + WS_KV);
    f32x4 nx[2][4]; v2u nb[2][4];
#pragma unroll
    for (int q = 0; q < 2; ++q)
#pragma unroll
        for (int j = 0; j < 4; ++j) { const size_t o_ = (size_t)(blk * 128 + wv * 16 + q) * 1024 + j * 256 + lane * 4; nx[q][j] = *(const f32x4*)(xin + o_); nb[q][j] = *(const v2u*)(brn + o_); }
    for (int i = 0; i < 16; i += 2) {
        const int t0 = blk * 128 + wv * 16 + i;
        f32x4 v[2][4]; float sm[2] = {0.f, 0.f};
#pragma unroll
        for (int q = 0; q < 2; ++q)
#pragma unroll
            for (int j = 0; j < 4; ++j) { const v2u bw = nb[q][j]; v[q][j] = nx[q][j] * ALPHA + (f32x4){bflo(bw.x), bfhi(bw.x), bflo(bw.y), bfhi(bw.y)}; sm[q] += (v[q][j].x + v[q][j].y) + (v[q][j].z + v[q][j].w); }
        if (i + 2 < 16) {
#pragma unroll
            for (int q = 0; q < 2; ++q)
#pragma unroll
                for (int j = 0; j < 4; ++j) { const size_t o_ = (size_t)(t0 + 2 + q) * 1024 + j * 256 + lane * 4; nx[q][j] = *(const f32x4*)(xin + o_); nb[q][j] = *(const v2u*)(brn + o_); } }
        float mean[2], rstd[2];
#pragma unroll
        for (int q = 0; q < 2; ++q) mean[q] = wave_total(sm[q]) * (1.f / 1024.f);
#pragma unroll
        for (int q = 0; q < 2; ++q) { float sq = 0.f;
#pragma unroll
            for (int j = 0; j < 4; ++j) { v[q][j] = v[q][j] - mean[q]; sq += (v[q][j].x * v[q][j].x + v[q][j].y * v[q][j].y) + (v[q][j].z * v[q][j].z + v[q][j].w * v[q][j].w); }
            rstd[q] = 1.f / sqrtf(wave_total(sq) * (1.f / 1024.f) + LN_EPS); }
        f32x4 u[2][4];
#pragma unroll
        for (int j = 0; j < 4; ++j) { const int c = j * 256 + lane * 4; const f32x4 g = *(const f32x4*)(SMv + SM_LN1G + c), bb = *(const f32x4*)(SMv + SM_LN1B + c);
            const f32x4 s2 = *(const f32x4*)(sc2 + c), h2 = *(const f32x4*)(sh2 + c);
#pragma unroll
            for (int q = 0; q < 2; ++q) { const f32x4 x1 = v[q][j] * rstd[q] * g + bb; *(f32x4*)(xo + (size_t)(t0 + q) * 1024 + c) = x1;
                u[q][j] = x1 * (1.f + s2) + h2;
                v2u o; o.x = pk2(u[q][j].x, u[q][j].y); o.y = pk2(u[q][j].z, u[q][j].w); *(v2u*)(uo + (size_t)(t0 + q) * 1024 + c) = o; } }
        float lg0[20], lg1[20];
#pragma unroll
        for (int c = 0; c < 20; ++c) { float p0 = 0.f, p1 = 0.f;
#pragma unroll
            for (int j = 0; j < 4; ++j) { const f32x4 w = *(const f32x4*)(rw + c * 1024 + j * 256 + lane * 4);
                p0 += (u[0][j].x * w.x + u[0][j].y * w.y) + (u[0][j].z * w.z + u[0][j].w * w.w); p1 += (u[1][j].x * w.x + u[1][j].y * w.y) + (u[1][j].z * w.z + u[1][j].w * w.w); }
            const float bias = c < 4 ? SMv[SM_BGRP + c] : SMv[SM_BER + (c - 4)];
            lg0[c] = wave_total(p0) + bias; lg1[c] = wave_total(p1) + bias; }
        int bk0, bk1; float wl0, wh0, wl1, wh1;
        route_decide(lg0, bk0, wl0, wh0); route_decide(lg1, bk1, wl1, wh1);
        if (lane == 0 && !dry) { Route r; r.bucket = bk0; r.wi = wl0; r.wj = wh0; r.pad = 0; RT[t0] = r; atomicAdd(&cnt[bk0], 1);
            r.bucket = bk1; r.wi = wl1; r.wj = wh1; RT[t0 + 1] = r; atomicAdd(&cnt[bk1], 1); }
    }
    __syncthreads();
    if (tid < 24 && !dry) CNT[blk * 24 + tid] = cnt[tid];
    __syncthreads();
}
__device__ __forceinline__ void p8_sort(const Ctx& a, unsigned char* lds, int WID_) {
    unsigned char* ws = a.ws(); const int tid = otid(WID_), blk = blockIdx.x;
    const Route* RT = (const Route*)(ws + WS_ROUTE2); int* PERM = (int*)(ws + WS_ROUTE2 + 512 * 1024); const int* CNT = (const int*)(ws + WS_ROUTE2 + 1024 * 1024);
    int* BASES = (int*)(ws + WS_ROUTE2 + 1024 * 1024 + 32768); float* SLOTW = (float*)(ws + WS_ROUTE2 + 1280 * 1024);
    const bf16* U2 = (const bf16*)(ws + WS_U2); bf16* XS = (bf16*)(ws + WS_XS);
    int* tot = (int*)lds; int* pre = tot + 32; int* base = pre + 32; int* bk = base + 32; int* slot = bk + 128;
    if (tid < 64) tot[tid] = 0;
    __syncthreads();
    if (tid < 384) { const int p = tid >> 4, sg = tid & 15; int sa = 0, sp = 0;
#pragma unroll
        for (int i = 0; i < 16; ++i) { const int bb = sg * 16 + i; const int c = CNT[bb * 24 + p]; sa += c; sp += bb < blk ? c : 0; }
        atomicAdd(&tot[p], sa); atomicAdd(&pre[p], sp); }
    __syncthreads();
    if (tid == 0) { int acc = 0; for (int p = 0; p < 24; ++p) { base[p] = acc; acc += (tot[p] + 255) & ~255; } base[24] = acc;
        if (blk == 0) { for (int p = 0; p <= 24; ++p) BASES[p] = base[p]; } }
    if (tid < 128) bk[tid] = RT[blk * 128 + tid].bucket;
    __syncthreads();
    if (tid < 128) { const int p = bk[tid]; int r = 0; for (int j = 0; j < tid; ++j) r += bk[j] == p ? 1 : 0; const int s = base[p] + pre[p] + r; slot[tid] = s;
        const int t = blk * 128 + tid; PERM[s] = t; SLOTW[2 * s] = RT[t].wi; SLOTW[2 * s + 1] = RT[t].wj; }
    __syncthreads();
    for (int i0 = tid; i0 < 128 * 128; i0 += 512 * 8) {
        v4u cv[8];
#pragma unroll
        for (int j = 0; j < 8; ++j) { const int i = i0 + j * 512, r = i >> 7, c = i & 127; cv[j] = ((const v4u*)(U2 + (size_t)(blk * 128 + r) * 1024))[c]; }
#pragma unroll
        for (int j = 0; j < 8; ++j) { const int i = i0 + j * 512, r = i >> 7, c = i & 127; ((v4u*)(XS + (size_t)slot[r] * 1024))[c] = cv[j]; } }
    __syncthreads();
}
__device__ __forceinline__ int bucket_of_slot(const int* BASES, int s) { int p = 0; for (int q = 1; q < 24; ++q) if (s >= BASES[q]) p = q; return p; }
__device__ __forceinline__ void pair_experts(int p, int& ei, int& ej) { const int g = p / 6, pi = p % 6; ei = 4 * g + (pi < 3 ? 0 : (pi < 5 ? 1 : 2)); ej = 4 * g + (pi < 3 ? pi + 1 : (pi < 5 ? pi - 1 : 3)); }
__device__ __forceinline__ void naive_moe1(const Ctx& a, unsigned char* lds, int WID_) {
    unsigned char* ws = a.ws(); const int tid = otid(WID_);
    const int* PERM = (const int*)(ws + WS_ROUTE2 + 512 * 1024); const int* BASES = (const int*)(ws + WS_ROUTE2 + 1024 * 1024 + 32768); const float* SLOTW = (const float*)(ws + WS_ROUTE2 + 1280 * 1024);
    const bf16* XS = (const bf16*)(ws + WS_XS); const bf16* W1 = (const bf16*)(ws + WS_W1); bf16* H = (bf16*)(ws + WS_H);
    float* xs = (float*)lds; const int nslot = BASES[24];
    for (int s = blockIdx.x; s < nslot; s += gridDim.x) {
        if (PERM[s] < 0) continue;
        const int p = bucket_of_slot(BASES, s); int ei, ej; pair_experts(p, ei, ej);
        __syncthreads();
        xs[tid] = bf2f(XS[(size_t)s * 1024 + tid]); xs[tid + 512] = bf2f(XS[(size_t)s * 1024 + 512 + tid]);
        __syncthreads();
        const int m = tid >> 8, c = tid & 255, e = m ? ej : ei; const int grow = (c >> 7) * 256 + (c & 127);
        const v4u* wg = (const v4u*)(W1 + ((size_t)e * 512 + grow) * 1024); const v4u* wu = (const v4u*)(W1 + ((size_t)e * 512 + grow + 128) * 1024);
        float dg = 0.f, du = 0.f;
        for (int i = 0; i < 128; ++i) { const v4u g = wg[i], u = wu[i]; const float* x = xs + 8 * i;
            dg = fmaf(x[0], bflo(g.x), dg); dg = fmaf(x[1], bfhi(g.x), dg); dg = fmaf(x[2], bflo(g.y), dg); dg = fmaf(x[3], bfhi(g.y), dg);
            dg = fmaf(x[4], bflo(g.z), dg); dg = fmaf(x[5], bfhi(g.z), dg); dg = fmaf(x[6], bflo(g.w), dg); dg = fmaf(x[7], bfhi(g.w), dg);
            du = fmaf(x[0], bflo(u.x), du); du = fmaf(x[1], bfhi(u.x), du); du = fmaf(x[2], bflo(u.y), du); du = fmaf(x[3], bfhi(u.y), du);
            du = fmaf(x[4], bflo(u.z), du); du = fmaf(x[5], bfhi(u.z), du); du = fmaf(x[6], bflo(u.w), du); du = fmaf(x[7], bfhi(u.w), du); }
        const float hv = dg / (1.f + __expf(-dg)) * du * SLOTW[2 * s + m];
        H[(size_t)s * 512 + tid] = (bf16)f2bf(hv);
    }
    __syncthreads();
}
__device__ __forceinline__ void naive_moe2(const Ctx& a, unsigned char* lds, int WID_) {
    unsigned char* ws = a.ws(); const int tid = otid(WID_);
    const int* PERM = (const int*)(ws + WS_ROUTE2 + 512 * 1024); const int* BASES = (const int*)(ws + WS_ROUTE2 + 1024 * 1024 + 32768);
    const bf16* W2P = (const bf16*)(ws + WS_W2P); const bf16* H = (const bf16*)(ws + WS_H); const float* MOD = (const float*)(ws + WS_MOD);
    float* hs = (float*)lds; const int nslot = BASES[24];
    for (int s = blockIdx.x; s < nslot; s += gridDim.x) {
        const int t = PERM[s]; if (t < 0) continue;
        const int p = bucket_of_slot(BASES, s);
        __syncthreads();
        hs[tid] = bf2f(H[(size_t)s * 512 + tid]);
        __syncthreads();
        for (int j = tid; j < 1024; j += 512) {
            const v4u* w = (const v4u*)(W2P + ((size_t)p * 1024 + j) * 512); float y = 0.f;
            for (int i = 0; i < 64; ++i) { const v4u g = w[i]; const float* x = hs + 8 * i;
                y = fmaf(x[0], bflo(g.x), y); y = fmaf(x[1], bfhi(g.x), y); y = fmaf(x[2], bflo(g.y), y); y = fmaf(x[3], bfhi(g.y), y);
                y = fmaf(x[4], bflo(g.z), y); y = fmaf(x[5], bfhi(g.z), y); y = fmaf(x[6], bflo(g.w), y); y = fmaf(x[7], bfhi(g.w), y); }
            const size_t o = (size_t)t * 1024 + j; a.out()[o] = ALPHA * a.out()[o] + MOD[(t >> 11) * 6144 + 5120 + j] * y;
        }
    }
    __syncthreads();
}
__device__ __forceinline__ void p11_ln(const Ctx& a, bool dry, int WID_) {
    const float* SMv = (const float*)(a.ws() + WS_SMALL);
    const int tid = otid(WID_); const int lane = tid & 63, gw = blockIdx.x * 8 + (tid >> 6), NW = gridDim.x * 8;
    float* const outp = a.out(); const bf16* const brn = (const bf16*)(a.ws() + WS_U);
    f32x4 nx[4]; v2u nb[4];
#pragma unroll
    for (int j = 0; j < 4; ++j) { const size_t o_ = (size_t)gw * 1024 + j * 256 + lane * 4; nx[j] = *(const f32x4*)(outp + o_); nb[j] = *(const v2u*)(brn + o_); }
    for (int t = gw; t < T; t += NW) {
        float* row = outp + (size_t)t * 1024; f32x4 v[4]; float sm = 0.f;
#pragma unroll
        for (int j = 0; j < 4; ++j) { const v2u bw = nb[j]; v[j] = nx[j] * ALPHA + (f32x4){bflo(bw.x), bfhi(bw.x), bflo(bw.y), bfhi(bw.y)}; sm += (v[j].x + v[j].y) + (v[j].z + v[j].w); }
        if (t + NW < T) {
#pragma unroll
            for (int j = 0; j < 4; ++j) { const size_t o_ = (size_t)(t + NW) * 1024 + j * 256 + lane * 4; nx[j] = *(const f32x4*)(outp + o_); nb[j] = *(const v2u*)(brn + o_); } }
        const float mean = wave_sum(sm) * (1.f / 1024.f); float sq = 0.f;
#pragma unroll
        for (int j = 0; j < 4; ++j) { v[j] = v[j] - mean; sq += (v[j].x * v[j].x + v[j].y * v[j].y) + (v[j].z * v[j].z + v[j].w * v[j].w); }
        const float rstd = 1.f / sqrtf(wave_sum(sq) * (1.f / 1024.f) + LN_EPS);
#pragma unroll
        for (int j = 0; j < 4; ++j) { const int c = j * 256 + lane * 4; const f32x4 g = *(const f32x4*)(SMv + SM_LN2G + c), bb = *(const f32x4*)(SMv + SM_LN2B + c); *(f32x4*)((dry ? (float*)(a.ws() + 60 * MiB) + (size_t)t * 1024 : row) + c) = v[j] * rstd * g + bb; }
    }
}

namespace pg8 {
#define PG8_LAS __attribute__((address_space(3)))
typedef unsigned short bf16_t;
typedef short bf16x8 __attribute__((ext_vector_type(8)));
typedef float f32x4 __attribute__((ext_vector_type(4)));
typedef unsigned u32x4 __attribute__((ext_vector_type(4)));
constexpr int BM = 256, BK = 64, HALF = 128, HTB = HALF * BK * 2  , STAGE_BYTES = 8 * HTB, NXCD = 8, WGM = 8;

__host__ __device__ __forceinline__ int lds_byte(int r, int c) { const int st = (r >> 4) * 2 + (c >> 5), rr = r & 15, cc = c & 31, ob = rr * 64 + cc * 2; return st * 1024 + (ob ^ (((ob >> 9) & 1) << 5)); }
__host__ __device__ __forceinline__ void stage_rc(int b, int& R, int& C) { const int st = b / 1024, sb = b % 1024, swz = sb ^ (((sb >> 9) & 1) << 5); R = (st >> 1) * 16 + swz / 64; C = (st & 1) * 32 + (swz % 64) / 2; }
__host__ __device__ __forceinline__ int perm32(int rho) { const int n = rho >> 4, i = rho & 15; return 8 * (i >> 2) + 4 * n + (i & 3); }

struct Unit { int pm, pn; };
struct Gemm { const bf16_t* A; const bf16_t* Bt; int M, N, K, lda, ldb; };

struct StaticOrder {
    int nM, nN, nwg, G, c;
    __host__ __device__ void init(int M, int N, int G_, int c_) { nM = M / BM; nN = N / BM; nwg = nM * nN; G = G_; c = c_; }
    __host__ __device__ bool next(int i, Unit& u) const {
        const long L = (long)i * G + c; if (L >= nwg) return false;
        int wgid = (int)L; { const int q = nwg / NXCD, r = nwg % NXCD, xcd = wgid % NXCD, off = wgid / NXCD; wgid = (xcd < r ? xcd * (q + 1) : r * (q + 1) + (xcd - r) * q) + off; }
        const int nig = WGM * nN, gid = wgid / nig, fm = gid * WGM, gsz = (nM - fm) < WGM ? (nM - fm) : WGM;
        u.pm = fm + ((wgid % nig) % gsz); u.pn = (wgid % nig) / gsz; return true;
    }
    __device__ __forceinline__ void a_ready(const Unit&) const {}
    __device__ __forceinline__ void done(const Unit&) const {}
    __device__ __forceinline__ const char* bbase(const Gemm& g, const Unit& u) const { return (const char*)g.Bt + (size_t)u.pn * ((size_t)BM * g.ldb * 2); }
};

template <class Epi, class Sched, bool ALIGN_EPI, bool SP2, int KK, int LDA, int LDB, int AJT = 0, int AJB = 0>
__device__ __forceinline__ void gemm_phase(PG8_LAS unsigned char* lds, const Gemm g, const Sched& S, const Epi& E, int WID_) {
    int tid_ = otid(WID_);
    const int tid = tid_, wid = __builtin_amdgcn_readfirstlane(tid >> 6), lane = tid & 63, wr = wid >> 2, wc = wid & 3, fr = lane & 15, fq = lane >> 4;
    constexpr int K = KK, nt = K / BK;
    unsigned voffA[2], voffB[2];
#pragma unroll
    for (int i = 0; i < 2; ++i) { int R, C; stage_rc(tid * 16 + i * 8192, R, C); const int Rb = Epi::PERM ? ((R & ~31) + perm32(R & 31)) : R;
        voffA[i] = (unsigned)(R * LDA + C) * 2u; voffB[i] = (unsigned)(Rb * LDB + C) * 2u; }
    constexpr size_t kstep = (size_t)(BK * 2);
    constexpr size_t hstepA = (size_t)HALF * LDA * 2, hstepB = (size_t)HALF * LDB * 2;
    constexpr size_t tstepA = 2 * hstepA;
    const unsigned ldsw = (unsigned)wid * 1024u;
    const int aoff = lds_byte(wr * 64 + fr, fq * 8), boff = lds_byte(wc * 32 + fr, fq * 8);
#define PG8_SA(b, h) (((b) * 2 + (h)) * HTB)
#define PG8_SB(b, h) ((4 + (b) * 2 + (h)) * HTB)
#define PG8_STAGE(bufoff, gbase, voff) do { _Pragma("unroll") for (int _i = 0; _i < 2; ++_i) \
        __builtin_amdgcn_global_load_lds((const unsigned*)((const char*)(gbase) + (voff)[_i]), (PG8_LAS unsigned*)(lds + (bufoff) + ldsw + _i * 8192), 16, 0, 0); } while (0)
#define PG8_LDA(dst, b, h) do { _Pragma("unroll") for (int m = 0; m < 4; ++m) _Pragma("unroll") for (int k = 0; k < 2; ++k) dst[m][k] = *(const PG8_LAS bf16x8*)(lds + PG8_SA(b, h) + aoff + m * 2048 + k * 1024); } while (0)
#define PG8_LDB(dst, b, h) do { _Pragma("unroll") for (int n = 0; n < 2; ++n) _Pragma("unroll") for (int k = 0; k < 2; ++k) dst[n][k] = *(const PG8_LAS bf16x8*)(lds + PG8_SB(b, h) + boff + n * 2048 + k * 1024); } while (0)
#define PG8_MMA(ai, bj, At, Bt) do { __builtin_amdgcn_s_setprio(1); _Pragma("unroll") for (int m = 0; m < 4; ++m) _Pragma("unroll") for (int n = 0; n < 2; ++n) _Pragma("unroll") for (int k = 0; k < 2; ++k) \
        acc[ai][bj][m][n] = __builtin_amdgcn_mfma_f32_16x16x32_bf16(Bt[n][k], At[m][k], acc[ai][bj][m][n], 0, 0, 0); __builtin_amdgcn_s_setprio(0); } while (0)
#define PG8_WAIT_V(n) asm volatile("s_waitcnt vmcnt(" #n ")" ::: "memory")
#define PG8_WAIT_L(n) asm volatile("s_waitcnt lgkmcnt(" #n ")" ::: "memory")
#define PG8_BAR __builtin_amdgcn_s_barrier()
#define PG8_SCHED __builtin_amdgcn_sched_barrier(0)
    Unit cur, nxt; int ui = 0;
    if (!S.next(0, cur)) return;
    f32x4 acc[2][2][4][2];
#pragma unroll
    for (int a = 0; a < 2; ++a)
#pragma unroll
        for (int b = 0; b < 2; ++b)
#pragma unroll
            for (int m = 0; m < 4; ++m)
#pragma unroll
                for (int n = 0; n < 2; ++n) acc[a][b][m][n] = (f32x4){0.f, 0.f, 0.f, 0.f};
    bf16x8 At[4][2], B0[2][2], B1[2][2];
    const char* cA = (const char*)g.A + (size_t)cur.pm * tstepA; const char* cB = S.bbase(g, cur);
    S.a_ready(cur);
    if constexpr (SP2) {
        PG8_STAGE(PG8_SB(0, 0), cB, voffB); PG8_STAGE(PG8_SB(0, 1), cB + hstepB, voffB); PG8_STAGE(PG8_SA(0, 0), cA, voffA); PG8_STAGE(PG8_SA(0, 1), cA + hstepA, voffA);
        if (wr == 1) PG8_BAR;
        PG8_WAIT_V(2); PG8_BAR;
        PG8_STAGE(PG8_SB(1, 0), cB + kstep, voffB); PG8_STAGE(PG8_SA(1, 0), cA + kstep, voffA); PG8_STAGE(PG8_SB(1, 1), cB + hstepB + kstep, voffB);
        PG8_WAIT_V(6); PG8_BAR;
    } else {
        PG8_STAGE(PG8_SB(0, 0), cB, voffB); PG8_STAGE(PG8_SA(0, 0), cA, voffA); PG8_STAGE(PG8_SB(0, 1), cB + hstepB, voffB); PG8_STAGE(PG8_SA(0, 1), cA + hstepA, voffA);
        if (wr == 1) PG8_BAR;
        PG8_WAIT_V(4); PG8_BAR;
        PG8_STAGE(PG8_SB(1, 0), cB + kstep, voffB); PG8_STAGE(PG8_SA(1, 0), cA + kstep, voffA); PG8_STAGE(PG8_SB(1, 1), cB + hstepB + kstep, voffB);
        PG8_WAIT_V(6); PG8_BAR;
    }
    for (;;) {
        const bool has_next = S.next(ui + 1, nxt);
        const char* nA = has_next ? (const char*)g.A + (size_t)nxt.pm * tstepA : cA; const char* nB = has_next ? S.bbase(g, nxt) : cB;
        for (int t = 0; t < nt; t += 2) {
            const bool last = (t == nt - 2);
            if constexpr (AJT != 0) { if (t == AJT) E.mid(acc, cur, wr, wc, fr, fq); }
#define PG8_AOFF(kt) ((size_t)(kt) * kstep + ((AJT != 0 && (kt) >= AJT) ? (size_t)AJB : (size_t)0))
            const char* a1 = cA + PG8_AOFF(t + 1);
            const char* a2 = last ? nA : cA + PG8_AOFF(t + 2); const char* b2 = last ? nB : cB + (size_t)(t + 2) * kstep;
            const char* a3 = last ? nA + kstep : cA + PG8_AOFF(t + 3); const char* b3 = b2 + kstep;
#undef PG8_AOFF
            if (last && has_next) S.a_ready(nxt);
            if constexpr (SP2) {
            PG8_LDB(B0, 0, 0); PG8_LDB(B1, 0, 1); PG8_SCHED; PG8_LDA(At, 0, 0); PG8_STAGE(PG8_SA(1, 1), a1 + hstepA, voffA);
            PG8_WAIT_V(8); PG8_WAIT_L(0); PG8_BAR; PG8_MMA(0, 0, At, B0); PG8_MMA(0, 1, At, B1); PG8_BAR; PG8_SCHED;
            PG8_LDA(At, 0, 1); PG8_STAGE(PG8_SB(0, 0), b2, voffB); PG8_STAGE(PG8_SB(0, 1), b2 + hstepB, voffB); PG8_STAGE(PG8_SA(0, 0), a2, voffA);
            PG8_WAIT_V(8); PG8_WAIT_L(0); PG8_BAR; PG8_MMA(1, 0, At, B0); PG8_MMA(1, 1, At, B1); PG8_BAR; PG8_SCHED;
            PG8_LDB(B0, 1, 0); PG8_LDB(B1, 1, 1); PG8_SCHED; PG8_LDA(At, 1, 0); PG8_STAGE(PG8_SA(0, 1), a2 + hstepA, voffA);
            PG8_WAIT_V(8); PG8_WAIT_L(0); PG8_BAR; PG8_MMA(0, 0, At, B0); PG8_MMA(0, 1, At, B1); PG8_BAR; PG8_SCHED;
            PG8_LDA(At, 1, 1); PG8_STAGE(PG8_SB(1, 0), b3, voffB); PG8_STAGE(PG8_SB(1, 1), b3 + hstepB, voffB); PG8_STAGE(PG8_SA(1, 0), a3, voffA);
            PG8_WAIT_V(8); PG8_WAIT_L(0); PG8_BAR; PG8_MMA(1, 0, At, B0); PG8_MMA(1, 1, At, B1); PG8_BAR; PG8_SCHED;
            } else {
            PG8_LDB(B0, 0, 0); PG8_SCHED; PG8_LDA(At, 0, 0); PG8_STAGE(PG8_SA(1, 1), a1 + hstepA, voffA);
            PG8_WAIT_L(8); PG8_BAR; PG8_WAIT_L(0); PG8_MMA(0, 0, At, B0); PG8_BAR; PG8_SCHED;
            PG8_LDB(B1, 0, 1); PG8_STAGE(PG8_SB(0, 0), b2, voffB);
            PG8_BAR; PG8_WAIT_L(0); PG8_MMA(0, 1, At, B1); PG8_BAR;
            PG8_LDA(At, 0, 1); PG8_STAGE(PG8_SA(0, 0), a2, voffA);
            PG8_BAR; PG8_WAIT_L(0); PG8_MMA(1, 0, At, B0); PG8_BAR; PG8_SCHED;
            PG8_STAGE(PG8_SB(0, 1), b2 + hstepB, voffB);
            PG8_WAIT_V(6); PG8_BAR; PG8_MMA(1, 1, At, B1); PG8_BAR;
            PG8_LDB(B0, 1, 0); PG8_SCHED; PG8_LDA(At, 1, 0); PG8_STAGE(PG8_SA(0, 1), a2 + hstepA, voffA);
            PG8_WAIT_L(8); PG8_BAR; PG8_WAIT_L(0); PG8_MMA(0, 0, At, B0); PG8_BAR; PG8_SCHED;
            PG8_LDB(B1, 1, 1); PG8_STAGE(PG8_SB(1, 0), b3, voffB);
            PG8_BAR; PG8_WAIT_L(0); PG8_MMA(0, 1, At, B1); PG8_BAR;
            PG8_LDA(At, 1, 1); PG8_STAGE(PG8_SA(1, 0), a3, voffA);
            PG8_BAR; PG8_WAIT_L(0); PG8_MMA(1, 0, At, B0); PG8_BAR; PG8_SCHED;
            PG8_STAGE(PG8_SB(1, 1), b3 + hstepB, voffB);
            PG8_WAIT_V(6); PG8_BAR; PG8_MMA(1, 1, At, B1); PG8_BAR;
            }
        }
        if constexpr (ALIGN_EPI) { if (wr == 0) PG8_BAR; }
        if constexpr (!Epi::AFTER_DRAIN) { E(acc, cur, wr, wc, fr, fq); S.done(cur); }
        if (!has_next) break;
#pragma unroll
        for (int a = 0; a < 2; ++a)
#pragma unroll
            for (int b = 0; b < 2; ++b)
#pragma unroll
                for (int m = 0; m < 4; ++m)
#pragma unroll
                    for (int n = 0; n < 2; ++n) acc[a][b][m][n] = (f32x4){0.f, 0.f, 0.f, 0.f};
        cur = nxt; cA = nA; cB = nB; ++ui;
        if constexpr (ALIGN_EPI) { if (wr == 1) PG8_BAR; }
    }
    PG8_WAIT_V(0);
    if constexpr (!ALIGN_EPI) { if (wr == 0) PG8_BAR; }
    PG8_BAR;
    if constexpr (Epi::AFTER_DRAIN) { E.fused(acc, cur, wr, wc, fr, fq, lds, wid, lane); S.done(cur); }
#undef PG8_SA
#undef PG8_SB
#undef PG8_STAGE
#undef PG8_LDA
#undef PG8_LDB
#undef PG8_MMA
#undef PG8_WAIT_V
#undef PG8_WAIT_L
#undef PG8_BAR
#undef PG8_SCHED
}

__device__ __forceinline__ unsigned cvt_pk_bf16(float lo, float hi) { unsigned r; asm volatile("v_cvt_pk_bf16_f32 %0, %1, %2" : "=v"(r) : "v"(lo), "v"(hi)); return r; }
__device__ __forceinline__ float blo(unsigned w) { return __uint_as_float(w << 16); }
__device__ __forceinline__ float bhi(unsigned w) { return __uint_as_float(w & 0xffff0000u); }
__device__ __forceinline__ float sigm(float v) { return __builtin_amdgcn_rcpf(1.f + __builtin_amdgcn_exp2f(-1.4426950408889634f * v)); }
struct EpiProjF {
    static constexpr bool PERM = true, AFTER_DRAIN = false;
    bf16_t* O; int ldc; float qs; float* R; PG8_LAS float* xs;
    __device__ __forceinline__ void operator()(const f32x4 (&acc)[2][2][4][2], const Unit& u, int wr, int wc, int fr, int fq) const {
        const int row0 = u.pm * BM + wr * 64 + fr, col0 = u.pn * BM + wc * 32 + 8 * fq;
        const int mode = (u.pn < 2 || u.pn == 6 || u.pn == 7) ? 1 : (u.pn >= 11 ? 2 : 0);
        if (u.pn == 8) {
#pragma unroll
            for (int ai = 0; ai < 2; ++ai)
#pragma unroll
                for (int m = 0; m < 4; ++m) { const f32x4 a0 = acc[ai][0][m][0], a1 = acc[ai][0][m][1];
                    float ss = (a0[0] * a0[0] + a0[1] * a0[1]) + (a0[2] * a0[2] + a0[3] * a0[3]) + (a1[0] * a1[0] + a1[1] * a1[1]) + (a1[2] * a1[2] + a1[3] * a1[3]);
                    ss += __shfl_xor(ss, 16); ss += __shfl_xor(ss, 32);
                    if (fq == 0) xs[(ai * HALF + wr * 64 + m * 16 + fr) * 4 + wc] = ss; }
            asm volatile("s_waitcnt lgkmcnt(0)" ::: "memory"); __builtin_amdgcn_s_barrier(); asm volatile("" ::: "memory");
            const int tl = (wr * 4 + wc) * 64 + fq * 16 + fr;
            if (tl < BM) { const float sm = (xs[tl * 4] + xs[tl * 4 + 1]) + (xs[tl * 4 + 2] + xs[tl * 4 + 3]); R[u.pm * BM + tl] = __builtin_amdgcn_rsqf(sm * (1.f / 128.f) + 1e-5f); }
        }
#pragma unroll
        for (int ai = 0; ai < 2; ++ai)
#pragma unroll
            for (int m = 0; m < 4; ++m) { bf16_t* rowp = O + (size_t)(row0 + ai * HALF + m * 16) * ldc + col0;
#pragma unroll
                for (int bj = 0; bj < 2; ++bj) { f32x4 v0 = acc[ai][bj][m][0], v1 = acc[ai][bj][m][1];
                    if (mode == 1) { v0 = v0 * qs; v1 = v1 * qs; }
                    else if (mode == 2) { v0 = (f32x4){sigm(v0[0]), sigm(v0[1]), sigm(v0[2]), sigm(v0[3])}; v1 = (f32x4){sigm(v1[0]), sigm(v1[1]), sigm(v1[2]), sigm(v1[3])}; }
                    u32x4 w; w.x = cvt_pk_bf16(v0[0], v0[1]); w.y = cvt_pk_bf16(v0[2], v0[3]); w.z = cvt_pk_bf16(v1[0], v1[1]); w.w = cvt_pk_bf16(v1[2], v1[3]);
                    *(u32x4*)(rowp + bj * HALF) = w; } }
    }
};
struct EpiRowScale {
    static constexpr bool PERM = true, AFTER_DRAIN = false;
    bf16_t* O; int ldc; const float* rs;
    __device__ __forceinline__ void operator()(const f32x4 (&acc)[2][2][4][2], const Unit& u, int wr, int wc, int fr, int fq) const {
        const int row0 = u.pm * BM + wr * 64 + fr, col0 = u.pn * BM + wc * 32 + 8 * fq;
#pragma unroll
        for (int ai = 0; ai < 2; ++ai)
#pragma unroll
            for (int m = 0; m < 4; ++m) { const int r = row0 + ai * HALF + m * 16; const float s = rs[r]; bf16_t* rowp = O + (size_t)r * ldc + col0;
#pragma unroll
                for (int bj = 0; bj < 2; ++bj) { const f32x4 v0 = acc[ai][bj][m][0] * s, v1 = acc[ai][bj][m][1] * s;
                    u32x4 w; w.x = cvt_pk_bf16(v0[0], v0[1]); w.y = cvt_pk_bf16(v0[2], v0[3]); w.z = cvt_pk_bf16(v1[0], v1[1]); w.w = cvt_pk_bf16(v1[2], v1[3]);
                    *(u32x4*)(rowp + bj * HALF) = w; } }
    }
};
template <bool FIRST> struct EpiMix {
    static constexpr bool PERM = true, AFTER_DRAIN = false;
    bf16_t* O; int ldc; const bf16_t* G; int ldg;
    __device__ __forceinline__ void operator()(const f32x4 (&acc)[2][2][4][2], const Unit& u, int wr, int wc, int fr, int fq) const {
        const int row0 = u.pm * BM + wr * 64 + fr, col0 = u.pn * BM + wc * 32 + 8 * fq;
#pragma unroll
        for (int ai = 0; ai < 2; ++ai)
#pragma unroll
            for (int m = 0; m < 4; ++m) { const int r = row0 + ai * HALF + m * 16; bf16_t* rowp = O + (size_t)r * ldc + col0; const bf16_t* gp = G + (size_t)r * ldg + col0;
#pragma unroll
                for (int bj = 0; bj < 2; ++bj) { const u32x4 gw = *(const u32x4*)(gp + bj * HALF); f32x4 v0 = acc[ai][bj][m][0], v1 = acc[ai][bj][m][1];
                    v0 = v0 * (f32x4){blo(gw.x), bhi(gw.x), blo(gw.y), bhi(gw.y)}; v1 = v1 * (f32x4){blo(gw.z), bhi(gw.z), blo(gw.w), bhi(gw.w)};
                    if (!FIRST) { const u32x4 ow = *(const u32x4*)(rowp + bj * HALF); v0 = v0 + (f32x4){blo(ow.x), bhi(ow.x), blo(ow.y), bhi(ow.y)}; v1 = v1 + (f32x4){blo(ow.z), bhi(ow.z), blo(ow.w), bhi(ow.w)}; }
                    u32x4 w; w.x = cvt_pk_bf16(v0[0], v0[1]); w.y = cvt_pk_bf16(v0[2], v0[3]); w.z = cvt_pk_bf16(v1[0], v1[1]); w.w = cvt_pk_bf16(v1[2], v1[3]);
                    *(u32x4*)(rowp + bj * HALF) = w; } }
    }
};
struct EpiMixFused {
    static constexpr bool PERM = true, AFTER_DRAIN = false;
    bf16_t* O; int ldc; const bf16_t* G; int ldg;
    __device__ __forceinline__ void mid(f32x4 (&acc)[2][2][4][2], const Unit& u, int wr, int wc, int fr, int fq) const {
        int row0 = u.pm * BM + wr * 64 + fr, col0 = u.pn * BM + wc * 32 + 8 * fq;
        asm volatile("" : "+v"(row0), "+v"(col0));
#pragma unroll
        for (int ai = 0; ai < 2; ++ai)
#pragma unroll
            for (int m = 0; m < 4; ++m) { const bf16_t* gp = G + (size_t)(row0 + ai * HALF + m * 16) * ldg + col0;
#pragma unroll
                for (int bj = 0; bj < 2; ++bj) { const u32x4 a = *(const u32x4*)(gp + bj * HALF), b = *(const u32x4*)(gp + 1024 + bj * HALF);
                    const f32x4 r0 = (f32x4){blo(a.x) * __builtin_amdgcn_rcpf(fmaxf(blo(b.x), 1e-30f)), bhi(a.x) * __builtin_amdgcn_rcpf(fmaxf(bhi(b.x), 1e-30f)), blo(a.y) * __builtin_amdgcn_rcpf(fmaxf(blo(b.y), 1e-30f)), bhi(a.y) * __builtin_amdgcn_rcpf(fmaxf(bhi(b.y), 1e-30f))};
                    const f32x4 r1 = (f32x4){blo(a.z) * __builtin_amdgcn_rcpf(fmaxf(blo(b.z), 1e-30f)), bhi(a.z) * __builtin_amdgcn_rcpf(fmaxf(bhi(b.z), 1e-30f)), blo(a.w) * __builtin_amdgcn_rcpf(fmaxf(blo(b.w), 1e-30f)), bhi(a.w) * __builtin_amdgcn_rcpf(fmaxf(bhi(b.w), 1e-30f))};
                    acc[ai][bj][m][0] = acc[ai][bj][m][0] * r0; acc[ai][bj][m][1] = acc[ai][bj][m][1] * r1; }
                if (m & 1) asm volatile("" ::: "memory"); }
    }
    __device__ __forceinline__ void operator()(const f32x4 (&acc)[2][2][4][2], const Unit& u, int wr, int wc, int fr, int fq) const {
        const int row0 = u.pm * BM + wr * 64 + fr, col0 = u.pn * BM + wc * 32 + 8 * fq;
#pragma unroll
        for (int ai = 0; ai < 2; ++ai)
#pragma unroll
            for (int m = 0; m < 4; ++m) { const int r = row0 + ai * HALF + m * 16; bf16_t* rowp = O + (size_t)r * ldc + col0; const bf16_t* gp = G + (size_t)r * ldg + 1024 + col0;
#pragma unroll
                for (int bj = 0; bj < 2; ++bj) { const u32x4 gw = *(const u32x4*)(gp + bj * HALF);
                    const f32x4 v0 = acc[ai][bj][m][0] * (f32x4){blo(gw.x), bhi(gw.x), blo(gw.y), bhi(gw.y)}, v1 = acc[ai][bj][m][1] * (f32x4){blo(gw.z), bhi(gw.z), blo(gw.w), bhi(gw.w)};
                    u32x4 w; w.x = cvt_pk_bf16(v0[0], v0[1]); w.y = cvt_pk_bf16(v0[2], v0[3]); w.z = cvt_pk_bf16(v1[0], v1[1]); w.w = cvt_pk_bf16(v1[2], v1[3]);
                    *(u32x4*)(rowp + bj * HALF) = w; } }
    }
};
struct EpiGateBf16 {
    static constexpr bool PERM = true, AFTER_DRAIN = false;
    bf16_t* O; int ldc; const float* gate; int gstride;
    __device__ __forceinline__ void operator()(const f32x4 (&acc)[2][2][4][2], const Unit& u, int wr, int wc, int fr, int fq) const {
        const int row0 = u.pm * BM + wr * 64 + fr, col0 = u.pn * BM + wc * 32 + 8 * fq; const float* gb = gate + (size_t)((u.pm * BM) >> 11) * gstride + col0;
        f32x4 gv[2][2];
#pragma unroll
        for (int bj = 0; bj < 2; ++bj)
#pragma unroll
            for (int n = 0; n < 2; ++n) gv[bj][n] = *(const f32x4*)(gb + bj * HALF + n * 4);
#pragma unroll
        for (int ai = 0; ai < 2; ++ai)
#pragma unroll
            for (int m = 0; m < 4; ++m) { bf16_t* rowp = O + (size_t)(row0 + ai * HALF + m * 16) * ldc + col0;
#pragma unroll
                for (int bj = 0; bj < 2; ++bj) { const f32x4 v0 = acc[ai][bj][m][0] * gv[bj][0], v1 = acc[ai][bj][m][1] * gv[bj][1];
                    u32x4 w; w.x = cvt_pk_bf16(v0[0], v0[1]); w.y = cvt_pk_bf16(v0[2], v0[3]); w.z = cvt_pk_bf16(v1[0], v1[1]); w.w = cvt_pk_bf16(v1[2], v1[3]);
                    *(u32x4*)(rowp + bj * HALF) = w; } }
    }
};
struct EpiResGate {
    static constexpr bool PERM = false, AFTER_DRAIN = false;
    float* out; const float* x; const float* gate; int gstride; float alpha;
    __device__ __forceinline__ void operator()(const f32x4 (&acc)[2][2][4][2], const Unit& u, int wr, int wc, int fr, int fq) const {
        const int col0 = u.pn * BM + wc * 32 + 4 * fq; const float* gb = gate + (size_t)((u.pm * BM) >> 11) * gstride + col0;
        f32x4 gv[2][2];
#pragma unroll
        for (int bj = 0; bj < 2; ++bj)
#pragma unroll
            for (int n = 0; n < 2; ++n) gv[bj][n] = *(const f32x4*)(gb + bj * HALF + n * 16);
#pragma unroll
        for (int ai = 0; ai < 2; ++ai)
#pragma unroll
            for (int m = 0; m < 4; ++m) { const size_t off = (size_t)(u.pm * BM + ai * HALF + wr * 64 + m * 16 + fr) * 1024 + col0;
#pragma unroll
                for (int bj = 0; bj < 2; ++bj)
#pragma unroll
                    for (int n = 0; n < 2; ++n) { const f32x4 xv = *(const f32x4*)(x + off + bj * HALF + n * 16); *(f32x4*)(out + off + bj * HALF + n * 16) = xv * alpha + gv[bj][n] * acc[ai][bj][m][n]; } }
    }
};
__device__ __forceinline__ int tile_bucket(const int* BASES, int pm) { const int s = pm * BM; int p = 0;
#pragma unroll
    for (int q = 1; q < 24; ++q) p = (s >= BASES[q]) ? q : p;
    return p; }
struct MoeOrder1 {
    StaticOrder so; const int* BASES; const bf16_t* W1;
    __device__ __forceinline__ bool next(int i, Unit& u) const { return so.next(i, u); }
    __device__ __forceinline__ void a_ready(const Unit&) const {}
    __device__ __forceinline__ void done(const Unit&) const {}
    __device__ __forceinline__ const char* bbase(const Gemm&, const Unit& u) const {
        const int p = tile_bucket(BASES, u.pm), g = p / 6, pi = p % 6;
        const int ei = 4 * g + (pi < 3 ? 0 : (pi < 5 ? 1 : 2)), ej = 4 * g + (pi < 3 ? pi + 1 : (pi < 5 ? pi - 1 : 3));
        const int e = u.pn < 2 ? ei : ej;
        return (const char*)(W1 + ((size_t)e * 512 + (size_t)(u.pn & 1) * 256) * 1024); }
};
struct MoeOrder2 {
    StaticOrder so; const int* BASES; const bf16_t* W2P;
    __device__ __forceinline__ bool next(int i, Unit& u) const { return so.next(i, u); }
    __device__ __forceinline__ void a_ready(const Unit&) const {}
    __device__ __forceinline__ void done(const Unit&) const {}
    __device__ __forceinline__ const char* bbase(const Gemm&, const Unit& u) const {
        const int p = tile_bucket(BASES, u.pm); return (const char*)(W2P + ((size_t)p * 1024 + (size_t)u.pn * 256) * 512); }
};
struct EpiMoe1 {
    static constexpr bool PERM = true, AFTER_DRAIN = false;
    bf16_t* H; const float* SLOTW;
    __device__ __forceinline__ void operator()(const f32x4 (&acc)[2][2][4][2], const Unit& u, int wr, int wc, int fr, int fq) const {
        const int row0 = u.pm * BM + wr * 64 + fr, col0 = (u.pn >> 1) * 256 + (u.pn & 1) * 128 + wc * 32 + 8 * fq, wsel = u.pn >> 1;
#pragma unroll
        for (int ai = 0; ai < 2; ++ai)
#pragma unroll
            for (int m = 0; m < 4; ++m) { const int r = row0 + ai * HALF + m * 16; const float w = SLOTW[2 * r + wsel];
                float o[8];
#pragma unroll
                for (int n = 0; n < 2; ++n)
#pragma unroll
                    for (int i = 0; i < 4; ++i) { const float g = acc[ai][0][m][n][i], up = acc[ai][1][m][n][i]; o[4 * n + i] = g * sigm(g) * up * w; }
                u32x4 wv; wv.x = cvt_pk_bf16(o[0], o[1]); wv.y = cvt_pk_bf16(o[2], o[3]); wv.z = cvt_pk_bf16(o[4], o[5]); wv.w = cvt_pk_bf16(o[6], o[7]);
                *(u32x4*)(H + (size_t)r * 512 + col0) = wv; }
    }
};
struct EpiMoe2 {
    static constexpr bool PERM = false, AFTER_DRAIN = false;
    float* out; const int* PERMV; const float* gate; int gstride; float alpha; float* wout;
    __device__ __forceinline__ void operator()(const f32x4 (&acc)[2][2][4][2], const Unit& u, int wr, int wc, int fr, int fq) const {
        const int col0 = u.pn * BM + wc * 32 + 4 * fq;
#pragma unroll
        for (int ai = 0; ai < 2; ++ai)
#pragma unroll
            for (int m = 0; m < 4; ++m) { const int t = PERMV[u.pm * BM + ai * HALF + wr * 64 + m * 16 + fr];
                if (t >= 0) { const size_t off = (size_t)t * 1024 + col0; const float* gb = gate + (size_t)(t >> 11) * gstride + col0;
#pragma unroll
                    for (int bj = 0; bj < 2; ++bj)
#pragma unroll
                        for (int n = 0; n < 2; ++n) { const f32x4 xv = *(const f32x4*)(out + off + bj * HALF + n * 16); const f32x4 gv = *(const f32x4*)(gb + bj * HALF + n * 16);
                            *(f32x4*)(wout + off + bj * HALF + n * 16) = xv * alpha + gv * acc[ai][bj][m][n]; } } }
    }
};
struct EpiMoe2B {
    static constexpr bool PERM = true, AFTER_DRAIN = false;
    bf16_t* Y; const int* PERMV; const float* gate; int gstride;
    __device__ __forceinline__ void operator()(const f32x4 (&acc)[2][2][4][2], const Unit& u, int wr, int wc, int fr, int fq) const {
        const int col0 = u.pn * BM + wc * 32 + 8 * fq;
#pragma unroll
        for (int ai = 0; ai < 2; ++ai)
#pragma unroll
            for (int m = 0; m < 4; ++m) { const int t = PERMV[u.pm * BM + ai * HALF + wr * 64 + m * 16 + fr];
                if (t >= 0) { bf16_t* rowp = Y + (size_t)t * 1024 + col0; const float* gb = gate + (size_t)(t >> 11) * gstride + col0;
#pragma unroll
                    for (int bj = 0; bj < 2; ++bj) { const f32x4 g0 = *(const f32x4*)(gb + bj * HALF), g1 = *(const f32x4*)(gb + bj * HALF + 4);
                        const f32x4 v0 = acc[ai][bj][m][0] * g0, v1 = acc[ai][bj][m][1] * g1;
                        u32x4 w; w.x = cvt_pk_bf16(v0[0], v0[1]); w.y = cvt_pk_bf16(v0[2], v0[3]); w.z = cvt_pk_bf16(v1[0], v1[1]); w.w = cvt_pk_bf16(v1[2], v1[3]);
                        *(u32x4*)(rowp + bj * HALF) = w; } } }
    }
};
}


namespace att {
typedef short bf16x8 __attribute__((ext_vector_type(8)));
typedef short s16x4 __attribute__((ext_vector_type(4)));
typedef short v4i16_t __attribute__((ext_vector_type(4)));
typedef float f32x16 __attribute__((ext_vector_type(16)));
typedef unsigned u32x4 __attribute__((ext_vector_type(4)));
typedef float f32x2_t __attribute__((ext_vector_type(2))); typedef __bf16 bf16x2_t __attribute__((ext_vector_type(2)));
typedef LAS const char* lds_cptr;
constexpr float THR = 8.f;
__device__ __forceinline__ unsigned cvtpk(float lo, float hi) { f32x2_t v = {lo, hi}; bf16x2_t b = __builtin_convertvector(v, bf16x2_t); return __builtin_bit_cast(unsigned, b); }
__device__ __forceinline__ s16x4 vtr(lds_cptr p) { return __builtin_bit_cast(s16x4, __builtin_amdgcn_ds_read_tr16_b64_v4i16((LAS v4i16_t*)p)); }
__device__ __forceinline__ float swapmax(float m) { auto rr = __builtin_amdgcn_permlane32_swap(__float_as_uint(m), __float_as_uint(m), false, false); return fmaxf(__uint_as_float(rr[0]), __uint_as_float(rr[1])); }
__device__ __forceinline__ float swapsum(float m) { auto rr = __builtin_amdgcn_permlane32_swap(__float_as_uint(m), __float_as_uint(m), false, false); return __uint_as_float(rr[0]) + __uint_as_float(rr[1]); }
__device__ __forceinline__ void glds16(const void* g, LAS unsigned char* l) { __builtin_amdgcn_global_load_lds((const unsigned*)g, (LAS unsigned*)l, 16, 0, 0); }
__device__ __forceinline__ void qkt(f32x16& p0, f32x16& p1, lds_cptr kslot, const bf16x8 (&qr)[4], int r32, int hi) {
    lds_cptr kb = kslot + hi * 1024 + r32 * 16;
#pragma unroll
    for (int d0 = 0; d0 < 4; ++d0) {
        const bf16x8 b0 = *(const LAS bf16x8*)(kb + d0 * 2048), b1 = *(const LAS bf16x8*)(kb + d0 * 2048 + 512);
        p0 = __builtin_amdgcn_mfma_f32_32x32x16_bf16(b0, qr[d0], p0, 0, 0, 0);
        p1 = __builtin_amdgcn_mfma_f32_32x32x16_bf16(b1, qr[d0], p1, 0, 0, 0);
    }
}
template <int ND, bool LM> __device__ __forceinline__ void pv(f32x16 (&o)[ND + (LM ? 1 : 0)], int vb, bf16x8 pa0, bf16x8 pa1, bf16x8 pa2, bf16x8 pa3) {
    if constexpr (LM) {
        const bf16x8 ones = (bf16x8){0x3F80, 0x3F80, 0x3F80, 0x3F80, 0x3F80, 0x3F80, 0x3F80, 0x3F80};
        o[ND] = __builtin_amdgcn_mfma_f32_32x32x16_bf16(pa0, ones, o[ND], 0, 0, 0); o[ND] = __builtin_amdgcn_mfma_f32_32x32x16_bf16(pa1, ones, o[ND], 0, 0, 0);
        o[ND] = __builtin_amdgcn_mfma_f32_32x32x16_bf16(pa2, ones, o[ND], 0, 0, 0); o[ND] = __builtin_amdgcn_mfma_f32_32x32x16_bf16(pa3, ones, o[ND], 0, 0, 0);
    }
#pragma unroll
    for (int d0 = 0; d0 < ND; ++d0) {
        s16x4 lo[4], hi[4];
#pragma unroll
        for (int ks = 0; ks < 4; ++ks) {
            asm volatile("ds_read_b64_tr_b16 %0, %1 offset:%c2" : "=&v"(lo[ks]) : "v"(vb), "i"(d0 * 4096 + ks * 1024) : "memory");
            asm volatile("ds_read_b64_tr_b16 %0, %1 offset:%c2" : "=&v"(hi[ks]) : "v"(vb), "i"(d0 * 4096 + ks * 1024 + 512) : "memory"); }
        asm volatile("s_waitcnt lgkmcnt(0)" ::: "memory"); __builtin_amdgcn_sched_barrier(0);
#define ATT_PK(k) (bf16x8){lo[k][0], lo[k][1], lo[k][2], lo[k][3], hi[k][0], hi[k][1], hi[k][2], hi[k][3]}
        o[d0] = __builtin_amdgcn_mfma_f32_32x32x16_bf16(pa0, ATT_PK(0), o[d0], 0, 0, 0);
        o[d0] = __builtin_amdgcn_mfma_f32_32x32x16_bf16(pa1, ATT_PK(1), o[d0], 0, 0, 0);
        o[d0] = __builtin_amdgcn_mfma_f32_32x32x16_bf16(pa2, ATT_PK(2), o[d0], 0, 0, 0);
        o[d0] = __builtin_amdgcn_mfma_f32_32x32x16_bf16(pa3, ATT_PK(3), o[d0], 0, 0, 0);
#undef ATT_PK
    }
}
__device__ __forceinline__ void alibi_cin(f32x16& p0, f32x16& p1, float qrel, float sl2, float m, bool past) {
    if (past) { const float bm = -sl2 * qrel - m;
#pragma unroll
        for (int r = 0; r < 16; ++r) { const float c = (float)((r & 3) + 8 * (r >> 2)); p0[r] = fmaf(sl2, c, bm); p1[r] = fmaf(sl2, c + 32.f, bm); }
    } else {
#pragma unroll
        for (int r = 0; r < 16; ++r) { const float c = (float)((r & 3) + 8 * (r >> 2)); p0[r] = -sl2 * fabsf(qrel - c) - m; p1[r] = -sl2 * fabsf(qrel - 32.f - c) - m; }
    }
}
template <int ND, bool LM> __device__ __forceinline__ bool softmax_step(f32x16& p0, f32x16& p1, float& m, float& l, f32x16 (&o)[ND + (LM ? 1 : 0)], LAS float* wsf, int r32, int hi, bool first) {
    float mxa = fmaxf(fmaxf(p0[0], p0[1]), p1[0]), mxb = fmaxf(fmaxf(p0[2], p0[3]), p1[1]);
    mxa = fmaxf(fmaxf(mxa, p1[2]), p1[3]);
#pragma unroll
    for (int r = 4; r < 16; r += 4) { mxa = fmaxf(fmaxf(mxa, p0[r]), p0[r + 1]); mxb = fmaxf(fmaxf(mxb, p0[r + 2]), p0[r + 3]); mxa = fmaxf(fmaxf(mxa, p1[r]), p1[r + 1]); mxb = fmaxf(fmaxf(mxb, p1[r + 2]), p1[r + 3]); }
    float mx = swapmax(fmaxf(mxa, mxb));
    if (!first && __all(mx < -160.f)) return false;
    if (first) { const float dl = (mx == -INFINITY) ? 0.f : mx; m += dl;
#pragma unroll
        for (int r = 0; r < 16; ++r) { p0[r] -= dl; p1[r] -= dl; }
    } else if (__any(mx > THR)) {
        const float dl = fmaxf(mx, 0.f); m += dl;
#pragma unroll
        for (int r = 0; r < 16; ++r) { p0[r] -= dl; p1[r] -= dl; }
        const float f = __builtin_amdgcn_exp2f(-dl); if constexpr (!LM) l *= f; wsf[r32] = f;
        LDS_WAIT();
#pragma unroll
        for (int r = 0; r < 16; ++r) { const float fr = wsf[(r & 3) + 8 * (r >> 2) + 4 * hi];
#pragma unroll
            for (int d = 0; d < ND + (LM ? 1 : 0); ++d) o[d][r] *= fr; }
        LDS_WAIT();
    }
    float sacc = 0.f;
#pragma unroll
    for (int r = 0; r < 16; ++r) { p0[r] = __builtin_amdgcn_exp2f(p0[r]); p1[r] = __builtin_amdgcn_exp2f(p1[r]); if constexpr (!LM) sacc += p0[r] + p1[r]; }
    if constexpr (!LM) l += sacc;
    return true;
}
#define ATT_PACK(P, B) (u32x4){cvtpk(P[B], P[B + 1]), cvtpk(P[B + 2], P[B + 3]), cvtpk(P[B + 4], P[B + 5]), cvtpk(P[B + 6], P[B + 7])}

#define ATT_WAITBAR(N) do { asm volatile("s_waitcnt vmcnt(" #N ") lgkmcnt(0)" ::: "memory"); __builtin_amdgcn_s_barrier(); asm volatile("" ::: "memory"); } while (0)
__device__ __forceinline__ void battn_unit(LAS unsigned char* L, int b, int h, int qb, bf16* P, const bf16* KV, const unsigned* MASK, bool dry, int WID_) {
    const int tid = otid(WID_), lane = tid & 63, wid = __builtin_amdgcn_readfirstlane(tid >> 6), r32 = lane & 31, hi = lane >> 5;
    const int q0 = qb * 256, qpos = q0 + wid * 32 + r32, cq = (q0 + wid * 32) >> 6, NT = (q0 + 256) >> 6;
    const size_t rowbase = (size_t)b * SEQ;
    const bf16* Kh = KV + rowbase * 1024 + h * 64;
    bf16* Qw = P + (rowbase + q0 + wid * 32) * NP + C_BQ + h * 64;
    const char* ksrc = (const char*)(Kh + (size_t)lane * 1024 + wid * 8);
    const char* vsrc = (const char*)(Kh + 512 + (size_t)(16 * (wid & 3) + (lane >> 2)) * 1024 + (wid >> 2) * 32 + (lane & 3) * 8);
    const char* msrc = (const char*)(MASK + (rowbase + q0 + wid * 32 + (lane >> 1)) * 64 + (lane & 1));
    LAS unsigned char* kdst = L + wid * 1024; LAS unsigned char* vdst = L + 8192 + wid * 1024; LAS unsigned char* mdst = L + 65536 + wid * 256;
    LAS float* wsf = (LAS float*)(L + 73728 + wid * 256);
    bf16x8 qr[4];
#pragma unroll
    for (int d0 = 0; d0 < 4; ++d0) qr[d0] = *(const bf16x8*)(Qw + (size_t)r32 * NP + d0 * 16 + hi * 8);
    __builtin_amdgcn_s_waitcnt(0x0F70);
    const float sl2 = SLOPE_B[h] * LOG2E;
    float m = 0.f; f32x16 o[3]; o[0] = f32x16{}; o[1] = f32x16{}; o[2] = f32x16{};
#define B_DMA(it_) do { const int t_ = NT - 1 - (it_) > 0 ? NT - 1 - (it_) : 0; const int s_ = (it_) & 3; \
        glds16(ksrc + (size_t)t_ * (64 * 1024 * 2), kdst + s_ * 16384); glds16(vsrc + (size_t)t_ * (64 * 1024 * 2), vdst + s_ * 16384); \
        __builtin_amdgcn_global_load_lds((const unsigned*)(msrc + t_ * 8), (LAS unsigned*)(mdst + s_ * 2048), 4, 0, 0); } while (0)
    B_DMA(0); B_DMA(1); B_DMA(2);
    const int vb0 = (int)(unsigned)(size_t)(L + 8192) + ((lane >> 4) & 1) * 32 + (lane & 3) * 8 + (4 * hi + ((lane & 15) >> 2)) * 64;
    for (int it = 0; it < NT; ++it) {
        const int t = NT - 1 - it, sl = it & 3;
        ATT_WAITBAR(6);
        B_DMA(it + 3);
        if (t <= cq) {
            f32x16 p0, p1;
            alibi_cin(p0, p1, (float)(qpos - 64 * t - 4 * hi), sl2, m, t < cq);
            const v2u mcur = *(const LAS v2u*)(mdst + sl * 2048 + r32 * 8);
            const unsigned mx0 = mcur.x >> (4 * hi), mx1 = mcur.y >> (4 * hi);
#pragma unroll
            for (int r = 0; r < 16; ++r) { const int c = (r & 3) + 8 * (r >> 2); p0[r] = ((mx0 >> c) & 1u) ? p0[r] : -INFINITY; p1[r] = ((mx1 >> c) & 1u) ? p1[r] : -INFINITY; }
            qkt(p0, p1, (lds_cptr)L + sl * 16384, qr, r32, hi);
            if (softmax_step<2, true>(p0, p1, m, m  , o, wsf, r32, hi, t == cq)) {
                const u32x4 w0 = ATT_PACK(p0, 0), w1 = ATT_PACK(p0, 8), w2 = ATT_PACK(p1, 0), w3 = ATT_PACK(p1, 8);
                pv<2, true>(o, vb0 + sl * 16384, __builtin_bit_cast(bf16x8, w0), __builtin_bit_cast(bf16x8, w1), __builtin_bit_cast(bf16x8, w2), __builtin_bit_cast(bf16x8, w3)); }
        }
    }
#undef B_DMA
    LAS bf16* stg = (LAS bf16*)(L + 75776 + wid * 4096);
#pragma unroll
    for (int r = 0; r < 16; ++r) { const int orow = (r & 3) + 8 * (r >> 2) + 4 * hi; const float rl = 1.f / o[2][r];
        stg[orow * 64 + r32] = (bf16)f2bf(o[0][r] * rl); stg[orow * 64 + 32 + r32] = (bf16)f2bf(o[1][r] * rl); }
    LDS_WAIT();
#pragma unroll
    for (int i = 0; i < 4; ++i) { const int row = i * 8 + (lane >> 3), ch = lane & 7; const u32x4 v = *(const LAS u32x4*)(stg + row * 64 + ch * 8); if (!dry) *(u32x4*)(Qw + (size_t)row * NP + ch * 8) = v; }
    ATT_WAITBAR(0);
}
__device__ __forceinline__ void battn_phase(LAS unsigned char* L, const Ctx& a, bool dry, int WID_) {
    const int bx = blockIdx.x, x = bx & 7, c = (bx >> 3) & 31, b = 2 * x + (c >> 4), cc = c & 15, hpar = cc & 1, sel = (cc >> 1) & 1, rot = cc >> 2;
    bf16* P = (bf16*)(a.ws() + WS_PROJ); const bf16* KV = (const bf16*)(a.ws() + WS_KV); const unsigned* MASK = (const unsigned*)(a.ws() + WS_MASK);
    for (int i = 0; i < 4; ++i) { const int qb = i == 0 ? sel : (i == 1 ? 7 - sel : (i == 2 ? 2 + sel : 5 - sel)); const int h = 2 * ((i + rot) & 3) + hpar; battn_unit(L, b, h, qb, P, KV, MASK, dry, WID_); }
}

__device__ __forceinline__ void dattn_unit(LAS unsigned char* L, int b, int h, int qb, bf16* P, float lam, const float* subg, bool dry, int WID_) {
    const int tid = otid(WID_), lane = tid & 63, wid = __builtin_amdgcn_readfirstlane(tid >> 6), r32 = lane & 31, hi = lane >> 5, rg = wid & 3, mp = wid >> 2;
    const int q0 = qb * 128, qpos = q0 + rg * 32 + r32, cq = (q0 + rg * 32) >> 6, NT = (q0 + 128) >> 6;
    const size_t rowbase = (size_t)b * SEQ;
    const bf16* Kb = P + rowbase * NP + C_AK + h * 128;
    const bf16* Vb = P + rowbase * NP + C_AV + h * 128;
    bf16* Qw = P + (rowbase + q0 + rg * 32) * NP + C_AQ + h * 128;
    const char* k0src = (const char*)(Kb + (size_t)lane * NP + wid * 8);
    const char* k1src = (const char*)(Kb + (size_t)lane * NP + 64 + wid * 8);
    const char* v0src = (const char*)(Vb + (size_t)(16 * (wid & 3) + (lane >> 2)) * NP + (wid >> 2) * 32 + (lane & 3) * 8);
    const char* v1src = v0src + 64 * 2;
    LAS unsigned char* dst = L + wid * 1024;
    LAS float* wsf = (LAS float*)(L + 131072 + wid * 256);
    bf16x8 qr[4];
#pragma unroll
    for (int d0 = 0; d0 < 4; ++d0) qr[d0] = *(const bf16x8*)(Qw + (size_t)r32 * NP + mp * 64 + d0 * 16 + hi * 8);
    __builtin_amdgcn_s_waitcnt(0x0F70);
    const float sl2 = SLOPE_A[h] * LOG2E;
    float m = 0.f, l = 0.f; f32x16 o[4];
#pragma unroll
    for (int d = 0; d < 4; ++d) o[d] = f32x16{};
    constexpr size_t TS = (size_t)64 * NP * 2;
#define D_DMA(it_) do { const int t_ = NT - 1 - (it_) > 0 ? NT - 1 - (it_) : 0; LAS unsigned char* d2 = dst + ((it_) & 3) * 32768; const size_t go = (size_t)t_ * TS; \
        glds16(k0src + go, d2); glds16(k1src + go, d2 + 8192); glds16(v0src + go, d2 + 16384); glds16(v1src + go, d2 + 24576); } while (0)
    D_DMA(0); D_DMA(1); D_DMA(2);
    const int vb0 = (int)(unsigned)(size_t)(L + 16384) + ((lane >> 4) & 1) * 32 + (lane & 3) * 8 + (4 * hi + ((lane & 15) >> 2)) * 64;
    for (int it = 0; it < NT; ++it) {
        const int t = NT - 1 - it, sl = it & 3;
        ATT_WAITBAR(8);
        D_DMA(it + 3);
        if (t <= cq) {
            f32x16 p0, p1;
            alibi_cin(p0, p1, (float)(qpos - 64 * t - 4 * hi), sl2, m, t < cq);
            qkt(p0, p1, (lds_cptr)L + sl * 32768 + mp * 8192, qr, r32, hi);
            if (softmax_step<4, false>(p0, p1, m, l, o, wsf, r32, hi, t == cq)) {
                const u32x4 w0 = ATT_PACK(p0, 0), w1 = ATT_PACK(p0, 8), w2 = ATT_PACK(p1, 0), w3 = ATT_PACK(p1, 8);
                pv<4, false>(o, vb0 + sl * 32768, __builtin_bit_cast(bf16x8, w0), __builtin_bit_cast(bf16x8, w1), __builtin_bit_cast(bf16x8, w2), __builtin_bit_cast(bf16x8, w3)); }
        }
    }
#undef D_DMA
    ATT_WAITBAR(0);
    l = swapsum(l); wsf[32 + r32] = l; LDS_WAIT();
    LAS float* X = (LAS float*)L + rg * (32 * 132);
    if (mp == 1) {
#pragma unroll
        for (int r = 0; r < 16; ++r) { const int orow = (r & 3) + 8 * (r >> 2) + 4 * hi; const float rl = lam / wsf[32 + orow];
#pragma unroll
            for (int d = 0; d < 4; ++d) X[orow * 132 + d * 32 + r32] = o[d][r] * rl; }
    }
    asm volatile("s_waitcnt lgkmcnt(0)" ::: "memory"); __syncthreads();
    if (mp == 0) {
#pragma unroll
        for (int r = 0; r < 16; ++r) { const int orow = (r & 3) + 8 * (r >> 2) + 4 * hi; const float rl = 1.f / wsf[32 + orow];
#pragma unroll
            for (int d = 0; d < 4; ++d) { LAS float* xp = X + orow * 132 + d * 32 + r32; *xp = o[d][r] * rl - *xp; } }
        LDS_WAIT();
        const int row = lane >> 1, half = lane & 1; const LAS f32x4* xr = (const LAS f32x4*)(X + row * 132 + half * 64);
        f32x4 y[16]; float ss = 0.f;
#pragma unroll
        for (int j = 0; j < 16; ++j) { y[j] = xr[j]; ss += (y[j].x * y[j].x + y[j].y * y[j].y) + (y[j].z * y[j].z + y[j].w * y[j].w); }
        ss += __shfl_xor(ss, 1);
        const float rn = 0.8f / sqrtf(ss * (1.f / 128.f) + RMS_EPS);
        bf16* op = Qw + (size_t)row * NP + half * 64; const f32x4* gp = (const f32x4*)(subg + half * 64);
#pragma unroll
        for (int j = 0; j < 8; ++j) { const f32x4 g0 = gp[2 * j], g1 = gp[2 * j + 1]; const f32x4 a0 = y[2 * j] * rn * g0, a1 = y[2 * j + 1] * rn * g1;
            u32x4 w; w.x = cvtpk(a0.x, a0.y); w.y = cvtpk(a0.z, a0.w); w.z = cvtpk(a1.x, a1.y); w.w = cvtpk(a1.z, a1.w); if (!dry) *(u32x4*)(op + j * 8) = w; }
    }
    asm volatile("s_waitcnt lgkmcnt(0)" ::: "memory"); __syncthreads();
}
__device__ __forceinline__ void dattn_phase(LAS unsigned char* L, const Ctx& a, bool dry, int WID_) {
    const int bx = blockIdx.x, x = bx & 7, c = (bx >> 3) & 31, b = 2 * x + (c >> 4), cc = c & 15, rot = cc & 3, j = cc >> 2;
    bf16* P = (bf16*)(a.ws() + WS_PROJ); const float* SMv = (const float*)(a.ws() + WS_SMALL); const float lam = SMv[SM_LAM];
    for (int i = 0; i < 4; ++i) { const int qb = i == 0 ? j : (i == 1 ? 7 - j : (i == 2 ? 8 + j : 15 - j)); const int h = (i + rot) & 3; dattn_unit(L, b, h, qb, P, lam, SMv + SM_SUBLN, dry, WID_); }
}
#undef ATT_PACK
}


namespace idx {
typedef short bf16x8 __attribute__((ext_vector_type(8)));
typedef float f32x16 __attribute__((ext_vector_type(16)));
typedef unsigned u32x4 __attribute__((ext_vector_type(4)));
__device__ __forceinline__ void cnt_ge(int& c, unsigned key, unsigned t) { asm("v_cmp_ge_u32_e32 vcc, %1, %2\n\tv_addc_co_u32_e32 %0, vcc, 0, %0, vcc" : "+v"(c) : "v"(key), "v"(t) : "vcc"); }
__device__ __forceinline__ void cnt_gt(int& c, unsigned key, unsigned t) { asm("v_cmp_gt_u32_e32 vcc, %1, %2\n\tv_addc_co_u32_e32 %0, vcc, 0, %0, vcc" : "+v"(c) : "v"(key), "v"(t) : "vcc"); }
__device__ __forceinline__ int row16_sum(int x) {
    x += __builtin_amdgcn_update_dpp(0, x, 0xB1, 0xF, 0xF, true);
    x += __builtin_amdgcn_update_dpp(0, x, 0x4E, 0xF, 0xF, true);
    x += __builtin_amdgcn_update_dpp(0, x, 0x141, 0xF, 0xF, true);
    x += __builtin_amdgcn_update_dpp(0, x, 0x140, 0xF, 0xF, true);
    return x;
}
__device__ __forceinline__ int half_sum(int x, int hi) {
    x = row16_sum(x);
    const int s0 = __builtin_amdgcn_readlane(x, 0) + __builtin_amdgcn_readlane(x, 16), s1 = __builtin_amdgcn_readlane(x, 32) + __builtin_amdgcn_readlane(x, 48);
    return hi ? s1 : s0;
}
__device__ __forceinline__ float relu1(float x) { return __builtin_amdgcn_fmed3f(x, 0.f, __builtin_inff()); }
template <int NS> __device__ __forceinline__ void idx_unit_t(LAS unsigned char* L, int b, int g, const bf16* P, unsigned* MASK, int WID_) {
    const int tid = otid(WID_), lane = tid & 63, wid = __builtin_amdgcn_readfirstlane(tid >> 6), r32 = lane & 31, hi = lane >> 5;
    const int nblk = 2 * ((g >> 1) + 1);
    const size_t rowbase = (size_t)b * SEQ; const int tq0 = g * 32 + wid * 4;
    unsigned* mrow0 = MASK + (rowbase + tq0 + 2 * hi) * 64;
    const int qsel = 2 * ((r32 >> 2) & 1) + (r32 >> 4), hsel = ((r32 >> 3) & 1) * 4 + (r32 & 3);
    const bf16* qp = P + (rowbase + tq0 + qsel) * NP + C_IQ + hsel * 64 + hi * 8;
    bf16x8 qa[4];
#pragma unroll
    for (int ks = 0; ks < 4; ++ks) qa[ks] = *(const bf16x8*)(qp + ks * 16);
    float w[2][8];
#pragma unroll
    for (int q2 = 0; q2 < 2; ++q2) { const u32x4 wv = *(const u32x4*)(P + (rowbase + tq0 + 2 * hi + q2) * NP + C_IW);
        w[q2][0] = bflo(wv.x); w[q2][1] = bfhi(wv.x); w[q2][2] = bflo(wv.y); w[q2][3] = bfhi(wv.y); w[q2][4] = bflo(wv.z); w[q2][5] = bfhi(wv.z); w[q2][6] = bflo(wv.w); w[q2][7] = bfhi(wv.w); }
    const char* ksrc = (const char*)(P + (rowbase + lane) * NP + C_IK + wid * 8);
    LAS unsigned char* kdst = L + wid * 1024;
    const char* kp = ksrc;
#define IDX_DMA(s_) do { _Pragma("unroll") for (int sub = 0; sub < 4; ++sub) \
        __builtin_amdgcn_global_load_lds((const unsigned*)(kp + (size_t)(64 * sub) * (NP * 2)), (LAS unsigned*)(kdst + ((s_) & 1) * 32768 + sub * 8192), 16, 0, 0); \
        kp += (size_t)256 * (NP * 2); asm volatile("" : "+v"(kp)); } while (0)
    unsigned key[2][8 * NS];
    IDX_DMA(0);
#pragma unroll
    for (int s_ = 0; s_ < NS; ++s_) {
        asm volatile("s_waitcnt vmcnt(0)" ::: "memory"); __syncthreads();
        if (s_ + 1 < NS) IDX_DMA(s_ + 1);
#pragma unroll
        for (int j = 0; j < 8; ++j) {
            const int blk = 8 * s_ + j;
            const LAS unsigned char* kb = L + (s_ & 1) * 32768 + (j >> 1) * 8192 + hi * 1024 + ((j & 1) * 32 + r32) * 16;
            f32x16 acc = f32x16{};
#pragma unroll
            for (int ks = 0; ks < 4; ++ks) { const bf16x8 kf = *(const LAS bf16x8*)(kb + ks * 2048); acc = __builtin_amdgcn_mfma_f32_32x32x16_bf16(qa[ks], kf, acc, 0, 0, 0); }
            const bool vis = blk < nblk;
#pragma unroll
            for (int q2 = 0; q2 < 2; ++q2) { float sc = 0.f;
#pragma unroll
                for (int h = 0; h < 8; ++h) sc = fmaf(w[q2][h], relu1(acc[8 * q2 + h]), sc);
                key[q2][blk] = vis ? sortable(sc + 0.f) : 0u; asm volatile("" : "+v"(key[q2][blk])); }
        }
    }
#undef IDX_DMA
    unsigned K0 = 0u, K1 = 0u; int g0 = 0x7fffffff, g1 = 0x7fffffff;
    for (int bit = 31; bit >= 0; --bit) {
        const unsigned t0 = K0 | (1u << bit), t1 = K1 | (1u << bit);
        int c0 = 0, c1 = 0;
#pragma unroll
        for (int i = 0; i < 8 * NS; ++i) { cnt_ge(c0, key[0][i], t0); cnt_ge(c1, key[1][i], t1); }
        c0 = half_sum(c0, hi); c1 = half_sum(c1, hi);
        if (c0 >= TOPK) { K0 = t0; g0 = c0; }
        if (c1 >= TOPK) { K1 = t1; g1 = c1; }
        if (__all(g0 == TOPK && g1 == TOPK)) break;
    }
    unsigned m00 = 0u, m01 = 0u, m10 = 0u, m11 = 0u;
    if (__all(g0 == TOPK && g1 == TOPK)) {
#pragma unroll
        for (int blk = 0; blk < 8 * NS; ++blk) {
            const unsigned long long b0 = __ballot(key[0][blk] >= K0), b1 = __ballot(key[1][blk] >= K1);
            const unsigned w0 = hi ? (unsigned)(b0 >> 32) : (unsigned)b0, w1 = hi ? (unsigned)(b1 >> 32) : (unsigned)b1;
            if (r32 == (blk & 31)) { if (blk < 32) { m00 = w0; m10 = w1; } else { m01 = w0; m11 = w1; } }
            __builtin_amdgcn_sched_barrier(0); }
    } else {
        int c0 = 0, c1 = 0;
#pragma unroll
        for (int i = 0; i < 8 * NS; ++i) { cnt_gt(c0, key[0][i], K0); cnt_gt(c1, key[1][i], K1); }
        const int need0 = TOPK - half_sum(c0, hi), need1 = TOPK - half_sum(c1, hi);
        int tk0 = 0, tk1 = 0; const unsigned lt = (1u << r32) - 1u;
#pragma unroll
        for (int blk = 0; blk < 8 * NS; ++blk) {
            const unsigned long long e0b = __ballot(key[0][blk] == K0), e1b = __ballot(key[1][blk] == K1);
            const unsigned e0 = hi ? (unsigned)(e0b >> 32) : (unsigned)e0b, e1 = hi ? (unsigned)(e1b >> 32) : (unsigned)e1b;
            const bool s0 = key[0][blk] > K0 || (key[0][blk] == K0 && tk0 + __popc(e0 & lt) < need0);
            const bool s1 = key[1][blk] > K1 || (key[1][blk] == K1 && tk1 + __popc(e1 & lt) < need1);
            tk0 += __popc(e0); tk1 += __popc(e1);
            const unsigned long long b0 = __ballot(s0), b1 = __ballot(s1);
            const unsigned w0 = hi ? (unsigned)(b0 >> 32) : (unsigned)b0, w1 = hi ? (unsigned)(b1 >> 32) : (unsigned)b1;
            if (r32 == (blk & 31)) { if (blk < 32) { m00 = w0; m10 = w1; } else { m01 = w0; m11 = w1; } }
            __builtin_amdgcn_sched_barrier(0); }
    }
    mrow0[r32] = m00; mrow0[32 + r32] = m01; mrow0[64 + r32] = m10; mrow0[96 + r32] = m11;
}
__device__ __forceinline__ void idx_unit(LAS unsigned char* L, int b, int g, const bf16* P, unsigned* MASK, int WID_) {
    const int nblk = 2 * ((g >> 1) + 1), ns = (nblk + 7) >> 3;
    if (ns <= 1) {
        const int tid = otid(WID_), lane = tid & 63, wid = __builtin_amdgcn_readfirstlane(tid >> 6), r32 = lane & 31, hi = lane >> 5;
        unsigned* mrow0 = MASK + ((size_t)b * SEQ + g * 32 + wid * 4 + 2 * hi) * 64;
        const unsigned wlo = r32 < nblk ? 0xffffffffu : 0u;
        mrow0[r32] = wlo; mrow0[32 + r32] = 0u; mrow0[64 + r32] = wlo; mrow0[96 + r32] = 0u;
    }
    else if (ns == 2) idx_unit_t<2>(L, b, g, P, MASK, WID_);
    else if (ns == 3) idx_unit_t<3>(L, b, g, P, MASK, WID_);
    else if (ns == 4) idx_unit_t<4>(L, b, g, P, MASK, WID_);
    else if (ns == 5) idx_unit_t<5>(L, b, g, P, MASK, WID_);
    else if (ns == 6) idx_unit_t<6>(L, b, g, P, MASK, WID_);
    else if (ns == 7) idx_unit_t<7>(L, b, g, P, MASK, WID_);
    else idx_unit_t<8>(L, b, g, P, MASK, WID_);
}
__device__ __forceinline__ void idx_phase(LAS unsigned char* L, const Ctx& a, int WID_) {
    const int G = gridDim.x, bx = blockIdx.x, vcu = (bx % 8) * (G / 8) + bx / 8, b = vcu >> 4, j = vcu & 15;
    const bf16* P = (const bf16*)(a.ws() + WS_PROJ); unsigned* MASK = (unsigned*)(a.ws() + WS_MASK);
    for (int i = 0; i < 4; ++i) { const int g = i == 0 ? j : (i == 1 ? 31 - j : (i == 2 ? 32 + j : 63 - j)); idx_unit(L, b, g, P, MASK, WID_);
        asm volatile("s_waitcnt lgkmcnt(0)" ::: "memory"); __syncthreads(); }
}
}

__global__ void __launch_bounds__(512, 2) fwd(Args karg) {
    extern __shared__ __attribute__((aligned(16))) unsigned char lds[];
    const int tid = threadIdx.x; const int WID_ = __builtin_amdgcn_readfirstlane(tid >> 6);
    if (tid < 27) ((LAS unsigned long long*)((LAS unsigned char*)lds + LDSCTL_OFF + 512))[tid] = (unsigned long long)karg.in[tid];
    if (tid == 27) ((LAS unsigned long long*)((LAS unsigned char*)lds + LDSCTL_OFF + 512))[27] = (unsigned long long)karg.out;
    if (tid == 28) ((LAS unsigned long long*)((LAS unsigned char*)lds + LDSCTL_OFF + 512))[28] = (unsigned long long)karg.ws;
    unsigned char* ws = karg.ws;
    Ctx a; a.tab = (LAS const unsigned long long*)((LAS unsigned char*)lds + LDSCTL_OFF + 512);
    if (tid < 128) ((LAS unsigned*)((LAS unsigned char*)lds + LDSCTL_OFF))[tid] = 0u;
    __syncthreads();
    XcdBarrier bar = xcd_barrier_post((unsigned*)(ws + WS_CTL) + CW_BAR, (volatile LAS unsigned*)((LAS unsigned char*)lds + MISC_OFF) + 8);
#define GRID_BAR() do { for (int br_ = 0; br_ < PROBE_BAR; ++br_) xcd_barrier(bar); } while (0)
    bf16* PROJ = (bf16*)(ws + WS_PROJ); bf16* U = (bf16*)(ws + WS_U);
    LAS unsigned char* LL = (LAS unsigned char*)lds;

    for (int rep = 0; rep < PROBE_P0P1; ++rep) {
    for (int r2 = 0; r2 < PROBE_P0; ++r2) {
#if FAST_P0
    p0_fast(a, LL, WID_);
#else
    p0_naive(a, lds, WID_);
#endif
    __syncthreads(); }
    GRID_BAR();
    for (int r2 = 0; r2 < PROBE_P1; ++r2) { p1_modulate(a, lds, WID_); __syncthreads(); }
    GRID_BAR();
    }
    for (int rep = 0; rep < PROBE_P2; ++rep) {
#if FAST_P2
    { pg8::Gemm g{U, (const bf16*)(ws + WS_WIN), T, NP, 1024, 1024, 1024}; pg8::StaticOrder S; S.init(T, NP, (int)gridDim.x, (int)blockIdx.x);
      pg8::EpiProjF E{PROJ, NP, QSCALE, (float*)(ws + WS_R), (LAS float*)(LL + 131072)}; pg8::gemm_phase<pg8::EpiProjF, pg8::StaticOrder, true, true, 1024, 1024, 1024>(LL, g, S, E, WID_); }
#else
    { EpiProj e{PROJ}; naive_gemm((float*)lds, U, 1024, (const bf16*)(ws + WS_WIN), 1024, T, NP, 1024, e, WID_); }
#endif
    GRID_BAR();
    }
#if !FAST_P2
    naive_rms_rows(a, WID_);
    GRID_BAR();
#endif
    for (int rep = 0; rep < PROBE_KVIDX; ++rep) {
    for (int r2 = 0; r2 < PROBE_KV; ++r2) {
#if FAST_KV
    { pg8::Gemm g{PROJ + C_BKV, (const bf16*)(ws + WS_WKV), T, 1024, 128, NP, 128}; pg8::StaticOrder S; S.init(T, 1024, (int)gridDim.x, (int)blockIdx.x);
      pg8::EpiRowScale E{(bf16*)(ws + WS_KV), 1024, (const float*)(ws + WS_R)}; pg8::gemm_phase<pg8::EpiRowScale, pg8::StaticOrder, true, true, 128, NP, 128>(LL, g, S, E, WID_); }
#else
    { EpiKV e{(bf16*)(ws + WS_KV), (const float*)(ws + WS_R)}; naive_gemm((float*)lds, PROJ + C_BKV, NP, (const bf16*)(ws + WS_WKV), 128, T, 1024, 128, e, WID_); }
#endif
    __syncthreads(); }
    for (int r2 = 0; r2 < PROBE_IDX; ++r2) {
#if FAST_IDX
    idx::idx_phase(LL, a, WID_);
#else
    naive_indexer(a, lds, WID_);
#endif
    __syncthreads(); }
    }
#if FAST_DATT
    for (int rep = PROBE_DATT - 1; rep >= 0; --rep) { att::dattn_phase(LL, a, rep > 0, WID_); __syncthreads(); }
#else
    naive_diffattn(a, lds, WID_);
#endif
    GRID_BAR();
#if FAST_BATT
    for (int rep = PROBE_BATT - 1; rep >= 0; --rep) { att::battn_phase(LL, a, rep > 0, WID_); __syncthreads(); }
#else
    naive_battn(a, lds, WID_);
#endif
    GRID_BAR();
    for (int rep = 0; rep < PROBE_MIXWO; ++rep) {
    for (int r2 = 0; r2 < PROBE_MIX; ++r2) {
#if FAST_MIX
    { pg8::StaticOrder S; S.init(T, 1024, (int)gridDim.x, (int)blockIdx.x);
      pg8::Gemm g{PROJ + C_AQ, (const bf16*)(ws + WS_WA), T, 1024, 1024, NP, 1024}; pg8::EpiMixFused E{U, 1024, PROJ + C_G, NP};
      pg8::gemm_phase<pg8::EpiMixFused, pg8::StaticOrder, true, true, 1024, NP, 1024, 8, (C_BQ - C_AQ - 512) * 2>(LL, g, S, E, WID_); }
#else
    { EpiMixA e{U, PROJ}; naive_gemm((float*)lds, PROJ + C_AQ, NP, (const bf16*)(ws + WS_WA), 512, T, 1024, 512, e, WID_); }
    __syncthreads();
    { EpiMixB e{U, PROJ}; naive_gemm((float*)lds, PROJ + C_BQ, NP, (const bf16*)(ws + WS_WB), 512, T, 1024, 512, e, WID_); }
#endif
    asm volatile("s_waitcnt vmcnt(0)" ::: "memory"); __syncthreads(); }
    GRID_BAR();
    for (int r2 = 0; r2 < PROBE_WO; ++r2) {
#if FAST_WO
    { pg8::Gemm g{U, (const bf16*)(ws + WS_WO), T, 1024, 1024, 1024, 1024}; pg8::StaticOrder S; S.init(T, 1024, (int)gridDim.x, (int)blockIdx.x);
      pg8::EpiGateBf16 E{(bf16*)(ws + WS_KV), 1024, (const float*)(ws + WS_MOD) + 2048, 6144};
      pg8::gemm_phase<pg8::EpiGateBf16, pg8::StaticOrder, true, true, 1024, 1024, 1024>(LL, g, S, E, WID_); }
#else
    { EpiWo e{a.out(), a.in(I_X), (const float*)(ws + WS_MOD)}; naive_gemm((float*)lds, U, 1024, (const bf16*)(ws + WS_WO), 1024, T, 1024, 1024, e, WID_); }
#endif
    __syncthreads(); }
    GRID_BAR();
    }
    for (int rep = PROBE_ROWS * PROBE_P7 - 1; rep >= 0; --rep) p7_ln_route(a, lds, rep > 0, WID_);
    GRID_BAR();
    for (int rep = 0; rep < PROBE_ROWS * PROBE_P8; ++rep) { p8_sort(a, lds, WID_);
    GRID_BAR(); }
    for (int rep = 0; rep < PROBE_MOE * PROBE_MOE1; ++rep) {
#if FAST_MOE
    { const int* BASES = (const int*)(ws + WS_ROUTE2 + 1024 * 1024 + 32768); const int nslot = BASES[24];
      pg8::Gemm g{(const bf16*)(ws + WS_XS), (const bf16*)(ws + WS_W1), nslot, 1024, 1024, 1024, 1024};
      pg8::MoeOrder1 S; S.so.init(nslot, 1024, (int)gridDim.x, (int)blockIdx.x); S.BASES = BASES; S.W1 = (const bf16*)(ws + WS_W1);
      pg8::EpiMoe1 E{(bf16*)(ws + WS_H), (const float*)(ws + WS_ROUTE2 + 1280 * 1024)};
      pg8::gemm_phase<pg8::EpiMoe1, pg8::MoeOrder1, true, true, 1024, 1024, 1024>(LL, g, S, E, WID_); }
#else
    naive_moe1(a, lds, WID_);
#endif
    GRID_BAR();
    }
    for (int rep = PROBE_MOE * PROBE_MOE2 - 1; rep >= 0; --rep) {
#if FAST_MOE
    { const int* BASES = (const int*)(ws + WS_ROUTE2 + 1024 * 1024 + 32768); const int nslot = BASES[24];
      pg8::Gemm g{(const bf16*)(ws + WS_H), (const bf16*)(ws + WS_W2P), nslot, 1024, 512, 512, 512};
      pg8::MoeOrder2 S; S.so.init(nslot, 1024, (int)gridDim.x, (int)blockIdx.x); S.BASES = BASES; S.W2P = (const bf16*)(ws + WS_W2P);
      pg8::EpiMoe2B E{(bf16*)(ws + WS_U), (const int*)(ws + WS_ROUTE2 + 512 * 1024), (const float*)(ws + WS_MOD) + 5120, 6144};
      pg8::gemm_phase<pg8::EpiMoe2B, pg8::MoeOrder2, true, true, 512, 512, 512>(LL, g, S, E, WID_); }
#else
    naive_moe2(a, lds, WID_);
#endif
    GRID_BAR();
    }
    for (int rep = PROBE_ROWS * PROBE_P11 - 1; rep >= 0; --rep) p11_ln(a, rep > 0, WID_);
}

extern "C" void kernel_launch(void* const* d_in, const int* in_sizes, int n_in, void* d_out, int out_size, void* d_ws, size_t ws_size, hipStream_t stream) {
    static int grid = 0;
    if (grid == 0) {
        if (n_in != 27 || out_size != T * D || ws_size < WS_END) { fprintf(stderr, "kernel_launch: unexpected problem (n_in %d, out %d, ws %zu); nothing launched\n", n_in, out_size, ws_size); grid = -1; return; }
        int dev = 0, cus = 0;
        if (hipGetDevice(&dev) != hipSuccess || hipDeviceGetAttribute(&cus, hipDeviceAttributeMultiprocessorCount, dev) != hipSuccess) { grid = -1; return; }
        if (hipFuncSetAttribute((const void*)fwd, hipFuncAttributeMaxDynamicSharedMemorySize, LDS_BYTES) != hipSuccess) { fprintf(stderr, "kernel_launch: hipFuncSetAttribute failed\n"); grid = -1; return; }
        if (cus != 256) { fprintf(stderr, "kernel_launch: built for 256 CUs, device has %d; nothing launched\n", cus); grid = -1; return; }
        grid = cus;
    }
    if (grid < 0) return;
    if (hipMemsetAsync((char*)d_ws + WS_CTL, 0, CTL_ZERO_BYTES, stream) != hipSuccess) return;
    Args a{};
    for (int i = 0; i < 27; ++i) a.in[i] = (const float*)d_in[i];
    a.out = (float*)d_out; a.ws = (unsigned char*)d_ws;
    hipLaunchKernelGGL(fwd, dim3(grid), dim3(512), LDS_BYTES, stream, a);
}
```

```cpp
#include <hip/hip_runtime.h>
#include <hip/hip_bf16.h>
#include <cstdio>
#include <cstdint>

#define GAS __attribute__((address_space(1)))
#define LAS __attribute__((address_space(3)))
typedef unsigned short bf16;
typedef GAS unsigned gu32;
typedef unsigned v4u __attribute__((ext_vector_type(4)));
typedef unsigned v2u __attribute__((ext_vector_type(2)));
typedef float f32x4 __attribute__((ext_vector_type(4)));
#define RLX_AGENT __ATOMIC_RELAXED, __HIP_MEMORY_SCOPE_AGENT

#ifndef FAST_P0
#define FAST_P0 1
#endif
#ifndef FAST_P2
#define FAST_P2 1
#endif
#ifndef FAST_KV
#define FAST_KV 1
#endif
#ifndef FAST_MIX
#define FAST_MIX 1
#endif
#ifndef FAST_WO
#define FAST_WO 1
#endif
#ifndef FAST_MOE
#define FAST_MOE 1
#endif
#ifndef FAST_DATT
#define FAST_DATT 1
#endif
#ifndef FAST_IDX
#define FAST_IDX 1
#endif
#ifndef FAST_BATT
#define FAST_BATT 1
#endif
#ifndef PROBE_P0P1
#define PROBE_P0P1 1
#endif
#ifndef PROBE_P2
#define PROBE_P2 1
#endif
#ifndef PROBE_KVIDX
#define PROBE_KVIDX 1
#endif
#ifndef PROBE_DATT
#define PROBE_DATT 1
#endif
#ifndef PROBE_BATT
#define PROBE_BATT 1
#endif
#ifndef PROBE_MIXWO
#define PROBE_MIXWO 1
#endif
#ifndef PROBE_MOE
#define PROBE_MOE 1
#endif
#ifndef PROBE_ROWS
#define PROBE_ROWS 1
#endif
#ifndef PROBE_P7
#define PROBE_P7 1
#endif
#ifndef PROBE_P8
#define PROBE_P8 1
#endif
#ifndef PROBE_P11
#define PROBE_P11 1
#endif
#ifndef PROBE_BAR
#define PROBE_BAR 1
#endif
#ifndef PROBE_MOE1
#define PROBE_MOE1 1
#endif
#ifndef PROBE_MOE2
#define PROBE_MOE2 1
#endif
#ifndef PROBE_P0
#define PROBE_P0 1
#endif
#ifndef PROBE_P1
#define PROBE_P1 1
#endif
#ifndef PROBE_KV
#define PROBE_KV 1
#endif
#ifndef PROBE_IDX
#define PROBE_IDX 1
#endif
#ifndef PROBE_MIX
#define PROBE_MIX 1
#endif
#ifndef PROBE_WO
#define PROBE_WO 1
#endif
constexpr int BATCH = 16, SEQ = 2048, D = 1024, T = BATCH * SEQ;
constexpr int NP = 4864;
constexpr int C_AQ = 0, C_AK = 512, C_AV = 1024, C_BQ = 1536, C_BKV = 2048, C_IQ = 2176, C_IK = 2688, C_IW = 2752, C_PADB = 2760, C_G = 2816;
constexpr int IN_COLS = 4808;
constexpr float LOG2E = 1.4426950408889634f;
constexpr float QSCALE = 0.125f * LOG2E;
constexpr float ALPHA = 1.189207115002721f;
constexpr float LN_EPS = 1e-5f, RMS_EPS = 1e-5f;
constexpr int TOPK = 256;
constexpr int MAXSLOT = 40960;

__device__ __constant__ float SLOPE_A[4] = {0.6299605369567871f, 0.15749013423919678f, 0.039372533559799194f, 0.009843133389949799f};
__device__ __constant__ float SLOPE_B[8] = {0.39685025811195374f, 0.25f, 0.09921256452798843f, 0.0625f, 0.02480314113199711f, 0.015625f, 0.006200785282999277f, 0.00390625f};

constexpr size_t MiB = 1u << 20;
constexpr size_t WS_CTL = 0, CTL_ZERO_BYTES = 1 * MiB;
constexpr size_t WS_MOD = 1 * MiB;
constexpr size_t WS_R = WS_MOD + 512 * 1024;
constexpr size_t WS_ROUTE = WS_R + 128 * 1024;
constexpr size_t WS_SMALL = WS_R + 128 * 1024;
constexpr int SM_LN1G = 0, SM_LN1B = 1024, SM_LN2G = 2048, SM_LN2B = 3072, SM_SUBLN = 4096, SM_BGRP = 4224, SM_BER = 4228, SM_LAM = 4244, SM_ADAB = 4352;
constexpr size_t WS_WIN = 2 * MiB;
constexpr size_t WS_WA = 12 * MiB;
constexpr size_t WS_WB = 13 * MiB;
constexpr size_t WS_WO = 14 * MiB;
constexpr size_t WS_WKV = 16 * MiB;
constexpr size_t WS_W1 = 17 * MiB;
constexpr size_t WS_W2P = 33 * MiB;
constexpr size_t WS_ROUTE2 = 57 * MiB;
constexpr size_t WS_RW = 59 * MiB;
constexpr size_t WS_MODP = 59 * MiB + 128 * 1024;
constexpr size_t WS_MASK = 60 * MiB;
constexpr size_t WS_KV = 68 * MiB;
constexpr size_t WS_U = 132 * MiB;
constexpr size_t WS_PROJ = 196 * MiB;
constexpr size_t WS_U2 = 196 * MiB;
constexpr size_t WS_H = 260 * MiB;
constexpr size_t WS_XS = 300 * MiB;
constexpr size_t WS_MODPART = 500 * MiB;
constexpr size_t WS_END = 512 * MiB;

constexpr int CW_BAR = 4096;

constexpr int LDSCTL_OFF = 139264, MISC_OFF = LDSCTL_OFF + 320, LDS_BYTES = 147456;

__device__ __forceinline__ unsigned f2bf(float f) { unsigned u = __float_as_uint(f); return (u + 0x7fffu + ((u >> 16) & 1u)) >> 16; }
__device__ __forceinline__ float bf2f(unsigned h) { return __uint_as_float(h << 16); }
__device__ __forceinline__ float bflo(unsigned w) { return __uint_as_float(w << 16); }
__device__ __forceinline__ float bfhi(unsigned w) { return __uint_as_float(w & 0xffff0000u); }
__device__ __forceinline__ unsigned pk2(float lo, float hi) { return f2bf(lo) | (f2bf(hi) << 16); }
#define DPP_ADD(x, ctrl) x += __builtin_bit_cast(float, __builtin_amdgcn_update_dpp(0, __builtin_bit_cast(int, x), ctrl, 0xF, 0xF, true))
__device__ __forceinline__ float wave_sum(float v) {
    DPP_ADD(v, 0xB1); DPP_ADD(v, 0x4E); DPP_ADD(v, 0x141); DPP_ADD(v, 0x140);
    const int iv = __builtin_bit_cast(int, v);
    const float s0 = __builtin_bit_cast(float, __builtin_amdgcn_readlane(iv, 0)), s1 = __builtin_bit_cast(float, __builtin_amdgcn_readlane(iv, 16));
    const float s2 = __builtin_bit_cast(float, __builtin_amdgcn_readlane(iv, 32)), s3 = __builtin_bit_cast(float, __builtin_amdgcn_readlane(iv, 48));
    return (s0 + s1) + (s2 + s3);
}
__device__ __forceinline__ float wave_max(float v) {
#pragma unroll
    for (int o = 1; o < 64; o <<= 1) v = fmaxf(v, __shfl_xor(v, o));
    return v;
}
__device__ __forceinline__ int wave_sum_i(int v) {
#pragma unroll
    for (int o = 1; o < 64; o <<= 1) v += __shfl_xor(v, o);
    return v;
}
#define LDS_WAIT() asm volatile("s_waitcnt lgkmcnt(0)" ::: "memory")
__device__ __forceinline__ int otid(int wid) { unsigned z; asm volatile("v_mov_b32 %0, 0" : "=v"(z)); return wid * 64 + (int)__builtin_amdgcn_mbcnt_hi(~0u, __builtin_amdgcn_mbcnt_lo(~0u, z)); }

#define XB_TMO      128
#define XB_XCNT(j)  (256  + 64 * (j))
#define XB_XSUB(j)  (1280 + 64 * (j))
#define XB_XGEN(j)  (2304 + 64 * (j))
#define XB_TOP      3328
#define XB_TOPGEN   3392
#define XCD_BAR_WORDS 3456
#define XB_SPIN_CAP (1u << 22)
__device__ __forceinline__ unsigned xb_ld(unsigned* p)              { return __hip_atomic_load(p, __ATOMIC_RELAXED, __HIP_MEMORY_SCOPE_AGENT); }
__device__ __forceinline__ unsigned xb_add(unsigned* p, unsigned v) { return __hip_atomic_fetch_add(p, v, __ATOMIC_RELAXED, __HIP_MEMORY_SCOPE_AGENT); }
__device__ __forceinline__ unsigned xb_xcc_id() { return (unsigned)__builtin_amdgcn_s_getreg((3 << 11) | 20) & 0xFu; }
#define XB_SPIN(cond, bar) do { unsigned _sp = 0; while (cond) { __builtin_amdgcn_s_sleep(1); \
    if ((++_sp & 255u) == 0u) { if (xb_ld(&(bar)[XB_TMO])) break; if (_sp > XB_SPIN_CAP) { atomicAdd(&(bar)[XB_TMO], 1u); break; } } } } while (0)
struct XcdBarrier { unsigned* bar; unsigned x; volatile LAS unsigned* st; };
__device__ __forceinline__ XcdBarrier xcd_barrier_post(unsigned* bar, volatile LAS unsigned* st) {
    XcdBarrier b; b.bar = bar; b.x = xb_xcc_id(); b.st = st;
    if (threadIdx.x == 0) (void)xb_add(&bar[XB_XCNT(b.x)], 1u);
    return b;
}
__device__ __forceinline__ void xcd_barrier_complete(unsigned* bar, unsigned x, unsigned& nloc, unsigned& nx) {
    const unsigned G = gridDim.x * gridDim.y * gridDim.z;
    unsigned sum, cnt, mine, sp = 0u;
    for (;;) {
        sum = 0u; cnt = 0u; mine = 0u;
#pragma unroll
        for (unsigned j = 0; j < 16; ++j) { const unsigned c = xb_ld(&bar[XB_XCNT(j)]); sum += c; cnt += (c > 0u) ? 1u : 0u; mine = (j == x) ? c : mine; }
        if (sum == G) break;
        __builtin_amdgcn_s_sleep(1);
        if ((++sp & 255u) == 0u) { if (xb_ld(&bar[XB_TMO])) break; if (sp > XB_SPIN_CAP) { atomicAdd(&bar[XB_TMO], 1u); break; } }
    }
    nloc = mine > 0u ? mine : 1u; nx = cnt > 0u ? cnt : 1u;
}
__device__ __forceinline__ void xcd_barrier(const XcdBarrier& b) {
    asm volatile("s_waitcnt vmcnt(0)" ::: "memory");
    __syncthreads();
    if (threadIdx.x == 0) {
        unsigned* bar = b.bar;
        __builtin_amdgcn_s_waitcnt(0);
        unsigned nloc = b.st[0], nx = b.st[1];
        if (nloc == 0u) { xcd_barrier_complete(bar, b.x, nloc, nx); b.st[0] = nloc; b.st[1] = nx; }
        const unsigned old = xb_add(&bar[XB_XSUB(b.x)], 1u);
        const unsigned gen = old / nloc;
        if (old + 1u == (gen + 1u) * nloc) {
            __builtin_amdgcn_fence(__ATOMIC_RELEASE, "agent");
            asm volatile("s_waitcnt vmcnt(0)" ::: "memory");
            const unsigned og = xb_add(&bar[XB_TOP], 1u);
            const unsigned tg = og / nx;
            if (og + 1u == (tg + 1u) * nx) xb_add(&bar[XB_TOPGEN], 1u);
            else XB_SPIN(xb_ld(&bar[XB_TOPGEN]) == tg, bar);
            __builtin_amdgcn_fence(__ATOMIC_ACQUIRE, "agent");
            xb_add(&bar[XB_XGEN(b.x)], 1u);
            asm volatile("s_waitcnt vmcnt(0)" ::: "memory");
        } else {
            XB_SPIN(xb_ld(&bar[XB_XGEN(b.x)]) == gen, bar);
            __builtin_amdgcn_fence(__ATOMIC_ACQUIRE, "agent");
            asm volatile("s_waitcnt vmcnt(0)" ::: "memory");
        }
    }
    __syncthreads();
}

struct Args { const float* in[27]; float* out; unsigned char* ws; };
__device__ __forceinline__ const Args& kargs() { const Args* p = (const Args*)__builtin_amdgcn_kernarg_segment_ptr(); asm volatile("" : "+s"(p)); return *p; }
struct Ctx {
    LAS const unsigned long long* tab;
    __device__ __forceinline__ unsigned long long get(int i) const { const unsigned long long v = tab[i];
        const unsigned lo = __builtin_amdgcn_readfirstlane((unsigned)v), hi = __builtin_amdgcn_readfirstlane((unsigned)(v >> 32)); return ((unsigned long long)hi << 32) | lo; }
    __device__ __forceinline__ const float* in(int i) const { return (const float*)get(i); }
    __device__ __forceinline__ float* out() const { return (float*)get(27); }
    __device__ __forceinline__ unsigned char* ws() const { return (unsigned char*)get(28); }
};
enum { I_X = 0, I_C, I_ADAW, I_ADAB, I_WIN, I_LQ1, I_LK1, I_LQ2, I_LK2, I_SUBLN, I_KVG, I_WUK, I_WUV, I_WA, I_WB, I_WO, I_LN1G, I_LN1B, I_WGRP, I_BGRP, I_WER, I_BER, I_WEG, I_WEU, I_WED, I_LN2G, I_LN2B };

template <class Epi>
__device__ __forceinline__ void naive_gemm(float* sm, const bf16* A, int lda, const bf16* Bt, int ldb, int M, int N, int K, const Epi& epi, int WID_) {
    const int tid = otid(WID_), ty = tid >> 5, tx = tid & 31;
    float* As = sm; float* Bs = sm + 16 * 132;
    const int ntn = N / 128, ntiles = (M / 128) * ntn;
    for (int tile = blockIdx.x; tile < ntiles; tile += gridDim.x) {
        const int m0 = (tile / ntn) * 128, n0 = (tile % ntn) * 128;
        float acc[8][4];
#pragma unroll
        for (int i = 0; i < 8; ++i)
#pragma unroll
            for (int j = 0; j < 4; ++j) acc[i][j] = 0.f;
        for (int k0 = 0; k0 < K; k0 += 16) {
            {
                const int row = tid >> 2, kq = (tid & 3) * 4;
                const v2u av = *(const v2u*)(A + (size_t)(m0 + row) * lda + k0 + kq);
                As[(kq + 0) * 132 + row] = bflo(av.x); As[(kq + 1) * 132 + row] = bfhi(av.x);
                As[(kq + 2) * 132 + row] = bflo(av.y); As[(kq + 3) * 132 + row] = bfhi(av.y);
                const v2u bv = *(const v2u*)(Bt + (size_t)(n0 + row) * ldb + k0 + kq);
                Bs[(kq + 0) * 132 + row] = bflo(bv.x); Bs[(kq + 1) * 132 + row] = bfhi(bv.x);
                Bs[(kq + 2) * 132 + row] = bflo(bv.y); Bs[(kq + 3) * 132 + row] = bfhi(bv.y);
            }
            __syncthreads();
#pragma unroll
            for (int kk = 0; kk < 16; ++kk) {
                float a[8], b[4];
#pragma unroll
                for (int i = 0; i < 8; ++i) a[i] = As[kk * 132 + ty * 8 + i];
#pragma unroll
                for (int j = 0; j < 4; ++j) b[j] = Bs[kk * 132 + tx * 4 + j];
#pragma unroll
                for (int i = 0; i < 8; ++i)
#pragma unroll
                    for (int j = 0; j < 4; ++j) acc[i][j] = fmaf(a[i], b[j], acc[i][j]);
            }
            __syncthreads();
        }
#pragma unroll
        for (int i = 0; i < 8; ++i)
#pragma unroll
            for (int j = 0; j < 4; ++j) epi(m0 + ty * 8 + i, n0 + tx * 4 + j, acc[i][j]);
    }
}

struct EpiProj {
    bf16* P;
    __device__ __forceinline__ void operator()(int r, int c, float v) const {
        if (c < C_AK || (c >= C_BQ && c < C_BKV)) v *= QSCALE;
        else if (c >= C_G) v = 1.f / (1.f + __expf(-v));
        P[(size_t)r * NP + c] = (bf16)f2bf(v);
    }
};
struct EpiKV { bf16* KV; const float* R; __device__ __forceinline__ void operator()(int r, int c, float v) const { KV[(size_t)r * 1024 + c] = (bf16)f2bf(v * R[r]); } };
struct EpiMixA { bf16* MX; const bf16* P; __device__ __forceinline__ void operator()(int r, int c, float v) const { MX[(size_t)r * 1024 + c] = (bf16)f2bf(v * bf2f(P[(size_t)r * NP + C_G + c])); } };
struct EpiMixB { bf16* MX; const bf16* P; __device__ __forceinline__ void operator()(int r, int c, float v) const { const size_t o = (size_t)r * 1024 + c; MX[o] = (bf16)f2bf(bf2f(MX[o]) + v * bf2f(P[(size_t)r * NP + C_G + 1024 + c])); } };
struct EpiWo { float* out; const float* x; const float* MOD; __device__ __forceinline__ void operator()(int r, int c, float v) const { const size_t o = (size_t)r * 1024 + c; out[o] = ALPHA * x[o] + MOD[(r >> 11) * 6144 + 2048 + c] * v; } };

__device__ __forceinline__ void p0_naive(const Ctx& a, unsigned char* lds, int WID_) {
    unsigned char* ws = a.ws();
    const int tid = otid(WID_); const size_t gt = (size_t)blockIdx.x * 512 + tid, NT = (size_t)gridDim.x * 512;
    bf16* WIN = (bf16*)(ws + WS_WIN); bf16* WA = (bf16*)(ws + WS_WA); bf16* WB = (bf16*)(ws + WS_WB); bf16* WO = (bf16*)(ws + WS_WO);
    bf16* WKV = (bf16*)(ws + WS_WKV); bf16* W1 = (bf16*)(ws + WS_W1); bf16* W2P = (bf16*)(ws + WS_W2P); float* RW = (float*)(ws + WS_RW);
    for (size_t i = gt; i < (size_t)NP * 1024; i += NT) { const int n = (int)(i >> 10), k = (int)(i & 1023); const int o = n < C_PADB ? n : (n >= C_G ? n - 56 : -1);
        WIN[i] = o >= 0 ? (bf16)f2bf(a.in(I_WIN)[(size_t)k * IN_COLS + o]) : (bf16)0; }
    for (size_t i = gt; i < (size_t)1024 * 512; i += NT) { const int n = (int)(i >> 9), k = (int)(i & 511);
        WA[i] = (bf16)f2bf(a.in(I_WA)[(size_t)k * 1024 + n]); WB[i] = (bf16)f2bf(a.in(I_WB)[(size_t)k * 1024 + n]); }
    for (size_t i = gt; i < (size_t)1024 * 1024; i += NT) { const int n = (int)(i >> 10), k = (int)(i & 1023); WO[i] = (bf16)f2bf(a.in(I_WO)[(size_t)k * 1024 + n]); }
    for (size_t i = gt; i < (size_t)1024 * 128; i += NT) { const int n = (int)(i >> 7), r = (int)(i & 127);
        const float g = a.in(I_KVG)[r]; const float w = n < 512 ? a.in(I_WUK)[r * 512 + n] : a.in(I_WUV)[r * 512 + (n - 512)]; WKV[i] = (bf16)f2bf(g * w); }
    for (size_t i = gt; i < (size_t)16 * 512 * 1024; i += NT) { const int k = (int)(i & 1023), row = (int)((i >> 10) & 511), e = (int)(i >> 19);
        const int tile = row >> 8, half = (row >> 7) & 1, j = row & 127, col = tile * 128 + j;
        const float* src = half ? a.in(I_WEU) : a.in(I_WEG); W1[i] = (bf16)f2bf(src[((size_t)e * 1024 + k) * 256 + col]); }
    for (size_t i = gt; i < (size_t)24 * 1024 * 512; i += NT) { const int kk = (int)(i & 511), n = (int)((i >> 9) & 1023), p = (int)(i >> 19);
        const int g = p / 6, pi = p % 6; const int ei = pi < 3 ? 0 : (pi < 5 ? 1 : 2); const int ej = pi < 3 ? pi + 1 : (pi < 5 ? pi - 1 : 3);
        const int e = 4 * g + (kk < 256 ? ei : ej); W2P[i] = (bf16)f2bf(a.in(I_WED)[((size_t)e * 256 + (kk & 255)) * 1024 + n]); }
    for (size_t i = gt; i < (size_t)20 * 1024; i += NT) { const int c = (int)(i >> 10), k = (int)(i & 1023); RW[i] = c < 4 ? a.in(I_WGRP)[k * 4 + c] : a.in(I_WER)[k * 16 + (c - 4)]; }
    {
        float* sc = (float*)lds;
        const int kb = blockIdx.x >> 4, cb = blockIdx.x & 15;
        for (int i = tid; i < 16 * 64; i += 512) { const int b = i >> 6, kk = i & 63; const float cv = a.in(I_C)[b * 1024 + kb * 64 + kk]; sc[i] = cv / (1.f + __expf(-cv)); }
        __syncthreads();
        if (tid < 384) {
            const int j = cb * 384 + tid; float acc[16];
#pragma unroll
            for (int b = 0; b < 16; ++b) acc[b] = 0.f;
            for (int kk = 0; kk < 64; ++kk) { const float w = a.in(I_ADAW)[(size_t)(kb * 64 + kk) * 6144 + j];
#pragma unroll
                for (int b = 0; b < 16; ++b) acc[b] = fmaf(sc[b * 64 + kk], w, acc[b]); }
            float* MP = (float*)(ws + WS_MODPART);
#pragma unroll
            for (int b = 0; b < 16; ++b) MP[((size_t)kb * 16 + b) * 6144 + j] = acc[b];
        }
        __syncthreads();
    }
}
__device__ __forceinline__ float lam_value(const Ctx& a);
__device__ __forceinline__ void tr_item(const float* src, int ld, bf16* dst, int dld, LAS float* scr, int lane, int nvalid, const float* kscale) {
    const int n_ = lane & 31; const float* sp0 = src + (size_t)(lane >> 5) * ld + n_; const bool ok = n_ < nvalid;
    {
        float tv[32]; const float* pp = sp0; const size_t st = (size_t)2 * ld;
#pragma unroll
        for (int i = 0; i < 32; ++i) { tv[i] = ok ? *pp : 0.f; pp += st; asm volatile("" : "+v"(pp)); }
#pragma unroll
        for (int i = 0; i < 32; ++i) { const int kk = 2 * i + (lane >> 5); float v = tv[i]; if (kscale) v *= kscale[kk]; scr[kk * 33 + n_] = v; }
    }
    LDS_WAIT();
    const int c = lane & 7;
#pragma unroll
    for (int j = 0; j < 4; ++j) { const int n = (lane >> 3) + 8 * j; const LAS float* sp = scr + (8 * c) * 33 + n;
        v4u o; o.x = pk2(sp[0 * 33], sp[1 * 33]); o.y = pk2(sp[2 * 33], sp[3 * 33]); o.z = pk2(sp[4 * 33], sp[5 * 33]); o.w = pk2(sp[6 * 33], sp[7 * 33]);
        *(v4u*)(dst + (size_t)n * dld + 8 * c) = o; }
    LDS_WAIT();
}
__device__ __forceinline__ void p0_fast(const Ctx& a, LAS unsigned char* L, int WID_) {
    unsigned char* ws = a.ws();
    const int tid = otid(WID_), lane = tid & 63, wv = tid >> 6;
    bf16* WIN = (bf16*)(ws + WS_WIN); bf16* WA = (bf16*)(ws + WS_WA); bf16* WB = (bf16*)(ws + WS_WB); bf16* WO = (bf16*)(ws + WS_WO);
    bf16* WKV = (bf16*)(ws + WS_WKV); bf16* W1 = (bf16*)(ws + WS_W1); bf16* W2P = (bf16*)(ws + WS_W2P); float* RW = (float*)(ws + WS_RW);
    LAS float* scr = (LAS float*)(L + 8192 + wv * 8448);
    const int gw = blockIdx.x * 8 + wv, NW = gridDim.x * 8;
    constexpr int I_WINn = 16 * 152, I_WAn = 8 * 32, I_WOn = 16 * 32, I_KVn = 2 * 16 * 2, I_W1n = 16 * 2 * 16 * 8, I_W2n = 48 * 4 * 32;
    constexpr int NITEMS = I_WINn + 2 * I_WAn + I_WOn + I_KVn + I_W1n + I_W2n;
    for (int it = gw; it < NITEMS; it += NW) {
        int r = it;
        if (r < I_WINn) { const int kb = r / 152, nb = r % 152, n0 = nb * 32; const int o0 = n0 < C_PADB ? n0 : n0 - 56;
            const int nvalid = nb < 86 ? 32 : (nb == 86 ? 8 : (nb == 87 ? 0 : 32));
            tr_item(a.in(I_WIN) + (size_t)(kb * 64) * IN_COLS + (nb == 87 ? 0 : o0), IN_COLS, WIN + (size_t)n0 * 1024 + kb * 64, 1024, scr, lane, nvalid, nullptr); continue; }
        r -= I_WINn;
        if (r < I_WAn) { const int kb = r / 32, nb = r % 32; tr_item(a.in(I_WA) + (size_t)(kb * 64) * 1024 + nb * 32, 1024, WA + (size_t)(nb * 32) * 1024 + kb * 64, 1024, scr, lane, 32, nullptr); continue; }
        r -= I_WAn;
        if (r < I_WAn) { const int kb = r / 32, nb = r % 32; tr_item(a.in(I_WB) + (size_t)(kb * 64) * 1024 + nb * 32, 1024, WA + (size_t)(nb * 32) * 1024 + 512 + kb * 64, 1024, scr, lane, 32, nullptr); continue; }
        r -= I_WAn;
        if (r < I_WOn) { const int kb = r / 32, nb = r % 32; tr_item(a.in(I_WO) + (size_t)(kb * 64) * 1024 + nb * 32, 1024, WO + (size_t)(nb * 32) * 1024 + kb * 64, 1024, scr, lane, 32, nullptr); continue; }
        r -= I_WOn;
        if (r < I_KVn) { const int which = r / 32, rr = r % 32, kb = rr / 16, nb = rr % 16; const float* src = which ? a.in(I_WUV) : a.in(I_WUK);
            tr_item(src + (size_t)(kb * 64) * 512 + nb * 32, 512, WKV + (size_t)(which * 512 + nb * 32) * 128 + kb * 64, 128, scr, lane, 32, a.in(I_KVG) + kb * 64); continue; }
        r -= I_KVn;
        if (r < I_W1n) { const int e = r / 256, rr = r % 256, half = rr / 128, r2 = rr % 128, kb = r2 / 8, nb = r2 % 8, col = nb * 32; const float* src = half ? a.in(I_WEU) : a.in(I_WEG);
            const int row = (col >> 7) * 256 + half * 128 + (col & 127);
            tr_item(src + ((size_t)e * 1024 + kb * 64) * 256 + col, 256, W1 + ((size_t)e * 512 + row) * 1024 + kb * 64, 1024, scr, lane, 32, nullptr); continue; }
        r -= I_W1n;
        { const int ph = r / 128, r2 = r % 128, kb = r2 / 32, nb = r2 % 32, p = ph >> 1, half = ph & 1; const int g = p / 6, pi = p % 6;
            const int ei = pi < 3 ? 0 : (pi < 5 ? 1 : 2), ej = pi < 3 ? pi + 1 : (pi < 5 ? pi - 1 : 3); const int e = 4 * g + (half ? ej : ei);
            tr_item(a.in(I_WED) + ((size_t)e * 256 + kb * 64) * 1024 + nb * 32, 1024, W2P + ((size_t)p * 1024 + nb * 32) * 512 + half * 256 + kb * 64, 512, scr, lane, 32, nullptr); }
    }
    for (size_t i = (size_t)blockIdx.x * 512 + tid; i < (size_t)20 * 1024; i += (size_t)gridDim.x * 512) { const int c = (int)(i >> 10), k = (int)(i & 1023); RW[i] = c < 4 ? a.in(I_WGRP)[k * 4 + c] : a.in(I_WER)[k * 16 + (c - 4)]; }
    { float* SM = (float*)(ws + WS_SMALL); const int bx = blockIdx.x;
        if (bx < 2) { const int i = bx * 512 + tid; SM[SM_LN1G + i] = a.in(I_LN1G)[i]; SM[SM_LN1B + i] = a.in(I_LN1B)[i]; }
        else if (bx < 4) { const int i = (bx - 2) * 512 + tid; SM[SM_LN2G + i] = a.in(I_LN2G)[i]; SM[SM_LN2B + i] = a.in(I_LN2B)[i]; }
        else if (bx < 16) { const int i = (bx - 4) * 512 + tid; SM[SM_ADAB + i] = a.in(I_ADAB)[i]; }
        else if (bx == 16) { if (tid < 128) SM[SM_SUBLN + tid] = a.in(I_SUBLN)[tid];
            if (tid < 4) SM[SM_BGRP + tid] = a.in(I_BGRP)[tid];
            if (tid < 16) SM[SM_BER + tid] = a.in(I_BER)[tid];
            if (tid == 0) SM[SM_LAM] = lam_value(a); } }
    {
        LAS float* sc = (LAS float*)L;
        const int kb = blockIdx.x >> 4, cb = blockIdx.x & 15;
        for (int i = tid; i < 16 * 64; i += 512) { const int b = i >> 6, kk = i & 63; const float cv = a.in(I_C)[b * 1024 + kb * 64 + kk]; sc[i] = cv / (1.f + __expf(-cv)); }
        __syncthreads();
        if (tid < 384) {
            const int j = cb * 384 + tid; float acc[16];
#pragma unroll
            for (int b = 0; b < 16; ++b) acc[b] = 0.f;
#pragma unroll 8
            for (int kk = 0; kk < 64; ++kk) { const float w = a.in(I_ADAW)[(size_t)(kb * 64 + kk) * 6144 + j];
#pragma unroll
                for (int b = 0; b < 16; ++b) acc[b] = fmaf(sc[b * 64 + kk], w, acc[b]); }
            float* MP = (float*)(ws + WS_MODPART);
#pragma unroll
            for (int b = 0; b < 16; ++b) MP[((size_t)kb * 16 + b) * 6144 + j] = acc[b];
        }
        __syncthreads();
    }
}
__device__ __forceinline__ float mod_sum(const float* MP, const float* adab, int b, int j) {
    float s = adab[j];
#pragma unroll
    for (int ks = 0; ks < 16; ++ks) s += MP[((size_t)ks * 16 + b) * 6144 + j];
    return s;
}
__device__ __forceinline__ void p1_modulate(const Ctx& a, unsigned char* lds, int WID_) {
    unsigned char* ws = a.ws(); const int tid = otid(WID_), blk = blockIdx.x;
    const float* MP = (const float*)(ws + WS_MODPART); float* MOD = (float*)(ws + WS_MOD); bf16* U = (bf16*)(ws + WS_U);
    float* sh = (float*)lds; float* sc = sh + 1024; const float* SMv = (const float*)(ws + WS_SMALL);
    const int b = blk >> 4;
    for (int j = tid; j < 1024; j += 512) { sh[j] = mod_sum(MP, SMv + SM_ADAB, b, j); sc[j] = 1.f + mod_sum(MP, SMv + SM_ADAB, b, 1024 + j); }
    for (int e = tid; e < 384; e += 512) { const int flat = blk * 384 + e; MOD[flat] = mod_sum(MP, SMv + SM_ADAB, flat / 6144, flat % 6144); }
    __syncthreads();
    const f32x4* X = (const f32x4*)(a.in(I_X) + (size_t)blk * 128 * 1024); v2u* Uo = (v2u*)(U + (size_t)blk * 128 * 1024);
    for (int i0 = tid; i0 < 128 * 256; i0 += 512 * 8) {
        f32x4 xv[8];
#pragma unroll
        for (int j = 0; j < 8; ++j) xv[j] = X[i0 + j * 512];
#pragma unroll
        for (int j = 0; j < 8; ++j) { const int i = i0 + j * 512, c4 = (i & 255) * 4; const f32x4 x = xv[j];
            v2u o; o.x = pk2(x.x * sc[c4] + sh[c4], x.y * sc[c4 + 1] + sh[c4 + 1]); o.y = pk2(x.z * sc[c4 + 2] + sh[c4 + 2], x.w * sc[c4 + 3] + sh[c4 + 3]); Uo[i] = o; } }
    __syncthreads();
}
__device__ __forceinline__ void naive_rms_rows(const Ctx& a, int WID_) {
    const bf16* P = (const bf16*)(a.ws() + WS_PROJ); float* R = (float*)(a.ws() + WS_R);
    const int tid = otid(WID_); const int lane = tid & 63, gw = blockIdx.x * 8 + (tid >> 6), NW = gridDim.x * 8;
    for (int t0 = gw; t0 < T; t0 += NW * 8) {
        unsigned wv_[8];
#pragma unroll
        for (int j = 0; j < 8; ++j) wv_[j] = *(const unsigned*)(P + (size_t)(t0 + j * NW) * NP + C_BKV + lane * 2);
#pragma unroll
        for (int j = 0; j < 8; ++j) { const float x0 = bflo(wv_[j]), x1 = bfhi(wv_[j]); const float ss = wave_sum(x0 * x0 + x1 * x1); if (lane == 0) R[t0 + j * NW] = 1.f / sqrtf(ss * (1.f / 128.f) + RMS_EPS); } }
}
__device__ __forceinline__ unsigned sortable(float s) { const unsigned u = __float_as_uint(s); return (u & 0x80000000u) ? ~u : (u | 0x80000000u); }
__device__ __forceinline__ void naive_indexer(const Ctx& a, unsigned char* lds, int WID_) {
    const bf16* P = (const bf16*)(a.ws() + WS_PROJ); unsigned* MASK = (unsigned*)(a.ws() + WS_MASK);
    const int tid = otid(WID_), lane = tid & 63;
    float* qf = (float*)lds; float* wq = (float*)(lds + 2048); unsigned* keys = (unsigned*)(lds + 4096); unsigned* lcnt = (unsigned*)(lds + 12288); unsigned* maskw = (unsigned*)(lds + 12544);
    for (int t = blockIdx.x; t < T; t += gridDim.x) {
        const int b = t >> 11, s = t & 2047, vis = ((s >> 6) + 1) << 6;
        { const bf16* qr = P + (size_t)t * NP + C_IQ; qf[tid] = bf2f(qr[tid]); if (tid < 8) wq[tid] = bf2f(P[(size_t)t * NP + C_IW + tid]); if (tid < 40) lcnt[tid] = 0u; if (tid < 64) maskw[tid] = 0u; }
        __syncthreads();
        for (int k = tid; k < vis; k += 512) {
            const v4u* kr = (const v4u*)(P + (size_t)(b * SEQ + k) * NP + C_IK); float kf[64];
#pragma unroll
            for (int i = 0; i < 8; ++i) { const v4u v = kr[i]; kf[8 * i] = bflo(v.x); kf[8 * i + 1] = bfhi(v.x); kf[8 * i + 2] = bflo(v.y); kf[8 * i + 3] = bfhi(v.y); kf[8 * i + 4] = bflo(v.z); kf[8 * i + 5] = bfhi(v.z); kf[8 * i + 6] = bflo(v.w); kf[8 * i + 7] = bfhi(v.w); }
            float scv = 0.f;
            asm volatile("" ::: "memory");
#pragma unroll 1
            for (int h = 0; h < 8; ++h) { float d = 0.f;
#pragma unroll
                for (int i = 0; i < 64; ++i) d = fmaf(qf[h * 64 + i], kf[i], d);
                scv = fmaf(wq[h], fmaxf(d, 0.f), scv); }
            keys[k] = sortable(scv + 0.f);
        }
        __syncthreads();
        if (vis <= TOPK) { if (tid < 64) MASK[(size_t)t * 64 + tid] = (tid * 32 < vis) ? 0xffffffffu : 0u; }
        else {
            unsigned K = 0u;
            for (int bit = 31; bit >= 0; --bit) {
                const unsigned trial = K | (1u << bit); int c = 0;
                for (int k = tid; k < vis; k += 512) c += keys[k] >= trial ? 1 : 0;
                c = wave_sum_i(c); if (lane == 0 && c) atomicAdd(&lcnt[bit], (unsigned)c);
                __syncthreads();
                if (lcnt[bit] >= (unsigned)TOPK) K = trial;
            }
            { int c = 0; for (int k = tid; k < vis; k += 512) c += keys[k] > K ? 1 : 0; c = wave_sum_i(c); if (lane == 0 && c) atomicAdd(&lcnt[32], (unsigned)c); }
            __syncthreads();
            const int need = TOPK - (int)lcnt[32];
            for (int k = tid; k < vis; k += 512) {
                const unsigned kv = keys[k]; bool sel = kv > K;
                if (kv == K) { int r = 0; for (int j = 0; j < k; ++j) r += keys[j] == K ? 1 : 0; sel = r < need; }
                if (sel) atomicOr(&maskw[k >> 5], 1u << (k & 31));
            }
            __syncthreads();
            if (tid < 64) MASK[(size_t)t * 64 + tid] = maskw[tid];
        }
        __syncthreads();
    }
}
__device__ __forceinline__ float lam_value(const Ctx& a) {
    float s1 = 0.f, s2 = 0.f;
    for (int i = 0; i < 64; ++i) { s1 = fmaf(a.in(I_LQ1)[i], a.in(I_LK1)[i], s1); s2 = fmaf(a.in(I_LQ2)[i], a.in(I_LK2)[i], s2); }
    return expf(s1) - expf(s2) + 0.2f;
}
__device__ __forceinline__ void naive_diffattn(const Ctx& a, unsigned char* lds, int WID_) {
    bf16* P = (bf16*)(a.ws() + WS_PROJ);
    const int tid = otid(WID_), lane = tid & 63, wv = tid >> 6;
    float* lg = (float*)(lds + wv * 16384);
    float* qs = (float*)(lds + 131072 + wv * 512);
    const float lam = lam_value(a);
    const int gw = blockIdx.x * 8 + wv, NW = gridDim.x * 8;
    for (int it = gw; it < T * 4; it += NW) {
        const int t = it >> 2, h = it & 3, b = t >> 11, s = t & 2047, vis = ((s >> 6) + 1) << 6;
        const float sl = SLOPE_A[h] * LOG2E;
        { const bf16* qr = P + (size_t)t * NP + C_AQ + h * 128; qs[lane] = bf2f(qr[lane]); qs[lane + 64] = bf2f(qr[lane + 64]); }
        LDS_WAIT();
        float m0 = -1e30f, m1 = -1e30f;
        for (int k = lane; k < vis; k += 64) {
            asm volatile("" ::: "memory");
            const v4u* kr = (const v4u*)(P + (size_t)(b * SEQ + k) * NP + C_AK + h * 128); float d0 = 0.f, d1 = 0.f;
#pragma unroll
            for (int i = 0; i < 8; ++i) { const v4u v = kr[i]; const float* q = qs + 8 * i;
                d0 = fmaf(q[0], bflo(v.x), d0); d0 = fmaf(q[1], bfhi(v.x), d0); d0 = fmaf(q[2], bflo(v.y), d0); d0 = fmaf(q[3], bfhi(v.y), d0);
                d0 = fmaf(q[4], bflo(v.z), d0); d0 = fmaf(q[5], bfhi(v.z), d0); d0 = fmaf(q[6], bflo(v.w), d0); d0 = fmaf(q[7], bfhi(v.w), d0); }
#pragma unroll
            for (int i = 0; i < 8; ++i) { const v4u v = kr[8 + i]; const float* q = qs + 64 + 8 * i;
                d1 = fmaf(q[0], bflo(v.x), d1); d1 = fmaf(q[1], bfhi(v.x), d1); d1 = fmaf(q[2], bflo(v.y), d1); d1 = fmaf(q[3], bfhi(v.y), d1);
                d1 = fmaf(q[4], bflo(v.z), d1); d1 = fmaf(q[5], bfhi(v.z), d1); d1 = fmaf(q[6], bflo(v.w), d1); d1 = fmaf(q[7], bfhi(v.w), d1); }
            const float bias = sl * fabsf((float)(s - k));
            d0 -= bias; d1 -= bias; lg[k] = d0; lg[2048 + k] = d1; m0 = fmaxf(m0, d0); m1 = fmaxf(m1, d1);
        }
        m0 = wave_max(m0); m1 = wave_max(m1);
        float l0 = 0.f, l1 = 0.f;
        for (int k = lane; k < vis; k += 64) { const float p0 = exp2f(lg[k] - m0), p1 = exp2f(lg[2048 + k] - m1); lg[k] = p0; lg[2048 + k] = p1; l0 += p0; l1 += p1; }
        l0 = wave_sum(l0); l1 = wave_sum(l1);
        LDS_WAIT();
        float o00 = 0.f, o01 = 0.f, o10 = 0.f, o11 = 0.f;
        const bf16* vb = P + (size_t)(b * SEQ) * NP + C_AV + h * 128 + lane;
        for (int k = 0; k < vis; ++k) { const float v0 = bf2f(vb[(size_t)k * NP]), v1 = bf2f(vb[(size_t)k * NP + 64]); const float p0 = lg[k], p1 = lg[2048 + k];
            o00 = fmaf(p0, v0, o00); o01 = fmaf(p0, v1, o01); o10 = fmaf(p1, v0, o10); o11 = fmaf(p1, v1, o11); }
        const float r0 = 1.f / l0, r1 = lam / l1;
        const float y0 = o00 * r0 - o10 * r1, y1 = o01 * r0 - o11 * r1;
        const float ss = wave_sum(y0 * y0 + y1 * y1); const float rn = 0.8f / sqrtf(ss * (1.f / 128.f) + RMS_EPS);
        bf16* yo = P + (size_t)t * NP + C_AQ + h * 128;
        yo[lane] = (bf16)f2bf(y0 * rn * a.in(I_SUBLN)[lane]); yo[lane + 64] = (bf16)f2bf(y1 * rn * a.in(I_SUBLN)[lane + 64]);
        LDS_WAIT();
    }
}
__device__ __forceinline__ void naive_battn(const Ctx& a, unsigned char* lds, int WID_) {
    bf16* P = (bf16*)(a.ws() + WS_PROJ); const bf16* KV = (const bf16*)(a.ws() + WS_KV); const unsigned* MASK = (const unsigned*)(a.ws() + WS_MASK);
    const int tid = otid(WID_), lane = tid & 63, wv = tid >> 6;
    float* lg = (float*)(lds + wv * 16384); float* qs = (float*)(lds + 131072 + wv * 512);
    const int gw = blockIdx.x * 8 + wv, NW = gridDim.x * 8;
    for (int it = gw; it < T * 8; it += NW) {
        const int t = it >> 3, h = it & 7, b = t >> 11, s = t & 2047, vis = ((s >> 6) + 1) << 6;
        const float sl = SLOPE_B[h] * LOG2E;
        qs[lane] = bf2f(P[(size_t)t * NP + C_BQ + h * 64 + lane]);
        LDS_WAIT();
        float m0 = -1e30f;
        for (int k = lane; k < vis; k += 64) {
            const unsigned mw = MASK[(size_t)t * 64 + (k >> 5)]; float d0 = -INFINITY;
            asm volatile("" ::: "memory");
            if ((mw >> (k & 31)) & 1u) {
                const v4u* kr = (const v4u*)(KV + (size_t)(b * SEQ + k) * 1024 + h * 64); d0 = 0.f;
#pragma unroll
                for (int i = 0; i < 8; ++i) { const v4u v = kr[i]; const float* q = qs + 8 * i;
                    d0 = fmaf(q[0], bflo(v.x), d0); d0 = fmaf(q[1], bfhi(v.x), d0); d0 = fmaf(q[2], bflo(v.y), d0); d0 = fmaf(q[3], bfhi(v.y), d0);
                    d0 = fmaf(q[4], bflo(v.z), d0); d0 = fmaf(q[5], bfhi(v.z), d0); d0 = fmaf(q[6], bflo(v.w), d0); d0 = fmaf(q[7], bfhi(v.w), d0); }
                d0 -= sl * fabsf((float)(s - k));
            }
            lg[k] = d0; m0 = fmaxf(m0, d0);
        }
        m0 = wave_max(m0);
        float l0 = 0.f;
        for (int k = lane; k < vis; k += 64) { const float p0 = exp2f(lg[k] - m0); lg[k] = p0; l0 += p0; }
        l0 = wave_sum(l0);
        LDS_WAIT();
        float o = 0.f; const bf16* vb = KV + (size_t)(b * SEQ) * 1024 + 512 + h * 64 + lane;
        for (int k = 0; k < vis; ++k) o = fmaf(lg[k], bf2f(vb[(size_t)k * 1024]), o);
        P[(size_t)t * NP + C_BQ + h * 64 + lane] = (bf16)f2bf(o / l0);
        LDS_WAIT();
    }
}
struct Route { int bucket; float wi, wj; int pad; };
__device__ __forceinline__ float wave_total(float v) {
    DPP_ADD(v, 0xB1); DPP_ADD(v, 0x4E); DPP_ADD(v, 0x141); DPP_ADD(v, 0x140);
    v += __builtin_bit_cast(float, __builtin_amdgcn_update_dpp(0, __builtin_bit_cast(int, v), 0x142, 0xA, 0xF, false));
    v += __builtin_bit_cast(float, __builtin_amdgcn_update_dpp(0, __builtin_bit_cast(int, v), 0x143, 0xC, 0xF, false));
    return __builtin_bit_cast(float, __builtin_amdgcn_readlane(__builtin_bit_cast(int, v), 63));
}
__device__ __forceinline__ void route_decide(const float (&lgt)[20], int& bucket, float& wlo, float& whi) {
    int g = 0; float gm = lgt[0];
#pragma unroll
    for (int c = 1; c < 4; ++c) if (lgt[c] > gm) { gm = lgt[c]; g = c; }
    float gs = 0.f;
#pragma unroll
    for (int c = 0; c < 4; ++c) gs += __expf(lgt[c] - gm);
    const float gp = 1.f / gs;
    float el[4];
#pragma unroll
    for (int e = 0; e < 4; ++e) el[e] = g == 0 ? lgt[4 + e] : (g == 1 ? lgt[8 + e] : (g == 2 ? lgt[12 + e] : lgt[16 + e]));
    int i1 = 0; float v1 = el[0];
#pragma unroll
    for (int e = 1; e < 4; ++e) if (el[e] > v1) { v1 = el[e]; i1 = e; }
    int i2 = -1; float v2 = -INFINITY;
#pragma unroll
    for (int e = 0; e < 4; ++e) if (e != i1 && el[e] > v2) { v2 = el[e]; i2 = e; }
    const float e2 = __expf(v2 - v1); const float w1 = gp / (1.f + e2), w2 = gp * e2 / (1.f + e2);
    const int lo = i1 < i2 ? i1 : i2, hi = i1 < i2 ? i2 : i1; wlo = i1 < i2 ? w1 : w2; whi = i1 < i2 ? w2 : w1;
    const int pi = lo == 0 ? hi - 1 : (lo == 1 ? hi + 1 : 5);
    bucket = g * 6 + pi;
}
__device__ __forceinline__ void p7_ln_route(const Ctx& a, unsigned char* lds, bool dry, int WID_) {
    unsigned char* ws = a.ws(); const int tid = otid(WID_), lane = tid & 63, wv = tid >> 6, blk = blockIdx.x;
    float* rw = (float*)lds; int* cnt = (int*)(lds + 81920); const float* SMv = (const float*)(a.ws() + WS_SMALL);
    const float* RW = (const float*)(ws + WS_RW); const float* MOD = (const float*)(ws + WS_MOD);
    bf16* U2 = (bf16*)(ws + WS_U2); Route* RT = (Route*)(ws + WS_ROUTE2); int* PERM = (int*)(ws + WS_ROUTE2 + 512 * 1024); int* CNT = (int*)(ws + WS_ROUTE2 + 1024 * 1024);
    for (int i = tid; i < 20 * 1024 / 4; i += 512) ((f32x4*)rw)[i] = ((const f32x4*)RW)[i];
    if (tid < 24) cnt[tid] = 0;
    for (int i = blk * 512 + tid; i < MAXSLOT; i += gridDim.x * 512) PERM[i] = -1;
    __syncthreads();
    const int b = blk >> 4;
    const float* sh2 = MOD + b * 6144 + 3072; const float* sc2 = MOD + b * 6144 + 4096;
    float* const outp = a.out();
    float* const xo = dry ? (float*)(ws + 300 * MiB) : outp; bf16* const uo = dry ? (bf16*)(ws + 428 * MiB) : U2;
    const float* const xin = a.in(I_X); const bf16* const brn = (const bf16*)(ws + WS_KV);
    f32x4 nx[2][4]; v2u nb[2][4];
#pragma unroll
    for (int q = 0; q < 2; ++q)
#pragma unroll
        for (int j = 0; j < 4; ++j) { const size_t o_ = (size_t)(blk * 128 + wv * 16 + q) * 1024 + j * 256 + lane * 4; nx[q][j] = *(const f32x4*)(xin + o_); nb[q][j] = *(const v2u*)(brn + o_); }
    for (int i = 0; i < 16; i += 2) {
        const int t0 = blk * 128 + wv * 16 + i;
        f32x4 v[2][4]; float sm[2] = {0.f, 0.f};
#pragma unroll
        for (int q = 0; q < 2; ++q)
#pragma unroll
            for (int j = 0; j < 4; ++j) { const v2u bw = nb[q][j]; v[q][j] = nx[q][j] * ALPHA + (f32x4){bflo(bw.x), bfhi(bw.x), bflo(bw.y), bfhi(bw.y)}; sm[q] += (v[q][j].x + v[q][j].y) + (v[q][j].z + v[q][j].w); }
        if (i + 2 < 16) {
#pragma unroll
            for (int q = 0; q < 2; ++q)
#pragma unroll
                for (int j = 0; j < 4; ++j) { const size_t o_ = (size_t)(t0 + 2 + q) * 1024 + j * 256 + lane * 4; nx[q][j] = *(const f32x4*)(xin + o_); nb[q][j] = *(const v2u*)(brn + o_); } }
        float mean[2], rstd[2];
#pragma unroll
        for (int q = 0; q < 2; ++q) mean[q] = wave_total(sm[q]) * (1.f / 1024.f);
#pragma unroll
        for (int q = 0; q < 2; ++q) { float sq = 0.f;
#pragma unroll
            for (int j = 0; j < 4; ++j) { v[q][j] = v[q][j] - mean[q]; sq += (v[q][j].x * v[q][j].x + v[q][j].y * v[q][j].y) + (v[q][j].z * v[q][j].z + v[q][j].w * v[q][j].w); }
            rstd[q] = 1.f / sqrtf(wave_total(sq) * (1.f / 1024.f) + LN_EPS); }
        f32x4 u[2][4];
#pragma unroll
        for (int j = 0; j < 4; ++j) { const int c = j * 256 + lane * 4; const f32x4 g = *(const f32x4*)(SMv + SM_LN1G + c), bb = *(const f32x4*)(SMv + SM_LN1B + c);
            const f32x4 s2 = *(const f32x4*)(sc2 + c), h2 = *(const f32x4*)(sh2 + c);
#pragma unroll
            for (int q = 0; q < 2; ++q) { const f32x4 x1 = v[q][j] * rstd[q] * g + bb; *(f32x4*)(xo + (size_t)(t0 + q) * 1024 + c) = x1;
                u[q][j] = x1 * (1.f + s2) + h2;
                v2u o; o.x = pk2(u[q][j].x, u[q][j].y); o.y = pk2(u[q][j].z, u[q][j].w); *(v2u*)(uo + (size_t)(t0 + q) * 1024 + c) = o; } }
        float lg0[20], lg1[20];
#pragma unroll
        for (int c = 0; c < 20; ++c) { float p0 = 0.f, p1 = 0.f;
#pragma unroll
            for (int j = 0; j < 4; ++j) { const f32x4 w = *(const f32x4*)(rw + c * 1024 + j * 256 + lane * 4);
                p0 += (u[0][j].x * w.x + u[0][j].y * w.y) + (u[0][j].z * w.z + u[0][j].w * w.w); p1 += (u[1][j].x * w.x + u[1][j].y * w.y) + (u[1][j].z * w.z + u[1][j].w * w.w); }
            const float bias = c < 4 ? SMv[SM_BGRP + c] : SMv[SM_BER + (c - 4)];
            lg0[c] = wave_total(p0) + bias; lg1[c] = wave_total(p1) + bias; }
        int bk0, bk1; float wl0, wh0, wl1, wh1;
        route_decide(lg0, bk0, wl0, wh0); route_decide(lg1, bk1, wl1, wh1);
        if (lane == 0 && !dry) { Route r; r.bucket = bk0; r.wi = wl0; r.wj = wh0; r.pad = 0; RT[t0] = r; atomicAdd(&cnt[bk0], 1);
            r.bucket = bk1; r.wi = wl1; r.wj = wh1; RT[t0 + 1] = r; atomicAdd(&cnt[bk1], 1); }
    }
    __syncthreads();
    if (tid < 24 && !dry) CNT[blk * 24 + tid] = cnt[tid];
    __syncthreads();
}
__device__ __forceinline__ void p8_sort(const Ctx& a, unsigned char* lds, int WID_) {
    unsigned char* ws = a.ws(); const int tid = otid(WID_), blk = blockIdx.x;
    const Route* RT = (const Route*)(ws + WS_ROUTE2); int* PERM = (int*)(ws + WS_ROUTE2 + 512 * 1024); const int* CNT = (const int*)(ws + WS_ROUTE2 + 1024 * 1024);
    int* BASES = (int*)(ws + WS_ROUTE2 + 1024 * 1024 + 32768); float* SLOTW = (float*)(ws + WS_ROUTE2 + 1280 * 1024);
    const bf16* U2 = (const bf16*)(ws + WS_U2); bf16* XS = (bf16*)(ws + WS_XS);
    int* tot = (int*)lds; int* pre = tot + 32; int* base = pre + 32; int* bk = base + 32; int* slot = bk + 128;
    if (tid < 64) tot[tid] = 0;
    __syncthreads();
    if (tid < 384) { const int p = tid >> 4, sg = tid & 15; int sa = 0, sp = 0;
#pragma unroll
        for (int i = 0; i < 16; ++i) { const int bb = sg * 16 + i; const int c = CNT[bb * 24 + p]; sa += c; sp += bb < blk ? c : 0; }
        atomicAdd(&tot[p], sa); atomicAdd(&pre[p], sp); }
    __syncthreads();
    if (tid == 0) { int acc = 0; for (int p = 0; p < 24; ++p) { base[p] = acc; acc += (tot[p] + 255) & ~255; } base[24] = acc;
        if (blk == 0) { for (int p = 0; p <= 24; ++p) BASES[p] = base[p]; } }
    if (tid < 128) bk[tid] = RT[blk * 128 + tid].bucket;
    __syncthreads();
    if (tid < 128) { const int p = bk[tid]; int r = 0; for (int j = 0; j < tid; ++j) r += bk[j] == p ? 1 : 0; const int s = base[p] + pre[p] + r; slot[tid] = s;
        const int t = blk * 128 + tid; PERM[s] = t; SLOTW[2 * s] = RT[t].wi; SLOTW[2 * s + 1] = RT[t].wj; }
    __syncthreads();
    __syncthreads();
}
__device__ __forceinline__ int bucket_of_slot(const int* BASES, int s) { int p = 0; for (int q = 1; q < 24; ++q) if (s >= BASES[q]) p = q; return p; }
__device__ __forceinline__ void pair_experts(int p, int& ei, int& ej) { const int g = p / 6, pi = p % 6; ei = 4 * g + (pi < 3 ? 0 : (pi < 5 ? 1 : 2)); ej = 4 * g + (pi < 3 ? pi + 1 : (pi < 5 ? pi - 1 : 3)); }
__device__ __forceinline__ void naive_moe1(const Ctx& a, unsigned char* lds, int WID_) {
    unsigned char* ws = a.ws(); const int tid = otid(WID_);
    const int* PERM = (const int*)(ws + WS_ROUTE2 + 512 * 1024); const int* BASES = (const int*)(ws + WS_ROUTE2 + 1024 * 1024 + 32768); const float* SLOTW = (const float*)(ws + WS_ROUTE2 + 1280 * 1024);
    const bf16* XS = (const bf16*)(ws + WS_XS); const bf16* W1 = (const bf16*)(ws + WS_W1); bf16* H = (bf16*)(ws + WS_H);
    float* xs = (float*)lds; const int nslot = BASES[24];
    for (int s = blockIdx.x; s < nslot; s += gridDim.x) {
        if (PERM[s] < 0) continue;
        const int p = bucket_of_slot(BASES, s); int ei, ej; pair_experts(p, ei, ej);
        __syncthreads();
        xs[tid] = bf2f(XS[(size_t)s * 1024 + tid]); xs[tid + 512] = bf2f(XS[(size_t)s * 1024 + 512 + tid]);
        __syncthreads();
        const int m = tid >> 8, c = tid & 255, e = m ? ej : ei; const int grow = (c >> 7) * 256 + (c & 127);
        const v4u* wg = (const v4u*)(W1 + ((size_t)e * 512 + grow) * 1024); const v4u* wu = (const v4u*)(W1 + ((size_t)e * 512 + grow + 128) * 1024);
        float dg = 0.f, du = 0.f;
        for (int i = 0; i < 128; ++i) { const v4u g = wg[i], u = wu[i]; const float* x = xs + 8 * i;
            dg = fmaf(x[0], bflo(g.x), dg); dg = fmaf(x[1], bfhi(g.x), dg); dg = fmaf(x[2], bflo(g.y), dg); dg = fmaf(x[3], bfhi(g.y), dg);
            dg = fmaf(x[4], bflo(g.z), dg); dg = fmaf(x[5], bfhi(g.z), dg); dg = fmaf(x[6], bflo(g.w), dg); dg = fmaf(x[7], bfhi(g.w), dg);
            du = fmaf(x[0], bflo(u.x), du); du = fmaf(x[1], bfhi(u.x), du); du = fmaf(x[2], bflo(u.y), du); du = fmaf(x[3], bfhi(u.y), du);
            du = fmaf(x[4], bflo(u.z), du); du = fmaf(x[5], bfhi(u.z), du); du = fmaf(x[6], bflo(u.w), du); du = fmaf(x[7], bfhi(u.w), du); }
        const float hv = dg / (1.f + __expf(-dg)) * du * SLOTW[2 * s + m];
        H[(size_t)s * 512 + tid] = (bf16)f2bf(hv);
    }
    __syncthreads();
}
__device__ __forceinline__ void naive_moe2(const Ctx& a, unsigned char* lds, int WID_) {
    unsigned char* ws = a.ws(); const int tid = otid(WID_);
    const int* PERM = (const int*)(ws + WS_ROUTE2 + 512 * 1024); const int* BASES = (const int*)(ws + WS_ROUTE2 + 1024 * 1024 + 32768);
    const bf16* W2P = (const bf16*)(ws + WS_W2P); const bf16* H = (const bf16*)(ws + WS_H); const float* MOD = (const float*)(ws + WS_MOD);
    float* hs = (float*)lds; const int nslot = BASES[24];
    for (int s = blockIdx.x; s < nslot; s += gridDim.x) {
        const int t = PERM[s]; if (t < 0) continue;
        const int p = bucket_of_slot(BASES, s);
        __syncthreads();
        hs[tid] = bf2f(H[(size_t)s * 512 + tid]);
        __syncthreads();
        for (int j = tid; j < 1024; j += 512) {
            const v4u* w = (const v4u*)(W2P + ((size_t)p * 1024 + j) * 512); float y = 0.f;
            for (int i = 0; i < 64; ++i) { const v4u g = w[i]; const float* x = hs + 8 * i;
                y = fmaf(x[0], bflo(g.x), y); y = fmaf(x[1], bfhi(g.x), y); y = fmaf(x[2], bflo(g.y), y); y = fmaf(x[3], bfhi(g.y), y);
                y = fmaf(x[4], bflo(g.z), y); y = fmaf(x[5], bfhi(g.z), y); y = fmaf(x[6], bflo(g.w), y); y = fmaf(x[7], bfhi(g.w), y); }
            const size_t o = (size_t)t * 1024 + j; a.out()[o] = ALPHA * a.out()[o] + MOD[(t >> 11) * 6144 + 5120 + j] * y;
        }
    }
    __syncthreads();
}
__device__ __forceinline__ void p11_ln(const Ctx& a, bool dry, int WID_) {
    const float* SMv = (const float*)(a.ws() + WS_SMALL);
    const int tid = otid(WID_); const int lane = tid & 63, gw = blockIdx.x * 8 + (tid >> 6), NW = gridDim.x * 8;
    float* const outp = a.out(); const bf16* const brn = (const bf16*)(a.ws() + WS_U);
    f32x4 nx[4]; v2u nb[4];
#pragma unroll
    for (int j = 0; j < 4; ++j) { const size_t o_ = (size_t)gw * 1024 + j * 256 + lane * 4; nx[j] = *(const f32x4*)(outp + o_); nb[j] = *(const v2u*)(brn + o_); }
    for (int t = gw; t < T; t += NW) {
        float* row = outp + (size_t)t * 1024; f32x4 v[4]; float sm = 0.f;
#pragma unroll
        for (int j = 0; j < 4; ++j) { const v2u bw = nb[j]; v[j] = nx[j] * ALPHA + (f32x4){bflo(bw.x), bfhi(bw.x), bflo(bw.y), bfhi(bw.y)}; sm += (v[j].x + v[j].y) + (v[j].z + v[j].w); }
        if (t + NW < T) {
#pragma unroll
            for (int j = 0; j < 4; ++j) { const size_t o_ = (size_t)(t + NW) * 1024 + j * 256 + lane * 4; nx[j] = *(const f32x4*)(outp + o_); nb[j] = *(const v2u*)(brn + o_); } }
        const float mean = wave_sum(sm) * (1.f / 1024.f); float sq = 0.f;
#pragma unroll
        for (int j = 0; j < 4; ++j) { v[j] = v[j] - mean; sq += (v[j].x * v[j].x + v[j].y * v[j].y) + (v[j].z * v[j].z + v[j].w * v[j].w); }
        const float rstd = 1.f / sqrtf(wave_sum(sq) * (1.f / 1024.f) + LN_EPS);
#pragma unroll
        for (int j = 0; j < 4; ++j) { const int c = j * 256 + lane * 4; const f32x4 g = *(const f32x4*)(SMv + SM_LN2G + c), bb = *(const f32x4*)(SMv + SM_LN2B + c); *(f32x4*)((dry ? (float*)(a.ws() + 60 * MiB) + (size_t)t * 1024 : row) + c) = v[j] * rstd * g + bb; }
    }
}

namespace pg8 {
#define PG8_LAS __attribute__((address_space(3)))
typedef unsigned short bf16_t;
typedef short bf16x8 __attribute__((ext_vector_type(8)));
typedef float f32x4 __attribute__((ext_vector_type(4)));
typedef unsigned u32x4 __attribute__((ext_vector_type(4)));
constexpr int BM = 256, BK = 64, HALF = 128, HTB = HALF * BK * 2  , STAGE_BYTES = 8 * HTB, NXCD = 8, WGM = 8;

__host__ __device__ __forceinline__ int lds_byte(int r, int c) { const int st = (r >> 4) * 2 + (c >> 5), rr = r & 15, cc = c & 31, ob = rr * 64 + cc * 2; return st * 1024 + (ob ^ (((ob >> 9) & 1) << 5)); }
__host__ __device__ __forceinline__ void stage_rc(int b, int& R, int& C) { const int st = b / 1024, sb = b % 1024, swz = sb ^ (((sb >> 9) & 1) << 5); R = (st >> 1) * 16 + swz / 64; C = (st & 1) * 32 + (swz % 64) / 2; }
__host__ __device__ __forceinline__ int perm32(int rho) { const int n = rho >> 4, i = rho & 15; return 8 * (i >> 2) + 4 * n + (i & 3); }

struct Unit { int pm, pn; };
struct Gemm { const bf16_t* A; const bf16_t* Bt; int M, N, K, lda, ldb; const int* rowidx; };

struct StaticOrder {
    int nM, nN, nwg, G, c;
    __host__ __device__ void init(int M, int N, int G_, int c_) { nM = M / BM; nN = N / BM; nwg = nM * nN; G = G_; c = c_; }
    __host__ __device__ bool next(int i, Unit& u) const {
        const long L = (long)i * G + c; if (L >= nwg) return false;
        int wgid = (int)L; { const int q = nwg / NXCD, r = nwg % NXCD, xcd = wgid % NXCD, off = wgid / NXCD; wgid = (xcd < r ? xcd * (q + 1) : r * (q + 1) + (xcd - r) * q) + off; }
        const int nig = WGM * nN, gid = wgid / nig, fm = gid * WGM, gsz = (nM - fm) < WGM ? (nM - fm) : WGM;
        u.pm = fm + ((wgid % nig) % gsz); u.pn = (wgid % nig) / gsz; return true;
    }
    __device__ __forceinline__ void a_ready(const Unit&) const {}
    __device__ __forceinline__ void done(const Unit&) const {}
    __device__ __forceinline__ const char* bbase(const Gemm& g, const Unit& u) const { return (const char*)g.Bt + (size_t)u.pn * ((size_t)BM * g.ldb * 2); }
};

template <class Epi, class Sched, bool ALIGN_EPI, bool SP2, int KK, int LDA, int LDB, int AJT = 0, int AJB = 0, bool GATHER = false>
__device__ __forceinline__ void gemm_phase(PG8_LAS unsigned char* lds, const Gemm g, const Sched& S, const Epi& E, int WID_) {
    int tid_ = otid(WID_);
    const int tid = tid_, wid = __builtin_amdgcn_readfirstlane(tid >> 6), lane = tid & 63, wr = wid >> 2, wc = wid & 3, fr = lane & 15, fq = lane >> 4;
    constexpr int K = KK, nt = K / BK;
    unsigned voffA[2], voffB[2];
#pragma unroll
    for (int i = 0; i < 2; ++i) { int R, C; stage_rc(tid * 16 + i * 8192, R, C); const int Rb = Epi::PERM ? ((R & ~31) + perm32(R & 31)) : R;
        voffA[i] = (unsigned)(R * LDA + C) * 2u; voffB[i] = (unsigned)(Rb * LDB + C) * 2u; }
    static_assert(SP2 || !GATHER, "gather is wired into the SP2 loop only");
    unsigned vA[2][2];
#define PG8_GOFF(dst, pm_) do { _Pragma("unroll") for (int h_ = 0; h_ < 2; ++h_) _Pragma("unroll") for (int i_ = 0; i_ < 2; ++i_) { int R_, C_; stage_rc(tid * 16 + i_ * 8192, R_, C_); \
        int r_ = g.rowidx[(pm_) * BM + h_ * HALF + R_]; r_ = r_ < 0 ? 0 : r_; dst[h_][i_] = (unsigned)(r_ * LDA + C_) * 2u; } } while (0)
    constexpr size_t kstep = (size_t)(BK * 2);
    constexpr size_t hstepA = (size_t)HALF * LDA * 2, hstepB = (size_t)HALF * LDB * 2;
    constexpr size_t tstepA = 2 * hstepA;
    const unsigned ldsw = (unsigned)wid * 1024u;
    const int aoff = lds_byte(wr * 64 + fr, fq * 8), boff = lds_byte(wc * 32 + fr, fq * 8);
#define PG8_SA(b, h) (((b) * 2 + (h)) * HTB)
#define PG8_SB(b, h) ((4 + (b) * 2 + (h)) * HTB)
#define PG8_STAGE(bufoff, gbase, voff) do { _Pragma("unroll") for (int _i = 0; _i < 2; ++_i) \
        __builtin_amdgcn_global_load_lds((const unsigned*)((const char*)(gbase) + (voff)[_i]), (PG8_LAS unsigned*)(lds + (bufoff) + ldsw + _i * 8192), 16, 0, 0); } while (0)
#define PG8_STAGE_A(bufoff, gbase, h, NX) do { if constexpr (GATHER) { PG8_STAGE(bufoff, gbase, vA[h]); } \
        else PG8_STAGE(bufoff, (gbase) + (h) * hstepA, voffA); } while (0)
#define PG8_LDA(dst, b, h) do { _Pragma("unroll") for (int m = 0; m < 4; ++m) _Pragma("unroll") for (int k = 0; k < 2; ++k) dst[m][k] = *(const PG8_LAS bf16x8*)(lds + PG8_SA(b, h) + aoff + m * 2048 + k * 1024); } while (0)
#define PG8_LDB(dst, b, h) do { _Pragma("unroll") for (int n = 0; n < 2; ++n) _Pragma("unroll") for (int k = 0; k < 2; ++k) dst[n][k] = *(const PG8_LAS bf16x8*)(lds + PG8_SB(b, h) + boff + n * 2048 + k * 1024); } while (0)
#define PG8_MMA(ai, bj, At, Bt) do { __builtin_amdgcn_s_setprio(1); _Pragma("unroll") for (int m = 0; m < 4; ++m) _Pragma("unroll") for (int n = 0; n < 2; ++n) _Pragma("unroll") for (int k = 0; k < 2; ++k) \
        acc[ai][bj][m][n] = __builtin_amdgcn_mfma_f32_16x16x32_bf16(Bt[n][k], At[m][k], acc[ai][bj][m][n], 0, 0, 0); __builtin_amdgcn_s_setprio(0); } while (0)
#define PG8_WAIT_V(n) asm volatile("s_waitcnt vmcnt(" #n ")" ::: "memory")
#define PG8_WAIT_L(n) asm volatile("s_waitcnt lgkmcnt(" #n ")" ::: "memory")
#define PG8_BAR __builtin_amdgcn_s_barrier()
#define PG8_SCHED __builtin_amdgcn_sched_barrier(0)
    Unit cur, nxt; int ui = 0;
    if (!S.next(0, cur)) return;
    f32x4 acc[2][2][4][2];
#pragma unroll
    for (int a = 0; a < 2; ++a)
#pragma unroll
        for (int b = 0; b < 2; ++b)
#pragma unroll
            for (int m = 0; m < 4; ++m)
#pragma unroll
                for (int n = 0; n < 2; ++n) acc[a][b][m][n] = (f32x4){0.f, 0.f, 0.f, 0.f};
    bf16x8 At[4][2], B0[2][2], B1[2][2];
    const char* cA = GATHER ? (const char*)g.A : (const char*)g.A + (size_t)cur.pm * tstepA; const char* cB = S.bbase(g, cur);
    if constexpr (GATHER) { PG8_GOFF(vA, cur.pm); }
    S.a_ready(cur);
    if constexpr (SP2) {
        PG8_STAGE(PG8_SB(0, 0), cB, voffB); PG8_STAGE(PG8_SB(0, 1), cB + hstepB, voffB); PG8_STAGE_A(PG8_SA(0, 0), cA, 0, false); PG8_STAGE_A(PG8_SA(0, 1), cA, 1, false);
        if (wr == 1) PG8_BAR;
        PG8_WAIT_V(2); PG8_BAR;
        PG8_STAGE(PG8_SB(1, 0), cB + kstep, voffB); PG8_STAGE_A(PG8_SA(1, 0), cA + kstep, 0, false); PG8_STAGE(PG8_SB(1, 1), cB + hstepB + kstep, voffB);
        PG8_WAIT_V(6); PG8_BAR;
    } else {
        PG8_STAGE(PG8_SB(0, 0), cB, voffB); PG8_STAGE(PG8_SA(0, 0), cA, voffA); PG8_STAGE(PG8_SB(0, 1), cB + hstepB, voffB); PG8_STAGE(PG8_SA(0, 1), cA + hstepA, voffA);
        if (wr == 1) PG8_BAR;
        PG8_WAIT_V(4); PG8_BAR;
        PG8_STAGE(PG8_SB(1, 0), cB + kstep, voffB); PG8_STAGE(PG8_SA(1, 0), cA + kstep, voffA); PG8_STAGE(PG8_SB(1, 1), cB + hstepB + kstep, voffB);
        PG8_WAIT_V(6); PG8_BAR;
    }
    for (;;) {
        const bool has_next = S.next(ui + 1, nxt);
        const char* nA = GATHER ? cA : (has_next ? (const char*)g.A + (size_t)nxt.pm * tstepA : cA); const char* nB = has_next ? S.bbase(g, nxt) : cB;
        for (int t = 0; t < nt; t += 2) {
            const bool last = (t == nt - 2);
            if constexpr (AJT != 0) { if (t == AJT) E.mid(acc, cur, wr, wc, fr, fq); }
#define PG8_AOFF(kt) ((size_t)(kt) * kstep + ((AJT != 0 && (kt) >= AJT) ? (size_t)AJB : (size_t)0))
            const char* a1 = cA + PG8_AOFF(t + 1);
            const char* a2 = last ? nA : cA + PG8_AOFF(t + 2); const char* b2 = last ? nB : cB + (size_t)(t + 2) * kstep;
            const char* a3 = last ? nA + kstep : cA + PG8_AOFF(t + 3); const char* b3 = b2 + kstep;
#undef PG8_AOFF
            if (last && has_next) S.a_ready(nxt);
            if constexpr (SP2) {
            PG8_LDB(B0, 0, 0); PG8_LDB(B1, 0, 1); PG8_SCHED; PG8_LDA(At, 0, 0); PG8_STAGE_A(PG8_SA(1, 1), a1, 1, false);
            if constexpr (GATHER) { if (last && has_next) PG8_GOFF(vA, nxt.pm); }
            PG8_WAIT_V(8); PG8_WAIT_L(0); PG8_BAR; PG8_MMA(0, 0, At, B0); PG8_MMA(0, 1, At, B1); PG8_BAR; PG8_SCHED;
            PG8_LDA(At, 0, 1); PG8_STAGE(PG8_SB(0, 0), b2, voffB); PG8_STAGE(PG8_SB(0, 1), b2 + hstepB, voffB); PG8_STAGE_A(PG8_SA(0, 0), a2, 0, last);
            PG8_WAIT_V(8); PG8_WAIT_L(0); PG8_BAR; PG8_MMA(1, 0, At, B0); PG8_MMA(1, 1, At, B1); PG8_BAR; PG8_SCHED;
            PG8_LDB(B0, 1, 0); PG8_LDB(B1, 1, 1); PG8_SCHED; PG8_LDA(At, 1, 0); PG8_STAGE_A(PG8_SA(0, 1), a2, 1, last);
            PG8_WAIT_V(8); PG8_WAIT_L(0); PG8_BAR; PG8_MMA(0, 0, At, B0); PG8_MMA(0, 1, At, B1); PG8_BAR; PG8_SCHED;
            PG8_LDA(At, 1, 1); PG8_STAGE(PG8_SB(1, 0), b3, voffB); PG8_STAGE(PG8_SB(1, 1), b3 + hstepB, voffB); PG8_STAGE_A(PG8_SA(1, 0), a3, 0, last);
            PG8_WAIT_V(8); PG8_WAIT_L(0); PG8_BAR; PG8_MMA(1, 0, At, B0); PG8_MMA(1, 1, At, B1); PG8_BAR; PG8_SCHED;
            } else {
            PG8_LDB(B0, 0, 0); PG8_SCHED; PG8_LDA(At, 0, 0); PG8_STAGE(PG8_SA(1, 1), a1 + hstepA, voffA);
            PG8_WAIT_L(8); PG8_BAR; PG8_WAIT_L(0); PG8_MMA(0, 0, At, B0); PG8_BAR; PG8_SCHED;
            PG8_LDB(B1, 0, 1); PG8_STAGE(PG8_SB(0, 0), b2, voffB);
            PG8_BAR; PG8_WAIT_L(0); PG8_MMA(0, 1, At, B1); PG8_BAR;
            PG8_LDA(At, 0, 1); PG8_STAGE(PG8_SA(0, 0), a2, voffA);
            PG8_BAR; PG8_WAIT_L(0); PG8_MMA(1, 0, At, B0); PG8_BAR; PG8_SCHED;
            PG8_STAGE(PG8_SB(0, 1), b2 + hstepB, voffB);
            PG8_WAIT_V(6); PG8_BAR; PG8_MMA(1, 1, At, B1); PG8_BAR;
            PG8_LDB(B0, 1, 0); PG8_SCHED; PG8_LDA(At, 1, 0); PG8_STAGE(PG8_SA(0, 1), a2 + hstepA, voffA);
            PG8_WAIT_L(8); PG8_BAR; PG8_WAIT_L(0); PG8_MMA(0, 0, At, B0); PG8_BAR; PG8_SCHED;
            PG8_LDB(B1, 1, 1); PG8_STAGE(PG8_SB(1, 0), b3, voffB);
            PG8_BAR; PG8_WAIT_L(0); PG8_MMA(0, 1, At, B1); PG8_BAR;
            PG8_LDA(At, 1, 1); PG8_STAGE(PG8_SA(1, 0), a3, voffA);
            PG8_BAR; PG8_WAIT_L(0); PG8_MMA(1, 0, At, B0); PG8_BAR; PG8_SCHED;
            PG8_STAGE(PG8_SB(1, 1), b3 + hstepB, voffB);
            PG8_WAIT_V(6); PG8_BAR; PG8_MMA(1, 1, At, B1); PG8_BAR;
            }
        }
        if constexpr (ALIGN_EPI) { if (wr == 0) PG8_BAR; }
        if constexpr (!Epi::AFTER_DRAIN) { E(acc, cur, wr, wc, fr, fq); S.done(cur); }
        if (!has_next) break;
#pragma unroll
        for (int a = 0; a < 2; ++a)
#pragma unroll
            for (int b = 0; b < 2; ++b)
#pragma unroll
                for (int m = 0; m < 4; ++m)
#pragma unroll
                    for (int n = 0; n < 2; ++n) acc[a][b][m][n] = (f32x4){0.f, 0.f, 0.f, 0.f};
        cur = nxt; cA = nA; cB = nB; ++ui;
        if constexpr (ALIGN_EPI) { if (wr == 1) PG8_BAR; }
    }
    PG8_WAIT_V(0);
    if constexpr (!ALIGN_EPI) { if (wr == 0) PG8_BAR; }
    PG8_BAR;
    if constexpr (Epi::AFTER_DRAIN) { E.fused(acc, cur, wr, wc, fr, fq, lds, wid, lane); S.done(cur); }
#undef PG8_SA
#undef PG8_SB
#undef PG8_STAGE
#undef PG8_STAGE_A
#undef PG8_GOFF
#undef PG8_LDA
#undef PG8_LDB
#undef PG8_MMA
#undef PG8_WAIT_V
#undef PG8_WAIT_L
#undef PG8_BAR
#undef PG8_SCHED
}

__device__ __forceinline__ unsigned cvt_pk_bf16(float lo, float hi) { unsigned r; asm volatile("v_cvt_pk_bf16_f32 %0, %1, %2" : "=v"(r) : "v"(lo), "v"(hi)); return r; }
__device__ __forceinline__ float blo(unsigned w) { return __uint_as_float(w << 16); }
__device__ __forceinline__ float bhi(unsigned w) { return __uint_as_float(w & 0xffff0000u); }
__device__ __forceinline__ float sigm(float v) { return __builtin_amdgcn_rcpf(1.f + __builtin_amdgcn_exp2f(-1.4426950408889634f * v)); }
struct EpiProjF {
    static constexpr bool PERM = true, AFTER_DRAIN = false;
    bf16_t* O; int ldc; float qs; float* R; PG8_LAS float* xs;
    __device__ __forceinline__ void operator()(const f32x4 (&acc)[2][2][4][2], const Unit& u, int wr, int wc, int fr, int fq) const {
        const int row0 = u.pm * BM + wr * 64 + fr, col0 = u.pn * BM + wc * 32 + 8 * fq;
        const int mode = (u.pn < 2 || u.pn == 6 || u.pn == 7) ? 1 : (u.pn >= 11 ? 2 : 0);
        if (u.pn == 8) {
#pragma unroll
            for (int ai = 0; ai < 2; ++ai)
#pragma unroll
                for (int m = 0; m < 4; ++m) { const f32x4 a0 = acc[ai][0][m][0], a1 = acc[ai][0][m][1];
                    float ss = (a0[0] * a0[0] + a0[1] * a0[1]) + (a0[2] * a0[2] + a0[3] * a0[3]) + (a1[0] * a1[0] + a1[1] * a1[1]) + (a1[2] * a1[2] + a1[3] * a1[3]);
                    ss += __shfl_xor(ss, 16); ss += __shfl_xor(ss, 32);
                    if (fq == 0) xs[(ai * HALF + wr * 64 + m * 16 + fr) * 4 + wc] = ss; }
            asm volatile("s_waitcnt lgkmcnt(0)" ::: "memory"); __builtin_amdgcn_s_barrier(); asm volatile("" ::: "memory");
            const int tl = (wr * 4 + wc) * 64 + fq * 16 + fr;
            if (tl < BM) { const float sm = (xs[tl * 4] + xs[tl * 4 + 1]) + (xs[tl * 4 + 2] + xs[tl * 4 + 3]); R[u.pm * BM + tl] = __builtin_amdgcn_rsqf(sm * (1.f / 128.f) + 1e-5f); }
        }
#pragma unroll
        for (int ai = 0; ai < 2; ++ai)
#pragma unroll
            for (int m = 0; m < 4; ++m) { bf16_t* rowp = O + (size_t)(row0 + ai * HALF + m * 16) * ldc + col0;
#pragma unroll
                for (int bj = 0; bj < 2; ++bj) { f32x4 v0 = acc[ai][bj][m][0], v1 = acc[ai][bj][m][1];
                    if (mode == 1) { v0 = v0 * qs; v1 = v1 * qs; }
                    else if (mode == 2) { v0 = (f32x4){sigm(v0[0]), sigm(v0[1]), sigm(v0[2]), sigm(v0[3])}; v1 = (f32x4){sigm(v1[0]), sigm(v1[1]), sigm(v1[2]), sigm(v1[3])}; }
                    u32x4 w; w.x = cvt_pk_bf16(v0[0], v0[1]); w.y = cvt_pk_bf16(v0[2], v0[3]); w.z = cvt_pk_bf16(v1[0], v1[1]); w.w = cvt_pk_bf16(v1[2], v1[3]);
                    *(u32x4*)(rowp + bj * HALF) = w; } }
    }
};
struct EpiRowScale {
    static constexpr bool PERM = true, AFTER_DRAIN = false;
    bf16_t* O; int ldc; const float* rs;
    __device__ __forceinline__ void operator()(const f32x4 (&acc)[2][2][4][2], const Unit& u, int wr, int wc, int fr, int fq) const {
        const int row0 = u.pm * BM + wr * 64 + fr, col0 = u.pn * BM + wc * 32 + 8 * fq;
#pragma unroll
        for (int ai = 0; ai < 2; ++ai)
#pragma unroll
            for (int m = 0; m < 4; ++m) { const int r = row0 + ai * HALF + m * 16; const float s = rs[r]; bf16_t* rowp = O + (size_t)r * ldc + col0;
#pragma unroll
                for (int bj = 0; bj < 2; ++bj) { const f32x4 v0 = acc[ai][bj][m][0] * s, v1 = acc[ai][bj][m][1] * s;
                    u32x4 w; w.x = cvt_pk_bf16(v0[0], v0[1]); w.y = cvt_pk_bf16(v0[2], v0[3]); w.z = cvt_pk_bf16(v1[0], v1[1]); w.w = cvt_pk_bf16(v1[2], v1[3]);
                    *(u32x4*)(rowp + bj * HALF) = w; } }
    }
};
template <bool FIRST> struct EpiMix {
    static constexpr bool PERM = true, AFTER_DRAIN = false;
    bf16_t* O; int ldc; const bf16_t* G; int ldg;
    __device__ __forceinline__ void operator()(const f32x4 (&acc)[2][2][4][2], const Unit& u, int wr, int wc, int fr, int fq) const {
        const int row0 = u.pm * BM + wr * 64 + fr, col0 = u.pn * BM + wc * 32 + 8 * fq;
#pragma unroll
        for (int ai = 0; ai < 2; ++ai)
#pragma unroll
            for (int m = 0; m < 4; ++m) { const int r = row0 + ai * HALF + m * 16; bf16_t* rowp = O + (size_t)r * ldc + col0; const bf16_t* gp = G + (size_t)r * ldg + col0;
#pragma unroll
                for (int bj = 0; bj < 2; ++bj) { const u32x4 gw = *(const u32x4*)(gp + bj * HALF); f32x4 v0 = acc[ai][bj][m][0], v1 = acc[ai][bj][m][1];
                    v0 = v0 * (f32x4){blo(gw.x), bhi(gw.x), blo(gw.y), bhi(gw.y)}; v1 = v1 * (f32x4){blo(gw.z), bhi(gw.z), blo(gw.w), bhi(gw.w)};
                    if (!FIRST) { const u32x4 ow = *(const u32x4*)(rowp + bj * HALF); v0 = v0 + (f32x4){blo(ow.x), bhi(ow.x), blo(ow.y), bhi(ow.y)}; v1 = v1 + (f32x4){blo(ow.z), bhi(ow.z), blo(ow.w), bhi(ow.w)}; }
                    u32x4 w; w.x = cvt_pk_bf16(v0[0], v0[1]); w.y = cvt_pk_bf16(v0[2], v0[3]); w.z = cvt_pk_bf16(v1[0], v1[1]); w.w = cvt_pk_bf16(v1[2], v1[3]);
                    *(u32x4*)(rowp + bj * HALF) = w; } }
    }
};
struct EpiMixFused {
    static constexpr bool PERM = true, AFTER_DRAIN = false;
    bf16_t* O; int ldc; const bf16_t* G; int ldg;
    __device__ __forceinline__ void mid(f32x4 (&acc)[2][2][4][2], const Unit& u, int wr, int wc, int fr, int fq) const {
        int row0 = u.pm * BM + wr * 64 + fr, col0 = u.pn * BM + wc * 32 + 8 * fq;
        asm volatile("" : "+v"(row0), "+v"(col0));
#pragma unroll
        for (int ai = 0; ai < 2; ++ai)
#pragma unroll
            for (int m = 0; m < 4; ++m) { const bf16_t* gp = G + (size_t)(row0 + ai * HALF + m * 16) * ldg + col0;
#pragma unroll
                for (int bj = 0; bj < 2; ++bj) { const u32x4 a = *(const u32x4*)(gp + bj * HALF), b = *(const u32x4*)(gp + 1024 + bj * HALF);
                    const f32x4 r0 = (f32x4){blo(a.x) * __builtin_amdgcn_rcpf(fmaxf(blo(b.x), 1e-30f)), bhi(a.x) * __builtin_amdgcn_rcpf(fmaxf(bhi(b.x), 1e-30f)), blo(a.y) * __builtin_amdgcn_rcpf(fmaxf(blo(b.y), 1e-30f)), bhi(a.y) * __builtin_amdgcn_rcpf(fmaxf(bhi(b.y), 1e-30f))};
                    const f32x4 r1 = (f32x4){blo(a.z) * __builtin_amdgcn_rcpf(fmaxf(blo(b.z), 1e-30f)), bhi(a.z) * __builtin_amdgcn_rcpf(fmaxf(bhi(b.z), 1e-30f)), blo(a.w) * __builtin_amdgcn_rcpf(fmaxf(blo(b.w), 1e-30f)), bhi(a.w) * __builtin_amdgcn_rcpf(fmaxf(bhi(b.w), 1e-30f))};
                    acc[ai][bj][m][0] = acc[ai][bj][m][0] * r0; acc[ai][bj][m][1] = acc[ai][bj][m][1] * r1; }
                if (m & 1) asm volatile("" ::: "memory"); }
    }
    __device__ __forceinline__ void operator()(const f32x4 (&acc)[2][2][4][2], const Unit& u, int wr, int wc, int fr, int fq) const {
        const int row0 = u.pm * BM + wr * 64 + fr, col0 = u.pn * BM + wc * 32 + 8 * fq;
#pragma unroll
        for (int ai = 0; ai < 2; ++ai)
#pragma unroll
            for (int m = 0; m < 4; ++m) { const int r = row0 + ai * HALF + m * 16; bf16_t* rowp = O + (size_t)r * ldc + col0; const bf16_t* gp = G + (size_t)r * ldg + 1024 + col0;
#pragma unroll
                for (int bj = 0; bj < 2; ++bj) { const u32x4 gw = *(const u32x4*)(gp + bj * HALF);
                    const f32x4 v0 = acc[ai][bj][m][0] * (f32x4){blo(gw.x), bhi(gw.x), blo(gw.y), bhi(gw.y)}, v1 = acc[ai][bj][m][1] * (f32x4){blo(gw.z), bhi(gw.z), blo(gw.w), bhi(gw.w)};
                    u32x4 w; w.x = cvt_pk_bf16(v0[0], v0[1]); w.y = cvt_pk_bf16(v0[2], v0[3]); w.z = cvt_pk_bf16(v1[0], v1[1]); w.w = cvt_pk_bf16(v1[2], v1[3]);
                    *(u32x4*)(rowp + bj * HALF) = w; } }
    }
};
struct EpiGateBf16 {
    static constexpr bool PERM = true, AFTER_DRAIN = false;
    bf16_t* O; int ldc; const float* gate; int gstride;
    __device__ __forceinline__ void operator()(const f32x4 (&acc)[2][2][4][2], const Unit& u, int wr, int wc, int fr, int fq) const {
        const int row0 = u.pm * BM + wr * 64 + fr, col0 = u.pn * BM + wc * 32 + 8 * fq; const float* gb = gate + (size_t)((u.pm * BM) >> 11) * gstride + col0;
        f32x4 gv[2][2];
#pragma unroll
        for (int bj = 0; bj < 2; ++bj)
#pragma unroll
            for (int n = 0; n < 2; ++n) gv[bj][n] = *(const f32x4*)(gb + bj * HALF + n * 4);
#pragma unroll
        for (int ai = 0; ai < 2; ++ai)
#pragma unroll
            for (int m = 0; m < 4; ++m) { bf16_t* rowp = O + (size_t)(row0 + ai * HALF + m * 16) * ldc + col0;
#pragma unroll
                for (int bj = 0; bj < 2; ++bj) { const f32x4 v0 = acc[ai][bj][m][0] * gv[bj][0], v1 = acc[ai][bj][m][1] * gv[bj][1];
                    u32x4 w; w.x = cvt_pk_bf16(v0[0], v0[1]); w.y = cvt_pk_bf16(v0[2], v0[3]); w.z = cvt_pk_bf16(v1[0], v1[1]); w.w = cvt_pk_bf16(v1[2], v1[3]);
                    *(u32x4*)(rowp + bj * HALF) = w; } }
    }
};
struct EpiResGate {
    static constexpr bool PERM = false, AFTER_DRAIN = false;
    float* out; const float* x; const float* gate; int gstride; float alpha;
    __device__ __forceinline__ void operator()(const f32x4 (&acc)[2][2][4][2], const Unit& u, int wr, int wc, int fr, int fq) const {
        const int col0 = u.pn * BM + wc * 32 + 4 * fq; const float* gb = gate + (size_t)((u.pm * BM) >> 11) * gstride + col0;
        f32x4 gv[2][2];
#pragma unroll
        for (int bj = 0; bj < 2; ++bj)
#pragma unroll
            for (int n = 0; n < 2; ++n) gv[bj][n] = *(const f32x4*)(gb + bj * HALF + n * 16);
#pragma unroll
        for (int ai = 0; ai < 2; ++ai)
#pragma unroll
            for (int m = 0; m < 4; ++m) { const size_t off = (size_t)(u.pm * BM + ai * HALF + wr * 64 + m * 16 + fr) * 1024 + col0;
#pragma unroll
                for (int bj = 0; bj < 2; ++bj)
#pragma unroll
                    for (int n = 0; n < 2; ++n) { const f32x4 xv = *(const f32x4*)(x + off + bj * HALF + n * 16); *(f32x4*)(out + off + bj * HALF + n * 16) = xv * alpha + gv[bj][n] * acc[ai][bj][m][n]; } }
    }
};
__device__ __forceinline__ int tile_bucket(const int* BASES, int pm) { const int s = pm * BM; int p = 0;
#pragma unroll
    for (int q = 1; q < 24; ++q) p = (s >= BASES[q]) ? q : p;
    return p; }
struct MoeOrder1 {
    StaticOrder so; const int* BASES; const bf16_t* W1;
    __device__ __forceinline__ bool next(int i, Unit& u) const { return so.next(i, u); }
    __device__ __forceinline__ void a_ready(const Unit&) const {}
    __device__ __forceinline__ void done(const Unit&) const {}
    __device__ __forceinline__ const char* bbase(const Gemm&, const Unit& u) const {
        const int p = tile_bucket(BASES, u.pm), g = p / 6, pi = p % 6;
        const int ei = 4 * g + (pi < 3 ? 0 : (pi < 5 ? 1 : 2)), ej = 4 * g + (pi < 3 ? pi + 1 : (pi < 5 ? pi - 1 : 3));
        const int e = u.pn < 2 ? ei : ej;
        return (const char*)(W1 + ((size_t)e * 512 + (size_t)(u.pn & 1) * 256) * 1024); }
};
struct MoeOrder2 {
    StaticOrder so; const int* BASES; const bf16_t* W2P;
    __device__ __forceinline__ bool next(int i, Unit& u) const { return so.next(i, u); }
    __device__ __forceinline__ void a_ready(const Unit&) const {}
    __device__ __forceinline__ void done(const Unit&) const {}
    __device__ __forceinline__ const char* bbase(const Gemm&, const Unit& u) const {
        const int p = tile_bucket(BASES, u.pm); return (const char*)(W2P + ((size_t)p * 1024 + (size_t)u.pn * 256) * 512); }
};
struct EpiMoe1 {
    static constexpr bool PERM = true, AFTER_DRAIN = false;
    bf16_t* H; const float* SLOTW;
    __device__ __forceinline__ void operator()(const f32x4 (&acc)[2][2][4][2], const Unit& u, int wr, int wc, int fr, int fq) const {
        const int row0 = u.pm * BM + wr * 64 + fr, col0 = (u.pn >> 1) * 256 + (u.pn & 1) * 128 + wc * 32 + 8 * fq, wsel = u.pn >> 1;
#pragma unroll
        for (int ai = 0; ai < 2; ++ai)
#pragma unroll
            for (int m = 0; m < 4; ++m) { const int r = row0 + ai * HALF + m * 16; const float w = SLOTW[2 * r + wsel];
                float o[8];
#pragma unroll
                for (int n = 0; n < 2; ++n)
#pragma unroll
                    for (int i = 0; i < 4; ++i) { const float g = acc[ai][0][m][n][i], up = acc[ai][1][m][n][i]; o[4 * n + i] = g * sigm(g) * up * w; }
                u32x4 wv; wv.x = cvt_pk_bf16(o[0], o[1]); wv.y = cvt_pk_bf16(o[2], o[3]); wv.z = cvt_pk_bf16(o[4], o[5]); wv.w = cvt_pk_bf16(o[6], o[7]);
                *(u32x4*)(H + (size_t)r * 512 + col0) = wv; }
    }
};
struct EpiMoe2 {
    static constexpr bool PERM = false, AFTER_DRAIN = false;
    float* out; const int* PERMV; const float* gate; int gstride; float alpha; float* wout;
    __device__ __forceinline__ void operator()(const f32x4 (&acc)[2][2][4][2], const Unit& u, int wr, int wc, int fr, int fq) const {
        const int col0 = u.pn * BM + wc * 32 + 4 * fq;
#pragma unroll
        for (int ai = 0; ai < 2; ++ai)
#pragma unroll
            for (int m = 0; m < 4; ++m) { const int t = PERMV[u.pm * BM + ai * HALF + wr * 64 + m * 16 + fr];
                if (t >= 0) { const size_t off = (size_t)t * 1024 + col0; const float* gb = gate + (size_t)(t >> 11) * gstride + col0;
#pragma unroll
                    for (int bj = 0; bj < 2; ++bj)
#pragma unroll
                        for (int n = 0; n < 2; ++n) { const f32x4 xv = *(const f32x4*)(out + off + bj * HALF + n * 16); const f32x4 gv = *(const f32x4*)(gb + bj * HALF + n * 16);
                            *(f32x4*)(wout + off + bj * HALF + n * 16) = xv * alpha + gv * acc[ai][bj][m][n]; } } }
    }
};
struct EpiMoe2B {
    static constexpr bool PERM = true, AFTER_DRAIN = false;
    bf16_t* Y; const int* PERMV; const float* gate; int gstride;
    __device__ __forceinline__ void operator()(const f32x4 (&acc)[2][2][4][2], const Unit& u, int wr, int wc, int fr, int fq) const {
        const int col0 = u.pn * BM + wc * 32 + 8 * fq;
#pragma unroll
        for (int ai = 0; ai < 2; ++ai)
#pragma unroll
            for (int m = 0; m < 4; ++m) { const int t = PERMV[u.pm * BM + ai * HALF + wr * 64 + m * 16 + fr];
                if (t >= 0) { bf16_t* rowp = Y + (size_t)t * 1024 + col0; const float* gb = gate + (size_t)(t >> 11) * gstride + col0;
#pragma unroll
                    for (int bj = 0; bj < 2; ++bj) { const f32x4 g0 = *(const f32x4*)(gb + bj * HALF), g1 = *(const f32x4*)(gb + bj * HALF + 4);
                        const f32x4 v0 = acc[ai][bj][m][0] * g0, v1 = acc[ai][bj][m][1] * g1;
                        u32x4 w; w.x = cvt_pk_bf16(v0[0], v0[1]); w.y = cvt_pk_bf16(v0[2], v0[3]); w.z = cvt_pk_bf16(v1[0], v1[1]); w.w = cvt_pk_bf16(v1[2], v1[3]);
                        *(u32x4*)(rowp + bj * HALF) = w; } } }
    }
};
}


namespace att {
typedef short bf16x8 __attribute__((ext_vector_type(8)));
typedef short s16x4 __attribute__((ext_vector_type(4)));
typedef short v4i16_t __attribute__((ext_vector_type(4)));
typedef float f32x16 __attribute__((ext_vector_type(16)));
typedef unsigned u32x4 __attribute__((ext_vector_type(4)));
typedef float f32x2_t __attribute__((ext_vector_type(2))); typedef __bf16 bf16x2_t __attribute__((ext_vector_type(2)));
typedef LAS const char* lds_cptr;
constexpr float THR = 8.f;
__device__ __forceinline__ unsigned cvtpk(float lo, float hi) { f32x2_t v = {lo, hi}; bf16x2_t b = __builtin_convertvector(v, bf16x2_t); return __builtin_bit_cast(unsigned, b); }
__device__ __forceinline__ s16x4 vtr(lds_cptr p) { return __builtin_bit_cast(s16x4, __builtin_amdgcn_ds_read_tr16_b64_v4i16((LAS v4i16_t*)p)); }
__device__ __forceinline__ float swapmax(float m) { auto rr = __builtin_amdgcn_permlane32_swap(__float_as_uint(m), __float_as_uint(m), false, false); return fmaxf(__uint_as_float(rr[0]), __uint_as_float(rr[1])); }
__device__ __forceinline__ float swapsum(float m) { auto rr = __builtin_amdgcn_permlane32_swap(__float_as_uint(m), __float_as_uint(m), false, false); return __uint_as_float(rr[0]) + __uint_as_float(rr[1]); }
__device__ __forceinline__ void glds16(const void* g, LAS unsigned char* l) { __builtin_amdgcn_global_load_lds((const unsigned*)g, (LAS unsigned*)l, 16, 0, 0); }
__device__ __forceinline__ void qkt(f32x16& p0, f32x16& p1, lds_cptr kslot, const bf16x8 (&qr)[4], int r32, int hi) {
    lds_cptr kb = kslot + hi * 1024 + r32 * 16;
#pragma unroll
    for (int d0 = 0; d0 < 4; ++d0) {
        const bf16x8 b0 = *(const LAS bf16x8*)(kb + d0 * 2048), b1 = *(const LAS bf16x8*)(kb + d0 * 2048 + 512);
        p0 = __builtin_amdgcn_mfma_f32_32x32x16_bf16(b0, qr[d0], p0, 0, 0, 0);
        p1 = __builtin_amdgcn_mfma_f32_32x32x16_bf16(b1, qr[d0], p1, 0, 0, 0);
    }
}
template <int ND, bool LM> __device__ __forceinline__ void pv(f32x16 (&o)[ND + (LM ? 1 : 0)], int vb, bf16x8 pa0, bf16x8 pa1, bf16x8 pa2, bf16x8 pa3) {
    if constexpr (LM) {
        const bf16x8 ones = (bf16x8){0x3F80, 0x3F80, 0x3F80, 0x3F80, 0x3F80, 0x3F80, 0x3F80, 0x3F80};
        o[ND] = __builtin_amdgcn_mfma_f32_32x32x16_bf16(pa0, ones, o[ND], 0, 0, 0); o[ND] = __builtin_amdgcn_mfma_f32_32x32x16_bf16(pa1, ones, o[ND], 0, 0, 0);
        o[ND] = __builtin_amdgcn_mfma_f32_32x32x16_bf16(pa2, ones, o[ND], 0, 0, 0); o[ND] = __builtin_amdgcn_mfma_f32_32x32x16_bf16(pa3, ones, o[ND], 0, 0, 0);
    }
#pragma unroll
    for (int d0 = 0; d0 < ND; ++d0) {
        s16x4 lo[4], hi[4];
#pragma unroll
        for (int ks = 0; ks < 4; ++ks) {
            asm volatile("ds_read_b64_tr_b16 %0, %1 offset:%c2" : "=&v"(lo[ks]) : "v"(vb), "i"(d0 * 4096 + ks * 1024) : "memory");
            asm volatile("ds_read_b64_tr_b16 %0, %1 offset:%c2" : "=&v"(hi[ks]) : "v"(vb), "i"(d0 * 4096 + ks * 1024 + 512) : "memory"); }
        asm volatile("s_waitcnt lgkmcnt(0)" ::: "memory"); __builtin_amdgcn_sched_barrier(0);
#define ATT_PK(k) (bf16x8){lo[k][0], lo[k][1], lo[k][2], lo[k][3], hi[k][0], hi[k][1], hi[k][2], hi[k][3]}
        o[d0] = __builtin_amdgcn_mfma_f32_32x32x16_bf16(pa0, ATT_PK(0), o[d0], 0, 0, 0);
        o[d0] = __builtin_amdgcn_mfma_f32_32x32x16_bf16(pa1, ATT_PK(1), o[d0], 0, 0, 0);
        o[d0] = __builtin_amdgcn_mfma_f32_32x32x16_bf16(pa2, ATT_PK(2), o[d0], 0, 0, 0);
        o[d0] = __builtin_amdgcn_mfma_f32_32x32x16_bf16(pa3, ATT_PK(3), o[d0], 0, 0, 0);
#undef ATT_PK
    }
}
__device__ __forceinline__ void alibi_cin(f32x16& p0, f32x16& p1, float qrel, float sl2, float m, bool past) {
    if (past) { const float bm = -sl2 * qrel - m;
#pragma unroll
        for (int r = 0; r < 16; ++r) { const float c = (float)((r & 3) + 8 * (r >> 2)); p0[r] = fmaf(sl2, c, bm); p1[r] = fmaf(sl2, c + 32.f, bm); }
    } else {
#pragma unroll
        for (int r = 0; r < 16; ++r) { const float c = (float)((r & 3) + 8 * (r >> 2)); p0[r] = -sl2 * fabsf(qrel - c) - m; p1[r] = -sl2 * fabsf(qrel - 32.f - c) - m; }
    }
}
template <int ND, bool LM> __device__ __forceinline__ bool softmax_step(f32x16& p0, f32x16& p1, float& m, float& l, f32x16 (&o)[ND + (LM ? 1 : 0)], LAS float* wsf, int r32, int hi, bool first) {
    float mxa = fmaxf(fmaxf(p0[0], p0[1]), p1[0]), mxb = fmaxf(fmaxf(p0[2], p0[3]), p1[1]);
    mxa = fmaxf(fmaxf(mxa, p1[2]), p1[3]);
#pragma unroll
    for (int r = 4; r < 16; r += 4) { mxa = fmaxf(fmaxf(mxa, p0[r]), p0[r + 1]); mxb = fmaxf(fmaxf(mxb, p0[r + 2]), p0[r + 3]); mxa = fmaxf(fmaxf(mxa, p1[r]), p1[r + 1]); mxb = fmaxf(fmaxf(mxb, p1[r + 2]), p1[r + 3]); }
    float mx = swapmax(fmaxf(mxa, mxb));
    if (!first && __all(mx < -160.f)) return false;
    float dl = 0.f; float fr[16];
#pragma unroll
    for (int r = 0; r < 16; ++r) fr[r] = 1.f;
    if (first) dl = (mx == -INFINITY) ? 0.f : mx;
    else if (__any(mx > THR)) {
        dl = fmaxf(mx, 0.f);
        const float f = __builtin_amdgcn_exp2f(-dl); if constexpr (!LM) l *= f; wsf[r32] = f;
        LDS_WAIT();
#pragma unroll
        for (int r = 0; r < 16; ++r) fr[r] = wsf[(r & 3) + 8 * (r >> 2) + 4 * hi];
        LDS_WAIT();
    }
    m += dl;
#pragma unroll
    for (int r = 0; r < 16; ++r) {
#pragma unroll
        for (int d = 0; d < ND + (LM ? 1 : 0); ++d) o[d][r] *= fr[r]; }
    if (__any(dl != 0.f)) {
#pragma unroll
        for (int r = 0; r < 16; ++r) { p0[r] -= dl; p1[r] -= dl; } }
    float sacc = 0.f;
#pragma unroll
    for (int r = 0; r < 16; ++r) { p0[r] = __builtin_amdgcn_exp2f(p0[r]); p1[r] = __builtin_amdgcn_exp2f(p1[r]); if constexpr (!LM) sacc += p0[r] + p1[r]; }
    if constexpr (!LM) l += sacc;
    return true;
}
#define ATT_PACK(P, B) (u32x4){cvtpk(P[B], P[B + 1]), cvtpk(P[B + 2], P[B + 3]), cvtpk(P[B + 4], P[B + 5]), cvtpk(P[B + 6], P[B + 7])}

#define ATT_WAITBAR(N) do { asm volatile("s_waitcnt vmcnt(" #N ") lgkmcnt(0)" ::: "memory"); __builtin_amdgcn_s_barrier(); asm volatile("" ::: "memory"); } while (0)
__device__ __forceinline__ void battn_unit(LAS unsigned char* L, int b, int h, int qb, bf16* P, const bf16* KV, const unsigned* MASK, bool dry, int WID_) {
    const int tid = otid(WID_), lane = tid & 63, wid = __builtin_amdgcn_readfirstlane(tid >> 6), r32 = lane & 31, hi = lane >> 5;
    const int q0 = qb * 256, qpos = q0 + wid * 32 + r32, cq = (q0 + wid * 32) >> 6, NT = (q0 + 256) >> 6;
    const size_t rowbase = (size_t)b * SEQ;
    const bf16* Kh = KV + rowbase * 1024 + h * 64;
    bf16* Qw = P + (rowbase + q0 + wid * 32) * NP + C_BQ + h * 64;
    const char* ksrc = (const char*)(Kh + (size_t)lane * 1024 + wid * 8);
    const char* vsrc = (const char*)(Kh + 512 + (size_t)(16 * (wid & 3) + (lane >> 2)) * 1024 + (wid >> 2) * 32 + (lane & 3) * 8);
    const char* msrc = (const char*)(MASK + (rowbase + q0 + wid * 32 + (lane >> 1)) * 64 + (lane & 1));
    LAS unsigned char* kdst = L + wid * 1024; LAS unsigned char* vdst = L + 8192 + wid * 1024; LAS unsigned char* mdst = L + 65536 + wid * 256;
    LAS float* wsf = (LAS float*)(L + 73728 + wid * 256);
    bf16x8 qr[4];
#pragma unroll
    for (int d0 = 0; d0 < 4; ++d0) qr[d0] = *(const bf16x8*)(Qw + (size_t)r32 * NP + d0 * 16 + hi * 8);
    __builtin_amdgcn_s_waitcnt(0x0F70);
    const float sl2 = SLOPE_B[h] * LOG2E;
    float m = 0.f; f32x16 o[3]; o[0] = f32x16{}; o[1] = f32x16{}; o[2] = f32x16{};
#define B_DMA(it_) do { const int t_ = NT - 1 - (it_) > 0 ? NT - 1 - (it_) : 0; const int s_ = (it_) & 3; \
        glds16(ksrc + (size_t)t_ * (64 * 1024 * 2), kdst + s_ * 16384); glds16(vsrc + (size_t)t_ * (64 * 1024 * 2), vdst + s_ * 16384); \
        __builtin_amdgcn_global_load_lds((const unsigned*)(msrc + t_ * 8), (LAS unsigned*)(mdst + s_ * 2048), 4, 0, 0); } while (0)
    B_DMA(0); B_DMA(1); B_DMA(2);
    const int vb0 = (int)(unsigned)(size_t)(L + 8192) + ((lane >> 4) & 1) * 32 + (lane & 3) * 8 + (4 * hi + ((lane & 15) >> 2)) * 64;
    for (int it = 0; it < NT; ++it) {
        const int t = NT - 1 - it, sl = it & 3;
        ATT_WAITBAR(6);
        B_DMA(it + 3);
        if (t <= cq) {
            f32x16 p0, p1;
            alibi_cin(p0, p1, (float)(qpos - 64 * t - 4 * hi), sl2, m, t < cq);
            const v2u mcur = *(const LAS v2u*)(mdst + sl * 2048 + r32 * 8);
            const unsigned mx0 = mcur.x >> (4 * hi), mx1 = mcur.y >> (4 * hi);
#pragma unroll
            for (int r = 0; r < 16; ++r) { const int c = (r & 3) + 8 * (r >> 2);
                const unsigned s0_ = (unsigned)__builtin_amdgcn_sbfe((int)mx0, c, 1), s1_ = (unsigned)__builtin_amdgcn_sbfe((int)mx1, c, 1);
                p0[r] = __uint_as_float((__float_as_uint(p0[r]) & s0_) | (0xff800000u & ~s0_)); p1[r] = __uint_as_float((__float_as_uint(p1[r]) & s1_) | (0xff800000u & ~s1_)); }
            qkt(p0, p1, (lds_cptr)L + sl * 16384, qr, r32, hi);
            if (softmax_step<2, true>(p0, p1, m, m  , o, wsf, r32, hi, t == cq)) {
                const u32x4 w0 = ATT_PACK(p0, 0), w1 = ATT_PACK(p0, 8), w2 = ATT_PACK(p1, 0), w3 = ATT_PACK(p1, 8);
                pv<2, true>(o, vb0 + sl * 16384, __builtin_bit_cast(bf16x8, w0), __builtin_bit_cast(bf16x8, w1), __builtin_bit_cast(bf16x8, w2), __builtin_bit_cast(bf16x8, w3)); }
        }
    }
#undef B_DMA
    LAS bf16* stg = (LAS bf16*)(L + 75776 + wid * 4096);
#pragma unroll
    for (int r = 0; r < 16; ++r) { const int orow = (r & 3) + 8 * (r >> 2) + 4 * hi; const float rl = 1.f / o[2][r];
        stg[orow * 64 + r32] = (bf16)f2bf(o[0][r] * rl); stg[orow * 64 + 32 + r32] = (bf16)f2bf(o[1][r] * rl); }
    LDS_WAIT();
#pragma unroll
    for (int i = 0; i < 4; ++i) { const int row = i * 8 + (lane >> 3), ch = lane & 7; const u32x4 v = *(const LAS u32x4*)(stg + row * 64 + ch * 8); if (!dry) *(u32x4*)(Qw + (size_t)row * NP + ch * 8) = v; }
    ATT_WAITBAR(0);
}
__device__ __forceinline__ void battn_phase(LAS unsigned char* L, const Ctx& a, bool dry, int WID_) {
    const int bx = blockIdx.x, x = bx & 7, c = (bx >> 3) & 31, b = 2 * x + (c >> 4), cc = c & 15, hpar = cc & 1, sel = (cc >> 1) & 1, rot = cc >> 2;
    bf16* P = (bf16*)(a.ws() + WS_PROJ); const bf16* KV = (const bf16*)(a.ws() + WS_KV); const unsigned* MASK = (const unsigned*)(a.ws() + WS_MASK);
    for (int i = 0; i < 4; ++i) { const int qb = i == 0 ? sel : (i == 1 ? 7 - sel : (i == 2 ? 2 + sel : 5 - sel)); const int h = 2 * ((i + rot) & 3) + hpar; battn_unit(L, b, h, qb, P, KV, MASK, dry, WID_); }
}

__device__ __forceinline__ void dattn_unit(LAS unsigned char* L, int b, int h, int qb, bf16* P, float lam, const float* subg, bool dry, int WID_) {
    const int tid = otid(WID_), lane = tid & 63, wid = __builtin_amdgcn_readfirstlane(tid >> 6), r32 = lane & 31, hi = lane >> 5, rg = wid & 3, mp = wid >> 2;
    const int q0 = qb * 128, qpos = q0 + rg * 32 + r32, cq = (q0 + rg * 32) >> 6, NT = (q0 + 128) >> 6;
    const size_t rowbase = (size_t)b * SEQ;
    const bf16* Kb = P + rowbase * NP + C_AK + h * 128;
    const bf16* Vb = P + rowbase * NP + C_AV + h * 128;
    bf16* Qw = P + (rowbase + q0 + rg * 32) * NP + C_AQ + h * 128;
    const char* k0src = (const char*)(Kb + (size_t)lane * NP + wid * 8);
    const char* k1src = (const char*)(Kb + (size_t)lane * NP + 64 + wid * 8);
    const char* v0src = (const char*)(Vb + (size_t)(16 * (wid & 3) + (lane >> 2)) * NP + (wid >> 2) * 32 + (lane & 3) * 8);
    const char* v1src = v0src + 64 * 2;
    LAS unsigned char* dst = L + wid * 1024;
    LAS float* wsf = (LAS float*)(L + 131072 + wid * 256);
    bf16x8 qr[4];
#pragma unroll
    for (int d0 = 0; d0 < 4; ++d0) qr[d0] = *(const bf16x8*)(Qw + (size_t)r32 * NP + mp * 64 + d0 * 16 + hi * 8);
    __builtin_amdgcn_s_waitcnt(0x0F70);
    const float sl2 = SLOPE_A[h] * LOG2E;
    float m = 0.f, l = 0.f; f32x16 o[4];
#pragma unroll
    for (int d = 0; d < 4; ++d) o[d] = f32x16{};
    constexpr size_t TS = (size_t)64 * NP * 2;
#define D_DMA(it_) do { const int t_ = NT - 1 - (it_) > 0 ? NT - 1 - (it_) : 0; LAS unsigned char* d2 = dst + ((it_) & 3) * 32768; const size_t go = (size_t)t_ * TS; \
        glds16(k0src + go, d2); glds16(k1src + go, d2 + 8192); glds16(v0src + go, d2 + 16384); glds16(v1src + go, d2 + 24576); } while (0)
    D_DMA(0); D_DMA(1); D_DMA(2);
    const int vb0 = (int)(unsigned)(size_t)(L + 16384) + ((lane >> 4) & 1) * 32 + (lane & 3) * 8 + (4 * hi + ((lane & 15) >> 2)) * 64;
    for (int it = 0; it < NT; ++it) {
        const int t = NT - 1 - it, sl = it & 3;
        ATT_WAITBAR(8);
        D_DMA(it + 3);
        if (t <= cq) {
            f32x16 p0, p1;
            alibi_cin(p0, p1, (float)(qpos - 64 * t - 4 * hi), sl2, m, t < cq);
            qkt(p0, p1, (lds_cptr)L + sl * 32768 + mp * 8192, qr, r32, hi);
            if (softmax_step<4, false>(p0, p1, m, l, o, wsf, r32, hi, t == cq)) {
                const u32x4 w0 = ATT_PACK(p0, 0), w1 = ATT_PACK(p0, 8), w2 = ATT_PACK(p1, 0), w3 = ATT_PACK(p1, 8);
                pv<4, false>(o, vb0 + sl * 32768, __builtin_bit_cast(bf16x8, w0), __builtin_bit_cast(bf16x8, w1), __builtin_bit_cast(bf16x8, w2), __builtin_bit_cast(bf16x8, w3)); }
        }
    }
#undef D_DMA
    ATT_WAITBAR(0);
    l = swapsum(l); wsf[32 + r32] = l; LDS_WAIT();
    LAS float* X = (LAS float*)L + rg * (32 * 132);
    if (mp == 1) {
#pragma unroll
        for (int r = 0; r < 16; ++r) { const int orow = (r & 3) + 8 * (r >> 2) + 4 * hi; const float rl = lam / wsf[32 + orow];
#pragma unroll
            for (int d = 0; d < 4; ++d) X[orow * 132 + d * 32 + r32] = o[d][r] * rl; }
    }
    asm volatile("s_waitcnt lgkmcnt(0)" ::: "memory"); __syncthreads();
    if (mp == 0) {
#pragma unroll
        for (int r = 0; r < 16; ++r) { const int orow = (r & 3) + 8 * (r >> 2) + 4 * hi; const float rl = 1.f / wsf[32 + orow];
#pragma unroll
            for (int d = 0; d < 4; ++d) { LAS float* xp = X + orow * 132 + d * 32 + r32; *xp = o[d][r] * rl - *xp; } }
        LDS_WAIT();
        const int row = lane >> 1, half = lane & 1; const LAS f32x4* xr = (const LAS f32x4*)(X + row * 132 + half * 64);
        f32x4 y[16]; float ss = 0.f;
#pragma unroll
        for (int j = 0; j < 16; ++j) { y[j] = xr[j]; ss += (y[j].x * y[j].x + y[j].y * y[j].y) + (y[j].z * y[j].z + y[j].w * y[j].w); }
        ss += __shfl_xor(ss, 1);
        const float rn = 0.8f / sqrtf(ss * (1.f / 128.f) + RMS_EPS);
        bf16* op = Qw + (size_t)row * NP + half * 64; const f32x4* gp = (const f32x4*)(subg + half * 64);
#pragma unroll
        for (int j = 0; j < 8; ++j) { const f32x4 g0 = gp[2 * j], g1 = gp[2 * j + 1]; const f32x4 a0 = y[2 * j] * rn * g0, a1 = y[2 * j + 1] * rn * g1;
            u32x4 w; w.x = cvtpk(a0.x, a0.y); w.y = cvtpk(a0.z, a0.w); w.z = cvtpk(a1.x, a1.y); w.w = cvtpk(a1.z, a1.w); if (!dry) *(u32x4*)(op + j * 8) = w; }
    }
    asm volatile("s_waitcnt lgkmcnt(0)" ::: "memory"); __syncthreads();
}
__device__ __forceinline__ void dattn_phase(LAS unsigned char* L, const Ctx& a, bool dry, int WID_) {
    const int bx = blockIdx.x, x = bx & 7, c = (bx >> 3) & 31, b = 2 * x + (c >> 4), cc = c & 15, rot = cc & 3, j = cc >> 2;
    bf16* P = (bf16*)(a.ws() + WS_PROJ); const float* SMv = (const float*)(a.ws() + WS_SMALL); const float lam = SMv[SM_LAM];
    for (int i = 0; i < 4; ++i) { const int qb = i == 0 ? j : (i == 1 ? 7 - j : (i == 2 ? 8 + j : 15 - j)); const int h = (i + rot) & 3; dattn_unit(L, b, h, qb, P, lam, SMv + SM_SUBLN, dry, WID_); }
}
#undef ATT_PACK
}


namespace idx {
typedef short bf16x8 __attribute__((ext_vector_type(8)));
typedef float f32x16 __attribute__((ext_vector_type(16)));
typedef unsigned u32x4 __attribute__((ext_vector_type(4)));
__device__ __forceinline__ void cnt_ge(int& c, unsigned key, unsigned t) { asm("v_cmp_ge_u32_e32 vcc, %1, %2\n\tv_addc_co_u32_e32 %0, vcc, 0, %0, vcc" : "+v"(c) : "v"(key), "v"(t) : "vcc"); }
__device__ __forceinline__ void cnt_gt(int& c, unsigned key, unsigned t) { asm("v_cmp_gt_u32_e32 vcc, %1, %2\n\tv_addc_co_u32_e32 %0, vcc, 0, %0, vcc" : "+v"(c) : "v"(key), "v"(t) : "vcc"); }
__device__ __forceinline__ int row16_sum(int x) {
    x += __builtin_amdgcn_update_dpp(0, x, 0xB1, 0xF, 0xF, true);
    x += __builtin_amdgcn_update_dpp(0, x, 0x4E, 0xF, 0xF, true);
    x += __builtin_amdgcn_update_dpp(0, x, 0x141, 0xF, 0xF, true);
    x += __builtin_amdgcn_update_dpp(0, x, 0x140, 0xF, 0xF, true);
    return x;
}
__device__ __forceinline__ int half_sum(int x, int hi) {
    x = row16_sum(x);
    const int s0 = __builtin_amdgcn_readlane(x, 0) + __builtin_amdgcn_readlane(x, 16), s1 = __builtin_amdgcn_readlane(x, 32) + __builtin_amdgcn_readlane(x, 48);
    return hi ? s1 : s0;
}
__device__ __forceinline__ float relu1(float x) { return __builtin_amdgcn_fmed3f(x, 0.f, __builtin_inff()); }
template <int NS> __device__ __forceinline__ void idx_unit_t(LAS unsigned char* L, int b, int g, const bf16* P, unsigned* MASK, int WID_) {
    const int tid = otid(WID_), lane = tid & 63, wid = __builtin_amdgcn_readfirstlane(tid >> 6), r32 = lane & 31, hi = lane >> 5;
    const int nblk = 2 * ((g >> 1) + 1);
    const size_t rowbase = (size_t)b * SEQ; const int tq0 = g * 32 + wid * 4;
    unsigned* mrow0 = MASK + (rowbase + tq0 + 2 * hi) * 64;
    const int qsel = 2 * ((r32 >> 2) & 1) + (r32 >> 4), hsel = ((r32 >> 3) & 1) * 4 + (r32 & 3);
    const bf16* qp = P + (rowbase + tq0 + qsel) * NP + C_IQ + hsel * 64 + hi * 8;
    bf16x8 qa[4];
#pragma unroll
    for (int ks = 0; ks < 4; ++ks) qa[ks] = *(const bf16x8*)(qp + ks * 16);
    float w[2][8];
#pragma unroll
    for (int q2 = 0; q2 < 2; ++q2) { const u32x4 wv = *(const u32x4*)(P + (rowbase + tq0 + 2 * hi + q2) * NP + C_IW);
        w[q2][0] = bflo(wv.x); w[q2][1] = bfhi(wv.x); w[q2][2] = bflo(wv.y); w[q2][3] = bfhi(wv.y); w[q2][4] = bflo(wv.z); w[q2][5] = bfhi(wv.z); w[q2][6] = bflo(wv.w); w[q2][7] = bfhi(wv.w); }
    const char* ksrc = (const char*)(P + (rowbase + lane) * NP + C_IK + wid * 8);
    LAS unsigned char* kdst = L + wid * 1024;
    const char* kp = ksrc;
#define IDX_DMA(s_) do { _Pragma("unroll") for (int sub = 0; sub < 4; ++sub) \
        __builtin_amdgcn_global_load_lds((const unsigned*)(kp + (size_t)(64 * sub) * (NP * 2)), (LAS unsigned*)(kdst + ((s_) % 3) * 32768 + sub * 8192), 16, 0, 0); \
        kp += (size_t)256 * (NP * 2); asm volatile("" : "+v"(kp)); } while (0)
    unsigned key[2][8 * NS];
    __builtin_amdgcn_s_waitcnt(0x0F70);
    IDX_DMA(0); if (NS > 1) IDX_DMA(1);
#pragma unroll
    for (int s_ = 0; s_ < NS; ++s_) {
        if (s_ + 1 < NS) asm volatile("s_waitcnt vmcnt(4) lgkmcnt(0)" ::: "memory"); else asm volatile("s_waitcnt vmcnt(0) lgkmcnt(0)" ::: "memory");
        __builtin_amdgcn_s_barrier(); asm volatile("" ::: "memory");
        if (s_ + 2 < NS) IDX_DMA(s_ + 2);
#pragma unroll
        for (int jj = 0; jj < 4; ++jj) {
            const LAS unsigned char* kb = L + (s_ % 3) * 32768 + jj * 8192 + hi * 1024 + r32 * 16;
            f32x16 acc0 = f32x16{}, acc1 = f32x16{};
#pragma unroll
            for (int ks = 0; ks < 4; ++ks) { const bf16x8 kf0 = *(const LAS bf16x8*)(kb + ks * 2048), kf1 = *(const LAS bf16x8*)(kb + ks * 2048 + 512);
                acc0 = __builtin_amdgcn_mfma_f32_32x32x16_bf16(qa[ks], kf0, acc0, 0, 0, 0); acc1 = __builtin_amdgcn_mfma_f32_32x32x16_bf16(qa[ks], kf1, acc1, 0, 0, 0); }
            const int blk = 8 * s_ + 2 * jj;
            const bool vis = blk < nblk;
            float sc[2][2];
#pragma unroll
            for (int q2 = 0; q2 < 2; ++q2) { float s0 = 0.f, s1 = 0.f;
#pragma unroll
                for (int h = 0; h < 8; ++h) { s0 = fmaf(w[q2][h], relu1(acc0[8 * q2 + h]), s0); s1 = fmaf(w[q2][h], relu1(acc1[8 * q2 + h]), s1); }
                sc[q2][0] = s0; sc[q2][1] = s1; }
#pragma unroll
            for (int q2 = 0; q2 < 2; ++q2) { key[q2][blk] = vis ? sortable(sc[q2][0] + 0.f) : 0u; key[q2][blk + 1] = vis ? sortable(sc[q2][1] + 0.f) : 0u; }
            asm volatile("" : "+v"(key[0][blk]), "+v"(key[0][blk + 1]), "+v"(key[1][blk]), "+v"(key[1][blk + 1]));
        }
    }
#undef IDX_DMA
    unsigned K0 = 0u, K1 = 0u; int g0 = 0x7fffffff, g1 = 0x7fffffff;
    for (int bit = 31; bit >= 0; --bit) {
        const unsigned t0 = K0 | (1u << bit), t1 = K1 | (1u << bit);
        int c0 = 0, c1 = 0;
#pragma unroll
        for (int i = 0; i < 8 * NS; ++i) { cnt_ge(c0, key[0][i], t0); cnt_ge(c1, key[1][i], t1); }
        c0 = half_sum(c0, hi); c1 = half_sum(c1, hi);
        if (c0 >= TOPK) { K0 = t0; g0 = c0; }
        if (c1 >= TOPK) { K1 = t1; g1 = c1; }
        if (__all(g0 == TOPK && g1 == TOPK)) break;
    }
    unsigned m00 = 0u, m01 = 0u, m10 = 0u, m11 = 0u;
    if (__all(g0 == TOPK && g1 == TOPK)) {
#pragma unroll
        for (int blk = 0; blk < 8 * NS; ++blk) {
            const unsigned long long b0 = __ballot(key[0][blk] >= K0), b1 = __ballot(key[1][blk] >= K1);
            const unsigned w0 = hi ? (unsigned)(b0 >> 32) : (unsigned)b0, w1 = hi ? (unsigned)(b1 >> 32) : (unsigned)b1;
            if (r32 == (blk & 31)) { if (blk < 32) { m00 = w0; m10 = w1; } else { m01 = w0; m11 = w1; } }
            __builtin_amdgcn_sched_barrier(0); }
    } else {
        int c0 = 0, c1 = 0;
#pragma unroll
        for (int i = 0; i < 8 * NS; ++i) { cnt_gt(c0, key[0][i], K0); cnt_gt(c1, key[1][i], K1); }
        const int need0 = TOPK - half_sum(c0, hi), need1 = TOPK - half_sum(c1, hi);
        int tk0 = 0, tk1 = 0; const unsigned lt = (1u << r32) - 1u;
#pragma unroll
        for (int blk = 0; blk < 8 * NS; ++blk) {
            const unsigned long long e0b = __ballot(key[0][blk] == K0), e1b = __ballot(key[1][blk] == K1);
            const unsigned e0 = hi ? (unsigned)(e0b >> 32) : (unsigned)e0b, e1 = hi ? (unsigned)(e1b >> 32) : (unsigned)e1b;
            const bool s0 = key[0][blk] > K0 || (key[0][blk] == K0 && tk0 + __popc(e0 & lt) < need0);
            const bool s1 = key[1][blk] > K1 || (key[1][blk] == K1 && tk1 + __popc(e1 & lt) < need1);
            tk0 += __popc(e0); tk1 += __popc(e1);
            const unsigned long long b0 = __ballot(s0), b1 = __ballot(s1);
            const unsigned w0 = hi ? (unsigned)(b0 >> 32) : (unsigned)b0, w1 = hi ? (unsigned)(b1 >> 32) : (unsigned)b1;
            if (r32 == (blk & 31)) { if (blk < 32) { m00 = w0; m10 = w1; } else { m01 = w0; m11 = w1; } }
            __builtin_amdgcn_sched_barrier(0); }
    }
    mrow0[r32] = m00; mrow0[32 + r32] = m01; mrow0[64 + r32] = m10; mrow0[96 + r32] = m11;
}
__device__ __forceinline__ void idx_unit(LAS unsigned char* L, int b, int g, const bf16* P, unsigned* MASK, int WID_) {
    const int nblk = 2 * ((g >> 1) + 1), ns = (nblk + 7) >> 3;
    if (ns <= 1) {
        const int tid = otid(WID_), lane = tid & 63, wid = __builtin_amdgcn_readfirstlane(tid >> 6), r32 = lane & 31, hi = lane >> 5;
        unsigned* mrow0 = MASK + ((size_t)b * SEQ + g * 32 + wid * 4 + 2 * hi) * 64;
        const unsigned wlo = r32 < nblk ? 0xffffffffu : 0u;
        mrow0[r32] = wlo; mrow0[32 + r32] = 0u; mrow0[64 + r32] = wlo; mrow0[96 + r32] = 0u;
    }
    else if (ns == 2) idx_unit_t<2>(L, b, g, P, MASK, WID_);
    else if (ns == 3) idx_unit_t<3>(L, b, g, P, MASK, WID_);
    else if (ns == 4) idx_unit_t<4>(L, b, g, P, MASK, WID_);
    else if (ns == 5) idx_unit_t<5>(L, b, g, P, MASK, WID_);
    else if (ns == 6) idx_unit_t<6>(L, b, g, P, MASK, WID_);
    else if (ns == 7) idx_unit_t<7>(L, b, g, P, MASK, WID_);
    else idx_unit_t<8>(L, b, g, P, MASK, WID_);
}
__device__ __forceinline__ void idx_phase(LAS unsigned char* L, const Ctx& a, int WID_) {
    const int G = gridDim.x, bx = blockIdx.x, vcu = (bx % 8) * (G / 8) + bx / 8, b = vcu >> 4, j = vcu & 15;
    const bf16* P = (const bf16*)(a.ws() + WS_PROJ); unsigned* MASK = (unsigned*)(a.ws() + WS_MASK);
    for (int i = 0; i < 4; ++i) { const int g = i == 0 ? j : (i == 1 ? 31 - j : (i == 2 ? 32 + j : 63 - j)); idx_unit(L, b, g, P, MASK, WID_);
        asm volatile("s_waitcnt lgkmcnt(0)" ::: "memory"); __syncthreads(); }
}
}

__global__ void __launch_bounds__(512, 2) fwd(Args karg) {
    extern __shared__ __attribute__((aligned(16))) unsigned char lds[];
    const int tid = threadIdx.x; const int WID_ = __builtin_amdgcn_readfirstlane(tid >> 6);
    if (tid < 27) ((LAS unsigned long long*)((LAS unsigned char*)lds + LDSCTL_OFF + 512))[tid] = (unsigned long long)karg.in[tid];
    if (tid == 27) ((LAS unsigned long long*)((LAS unsigned char*)lds + LDSCTL_OFF + 512))[27] = (unsigned long long)karg.out;
    if (tid == 28) ((LAS unsigned long long*)((LAS unsigned char*)lds + LDSCTL_OFF + 512))[28] = (unsigned long long)karg.ws;
    unsigned char* ws = karg.ws;
    Ctx a; a.tab = (LAS const unsigned long long*)((LAS unsigned char*)lds + LDSCTL_OFF + 512);
    if (tid < 128) ((LAS unsigned*)((LAS unsigned char*)lds + LDSCTL_OFF))[tid] = 0u;
    __syncthreads();
    XcdBarrier bar = xcd_barrier_post((unsigned*)(ws + WS_CTL) + CW_BAR, (volatile LAS unsigned*)((LAS unsigned char*)lds + MISC_OFF) + 8);
#define GRID_BAR() do { for (int br_ = 0; br_ < PROBE_BAR; ++br_) xcd_barrier(bar); } while (0)
    bf16* PROJ = (bf16*)(ws + WS_PROJ); bf16* U = (bf16*)(ws + WS_U);
    LAS unsigned char* LL = (LAS unsigned char*)lds;

    for (int rep = 0; rep < PROBE_P0P1; ++rep) {
    for (int r2 = 0; r2 < PROBE_P0; ++r2) {
#if FAST_P0
    p0_fast(a, LL, WID_);
#else
    p0_naive(a, lds, WID_);
#endif
    __syncthreads(); }
    GRID_BAR();
    for (int r2 = 0; r2 < PROBE_P1; ++r2) { p1_modulate(a, lds, WID_); __syncthreads(); }
    GRID_BAR();
    }
    for (int rep = 0; rep < PROBE_P2; ++rep) {
#if FAST_P2
    { pg8::Gemm g{U, (const bf16*)(ws + WS_WIN), T, NP, 1024, 1024, 1024}; pg8::StaticOrder S; S.init(T, NP, (int)gridDim.x, (int)blockIdx.x);
      pg8::EpiProjF E{PROJ, NP, QSCALE, (float*)(ws + WS_R), (LAS float*)(LL + 131072)}; pg8::gemm_phase<pg8::EpiProjF, pg8::StaticOrder, true, true, 1024, 1024, 1024>(LL, g, S, E, WID_); }
#else
    { EpiProj e{PROJ}; naive_gemm((float*)lds, U, 1024, (const bf16*)(ws + WS_WIN), 1024, T, NP, 1024, e, WID_); }
#endif
    GRID_BAR();
    }
#if !FAST_P2
    naive_rms_rows(a, WID_);
    GRID_BAR();
#endif
    for (int rep = 0; rep < PROBE_KVIDX; ++rep) {
    for (int r2 = 0; r2 < PROBE_KV; ++r2) {
#if FAST_KV
    { pg8::Gemm g{PROJ + C_BKV, (const bf16*)(ws + WS_WKV), T, 1024, 128, NP, 128}; pg8::StaticOrder S; S.init(T, 1024, (int)gridDim.x, (int)blockIdx.x);
      pg8::EpiRowScale E{(bf16*)(ws + WS_KV), 1024, (const float*)(ws + WS_R)}; pg8::gemm_phase<pg8::EpiRowScale, pg8::StaticOrder, true, true, 128, NP, 128>(LL, g, S, E, WID_); }
#else
    { EpiKV e{(bf16*)(ws + WS_KV), (const float*)(ws + WS_R)}; naive_gemm((float*)lds, PROJ + C_BKV, NP, (const bf16*)(ws + WS_WKV), 128, T, 1024, 128, e, WID_); }
#endif
    __syncthreads(); }
    for (int r2 = 0; r2 < PROBE_IDX; ++r2) {
#if FAST_IDX
    idx::idx_phase(LL, a, WID_);
#else
    naive_indexer(a, lds, WID_);
#endif
    __syncthreads(); }
    }
#if FAST_DATT
    for (int rep = PROBE_DATT - 1; rep >= 0; --rep) { att::dattn_phase(LL, a, rep > 0, WID_); __syncthreads(); }
#else
    naive_diffattn(a, lds, WID_);
#endif
    GRID_BAR();
#if FAST_BATT
    for (int rep = PROBE_BATT - 1; rep >= 0; --rep) { att::battn_phase(LL, a, rep > 0, WID_); __syncthreads(); }
#else
    naive_battn(a, lds, WID_);
#endif
    GRID_BAR();
    for (int rep = 0; rep < PROBE_MIXWO; ++rep) {
    for (int r2 = 0; r2 < PROBE_MIX; ++r2) {
#if FAST_MIX
    { pg8::StaticOrder S; S.init(T, 1024, (int)gridDim.x, (int)blockIdx.x);
      pg8::Gemm g{PROJ + C_AQ, (const bf16*)(ws + WS_WA), T, 1024, 1024, NP, 1024}; pg8::EpiMixFused E{U, 1024, PROJ + C_G, NP};
      pg8::gemm_phase<pg8::EpiMixFused, pg8::StaticOrder, true, true, 1024, NP, 1024, 8, (C_BQ - C_AQ - 512) * 2>(LL, g, S, E, WID_); }
#else
    { EpiMixA e{U, PROJ}; naive_gemm((float*)lds, PROJ + C_AQ, NP, (const bf16*)(ws + WS_WA), 512, T, 1024, 512, e, WID_); }
    __syncthreads();
    { EpiMixB e{U, PROJ}; naive_gemm((float*)lds, PROJ + C_BQ, NP, (const bf16*)(ws + WS_WB), 512, T, 1024, 512, e, WID_); }
#endif
    asm volatile("s_waitcnt vmcnt(0)" ::: "memory"); __syncthreads(); }
    GRID_BAR();
    for (int r2 = 0; r2 < PROBE_WO; ++r2) {
#if FAST_WO
    { pg8::Gemm g{U, (const bf16*)(ws + WS_WO), T, 1024, 1024, 1024, 1024}; pg8::StaticOrder S; S.init(T, 1024, (int)gridDim.x, (int)blockIdx.x);
      pg8::EpiGateBf16 E{(bf16*)(ws + WS_KV), 1024, (const float*)(ws + WS_MOD) + 2048, 6144};
      pg8::gemm_phase<pg8::EpiGateBf16, pg8::StaticOrder, true, true, 1024, 1024, 1024>(LL, g, S, E, WID_); }
#else
    { EpiWo e{a.out(), a.in(I_X), (const float*)(ws + WS_MOD)}; naive_gemm((float*)lds, U, 1024, (const bf16*)(ws + WS_WO), 1024, T, 1024, 1024, e, WID_); }
#endif
    __syncthreads(); }
    GRID_BAR();
    }
    for (int rep = PROBE_ROWS * PROBE_P7 - 1; rep >= 0; --rep) p7_ln_route(a, lds, rep > 0, WID_);
    GRID_BAR();
    for (int rep = 0; rep < PROBE_ROWS * PROBE_P8; ++rep) { p8_sort(a, lds, WID_);
    GRID_BAR(); }
    for (int rep = 0; rep < PROBE_MOE * PROBE_MOE1; ++rep) {
#if FAST_MOE
    { const int* BASES = (const int*)(ws + WS_ROUTE2 + 1024 * 1024 + 32768); const int nslot = BASES[24];
      pg8::Gemm g{(const bf16*)(ws + WS_U2), (const bf16*)(ws + WS_W1), nslot, 1024, 1024, 1024, 1024, (const int*)(ws + WS_ROUTE2 + 512 * 1024)};
      pg8::MoeOrder1 S; S.so.init(nslot, 1024, (int)gridDim.x, (int)blockIdx.x); S.BASES = BASES; S.W1 = (const bf16*)(ws + WS_W1);
      pg8::EpiMoe1 E{(bf16*)(ws + WS_H), (const float*)(ws + WS_ROUTE2 + 1280 * 1024)};
      pg8::gemm_phase<pg8::EpiMoe1, pg8::MoeOrder1, true, true, 1024, 1024, 1024, 0, 0, true>(LL, g, S, E, WID_); }
#else
    naive_moe1(a, lds, WID_);
#endif
    GRID_BAR();
    }
    for (int rep = PROBE_MOE * PROBE_MOE2 - 1; rep >= 0; --rep) {
#if FAST_MOE
    { const int* BASES = (const int*)(ws + WS_ROUTE2 + 1024 * 1024 + 32768); const int nslot = BASES[24];
      pg8::Gemm g{(const bf16*)(ws + WS_H), (const bf16*)(ws + WS_W2P), nslot, 1024, 512, 512, 512};
      pg8::MoeOrder2 S; S.so.init(nslot, 1024, (int)gridDim.x, (int)blockIdx.x); S.BASES = BASES; S.W2P = (const bf16*)(ws + WS_W2P);
      pg8::EpiMoe2B E{(bf16*)(ws + WS_U), (const int*)(ws + WS_ROUTE2 + 512 * 1024), (const float*)(ws + WS_MOD) + 5120, 6144};
      pg8::gemm_phase<pg8::EpiMoe2B, pg8::MoeOrder2, true, true, 512, 512, 512>(LL, g, S, E, WID_); }
#else
    naive_moe2(a, lds, WID_);
#endif
    GRID_BAR();
    }
    for (int rep = PROBE_ROWS * PROBE_P11 - 1; rep >= 0; --rep) p11_ln(a, rep > 0, WID_);
}

extern "C" void kernel_launch(void* const* d_in, const int* in_sizes, int n_in, void* d_out, int out_size, void* d_ws, size_t ws_size, hipStream_t stream) {
    static int grid = 0;
    if (grid == 0) {
        if (n_in != 27 || out_size != T * D || ws_size < WS_END) { fprintf(stderr, "kernel_launch: unexpected problem (n_in %d, out %d, ws %zu); nothing launched\n", n_in, out_size, ws_size); grid = -1; return; }
        int dev = 0, cus = 0;
        if (hipGetDevice(&dev) != hipSuccess || hipDeviceGetAttribute(&cus, hipDeviceAttributeMultiprocessorCount, dev) != hipSuccess) { grid = -1; return; }
        if (hipFuncSetAttribute((const void*)fwd, hipFuncAttributeMaxDynamicSharedMemorySize, LDS_BYTES) != hipSuccess) { fprintf(stderr, "kernel_launch: hipFuncSetAttribute failed\n"); grid = -1; return; }
        if (cus != 256) { fprintf(stderr, "kernel_launch: built for 256 CUs, device has %d; nothing launched\n", cus); grid = -1; return; }
        grid = cus;
    }
    if (grid < 0) return;
    if (hipMemsetAsync((char*)d_ws + WS_CTL, 0, CTL_ZERO_BYTES, stream) != hipSuccess) return;
    Args a{};
    for (int i = 0; i < 27; ++i) a.in[i] = (const float*)d_in[i];
    a.out = (float*)d_out; a.ws = (unsigned char*)d_ws;
    hipLaunchKernelGGL(fwd, dim3(grid), dim3(512), LDS_BYTES, stream, a);
}
```

```cpp
#include <hip/hip_runtime.h>
#include <hip/hip_bf16.h>
#include <cstdio>
#include <cstdint>

#define GAS __attribute__((address_space(1)))
#define LAS __attribute__((address_space(3)))
typedef unsigned short bf16;
typedef GAS unsigned gu32;
typedef unsigned v4u __attribute__((ext_vector_type(4)));
typedef unsigned v2u __attribute__((ext_vector_type(2)));
typedef float f32x4 __attribute__((ext_vector_type(4)));
#define RLX_AGENT __ATOMIC_RELAXED, __HIP_MEMORY_SCOPE_AGENT

#ifndef FAST_P0
#define FAST_P0 1
#endif
#ifndef FAST_P2
#define FAST_P2 1
#endif
#ifndef FAST_KV
#define FAST_KV 1
#endif
#ifndef FAST_MIX
#define FAST_MIX 1
#endif
#ifndef FAST_WO
#define FAST_WO 1
#endif
#ifndef FAST_MOE
#define FAST_MOE 1
#endif
#ifndef FAST_DATT
#define FAST_DATT 1
#endif
#ifndef FAST_IDX
#define FAST_IDX 1
#endif
#ifndef FAST_BATT
#define FAST_BATT 1
#endif
#ifndef PROBE_P0P1
#define PROBE_P0P1 1
#endif
#ifndef PROBE_P2
#define PROBE_P2 1
#endif
#ifndef PROBE_KVIDX
#define PROBE_KVIDX 1
#endif
#ifndef PROBE_DATT
#define PROBE_DATT 1
#endif
#ifndef PROBE_BATT
#define PROBE_BATT 1
#endif
#ifndef PROBE_MIXWO
#define PROBE_MIXWO 1
#endif
#ifndef PROBE_MOE
#define PROBE_MOE 1
#endif
#ifndef PROBE_ROWS
#define PROBE_ROWS 1
#endif
#ifndef PROBE_P7
#define PROBE_P7 1
#endif
#ifndef PROBE_P8
#define PROBE_P8 1
#endif
#ifndef PROBE_P11
#define PROBE_P11 1
#endif
#ifndef PROBE_BAR
#define PROBE_BAR 1
#endif
#ifndef PROBE_MOE1
#define PROBE_MOE1 1
#endif
#ifndef PROBE_MOE2
#define PROBE_MOE2 1
#endif
#ifndef PROBE_P0
#define PROBE_P0 1
#endif
#ifndef PROBE_P1
#define PROBE_P1 1
#endif
#ifndef PROBE_KV
#define PROBE_KV 1
#endif
#ifndef PROBE_IDX
#define PROBE_IDX 1
#endif
#ifndef PROBE_MIX
#define PROBE_MIX 1
#endif
#ifndef PROBE_WO
#define PROBE_WO 1
#endif
constexpr int BATCH = 16, SEQ = 2048, D = 1024, T = BATCH * SEQ;
constexpr int NP = 4864;
constexpr int C_AQ = 0, C_AK = 512, C_AV = 1024, C_BQ = 1536, C_BKV = 2048, C_IQ = 2176, C_IK = 2688, C_IW = 2752, C_PADB = 2760, C_G = 2816;
constexpr int IN_COLS = 4808;
constexpr float LOG2E = 1.4426950408889634f;
constexpr float QSCALE = 0.125f * LOG2E;
constexpr float ALPHA = 1.189207115002721f;
constexpr float LN_EPS = 1e-5f, RMS_EPS = 1e-5f;
constexpr int TOPK = 256;
constexpr int MAXSLOT = 40960;

__device__ __constant__ float SLOPE_A[4] = {0.6299605369567871f, 0.15749013423919678f, 0.039372533559799194f, 0.009843133389949799f};
__device__ __constant__ float SLOPE_B[8] = {0.39685025811195374f, 0.25f, 0.09921256452798843f, 0.0625f, 0.02480314113199711f, 0.015625f, 0.006200785282999277f, 0.00390625f};

constexpr size_t MiB = 1u << 20;
constexpr size_t WS_CTL = 0, CTL_ZERO_BYTES = 1 * MiB;
constexpr size_t WS_MOD = 1 * MiB;
constexpr size_t WS_R = WS_MOD + 512 * 1024;
constexpr size_t WS_ROUTE = WS_R + 128 * 1024;
constexpr size_t WS_SMALL = WS_R + 128 * 1024;
constexpr int SM_LN1G = 0, SM_LN1B = 1024, SM_LN2G = 2048, SM_LN2B = 3072, SM_SUBLN = 4096, SM_BGRP = 4224, SM_BER = 4228, SM_LAM = 4244, SM_ADAB = 4352;
constexpr size_t WS_WIN = 2 * MiB;
constexpr size_t WS_WA = 12 * MiB;
constexpr size_t WS_WB = 13 * MiB;
constexpr size_t WS_WO = 14 * MiB;
constexpr size_t WS_WKV = 16 * MiB;
constexpr size_t WS_W1 = 17 * MiB;
constexpr size_t WS_W2P = 33 * MiB;
constexpr size_t WS_ROUTE2 = 57 * MiB;
constexpr size_t WS_RW = 59 * MiB;
constexpr size_t WS_MODP = 59 * MiB + 128 * 1024;
constexpr size_t WS_MASK = 60 * MiB;
constexpr size_t WS_KV = 68 * MiB;
constexpr size_t WS_U = 132 * MiB;
constexpr size_t WS_PROJ = 196 * MiB;
constexpr size_t WS_U2 = 196 * MiB;
constexpr size_t WS_H = 260 * MiB;
constexpr size_t WS_XS = 300 * MiB;
constexpr size_t WS_MODPART = 500 * MiB;
constexpr size_t WS_END = 512 * MiB;

constexpr int CW_BAR = 4096;

constexpr int LDSCTL_OFF = 139264, MISC_OFF = LDSCTL_OFF + 320, LDS_BYTES = 147456;

__device__ __forceinline__ unsigned f2bf(float f) { unsigned u = __float_as_uint(f); return (u + 0x7fffu + ((u >> 16) & 1u)) >> 16; }
__device__ __forceinline__ float bf2f(unsigned h) { return __uint_as_float(h << 16); }
__device__ __forceinline__ float bflo(unsigned w) { return __uint_as_float(w << 16); }
__device__ __forceinline__ float bfhi(unsigned w) { return __uint_as_float(w & 0xffff0000u); }
__device__ __forceinline__ unsigned pk2(float lo, float hi) { return f2bf(lo) | (f2bf(hi) << 16); }
#define DPP_ADD(x, ctrl) x += __builtin_bit_cast(float, __builtin_amdgcn_update_dpp(0, __builtin_bit_cast(int, x), ctrl, 0xF, 0xF, true))
__device__ __forceinline__ float wave_sum(float v) {
    DPP_ADD(v, 0xB1); DPP_ADD(v, 0x4E); DPP_ADD(v, 0x141); DPP_ADD(v, 0x140);
    const int iv = __builtin_bit_cast(int, v);
    const float s0 = __builtin_bit_cast(float, __builtin_amdgcn_readlane(iv, 0)), s1 = __builtin_bit_cast(float, __builtin_amdgcn_readlane(iv, 16));
    const float s2 = __builtin_bit_cast(float, __builtin_amdgcn_readlane(iv, 32)), s3 = __builtin_bit_cast(float, __builtin_amdgcn_readlane(iv, 48));
    return (s0 + s1) + (s2 + s3);
}
__device__ __forceinline__ float wave_max(float v) {
#pragma unroll
    for (int o = 1; o < 64; o <<= 1) v = fmaxf(v, __shfl_xor(v, o));
    return v;
}
__device__ __forceinline__ int wave_sum_i(int v) {
#pragma unroll
    for (int o = 1; o < 64; o <<= 1) v += __shfl_xor(v, o);
    return v;
}
#define LDS_WAIT() asm volatile("s_waitcnt lgkmcnt(0)" ::: "memory")
__device__ __forceinline__ int otid(int wid) { unsigned z; asm volatile("v_mov_b32 %0, 0" : "=v"(z)); return wid * 64 + (int)__builtin_amdgcn_mbcnt_hi(~0u, __builtin_amdgcn_mbcnt_lo(~0u, z)); }

#define XB_TMO      128
#define XB_XCNT(j)  (256  + 64 * (j))
#define XB_XSUB(j)  (1280 + 64 * (j))
#define XB_XGEN(j)  (2304 + 64 * (j))
#define XB_TOP      3328
#define XB_TOPGEN   3392
#define XCD_BAR_WORDS 3456
#define XB_SPIN_CAP (1u << 22)
__device__ __forceinline__ unsigned xb_ld(unsigned* p)              { return __hip_atomic_load(p, __ATOMIC_RELAXED, __HIP_MEMORY_SCOPE_AGENT); }
__device__ __forceinline__ unsigned xb_add(unsigned* p, unsigned v) { return __hip_atomic_fetch_add(p, v, __ATOMIC_RELAXED, __HIP_MEMORY_SCOPE_AGENT); }
__device__ __forceinline__ unsigned xb_xcc_id() { return (unsigned)__builtin_amdgcn_s_getreg((3 << 11) | 20) & 0xFu; }
#define XB_SPIN(cond, bar) do { unsigned _sp = 0; while (cond) { __builtin_amdgcn_s_sleep(1); \
    if ((++_sp & 255u) == 0u) { if (xb_ld(&(bar)[XB_TMO])) break; if (_sp > XB_SPIN_CAP) { atomicAdd(&(bar)[XB_TMO], 1u); break; } } } } while (0)
struct XcdBarrier { unsigned* bar; unsigned x; volatile LAS unsigned* st; };
__device__ __forceinline__ XcdBarrier xcd_barrier_post(unsigned* bar, volatile LAS unsigned* st) {
    XcdBarrier b; b.bar = bar; b.x = xb_xcc_id(); b.st = st;
    if (threadIdx.x == 0) (void)xb_add(&bar[XB_XCNT(b.x)], 1u);
    return b;
}
__device__ __forceinline__ void xcd_barrier_complete(unsigned* bar, unsigned x, unsigned& nloc, unsigned& nx) {
    const unsigned G = gridDim.x * gridDim.y * gridDim.z;
    unsigned sum, cnt, mine, sp = 0u;
    for (;;) {
        sum = 0u; cnt = 0u; mine = 0u;
#pragma unroll
        for (unsigned j = 0; j < 16; ++j) { const unsigned c = xb_ld(&bar[XB_XCNT(j)]); sum += c; cnt += (c > 0u) ? 1u : 0u; mine = (j == x) ? c : mine; }
        if (sum == G) break;
        __builtin_amdgcn_s_sleep(1);
        if ((++sp & 255u) == 0u) { if (xb_ld(&bar[XB_TMO])) break; if (sp > XB_SPIN_CAP) { atomicAdd(&bar[XB_TMO], 1u); break; } }
    }
    nloc = mine > 0u ? mine : 1u; nx = cnt > 0u ? cnt : 1u;
}
__device__ __forceinline__ void xcd_barrier(const XcdBarrier& b) {
    asm volatile("s_waitcnt vmcnt(0)" ::: "memory");
    __syncthreads();
    if (threadIdx.x == 0) {
        unsigned* bar = b.bar;
        __builtin_amdgcn_s_waitcnt(0);
        unsigned nloc = b.st[0], nx = b.st[1];
        if (nloc == 0u) { xcd_barrier_complete(bar, b.x, nloc, nx); b.st[0] = nloc; b.st[1] = nx; }
        const unsigned old = xb_add(&bar[XB_XSUB(b.x)], 1u);
        const unsigned gen = old / nloc;
        if (old + 1u == (gen + 1u) * nloc) {
            __builtin_amdgcn_fence(__ATOMIC_RELEASE, "agent");
            asm volatile("s_waitcnt vmcnt(0)" ::: "memory");
            const unsigned og = xb_add(&bar[XB_TOP], 1u);
            const unsigned tg = og / nx;
            if (og + 1u == (tg + 1u) * nx) xb_add(&bar[XB_TOPGEN], 1u);
            else XB_SPIN(xb_ld(&bar[XB_TOPGEN]) == tg, bar);
            __builtin_amdgcn_fence(__ATOMIC_ACQUIRE, "agent");
            xb_add(&bar[XB_XGEN(b.x)], 1u);
            asm volatile("s_waitcnt vmcnt(0)" ::: "memory");
        } else {
            XB_SPIN(xb_ld(&bar[XB_XGEN(b.x)]) == gen, bar);
            __builtin_amdgcn_fence(__ATOMIC_ACQUIRE, "agent");
            asm volatile("s_waitcnt vmcnt(0)" ::: "memory");
        }
    }
    __syncthreads();
}

struct Args { const float* in[27]; float* out; unsigned char* ws; };
__device__ __forceinline__ const Args& kargs() { const Args* p = (const Args*)__builtin_amdgcn_kernarg_segment_ptr(); asm volatile("" : "+s"(p)); return *p; }
struct Ctx {
    LAS const unsigned long long* tab;
    __device__ __forceinline__ unsigned long long get(int i) const { const unsigned long long v = tab[i];
        const unsigned lo = __builtin_amdgcn_readfirstlane((unsigned)v), hi = __builtin_amdgcn_readfirstlane((unsigned)(v >> 32)); return ((unsigned long long)hi << 32) | lo; }
    __device__ __forceinline__ const float* in(int i) const { return (const float*)get(i); }
    __device__ __forceinline__ float* out() const { return (float*)get(27); }
    __device__ __forceinline__ unsigned char* ws() const { return (unsigned char*)get(28); }
};
enum { I_X = 0, I_C, I_ADAW, I_ADAB, I_WIN, I_LQ1, I_LK1, I_LQ2, I_LK2, I_SUBLN, I_KVG, I_WUK, I_WUV, I_WA, I_WB, I_WO, I_LN1G, I_LN1B, I_WGRP, I_BGRP, I_WER, I_BER, I_WEG, I_WEU, I_WED, I_LN2G, I_LN2B };

template <class Epi>
__device__ __forceinline__ void naive_gemm(float* sm, const bf16* A, int lda, const bf16* Bt, int ldb, int M, int N, int K, const Epi& epi, int WID_) {
    const int tid = otid(WID_), ty = tid >> 5, tx = tid & 31;
    float* As = sm; float* Bs = sm + 16 * 132;
    const int ntn = N / 128, ntiles = (M / 128) * ntn;
    for (int tile = blockIdx.x; tile < ntiles; tile += gridDim.x) {
        const int m0 = (tile / ntn) * 128, n0 = (tile % ntn) * 128;
        float acc[8][4];
#pragma unroll
        for (int i = 0; i < 8; ++i)
#pragma unroll
            for (int j = 0; j < 4; ++j) acc[i][j] = 0.f;
        for (int k0 = 0; k0 < K; k0 += 16) {
            {
                const int row = tid >> 2, kq = (tid & 3) * 4;
                const v2u av = *(const v2u*)(A + (size_t)(m0 + row) * lda + k0 + kq);
                As[(kq + 0) * 132 + row] = bflo(av.x); As[(kq + 1) * 132 + row] = bfhi(av.x);
                As[(kq + 2) * 132 + row] = bflo(av.y); As[(kq + 3) * 132 + row] = bfhi(av.y);
                const v2u bv = *(const v2u*)(Bt + (size_t)(n0 + row) * ldb + k0 + kq);
                Bs[(kq + 0) * 132 + row] = bflo(bv.x); Bs[(kq + 1) * 132 + row] = bfhi(bv.x);
                Bs[(kq + 2) * 132 + row] = bflo(bv.y); Bs[(kq + 3) * 132 + row] = bfhi(bv.y);
            }
            __syncthreads();
#pragma unroll
            for (int kk = 0; kk < 16; ++kk) {
                float a[8], b[4];
#pragma unroll
                for (int i = 0; i < 8; ++i) a[i] = As[kk * 132 + ty * 8 + i];
#pragma unroll
                for (int j = 0; j < 4; ++j) b[j] = Bs[kk * 132 + tx * 4 + j];
#pragma unroll
                for (int i = 0; i < 8; ++i)
#pragma unroll
                    for (int j = 0; j < 4; ++j) acc[i][j] = fmaf(a[i], b[j], acc[i][j]);
            }
            __syncthreads();
        }
#pragma unroll
        for (int i = 0; i < 8; ++i)
#pragma unroll
            for (int j = 0; j < 4; ++j) epi(m0 + ty * 8 + i, n0 + tx * 4 + j, acc[i][j]);
    }
}

struct EpiProj {
    bf16* P;
    __device__ __forceinline__ void operator()(int r, int c, float v) const {
        if (c < C_AK || (c >= C_BQ && c < C_BKV)) v *= QSCALE;
        else if (c >= C_G) v = 1.f / (1.f + __expf(-v));
        P[(size_t)r * NP + c] = (bf16)f2bf(v);
    }
};
struct EpiKV { bf16* KV; const float* R; __device__ __forceinline__ void operator()(int r, int c, float v) const { KV[(size_t)r * 1024 + c] = (bf16)f2bf(v * R[r]); } };
struct EpiMixA { bf16* MX; const bf16* P; __device__ __forceinline__ void operator()(int r, int c, float v) const { MX[(size_t)r * 1024 + c] = (bf16)f2bf(v * bf2f(P[(size_t)r * NP + C_G + c])); } };
struct EpiMixB { bf16* MX; const bf16* P; __device__ __forceinline__ void operator()(int r, int c, float v) const { const size_t o = (size_t)r * 1024 + c; MX[o] = (bf16)f2bf(bf2f(MX[o]) + v * bf2f(P[(size_t)r * NP + C_G + 1024 + c])); } };
struct EpiWo { float* out; const float* x; const float* MOD; __device__ __forceinline__ void operator()(int r, int c, float v) const { const size_t o = (size_t)r * 1024 + c; out[o] = ALPHA * x[o] + MOD[(r >> 11) * 6144 + 2048 + c] * v; } };

__device__ __forceinline__ void p0_naive(const Ctx& a, unsigned char* lds, int WID_) {
    unsigned char* ws = a.ws();
    const int tid = otid(WID_); const size_t gt = (size_t)blockIdx.x * 512 + tid, NT = (size_t)gridDim.x * 512;
    bf16* WIN = (bf16*)(ws + WS_WIN); bf16* WA = (bf16*)(ws + WS_WA); bf16* WB = (bf16*)(ws + WS_WB); bf16* WO = (bf16*)(ws + WS_WO);
    bf16* WKV = (bf16*)(ws + WS_WKV); bf16* W1 = (bf16*)(ws + WS_W1); bf16* W2P = (bf16*)(ws + WS_W2P); float* RW = (float*)(ws + WS_RW);
    for (size_t i = gt; i < (size_t)NP * 1024; i += NT) { const int n = (int)(i >> 10), k = (int)(i & 1023); const int o = n < C_PADB ? n : (n >= C_G ? n - 56 : -1);
        WIN[i] = o >= 0 ? (bf16)f2bf(a.in(I_WIN)[(size_t)k * IN_COLS + o]) : (bf16)0; }
    for (size_t i = gt; i < (size_t)1024 * 512; i += NT) { const int n = (int)(i >> 9), k = (int)(i & 511);
        WA[i] = (bf16)f2bf(a.in(I_WA)[(size_t)k * 1024 + n]); WB[i] = (bf16)f2bf(a.in(I_WB)[(size_t)k * 1024 + n]); }
    for (size_t i = gt; i < (size_t)1024 * 1024; i += NT) { const int n = (int)(i >> 10), k = (int)(i & 1023); WO[i] = (bf16)f2bf(a.in(I_WO)[(size_t)k * 1024 + n]); }
    for (size_t i = gt; i < (size_t)1024 * 128; i += NT) { const int n = (int)(i >> 7), r = (int)(i & 127);
        const float g = a.in(I_KVG)[r]; const float w = n < 512 ? a.in(I_WUK)[r * 512 + n] : a.in(I_WUV)[r * 512 + (n - 512)]; WKV[i] = (bf16)f2bf(g * w); }
    for (size_t i = gt; i < (size_t)16 * 512 * 1024; i += NT) { const int k = (int)(i & 1023), row = (int)((i >> 10) & 511), e = (int)(i >> 19);
        const int tile = row >> 8, half = (row >> 7) & 1, j = row & 127, col = tile * 128 + j;
        const float* src = half ? a.in(I_WEU) : a.in(I_WEG); W1[i] = (bf16)f2bf(src[((size_t)e * 1024 + k) * 256 + col]); }
    for (size_t i = gt; i < (size_t)24 * 1024 * 512; i += NT) { const int kk = (int)(i & 511), n = (int)((i >> 9) & 1023), p = (int)(i >> 19);
        const int g = p / 6, pi = p % 6; const int ei = pi < 3 ? 0 : (pi < 5 ? 1 : 2); const int ej = pi < 3 ? pi + 1 : (pi < 5 ? pi - 1 : 3);
        const int e = 4 * g + (kk < 256 ? ei : ej); W2P[i] = (bf16)f2bf(a.in(I_WED)[((size_t)e * 256 + (kk & 255)) * 1024 + n]); }
    for (size_t i = gt; i < (size_t)20 * 1024; i += NT) { const int c = (int)(i >> 10), k = (int)(i & 1023); RW[i] = c < 4 ? a.in(I_WGRP)[k * 4 + c] : a.in(I_WER)[k * 16 + (c - 4)]; }
    {
        float* sc = (float*)lds;
        const int kb = blockIdx.x >> 4, cb = blockIdx.x & 15;
        for (int i = tid; i < 16 * 64; i += 512) { const int b = i >> 6, kk = i & 63; const float cv = a.in(I_C)[b * 1024 + kb * 64 + kk]; sc[i] = cv / (1.f + __expf(-cv)); }
        __syncthreads();
        if (tid < 384) {
            const int j = cb * 384 + tid; float acc[16];
#pragma unroll
            for (int b = 0; b < 16; ++b) acc[b] = 0.f;
            for (int kk = 0; kk < 64; ++kk) { const float w = a.in(I_ADAW)[(size_t)(kb * 64 + kk) * 6144 + j];
#pragma unroll
                for (int b = 0; b < 16; ++b) acc[b] = fmaf(sc[b * 64 + kk], w, acc[b]); }
            float* MP = (float*)(ws + WS_MODPART);
#pragma unroll
            for (int b = 0; b < 16; ++b) MP[((size_t)kb * 16 + b) * 6144 + j] = acc[b];
        }
        __syncthreads();
    }
}
__device__ __forceinline__ float lam_value(const Ctx& a);
__device__ __forceinline__ void tr_item(const float* src, int ld, bf16* dst, int dld, LAS float* scr, int lane, int nvalid, const float* kscale) {
    const int n_ = lane & 31; const float* sp0 = src + (size_t)(lane >> 5) * ld + n_; const bool ok = n_ < nvalid;
    {
        float tv[32]; const float* pp = sp0; const size_t st = (size_t)2 * ld;
#pragma unroll
        for (int i = 0; i < 32; ++i) { tv[i] = ok ? *pp : 0.f; pp += st; asm volatile("" : "+v"(pp)); }
#pragma unroll
        for (int i = 0; i < 32; ++i) { const int kk = 2 * i + (lane >> 5); float v = tv[i]; if (kscale) v *= kscale[kk]; scr[kk * 33 + n_] = v; }
    }
    LDS_WAIT();
    const int c = lane & 7;
#pragma unroll
    for (int j = 0; j < 4; ++j) { const int n = (lane >> 3) + 8 * j; const LAS float* sp = scr + (8 * c) * 33 + n;
        v4u o; o.x = pk2(sp[0 * 33], sp[1 * 33]); o.y = pk2(sp[2 * 33], sp[3 * 33]); o.z = pk2(sp[4 * 33], sp[5 * 33]); o.w = pk2(sp[6 * 33], sp[7 * 33]);
        *(v4u*)(dst + (size_t)n * dld + 8 * c) = o; }
    LDS_WAIT();
}
__device__ __forceinline__ void p0_fast(const Ctx& a, LAS unsigned char* L, int WID_) {
    unsigned char* ws = a.ws();
    const int tid = otid(WID_), lane = tid & 63, wv = tid >> 6;
    bf16* WIN = (bf16*)(ws + WS_WIN); bf16* WA = (bf16*)(ws + WS_WA); bf16* WB = (bf16*)(ws + WS_WB); bf16* WO = (bf16*)(ws + WS_WO);
    bf16* WKV = (bf16*)(ws + WS_WKV); bf16* W1 = (bf16*)(ws + WS_W1); bf16* W2P = (bf16*)(ws + WS_W2P); float* RW = (float*)(ws + WS_RW);
    LAS float* scr = (LAS float*)(L + 8192 + wv * 8448);
    const int gw = blockIdx.x * 8 + wv, NW = gridDim.x * 8;
    constexpr int I_WINn = 16 * 152, I_WAn = 8 * 32, I_WOn = 16 * 32, I_KVn = 2 * 16 * 2, I_W1n = 16 * 2 * 16 * 8, I_W2n = 48 * 4 * 32;
    constexpr int NITEMS = I_WINn + 2 * I_WAn + I_WOn + I_KVn + I_W1n + I_W2n;
    for (int it = gw; it < NITEMS; it += NW) {
        int r = it;
        if (r < I_WINn) { const int kb = r / 152, nb = r % 152, n0 = nb * 32; const int o0 = n0 < C_PADB ? n0 : n0 - 56;
            const int nvalid = nb < 86 ? 32 : (nb == 86 ? 8 : (nb == 87 ? 0 : 32));
            tr_item(a.in(I_WIN) + (size_t)(kb * 64) * IN_COLS + (nb == 87 ? 0 : o0), IN_COLS, WIN + (size_t)n0 * 1024 + kb * 64, 1024, scr, lane, nvalid, nullptr); continue; }
        r -= I_WINn;
        if (r < I_WAn) { const int kb = r / 32, nb = r % 32; tr_item(a.in(I_WA) + (size_t)(kb * 64) * 1024 + nb * 32, 1024, WA + (size_t)(nb * 32) * 1024 + kb * 64, 1024, scr, lane, 32, nullptr); continue; }
        r -= I_WAn;
        if (r < I_WAn) { const int kb = r / 32, nb = r % 32; tr_item(a.in(I_WB) + (size_t)(kb * 64) * 1024 + nb * 32, 1024, WA + (size_t)(nb * 32) * 1024 + 512 + kb * 64, 1024, scr, lane, 32, nullptr); continue; }
        r -= I_WAn;
        if (r < I_WOn) { const int kb = r / 32, nb = r % 32; tr_item(a.in(I_WO) + (size_t)(kb * 64) * 1024 + nb * 32, 1024, WO + (size_t)(nb * 32) * 1024 + kb * 64, 1024, scr, lane, 32, nullptr); continue; }
        r -= I_WOn;
        if (r < I_KVn) { const int which = r / 32, rr = r % 32, kb = rr / 16, nb = rr % 16; const float* src = which ? a.in(I_WUV) : a.in(I_WUK);
            tr_item(src + (size_t)(kb * 64) * 512 + nb * 32, 512, WKV + (size_t)(which * 512 + nb * 32) * 128 + kb * 64, 128, scr, lane, 32, a.in(I_KVG) + kb * 64); continue; }
        r -= I_KVn;
        if (r < I_W1n) { const int e = r / 256, rr = r % 256, half = rr / 128, r2 = rr % 128, kb = r2 / 8, nb = r2 % 8, col = nb * 32; const float* src = half ? a.in(I_WEU) : a.in(I_WEG);
            const int row = (col >> 7) * 256 + half * 128 + (col & 127);
            tr_item(src + ((size_t)e * 1024 + kb * 64) * 256 + col, 256, W1 + ((size_t)e * 512 + row) * 1024 + kb * 64, 1024, scr, lane, 32, nullptr); continue; }
        r -= I_W1n;
        { const int ph = r / 128, r2 = r % 128, kb = r2 / 32, nb = r2 % 32, p = ph >> 1, half = ph & 1; const int g = p / 6, pi = p % 6;
            const int ei = pi < 3 ? 0 : (pi < 5 ? 1 : 2), ej = pi < 3 ? pi + 1 : (pi < 5 ? pi - 1 : 3); const int e = 4 * g + (half ? ej : ei);
            tr_item(a.in(I_WED) + ((size_t)e * 256 + kb * 64) * 1024 + nb * 32, 1024, W2P + ((size_t)p * 1024 + nb * 32) * 512 + half * 256 + kb * 64, 512, scr, lane, 32, nullptr); }
    }
    for (size_t i = (size_t)blockIdx.x * 512 + tid; i < (size_t)20 * 1024; i += (size_t)gridDim.x * 512) { const int c = (int)(i >> 10), k = (int)(i & 1023); RW[i] = c < 4 ? a.in(I_WGRP)[k * 4 + c] : a.in(I_WER)[k * 16 + (c - 4)]; }
    { float* SM = (float*)(ws + WS_SMALL); const int bx = blockIdx.x;
        if (bx < 2) { const int i = bx * 512 + tid; SM[SM_LN1G + i] = a.in(I_LN1G)[i]; SM[SM_LN1B + i] = a.in(I_LN1B)[i]; }
        else if (bx < 4) { const int i = (bx - 2) * 512 + tid; SM[SM_LN2G + i] = a.in(I_LN2G)[i]; SM[SM_LN2B + i] = a.in(I_LN2B)[i]; }
        else if (bx < 16) { const int i = (bx - 4) * 512 + tid; SM[SM_ADAB + i] = a.in(I_ADAB)[i]; }
        else if (bx == 16) { if (tid < 128) SM[SM_SUBLN + tid] = a.in(I_SUBLN)[tid];
            if (tid < 4) SM[SM_BGRP + tid] = a.in(I_BGRP)[tid];
            if (tid < 16) SM[SM_BER + tid] = a.in(I_BER)[tid];
            if (tid == 0) SM[SM_LAM] = lam_value(a); } }
    {
        LAS float* sc = (LAS float*)L;
        const int kb = blockIdx.x >> 4, cb = blockIdx.x & 15;
        for (int i = tid; i < 16 * 64; i += 512) { const int b = i >> 6, kk = i & 63; const float cv = a.in(I_C)[b * 1024 + kb * 64 + kk]; sc[i] = cv / (1.f + __expf(-cv)); }
        __syncthreads();
        if (tid < 384) {
            const int j = cb * 384 + tid; float acc[16];
#pragma unroll
            for (int b = 0; b < 16; ++b) acc[b] = 0.f;
#pragma unroll 8
            for (int kk = 0; kk < 64; ++kk) { const float w = a.in(I_ADAW)[(size_t)(kb * 64 + kk) * 6144 + j];
#pragma unroll
                for (int b = 0; b < 16; ++b) acc[b] = fmaf(sc[b * 64 + kk], w, acc[b]); }
            float* MP = (float*)(ws + WS_MODPART);
#pragma unroll
            for (int b = 0; b < 16; ++b) MP[((size_t)kb * 16 + b) * 6144 + j] = acc[b];
        }
        __syncthreads();
    }
}
__device__ __forceinline__ float mod_sum(const float* MP, const float* adab, int b, int j) {
    float s = adab[j];
#pragma unroll
    for (int ks = 0; ks < 16; ++ks) s += MP[((size_t)ks * 16 + b) * 6144 + j];
    return s;
}
__device__ __forceinline__ void p1_modulate(const Ctx& a, unsigned char* lds, int WID_) {
    unsigned char* ws = a.ws(); const int tid = otid(WID_), blk = blockIdx.x;
    const float* MP = (const float*)(ws + WS_MODPART); float* MOD = (float*)(ws + WS_MOD); bf16* U = (bf16*)(ws + WS_U);
    float* sh = (float*)lds; float* sc = sh + 1024; const float* SMv = (const float*)(ws + WS_SMALL);
    const int b = blk >> 4;
    for (int j = tid; j < 1024; j += 512) { sh[j] = mod_sum(MP, SMv + SM_ADAB, b, j); sc[j] = 1.f + mod_sum(MP, SMv + SM_ADAB, b, 1024 + j); }
    for (int e = tid; e < 384; e += 512) { const int flat = blk * 384 + e; MOD[flat] = mod_sum(MP, SMv + SM_ADAB, flat / 6144, flat % 6144); }
    __syncthreads();
    const f32x4* X = (const f32x4*)(a.in(I_X) + (size_t)blk * 128 * 1024); v2u* Uo = (v2u*)(U + (size_t)blk * 128 * 1024);
    for (int i0 = tid; i0 < 128 * 256; i0 += 512 * 8) {
        f32x4 xv[8];
#pragma unroll
        for (int j = 0; j < 8; ++j) xv[j] = X[i0 + j * 512];
#pragma unroll
        for (int j = 0; j < 8; ++j) { const int i = i0 + j * 512, c4 = (i & 255) * 4; const f32x4 x = xv[j];
            v2u o; o.x = pk2(x.x * sc[c4] + sh[c4], x.y * sc[c4 + 1] + sh[c4 + 1]); o.y = pk2(x.z * sc[c4 + 2] + sh[c4 + 2], x.w * sc[c4 + 3] + sh[c4 + 3]); Uo[i] = o; } }
    __syncthreads();
}
__device__ __forceinline__ void naive_rms_rows(const Ctx& a, int WID_) {
    const bf16* P = (const bf16*)(a.ws() + WS_PROJ); float* R = (float*)(a.ws() + WS_R);
    const int tid = otid(WID_); const int lane = tid & 63, gw = blockIdx.x * 8 + (tid >> 6), NW = gridDim.x * 8;
    for (int t0 = gw; t0 < T; t0 += NW * 8) {
        unsigned wv_[8];
#pragma unroll
        for (int j = 0; j < 8; ++j) wv_[j] = *(const unsigned*)(P + (size_t)(t0 + j * NW) * NP + C_BKV + lane * 2);
#pragma unroll
        for (int j = 0; j < 8; ++j) { const float x0 = bflo(wv_[j]), x1 = bfhi(wv_[j]); const float ss = wave_sum(x0 * x0 + x1 * x1); if (lane == 0) R[t0 + j * NW] = 1.f / sqrtf(ss * (1.f / 128.f) + RMS_EPS); } }
}
__device__ __forceinline__ unsigned sortable(float s) { const unsigned u = __float_as_uint(s); return (u & 0x80000000u) ? ~u : (u | 0x80000000u); }
__device__ __forceinline__ void naive_indexer(const Ctx& a, unsigned char* lds, int WID_) {
    const bf16* P = (const bf16*)(a.ws() + WS_PROJ); unsigned* MASK = (unsigned*)(a.ws() + WS_MASK);
    const int tid = otid(WID_), lane = tid & 63;
    float* qf = (float*)lds; float* wq = (float*)(lds + 2048); unsigned* keys = (unsigned*)(lds + 4096); unsigned* lcnt = (unsigned*)(lds + 12288); unsigned* maskw = (unsigned*)(lds + 12544);
    for (int t = blockIdx.x; t < T; t += gridDim.x) {
        const int b = t >> 11, s = t & 2047, vis = ((s >> 6) + 1) << 6;
        { const bf16* qr = P + (size_t)t * NP + C_IQ; qf[tid] = bf2f(qr[tid]); if (tid < 8) wq[tid] = bf2f(P[(size_t)t * NP + C_IW + tid]); if (tid < 40) lcnt[tid] = 0u; if (tid < 64) maskw[tid] = 0u; }
        __syncthreads();
        for (int k = tid; k < vis; k += 512) {
            const v4u* kr = (const v4u*)(P + (size_t)(b * SEQ + k) * NP + C_IK); float kf[64];
#pragma unroll
            for (int i = 0; i < 8; ++i) { const v4u v = kr[i]; kf[8 * i] = bflo(v.x); kf[8 * i + 1] = bfhi(v.x); kf[8 * i + 2] = bflo(v.y); kf[8 * i + 3] = bfhi(v.y); kf[8 * i + 4] = bflo(v.z); kf[8 * i + 5] = bfhi(v.z); kf[8 * i + 6] = bflo(v.w); kf[8 * i + 7] = bfhi(v.w); }
            float scv = 0.f;
            asm volatile("" ::: "memory");
#pragma unroll 1
            for (int h = 0; h < 8; ++h) { float d = 0.f;
#pragma unroll
                for (int i = 0; i < 64; ++i) d = fmaf(qf[h * 64 + i], kf[i], d);
                scv = fmaf(wq[h], fmaxf(d, 0.f), scv); }
            keys[k] = sortable(scv + 0.f);
        }
        __syncthreads();
        if (vis <= TOPK) { if (tid < 64) MASK[(size_t)t * 64 + tid] = (tid * 32 < vis) ? 0xffffffffu : 0u; }
        else {
            unsigned K = 0u;
            for (int bit = 31; bit >= 0; --bit) {
                const unsigned trial = K | (1u << bit); int c = 0;
                for (int k = tid; k < vis; k += 512) c += keys[k] >= trial ? 1 : 0;
                c = wave_sum_i(c); if (lane == 0 && c) atomicAdd(&lcnt[bit], (unsigned)c);
                __syncthreads();
                if (lcnt[bit] >= (unsigned)TOPK) K = trial;
            }
            { int c = 0; for (int k = tid; k < vis; k += 512) c += keys[k] > K ? 1 : 0; c = wave_sum_i(c); if (lane == 0 && c) atomicAdd(&lcnt[32], (unsigned)c); }
            __syncthreads();
            const int need = TOPK - (int)lcnt[32];
            for (int k = tid; k < vis; k += 512) {
                const unsigned kv = keys[k]; bool sel = kv > K;
                if (kv == K) { int r = 0; for (int j = 0; j < k; ++j) r += keys[j] == K ? 1 : 0; sel = r < need; }
                if (sel) atomicOr(&maskw[k >> 5], 1u << (k & 31));
            }
            __syncthreads();
            if (tid < 64) MASK[(size_t)t * 64 + tid] = maskw[tid];
        }
        __syncthreads();
    }
}
__device__ __forceinline__ float lam_value(const Ctx& a) {
    float s1 = 0.f, s2 = 0.f;
    for (int i = 0; i < 64; ++i) { s1 = fmaf(a.in(I_LQ1)[i], a.in(I_LK1)[i], s1); s2 = fmaf(a.in(I_LQ2)[i], a.in(I_LK2)[i], s2); }
    return expf(s1) - expf(s2) + 0.2f;
}
__device__ __forceinline__ void naive_diffattn(const Ctx& a, unsigned char* lds, int WID_) {
    bf16* P = (bf16*)(a.ws() + WS_PROJ);
    const int tid = otid(WID_), lane = tid & 63, wv = tid >> 6;
    float* lg = (float*)(lds + wv * 16384);
    float* qs = (float*)(lds + 131072 + wv * 512);
    const float lam = lam_value(a);
    const int gw = blockIdx.x * 8 + wv, NW = gridDim.x * 8;
    for (int it = gw; it < T * 4; it += NW) {
        const int t = it >> 2, h = it & 3, b = t >> 11, s = t & 2047, vis = ((s >> 6) + 1) << 6;
        const float sl = SLOPE_A[h] * LOG2E;
        { const bf16* qr = P + (size_t)t * NP + C_AQ + h * 128; qs[lane] = bf2f(qr[lane]); qs[lane + 64] = bf2f(qr[lane + 64]); }
        LDS_WAIT();
        float m0 = -1e30f, m1 = -1e30f;
        for (int k = lane; k < vis; k += 64) {
            asm volatile("" ::: "memory");
            const v4u* kr = (const v4u*)(P + (size_t)(b * SEQ + k) * NP + C_AK + h * 128); float d0 = 0.f, d1 = 0.f;
#pragma unroll
            for (int i = 0; i < 8; ++i) { const v4u v = kr[i]; const float* q = qs + 8 * i;
                d0 = fmaf(q[0], bflo(v.x), d0); d0 = fmaf(q[1], bfhi(v.x), d0); d0 = fmaf(q[2], bflo(v.y), d0); d0 = fmaf(q[3], bfhi(v.y), d0);
                d0 = fmaf(q[4], bflo(v.z), d0); d0 = fmaf(q[5], bfhi(v.z), d0); d0 = fmaf(q[6], bflo(v.w), d0); d0 = fmaf(q[7], bfhi(v.w), d0); }
#pragma unroll
            for (int i = 0; i < 8; ++i) { const v4u v = kr[8 + i]; const float* q = qs + 64 + 8 * i;
                d1 = fmaf(q[0], bflo(v.x), d1); d1 = fmaf(q[1], bfhi(v.x), d1); d1 = fmaf(q[2], bflo(v.y), d1); d1 = fmaf(q[3], bfhi(v.y), d1);
                d1 = fmaf(q[4], bflo(v.z), d1); d1 = fmaf(q[5], bfhi(v.z), d1); d1 = fmaf(q[6], bflo(v.w), d1); d1 = fmaf(q[7], bfhi(v.w), d1); }
            const float bias = sl * fabsf((float)(s - k));
            d0 -= bias; d1 -= bias; lg[k] = d0; lg[2048 + k] = d1; m0 = fmaxf(m0, d0); m1 = fmaxf(m1, d1);
        }
        m0 = wave_max(m0); m1 = wave_max(m1);
        float l0 = 0.f, l1 = 0.f;
        for (int k = lane; k < vis; k += 64) { const float p0 = exp2f(lg[k] - m0), p1 = exp2f(lg[2048 + k] - m1); lg[k] = p0; lg[2048 + k] = p1; l0 += p0; l1 += p1; }
        l0 = wave_sum(l0); l1 = wave_sum(l1);
        LDS_WAIT();
        float o00 = 0.f, o01 = 0.f, o10 = 0.f, o11 = 0.f;
        const bf16* vb = P + (size_t)(b * SEQ) * NP + C_AV + h * 128 + lane;
        for (int k = 0; k < vis; ++k) { const float v0 = bf2f(vb[(size_t)k * NP]), v1 = bf2f(vb[(size_t)k * NP + 64]); const float p0 = lg[k], p1 = lg[2048 + k];
            o00 = fmaf(p0, v0, o00); o01 = fmaf(p0, v1, o01); o10 = fmaf(p1, v0, o10); o11 = fmaf(p1, v1, o11); }
        const float r0 = 1.f / l0, r1 = lam / l1;
        const float y0 = o00 * r0 - o10 * r1, y1 = o01 * r0 - o11 * r1;
        const float ss = wave_sum(y0 * y0 + y1 * y1); const float rn = 0.8f / sqrtf(ss * (1.f / 128.f) + RMS_EPS);
        bf16* yo = P + (size_t)t * NP + C_AQ + h * 128;
        yo[lane] = (bf16)f2bf(y0 * rn * a.in(I_SUBLN)[lane]); yo[lane + 64] = (bf16)f2bf(y1 * rn * a.in(I_SUBLN)[lane + 64]);
        LDS_WAIT();
    }
}
__device__ __forceinline__ void naive_battn(const Ctx& a, unsigned char* lds, int WID_) {
    bf16* P = (bf16*)(a.ws() + WS_PROJ); const bf16* KV = (const bf16*)(a.ws() + WS_KV); const unsigned* MASK = (const unsigned*)(a.ws() + WS_MASK);
    const int tid = otid(WID_), lane = tid & 63, wv = tid >> 6;
    float* lg = (float*)(lds + wv * 16384); float* qs = (float*)(lds + 131072 + wv * 512);
    const int gw = blockIdx.x * 8 + wv, NW = gridDim.x * 8;
    for (int it = gw; it < T * 8; it += NW) {
        const int t = it >> 3, h = it & 7, b = t >> 11, s = t & 2047, vis = ((s >> 6) + 1) << 6;
        const float sl = SLOPE_B[h] * LOG2E;
        qs[lane] = bf2f(P[(size_t)t * NP + C_BQ + h * 64 + lane]);
        LDS_WAIT();
        float m0 = -1e30f;
        for (int k = lane; k < vis; k += 64) {
            const unsigned mw = MASK[(size_t)t * 64 + (k >> 5)]; float d0 = -INFINITY;
            asm volatile("" ::: "memory");
            if ((mw >> (k & 31)) & 1u) {
                const v4u* kr = (const v4u*)(KV + (size_t)(b * SEQ + k) * 1024 + h * 64); d0 = 0.f;
#pragma unroll
                for (int i = 0; i < 8; ++i) { const v4u v = kr[i]; const float* q = qs + 8 * i;
                    d0 = fmaf(q[0], bflo(v.x), d0); d0 = fmaf(q[1], bfhi(v.x), d0); d0 = fmaf(q[2], bflo(v.y), d0); d0 = fmaf(q[3], bfhi(v.y), d0);
                    d0 = fmaf(q[4], bflo(v.z), d0); d0 = fmaf(q[5], bfhi(v.z), d0); d0 = fmaf(q[6], bflo(v.w), d0); d0 = fmaf(q[7], bfhi(v.w), d0); }
                d0 -= sl * fabsf((float)(s - k));
            }
            lg[k] = d0; m0 = fmaxf(m0, d0);
        }
        m0 = wave_max(m0);
        float l0 = 0.f;
        for (int k = lane; k < vis; k += 64) { const float p0 = exp2f(lg[k] - m0); lg[k] = p0; l0 += p0; }
        l0 = wave_sum(l0);
        LDS_WAIT();
        float o = 0.f; const bf16* vb = KV + (size_t)(b * SEQ) * 1024 + 512 + h * 64 + lane;
        for (int k = 0; k < vis; ++k) o = fmaf(lg[k], bf2f(vb[(size_t)k * 1024]), o);
        P[(size_t)t * NP + C_BQ + h * 64 + lane] = (bf16)f2bf(o / l0);
        LDS_WAIT();
    }
}
struct Route { int bucket; float wi, wj; int pad; };
__device__ __forceinline__ float wave_total(float v) {
    DPP_ADD(v, 0xB1); DPP_ADD(v, 0x4E); DPP_ADD(v, 0x141); DPP_ADD(v, 0x140);
    v += __builtin_bit_cast(float, __builtin_amdgcn_update_dpp(0, __builtin_bit_cast(int, v), 0x142, 0xA, 0xF, false));
    v += __builtin_bit_cast(float, __builtin_amdgcn_update_dpp(0, __builtin_bit_cast(int, v), 0x143, 0xC, 0xF, false));
    return __builtin_bit_cast(float, __builtin_amdgcn_readlane(__builtin_bit_cast(int, v), 63));
}
__device__ __forceinline__ void route_decide(const float (&lgt)[20], int& bucket, float& wlo, float& whi) {
    int g = 0; float gm = lgt[0];
#pragma unroll
    for (int c = 1; c < 4; ++c) if (lgt[c] > gm) { gm = lgt[c]; g = c; }
    float gs = 0.f;
#pragma unroll
    for (int c = 0; c < 4; ++c) gs += __expf(lgt[c] - gm);
    const float gp = 1.f / gs;
    float el[4];
#pragma unroll
    for (int e = 0; e < 4; ++e) el[e] = g == 0 ? lgt[4 + e] : (g == 1 ? lgt[8 + e] : (g == 2 ? lgt[12 + e] : lgt[16 + e]));
    int i1 = 0; float v1 = el[0];
#pragma unroll
    for (int e = 1; e < 4; ++e) if (el[e] > v1) { v1 = el[e]; i1 = e; }
    int i2 = -1; float v2 = -INFINITY;
#pragma unroll
    for (int e = 0; e < 4; ++e) if (e != i1 && el[e] > v2) { v2 = el[e]; i2 = e; }
    const float e2 = __expf(v2 - v1); const float w1 = gp / (1.f + e2), w2 = gp * e2 / (1.f + e2);
    const int lo = i1 < i2 ? i1 : i2, hi = i1 < i2 ? i2 : i1; wlo = i1 < i2 ? w1 : w2; whi = i1 < i2 ? w2 : w1;
    const int pi = lo == 0 ? hi - 1 : (lo == 1 ? hi + 1 : 5);
    bucket = g * 6 + pi;
}
__device__ __forceinline__ void p7_ln_route(const Ctx& a, unsigned char* lds, bool dry, int WID_) {
    unsigned char* ws = a.ws(); const int tid = otid(WID_), lane = tid & 63, wv = tid >> 6, blk = blockIdx.x;
    float* rw = (float*)lds; int* cnt = (int*)(lds + 81920); const float* SMv = (const float*)(a.ws() + WS_SMALL);
    const float* RW = (const float*)(ws + WS_RW); const float* MOD = (const float*)(ws + WS_MOD);
    bf16* U2 = (bf16*)(ws + WS_U2); Route* RT = (Route*)(ws + WS_ROUTE2); int* PERM = (int*)(ws + WS_ROUTE2 + 512 * 1024); int* CNT = (int*)(ws + WS_ROUTE2 + 1024 * 1024);
    for (int i = tid; i < 20 * 1024 / 4; i += 512) ((f32x4*)rw)[i] = ((const f32x4*)RW)[i];
    if (tid < 24) cnt[tid] = 0;
    for (int i = blk * 512 + tid; i < MAXSLOT; i += gridDim.x * 512) PERM[i] = -1;
    __syncthreads();
    const int b = blk >> 4;
    const float* sh2 = MOD + b * 6144 + 3072; const float* sc2 = MOD + b * 6144 + 4096;
    float* const outp = a.out();
    float* const xo = dry ? (float*)(ws + 300 * MiB) : outp; bf16* const uo = dry ? (bf16*)(ws + 428 * MiB) : U2;
    const float* const xin = a.in(I_X); const bf16* const brn = (const bf16*)(ws + WS_KV);
    f32x4 nx[2][4]; v2u nb[2][4];
#pragma unroll
    for (int q = 0; q < 2; ++q)
#pragma unroll
        for (int j = 0; j < 4; ++j) { const size_t o_ = (size_t)(blk * 128 + wv * 16 + q) * 1024 + j * 256 + lane * 4; nx[q][j] = *(const f32x4*)(xin + o_); nb[q][j] = *(const v2u*)(brn + o_); }
    for (int i = 0; i < 16; i += 2) {
        const int t0 = blk * 128 + wv * 16 + i;
        f32x4 v[2][4]; float sm[2] = {0.f, 0.f};
#pragma unroll
        for (int q = 0; q < 2; ++q)
#pragma unroll
            for (int j = 0; j < 4; ++j) { const v2u bw = nb[q][j]; v[q][j] = nx[q][j] * ALPHA + (f32x4){bflo(bw.x), bfhi(bw.x), bflo(bw.y), bfhi(bw.y)}; sm[q] += (v[q][j].x + v[q][j].y) + (v[q][j].z + v[q][j].w); }
        if (i + 2 < 16) {
#pragma unroll
            for (int q = 0; q < 2; ++q)
#pragma unroll
                for (int j = 0; j < 4; ++j) { const size_t o_ = (size_t)(t0 + 2 + q) * 1024 + j * 256 + lane * 4; nx[q][j] = *(const f32x4*)(xin + o_); nb[q][j] = *(const v2u*)(brn + o_); } }
        float mean[2], rstd[2];
#pragma unroll
        for (int q = 0; q < 2; ++q) mean[q] = wave_total(sm[q]) * (1.f / 1024.f);
#pragma unroll
        for (int q = 0; q < 2; ++q) { float sq = 0.f;
#pragma unroll
            for (int j = 0; j < 4; ++j) { v[q][j] = v[q][j] - mean[q]; sq += (v[q][j].x * v[q][j].x + v[q][j].y * v[q][j].y) + (v[q][j].z * v[q][j].z + v[q][j].w * v[q][j].w); }
            rstd[q] = 1.f / sqrtf(wave_total(sq) * (1.f / 1024.f) + LN_EPS); }
        f32x4 u[2][4];
#pragma unroll
        for (int j = 0; j < 4; ++j) { const int c = j * 256 + lane * 4; const f32x4 g = *(const f32x4*)(SMv + SM_LN1G + c), bb = *(const f32x4*)(SMv + SM_LN1B + c);
            const f32x4 s2 = *(const f32x4*)(sc2 + c), h2 = *(const f32x4*)(sh2 + c);
#pragma unroll
            for (int q = 0; q < 2; ++q) { const f32x4 x1 = v[q][j] * rstd[q] * g + bb; *(f32x4*)(xo + (size_t)(t0 + q) * 1024 + c) = x1;
                u[q][j] = x1 * (1.f + s2) + h2;
                v2u o; o.x = pk2(u[q][j].x, u[q][j].y); o.y = pk2(u[q][j].z, u[q][j].w); *(v2u*)(uo + (size_t)(t0 + q) * 1024 + c) = o; } }
        float lg0[20], lg1[20];
#pragma unroll
        for (int c = 0; c < 20; ++c) { float p0 = 0.f, p1 = 0.f;
#pragma unroll
            for (int j = 0; j < 4; ++j) { const f32x4 w = *(const f32x4*)(rw + c * 1024 + j * 256 + lane * 4);
                p0 += (u[0][j].x * w.x + u[0][j].y * w.y) + (u[0][j].z * w.z + u[0][j].w * w.w); p1 += (u[1][j].x * w.x + u[1][j].y * w.y) + (u[1][j].z * w.z + u[1][j].w * w.w); }
            const float bias = c < 4 ? SMv[SM_BGRP + c] : SMv[SM_BER + (c - 4)];
            lg0[c] = wave_total(p0) + bias; lg1[c] = wave_total(p1) + bias; }
        int bk0, bk1; float wl0, wh0, wl1, wh1;
        route_decide(lg0, bk0, wl0, wh0); route_decide(lg1, bk1, wl1, wh1);
        if (lane == 0 && !dry) { Route r; r.bucket = bk0; r.wi = wl0; r.wj = wh0; r.pad = 0; RT[t0] = r; atomicAdd(&cnt[bk0], 1);
            r.bucket = bk1; r.wi = wl1; r.wj = wh1; RT[t0 + 1] = r; atomicAdd(&cnt[bk1], 1); }
    }
    __syncthreads();
    if (tid < 24 && !dry) CNT[blk * 24 + tid] = cnt[tid];
    __syncthreads();
}
__device__ __forceinline__ void p8_sort(const Ctx& a, unsigned char* lds, int WID_) {
    unsigned char* ws = a.ws(); const int tid = otid(WID_), blk = blockIdx.x;
    const Route* RT = (const Route*)(ws + WS_ROUTE2); int* PERM = (int*)(ws + WS_ROUTE2 + 512 * 1024); const int* CNT = (const int*)(ws + WS_ROUTE2 + 1024 * 1024);
    int* BASES = (int*)(ws + WS_ROUTE2 + 1024 * 1024 + 32768); float* SLOTW = (float*)(ws + WS_ROUTE2 + 1280 * 1024);
    const bf16* U2 = (const bf16*)(ws + WS_U2); bf16* XS = (bf16*)(ws + WS_XS);
    int* tot = (int*)lds; int* pre = tot + 32; int* base = pre + 32; int* bk = base + 32; int* slot = bk + 128;
    if (tid < 64) tot[tid] = 0;
    __syncthreads();
    if (tid < 384) { const int p = tid >> 4, sg = tid & 15; int sa = 0, sp = 0;
#pragma unroll
        for (int i = 0; i < 16; ++i) { const int bb = sg * 16 + i; const int c = CNT[bb * 24 + p]; sa += c; sp += bb < blk ? c : 0; }
        atomicAdd(&tot[p], sa); atomicAdd(&pre[p], sp); }
    __syncthreads();
    if (tid == 0) { int acc = 0; for (int p = 0; p < 24; ++p) { base[p] = acc; acc += (tot[p] + 255) & ~255; } base[24] = acc;
        if (blk == 0) { for (int p = 0; p <= 24; ++p) BASES[p] = base[p]; } }
    if (tid < 128) bk[tid] = RT[blk * 128 + tid].bucket;
    __syncthreads();
    if (tid < 128) { const int p = bk[tid]; int r = 0; for (int j = 0; j < tid; ++j) r += bk[j] == p ? 1 : 0; const int s = base[p] + pre[p] + r; slot[tid] = s;
        const int t = blk * 128 + tid; PERM[s] = t; SLOTW[2 * s] = RT[t].wi; SLOTW[2 * s + 1] = RT[t].wj; }
    __syncthreads();
    __syncthreads();
}
__device__ __forceinline__ int bucket_of_slot(const int* BASES, int s) { int p = 0; for (int q = 1; q < 24; ++q) if (s >= BASES[q]) p = q; return p; }
__device__ __forceinline__ void pair_experts(int p, int& ei, int& ej) { const int g = p / 6, pi = p % 6; ei = 4 * g + (pi < 3 ? 0 : (pi < 5 ? 1 : 2)); ej = 4 * g + (pi < 3 ? pi + 1 : (pi < 5 ? pi - 1 : 3)); }
__device__ __forceinline__ void naive_moe1(const Ctx& a, unsigned char* lds, int WID_) {
    unsigned char* ws = a.ws(); const int tid = otid(WID_);
    const int* PERM = (const int*)(ws + WS_ROUTE2 + 512 * 1024); const int* BASES = (const int*)(ws + WS_ROUTE2 + 1024 * 1024 + 32768); const float* SLOTW = (const float*)(ws + WS_ROUTE2 + 1280 * 1024);
    const bf16* XS = (const bf16*)(ws + WS_XS); const bf16* W1 = (const bf16*)(ws + WS_W1); bf16* H = (bf16*)(ws + WS_H);
    float* xs = (float*)lds; const int nslot = BASES[24];
    for (int s = blockIdx.x; s < nslot; s += gridDim.x) {
        if (PERM[s] < 0) continue;
        const int p = bucket_of_slot(BASES, s); int ei, ej; pair_experts(p, ei, ej);
        __syncthreads();
        xs[tid] = bf2f(XS[(size_t)s * 1024 + tid]); xs[tid + 512] = bf2f(XS[(size_t)s * 1024 + 512 + tid]);
        __syncthreads();
        const int m = tid >> 8, c = tid & 255, e = m ? ej : ei; const int grow = (c >> 7) * 256 + (c & 127);
        const v4u* wg = (const v4u*)(W1 + ((size_t)e * 512 + grow) * 1024); const v4u* wu = (const v4u*)(W1 + ((size_t)e * 512 + grow + 128) * 1024);
        float dg = 0.f, du = 0.f;
        for (int i = 0; i < 128; ++i) { const v4u g = wg[i], u = wu[i]; const float* x = xs + 8 * i;
            dg = fmaf(x[0], bflo(g.x), dg); dg = fmaf(x[1], bfhi(g.x), dg); dg = fmaf(x[2], bflo(g.y), dg); dg = fmaf(x[3], bfhi(g.y), dg);
            dg = fmaf(x[4], bflo(g.z), dg); dg = fmaf(x[5], bfhi(g.z), dg); dg = fmaf(x[6], bflo(g.w), dg); dg = fmaf(x[7], bfhi(g.w), dg);
            du = fmaf(x[0], bflo(u.x), du); du = fmaf(x[1], bfhi(u.x), du); du = fmaf(x[2], bflo(u.y), du); du = fmaf(x[3], bfhi(u.y), du);
            du = fmaf(x[4], bflo(u.z), du); du = fmaf(x[5], bfhi(u.z), du); du = fmaf(x[6], bflo(u.w), du); du = fmaf(x[7], bfhi(u.w), du); }
        const float hv = dg / (1.f + __expf(-dg)) * du * SLOTW[2 * s + m];
        H[(size_t)s * 512 + tid] = (bf16)f2bf(hv);
    }
    __syncthreads();
}
__device__ __forceinline__ void naive_moe2(const Ctx& a, unsigned char* lds, int WID_) {
    unsigned char* ws = a.ws(); const int tid = otid(WID_);
    const int* PERM = (const int*)(ws + WS_ROUTE2 + 512 * 1024); const int* BASES = (const int*)(ws + WS_ROUTE2 + 1024 * 1024 + 32768);
    const bf16* W2P = (const bf16*)(ws + WS_W2P); const bf16* H = (const bf16*)(ws + WS_H); const float* MOD = (const float*)(ws + WS_MOD);
    float* hs = (float*)lds; const int nslot = BASES[24];
    for (int s = blockIdx.x; s < nslot; s += gridDim.x) {
        const int t = PERM[s]; if (t < 0) continue;
        const int p = bucket_of_slot(BASES, s);
        __syncthreads();
        hs[tid] = bf2f(H[(size_t)s * 512 + tid]);
        __syncthreads();
        for (int j = tid; j < 1024; j += 512) {
            const v4u* w = (const v4u*)(W2P + ((size_t)p * 1024 + j) * 512); float y = 0.f;
            for (int i = 0; i < 64; ++i) { const v4u g = w[i]; const float* x = hs + 8 * i;
                y = fmaf(x[0], bflo(g.x), y); y = fmaf(x[1], bfhi(g.x), y); y = fmaf(x[2], bflo(g.y), y); y = fmaf(x[3], bfhi(g.y), y);
                y = fmaf(x[4], bflo(g.z), y); y = fmaf(x[5], bfhi(g.z), y); y = fmaf(x[6], bflo(g.w), y); y = fmaf(x[7], bfhi(g.w), y); }
            const size_t o = (size_t)t * 1024 + j; a.out()[o] = ALPHA * a.out()[o] + MOD[(t >> 11) * 6144 + 5120 + j] * y;
        }
    }
    __syncthreads();
}
__device__ __forceinline__ void p11_ln(const Ctx& a, bool dry, int WID_) {
    const float* SMv = (const float*)(a.ws() + WS_SMALL);
    const int tid = otid(WID_); const int lane = tid & 63, gw = blockIdx.x * 8 + (tid >> 6), NW = gridDim.x * 8;
    float* const outp = a.out(); const bf16* const brn = (const bf16*)(a.ws() + WS_U);
    f32x4 nx[4]; v2u nb[4];
#pragma unroll
    for (int j = 0; j < 4; ++j) { const size_t o_ = (size_t)gw * 1024 + j * 256 + lane * 4; nx[j] = *(const f32x4*)(outp + o_); nb[j] = *(const v2u*)(brn + o_); }
    for (int t = gw; t < T; t += NW) {
        float* row = outp + (size_t)t * 1024; f32x4 v[4]; float sm = 0.f;
#pragma unroll
        for (int j = 0; j < 4; ++j) { const v2u bw = nb[j]; v[j] = nx[j] * ALPHA + (f32x4){bflo(bw.x), bfhi(bw.x), bflo(bw.y), bfhi(bw.y)}; sm += (v[j].x + v[j].y) + (v[j].z + v[j].w); }
        if (t + NW < T) {
#pragma unroll
            for (int j = 0; j < 4; ++j) { const size_t o_ = (size_t)(t + NW) * 1024 + j * 256 + lane * 4; nx[j] = *(const f32x4*)(outp + o_); nb[j] = *(const v2u*)(brn + o_); } }
        const float mean = wave_sum(sm) * (1.f / 1024.f); float sq = 0.f;
#pragma unroll
        for (int j = 0; j < 4; ++j) { v[j] = v[j] - mean; sq += (v[j].x * v[j].x + v[j].y * v[j].y) + (v[j].z * v[j].z + v[j].w * v[j].w); }
        const float rstd = 1.f / sqrtf(wave_sum(sq) * (1.f / 1024.f) + LN_EPS);
#pragma unroll
        for (int j = 0; j < 4; ++j) { const int c = j * 256 + lane * 4; const f32x4 g = *(const f32x4*)(SMv + SM_LN2G + c), bb = *(const f32x4*)(SMv + SM_LN2B + c); *(f32x4*)((dry ? (float*)(a.ws() + 60 * MiB) + (size_t)t * 1024 : row) + c) = v[j] * rstd * g + bb; }
    }
}

namespace pg8 {
#define PG8_LAS __attribute__((address_space(3)))
typedef unsigned short bf16_t;
typedef short bf16x8 __attribute__((ext_vector_type(8)));
typedef float f32x4 __attribute__((ext_vector_type(4)));
typedef unsigned u32x4 __attribute__((ext_vector_type(4)));
constexpr int BM = 256, BK = 64, HALF = 128, HTB = HALF * BK * 2  , STAGE_BYTES = 8 * HTB, NXCD = 8, WGM = 8;

__host__ __device__ __forceinline__ int lds_byte(int r, int c) { const int st = (r >> 4) * 2 + (c >> 5), rr = r & 15, cc = c & 31, ob = rr * 64 + cc * 2; return st * 1024 + (ob ^ (((ob >> 9) & 1) << 5)); }
__host__ __device__ __forceinline__ void stage_rc(int b, int& R, int& C) { const int st = b / 1024, sb = b % 1024, swz = sb ^ (((sb >> 9) & 1) << 5); R = (st >> 1) * 16 + swz / 64; C = (st & 1) * 32 + (swz % 64) / 2; }
__host__ __device__ __forceinline__ int perm32(int rho) { const int n = rho >> 4, i = rho & 15; return 8 * (i >> 2) + 4 * n + (i & 3); }

struct Unit { int pm, pn; };
struct Gemm { const bf16_t* A; const bf16_t* Bt; int M, N, K, lda, ldb; const int* rowidx; };

struct StaticOrder {
    int nM, nN, nwg, G, c;
    __host__ __device__ void init(int M, int N, int G_, int c_) { nM = M / BM; nN = N / BM; nwg = nM * nN; G = G_; c = c_; }
    __host__ __device__ bool next(int i, Unit& u) const {
        const long L = (long)i * G + c; if (L >= nwg) return false;
        int wgid = (int)L; { const int q = nwg / NXCD, r = nwg % NXCD, xcd = wgid % NXCD, off = wgid / NXCD; wgid = (xcd < r ? xcd * (q + 1) : r * (q + 1) + (xcd - r) * q) + off; }
        const int nig = WGM * nN, gid = wgid / nig, fm = gid * WGM, gsz = (nM - fm) < WGM ? (nM - fm) : WGM;
        u.pm = fm + ((wgid % nig) % gsz); u.pn = (wgid % nig) / gsz; return true;
    }
    __device__ __forceinline__ void a_ready(const Unit&) const {}
    __device__ __forceinline__ void done(const Unit&) const {}
    __device__ __forceinline__ const char* bbase(const Gemm& g, const Unit& u) const { return (const char*)g.Bt + (size_t)u.pn * ((size_t)BM * g.ldb * 2); }
};

template <class Epi, class Sched, bool ALIGN_EPI, bool SP2, int KK, int LDA, int LDB, int AJT = 0, int AJB = 0, bool GATHER = false>
__device__ __forceinline__ void gemm_phase(PG8_LAS unsigned char* lds, const Gemm g, const Sched& S, const Epi& E, int WID_) {
    int tid_ = otid(WID_);
    const int tid = tid_, wid = __builtin_amdgcn_readfirstlane(tid >> 6), lane = tid & 63, wr = wid >> 2, wc = wid & 3, fr = lane & 15, fq = lane >> 4;
    constexpr int K = KK, nt = K / BK;
    unsigned voffA[2], voffB[2];
#pragma unroll
    for (int i = 0; i < 2; ++i) { int R, C; stage_rc(tid * 16 + i * 8192, R, C); const int Rb = Epi::PERM ? ((R & ~31) + perm32(R & 31)) : R;
        voffA[i] = (unsigned)(R * LDA + C) * 2u; voffB[i] = (unsigned)(Rb * LDB + C) * 2u; }
    static_assert(SP2 || !GATHER, "gather is wired into the SP2 loop only");
    unsigned vA[2][2];
#define PG8_GOFF(dst, pm_) do { _Pragma("unroll") for (int h_ = 0; h_ < 2; ++h_) _Pragma("unroll") for (int i_ = 0; i_ < 2; ++i_) { int R_, C_; stage_rc(tid * 16 + i_ * 8192, R_, C_); \
        int r_ = g.rowidx[(pm_) * BM + h_ * HALF + R_]; r_ = r_ < 0 ? 0 : r_; dst[h_][i_] = (unsigned)(r_ * LDA + C_) * 2u; } } while (0)
    constexpr size_t kstep = (size_t)(BK * 2);
    constexpr size_t hstepA = (size_t)HALF * LDA * 2, hstepB = (size_t)HALF * LDB * 2;
    constexpr size_t tstepA = 2 * hstepA;
    const unsigned ldsw = (unsigned)wid * 1024u;
    const int aoff = lds_byte(wr * 64 + fr, fq * 8), boff = lds_byte(wc * 32 + fr, fq * 8);
#define PG8_SA(b, h) (((b) * 2 + (h)) * HTB)
#define PG8_SB(b, h) ((4 + (b) * 2 + (h)) * HTB)
#define PG8_STAGE(bufoff, gbase, voff) do { _Pragma("unroll") for (int _i = 0; _i < 2; ++_i) \
        __builtin_amdgcn_global_load_lds((const unsigned*)((const char*)(gbase) + (voff)[_i]), (PG8_LAS unsigned*)(lds + (bufoff) + ldsw + _i * 8192), 16, 0, 0); } while (0)
#define PG8_STAGE_A(bufoff, gbase, h, NX) do { if constexpr (GATHER) { PG8_STAGE(bufoff, gbase, vA[h]); } \
        else PG8_STAGE(bufoff, (gbase) + (h) * hstepA, voffA); } while (0)
#define PG8_LDA(dst, b, h) do { _Pragma("unroll") for (int m = 0; m < 4; ++m) _Pragma("unroll") for (int k = 0; k < 2; ++k) dst[m][k] = *(const PG8_LAS bf16x8*)(lds + PG8_SA(b, h) + aoff + m * 2048 + k * 1024); } while (0)
#define PG8_LDB(dst, b, h) do { _Pragma("unroll") for (int n = 0; n < 2; ++n) _Pragma("unroll") for (int k = 0; k < 2; ++k) dst[n][k] = *(const PG8_LAS bf16x8*)(lds + PG8_SB(b, h) + boff + n * 2048 + k * 1024); } while (0)
#define PG8_MMA(ai, bj, At, Bt) do { __builtin_amdgcn_s_setprio(1); _Pragma("unroll") for (int m = 0; m < 4; ++m) _Pragma("unroll") for (int n = 0; n < 2; ++n) _Pragma("unroll") for (int k = 0; k < 2; ++k) \
        acc[ai][bj][m][n] = __builtin_amdgcn_mfma_f32_16x16x32_bf16(Bt[n][k], At[m][k], acc[ai][bj][m][n], 0, 0, 0); __builtin_amdgcn_s_setprio(0); } while (0)
#define PG8_WAIT_V(n) asm volatile("s_waitcnt vmcnt(" #n ")" ::: "memory")
#define PG8_WAIT_L(n) asm volatile("s_waitcnt lgkmcnt(" #n ")" ::: "memory")
#define PG8_BAR __builtin_amdgcn_s_barrier()
#define PG8_SCHED __builtin_amdgcn_sched_barrier(0)
    Unit cur, nxt; int ui = 0;
    if (!S.next(0, cur)) return;
    f32x4 acc[2][2][4][2];
#pragma unroll
    for (int a = 0; a < 2; ++a)
#pragma unroll
        for (int b = 0; b < 2; ++b)
#pragma unroll
            for (int m = 0; m < 4; ++m)
#pragma unroll
                for (int n = 0; n < 2; ++n) acc[a][b][m][n] = (f32x4){0.f, 0.f, 0.f, 0.f};
    bf16x8 At[4][2], B0[2][2], B1[2][2];
    const char* cA = GATHER ? (const char*)g.A : (const char*)g.A + (size_t)cur.pm * tstepA; const char* cB = S.bbase(g, cur);
    if constexpr (GATHER) { PG8_GOFF(vA, cur.pm); }
    S.a_ready(cur);
    if constexpr (SP2) {
        PG8_STAGE(PG8_SB(0, 0), cB, voffB); PG8_STAGE(PG8_SB(0, 1), cB + hstepB, voffB); PG8_STAGE_A(PG8_SA(0, 0), cA, 0, false); PG8_STAGE_A(PG8_SA(0, 1), cA, 1, false);
        if (wr == 1) PG8_BAR;
        PG8_WAIT_V(2); PG8_BAR;
        PG8_STAGE(PG8_SB(1, 0), cB + kstep, voffB); PG8_STAGE_A(PG8_SA(1, 0), cA + kstep, 0, false); PG8_STAGE(PG8_SB(1, 1), cB + hstepB + kstep, voffB);
        PG8_WAIT_V(6); PG8_BAR;
    } else {
        PG8_STAGE(PG8_SB(0, 0), cB, voffB); PG8_STAGE(PG8_SA(0, 0), cA, voffA); PG8_STAGE(PG8_SB(0, 1), cB + hstepB, voffB); PG8_STAGE(PG8_SA(0, 1), cA + hstepA, voffA);
        if (wr == 1) PG8_BAR;
        PG8_WAIT_V(4); PG8_BAR;
        PG8_STAGE(PG8_SB(1, 0), cB + kstep, voffB); PG8_STAGE(PG8_SA(1, 0), cA + kstep, voffA); PG8_STAGE(PG8_SB(1, 1), cB + hstepB + kstep, voffB);
        PG8_WAIT_V(6); PG8_BAR;
    }
    for (;;) {
        const bool has_next = S.next(ui + 1, nxt);
        const char* nA = GATHER ? cA : (has_next ? (const char*)g.A + (size_t)nxt.pm * tstepA : cA); const char* nB = has_next ? S.bbase(g, nxt) : cB;
        for (int t = 0; t < nt; t += 2) {
            const bool last = (t == nt - 2);
            if constexpr (AJT != 0) { if (t == AJT) E.mid(acc, cur, wr, wc, fr, fq); }
#define PG8_AOFF(kt) ((size_t)(kt) * kstep + ((AJT != 0 && (kt) >= AJT) ? (size_t)AJB : (size_t)0))
            const char* a1 = cA + PG8_AOFF(t + 1);
            const char* a2 = last ? nA : cA + PG8_AOFF(t + 2); const char* b2 = last ? nB : cB + (size_t)(t + 2) * kstep;
            const char* a3 = last ? nA + kstep : cA + PG8_AOFF(t + 3); const char* b3 = b2 + kstep;
#undef PG8_AOFF
            if (last && has_next) S.a_ready(nxt);
            if constexpr (SP2) {
            PG8_LDB(B0, 0, 0); PG8_LDB(B1, 0, 1); PG8_SCHED; PG8_LDA(At, 0, 0); PG8_STAGE_A(PG8_SA(1, 1), a1, 1, false);
            if constexpr (GATHER) { if (last && has_next) PG8_GOFF(vA, nxt.pm); }
            PG8_WAIT_V(8); PG8_WAIT_L(0); PG8_BAR; PG8_MMA(0, 0, At, B0); PG8_MMA(0, 1, At, B1); PG8_BAR; PG8_SCHED;
            PG8_LDA(At, 0, 1); PG8_STAGE(PG8_SB(0, 0), b2, voffB); PG8_STAGE(PG8_SB(0, 1), b2 + hstepB, voffB); PG8_STAGE_A(PG8_SA(0, 0), a2, 0, last);
            PG8_WAIT_V(8); PG8_WAIT_L(0); PG8_BAR; PG8_MMA(1, 0, At, B0); PG8_MMA(1, 1, At, B1); PG8_BAR; PG8_SCHED;
            PG8_LDB(B0, 1, 0); PG8_LDB(B1, 1, 1); PG8_SCHED; PG8_LDA(At, 1, 0); PG8_STAGE_A(PG8_SA(0, 1), a2, 1, last);
            PG8_WAIT_V(8); PG8_WAIT_L(0); PG8_BAR; PG8_MMA(0, 0, At, B0); PG8_MMA(0, 1, At, B1); PG8_BAR; PG8_SCHED;
            PG8_LDA(At, 1, 1); PG8_STAGE(PG8_SB(1, 0), b3, voffB); PG8_STAGE(PG8_SB(1, 1), b3 + hstepB, voffB); PG8_STAGE_A(PG8_SA(1, 0), a3, 0, last);
            PG8_WAIT_V(8); PG8_WAIT_L(0); PG8_BAR; PG8_MMA(1, 0, At, B0); PG8_MMA(1, 1, At, B1); PG8_BAR; PG8_SCHED;
            } else {
            PG8_LDB(B0, 0, 0); PG8_SCHED; PG8_LDA(At, 0, 0); PG8_STAGE(PG8_SA(1, 1), a1 + hstepA, voffA);
            PG8_WAIT_L(8); PG8_BAR; PG8_WAIT_L(0); PG8_MMA(0, 0, At, B0); PG8_BAR; PG8_SCHED;
            PG8_LDB(B1, 0, 1); PG8_STAGE(PG8_SB(0, 0), b2, voffB);
            PG8_BAR; PG8_WAIT_L(0); PG8_MMA(0, 1, At, B1); PG8_BAR;
            PG8_LDA(At, 0, 1); PG8_STAGE(PG8_SA(0, 0), a2, voffA);
            PG8_BAR; PG8_WAIT_L(0); PG8_MMA(1, 0, At, B0); PG8_BAR; PG8_SCHED;
            PG8_STAGE(PG8_SB(0, 1), b2 + hstepB, voffB);
            PG8_WAIT_V(6); PG8_BAR; PG8_MMA(1, 1, At, B1); PG8_BAR;
            PG8_LDB(B0, 1, 0); PG8_SCHED; PG8_LDA(At, 1, 0); PG8_STAGE(PG8_SA(0, 1), a2 + hstepA, voffA);
            PG8_WAIT_L(8); PG8_BAR; PG8_WAIT_L(0); PG8_MMA(0, 0, At, B0); PG8_BAR; PG8_SCHED;
            PG8_LDB(B1, 1, 1); PG8_STAGE(PG8_SB(1, 0), b3, voffB);
            PG8_BAR; PG8_WAIT_L(0); PG8_MMA(0, 1, At, B1); PG8_BAR;
            PG8_LDA(At, 1, 1); PG8_STAGE(PG8_SA(1, 0), a3, voffA);
            PG8_BAR; PG8_WAIT_L(0); PG8_MMA(1, 0, At, B0); PG8_BAR; PG8_SCHED;
            PG8_STAGE(PG8_SB(1, 1), b3 + hstepB, voffB);
            PG8_WAIT_V(6); PG8_BAR; PG8_MMA(1, 1, At, B1); PG8_BAR;
            }
        }
        if constexpr (ALIGN_EPI) { if (wr == 0) PG8_BAR; }
        if constexpr (!Epi::AFTER_DRAIN) { E(acc, cur, wr, wc, fr, fq); S.done(cur); }
        if (!has_next) break;
#pragma unroll
        for (int a = 0; a < 2; ++a)
#pragma unroll
            for (int b = 0; b < 2; ++b)
#pragma unroll
                for (int m = 0; m < 4; ++m)
#pragma unroll
                    for (int n = 0; n < 2; ++n) acc[a][b][m][n] = (f32x4){0.f, 0.f, 0.f, 0.f};
        cur = nxt; cA = nA; cB = nB; ++ui;
        if constexpr (ALIGN_EPI) { if (wr == 1) PG8_BAR; }
    }
    PG8_WAIT_V(0);
    if constexpr (!ALIGN_EPI) { if (wr == 0) PG8_BAR; }
    PG8_BAR;
    if constexpr (Epi::AFTER_DRAIN) { E.fused(acc, cur, wr, wc, fr, fq, lds, wid, lane); S.done(cur); }
#undef PG8_SA
#undef PG8_SB
#undef PG8_STAGE
#undef PG8_STAGE_A
#undef PG8_GOFF
#undef PG8_LDA
#undef PG8_LDB
#undef PG8_MMA
#undef PG8_WAIT_V
#undef PG8_WAIT_L
#undef PG8_BAR
#undef PG8_SCHED
}

__device__ __forceinline__ unsigned cvt_pk_bf16(float lo, float hi) { unsigned r; asm volatile("v_cvt_pk_bf16_f32 %0, %1, %2" : "=v"(r) : "v"(lo), "v"(hi)); return r; }
__device__ __forceinline__ float blo(unsigned w) { return __uint_as_float(w << 16); }
__device__ __forceinline__ float bhi(unsigned w) { return __uint_as_float(w & 0xffff0000u); }
__device__ __forceinline__ float sigm(float v) { return __builtin_amdgcn_rcpf(1.f + __builtin_amdgcn_exp2f(-1.4426950408889634f * v)); }
struct EpiProjF {
    static constexpr bool PERM = true, AFTER_DRAIN = false;
    bf16_t* O; int ldc; float qs; float* R; PG8_LAS float* xs;
    __device__ __forceinline__ void operator()(const f32x4 (&acc)[2][2][4][2], const Unit& u, int wr, int wc, int fr, int fq) const {
        const int row0 = u.pm * BM + wr * 64 + fr, col0 = u.pn * BM + wc * 32 + 8 * fq;
        const int mode = (u.pn < 2 || u.pn == 6 || u.pn == 7) ? 1 : (u.pn >= 11 ? 2 : 0);
        if (u.pn == 8) {
#pragma unroll
            for (int ai = 0; ai < 2; ++ai)
#pragma unroll
                for (int m = 0; m < 4; ++m) { const f32x4 a0 = acc[ai][0][m][0], a1 = acc[ai][0][m][1];
                    float ss = (a0[0] * a0[0] + a0[1] * a0[1]) + (a0[2] * a0[2] + a0[3] * a0[3]) + (a1[0] * a1[0] + a1[1] * a1[1]) + (a1[2] * a1[2] + a1[3] * a1[3]);
                    ss += __shfl_xor(ss, 16); ss += __shfl_xor(ss, 32);
                    if (fq == 0) xs[(ai * HALF + wr * 64 + m * 16 + fr) * 4 + wc] = ss; }
            asm volatile("s_waitcnt lgkmcnt(0)" ::: "memory"); __builtin_amdgcn_s_barrier(); asm volatile("" ::: "memory");
            const int tl = (wr * 4 + wc) * 64 + fq * 16 + fr;
            if (tl < BM) { const float sm = (xs[tl * 4] + xs[tl * 4 + 1]) + (xs[tl * 4 + 2] + xs[tl * 4 + 3]); R[u.pm * BM + tl] = __builtin_amdgcn_rsqf(sm * (1.f / 128.f) + 1e-5f); }
        }
#pragma unroll
        for (int ai = 0; ai < 2; ++ai)
#pragma unroll
            for (int m = 0; m < 4; ++m) { bf16_t* rowp = O + (size_t)(row0 + ai * HALF + m * 16) * ldc + col0;
#pragma unroll
                for (int bj = 0; bj < 2; ++bj) { f32x4 v0 = acc[ai][bj][m][0], v1 = acc[ai][bj][m][1];
                    if (mode == 1) { v0 = v0 * qs; v1 = v1 * qs; }
                    else if (mode == 2) { v0 = (f32x4){sigm(v0[0]), sigm(v0[1]), sigm(v0[2]), sigm(v0[3])}; v1 = (f32x4){sigm(v1[0]), sigm(v1[1]), sigm(v1[2]), sigm(v1[3])}; }
                    u32x4 w; w.x = cvt_pk_bf16(v0[0], v0[1]); w.y = cvt_pk_bf16(v0[2], v0[3]); w.z = cvt_pk_bf16(v1[0], v1[1]); w.w = cvt_pk_bf16(v1[2], v1[3]);
                    *(u32x4*)(rowp + bj * HALF) = w; } }
    }
};
struct EpiRowScale {
    static constexpr bool PERM = true, AFTER_DRAIN = false;
    bf16_t* O; int ldc; const float* rs;
    __device__ __forceinline__ void operator()(const f32x4 (&acc)[2][2][4][2], const Unit& u, int wr, int wc, int fr, int fq) const {
        const int row0 = u.pm * BM + wr * 64 + fr, col0 = u.pn * BM + wc * 32 + 8 * fq;
#pragma unroll
        for (int ai = 0; ai < 2; ++ai)
#pragma unroll
            for (int m = 0; m < 4; ++m) { const int r = row0 + ai * HALF + m * 16; const float s = rs[r]; bf16_t* rowp = O + (size_t)r * ldc + col0;
#pragma unroll
                for (int bj = 0; bj < 2; ++bj) { const f32x4 v0 = acc[ai][bj][m][0] * s, v1 = acc[ai][bj][m][1] * s;
                    u32x4 w; w.x = cvt_pk_bf16(v0[0], v0[1]); w.y = cvt_pk_bf16(v0[2], v0[3]); w.z = cvt_pk_bf16(v1[0], v1[1]); w.w = cvt_pk_bf16(v1[2], v1[3]);
                    *(u32x4*)(rowp + bj * HALF) = w; } }
    }
};
template <bool FIRST> struct EpiMix {
    static constexpr bool PERM = true, AFTER_DRAIN = false;
    bf16_t* O; int ldc; const bf16_t* G; int ldg;
    __device__ __forceinline__ void operator()(const f32x4 (&acc)[2][2][4][2], const Unit& u, int wr, int wc, int fr, int fq) const {
        const int row0 = u.pm * BM + wr * 64 + fr, col0 = u.pn * BM + wc * 32 + 8 * fq;
#pragma unroll
        for (int ai = 0; ai < 2; ++ai)
#pragma unroll
            for (int m = 0; m < 4; ++m) { const int r = row0 + ai * HALF + m * 16; bf16_t* rowp = O + (size_t)r * ldc + col0; const bf16_t* gp = G + (size_t)r * ldg + col0;
#pragma unroll
                for (int bj = 0; bj < 2; ++bj) { const u32x4 gw = *(const u32x4*)(gp + bj * HALF); f32x4 v0 = acc[ai][bj][m][0], v1 = acc[ai][bj][m][1];
                    v0 = v0 * (f32x4){blo(gw.x), bhi(gw.x), blo(gw.y), bhi(gw.y)}; v1 = v1 * (f32x4){blo(gw.z), bhi(gw.z), blo(gw.w), bhi(gw.w)};
                    if (!FIRST) { const u32x4 ow = *(const u32x4*)(rowp + bj * HALF); v0 = v0 + (f32x4){blo(ow.x), bhi(ow.x), blo(ow.y), bhi(ow.y)}; v1 = v1 + (f32x4){blo(ow.z), bhi(ow.z), blo(ow.w), bhi(ow.w)}; }
                    u32x4 w; w.x = cvt_pk_bf16(v0[0], v0[1]); w.y = cvt_pk_bf16(v0[2], v0[3]); w.z = cvt_pk_bf16(v1[0], v1[1]); w.w = cvt_pk_bf16(v1[2], v1[3]);
                    *(u32x4*)(rowp + bj * HALF) = w; } }
    }
};
struct EpiMixFused {
    static constexpr bool PERM = true, AFTER_DRAIN = false;
    bf16_t* O; int ldc; const bf16_t* G; int ldg;
    __device__ __forceinline__ void mid(f32x4 (&acc)[2][2][4][2], const Unit& u, int wr, int wc, int fr, int fq) const {
        int row0 = u.pm * BM + wr * 64 + fr, col0 = u.pn * BM + wc * 32 + 8 * fq;
        asm volatile("" : "+v"(row0), "+v"(col0));
#pragma unroll
        for (int ai = 0; ai < 2; ++ai)
#pragma unroll
            for (int m = 0; m < 4; ++m) { const bf16_t* gp = G + (size_t)(row0 + ai * HALF + m * 16) * ldg + col0;
#pragma unroll
                for (int bj = 0; bj < 2; ++bj) { const u32x4 a = *(const u32x4*)(gp + bj * HALF), b = *(const u32x4*)(gp + 1024 + bj * HALF);
                    const f32x4 r0 = (f32x4){blo(a.x) * __builtin_amdgcn_rcpf(fmaxf(blo(b.x), 1e-30f)), bhi(a.x) * __builtin_amdgcn_rcpf(fmaxf(bhi(b.x), 1e-30f)), blo(a.y) * __builtin_amdgcn_rcpf(fmaxf(blo(b.y), 1e-30f)), bhi(a.y) * __builtin_amdgcn_rcpf(fmaxf(bhi(b.y), 1e-30f))};
                    const f32x4 r1 = (f32x4){blo(a.z) * __builtin_amdgcn_rcpf(fmaxf(blo(b.z), 1e-30f)), bhi(a.z) * __builtin_amdgcn_rcpf(fmaxf(bhi(b.z), 1e-30f)), blo(a.w) * __builtin_amdgcn_rcpf(fmaxf(blo(b.w), 1e-30f)), bhi(a.w) * __builtin_amdgcn_rcpf(fmaxf(bhi(b.w), 1e-30f))};
                    acc[ai][bj][m][0] = acc[ai][bj][m][0] * r0; acc[ai][bj][m][1] = acc[ai][bj][m][1] * r1; }
                if (m & 1) asm volatile("" ::: "memory"); }
    }
    __device__ __forceinline__ void operator()(const f32x4 (&acc)[2][2][4][2], const Unit& u, int wr, int wc, int fr, int fq) const {
        const int row0 = u.pm * BM + wr * 64 + fr, col0 = u.pn * BM + wc * 32 + 8 * fq;
#pragma unroll
        for (int ai = 0; ai < 2; ++ai)
#pragma unroll
            for (int m = 0; m < 4; ++m) { const int r = row0 + ai * HALF + m * 16; bf16_t* rowp = O + (size_t)r * ldc + col0; const bf16_t* gp = G + (size_t)r * ldg + 1024 + col0;
#pragma unroll
                for (int bj = 0; bj < 2; ++bj) { const u32x4 gw = *(const u32x4*)(gp + bj * HALF);
                    const f32x4 v0 = acc[ai][bj][m][0] * (f32x4){blo(gw.x), bhi(gw.x), blo(gw.y), bhi(gw.y)}, v1 = acc[ai][bj][m][1] * (f32x4){blo(gw.z), bhi(gw.z), blo(gw.w), bhi(gw.w)};
                    u32x4 w; w.x = cvt_pk_bf16(v0[0], v0[1]); w.y = cvt_pk_bf16(v0[2], v0[3]); w.z = cvt_pk_bf16(v1[0], v1[1]); w.w = cvt_pk_bf16(v1[2], v1[3]);
                    *(u32x4*)(rowp + bj * HALF) = w; } }
    }
};
struct EpiGateBf16 {
    static constexpr bool PERM = true, AFTER_DRAIN = false;
    bf16_t* O; int ldc; const float* gate; int gstride;
    __device__ __forceinline__ void operator()(const f32x4 (&acc)[2][2][4][2], const Unit& u, int wr, int wc, int fr, int fq) const {
        const int row0 = u.pm * BM + wr * 64 + fr, col0 = u.pn * BM + wc * 32 + 8 * fq; const float* gb = gate + (size_t)((u.pm * BM) >> 11) * gstride + col0;
        f32x4 gv[2][2];
#pragma unroll
        for (int bj = 0; bj < 2; ++bj)
#pragma unroll
            for (int n = 0; n < 2; ++n) gv[bj][n] = *(const f32x4*)(gb + bj * HALF + n * 4);
#pragma unroll
        for (int ai = 0; ai < 2; ++ai)
#pragma unroll
            for (int m = 0; m < 4; ++m) { bf16_t* rowp = O + (size_t)(row0 + ai * HALF + m * 16) * ldc + col0;
#pragma unroll
                for (int bj = 0; bj < 2; ++bj) { const f32x4 v0 = acc[ai][bj][m][0] * gv[bj][0], v1 = acc[ai][bj][m][1] * gv[bj][1];
                    u32x4 w; w.x = cvt_pk_bf16(v0[0], v0[1]); w.y = cvt_pk_bf16(v0[2], v0[3]); w.z = cvt_pk_bf16(v1[0], v1[1]); w.w = cvt_pk_bf16(v1[2], v1[3]);
                    *(u32x4*)(rowp + bj * HALF) = w; } }
    }
};
struct EpiResGate {
    static constexpr bool PERM = false, AFTER_DRAIN = false;
    float* out; const float* x; const float* gate; int gstride; float alpha;
    __device__ __forceinline__ void operator()(const f32x4 (&acc)[2][2][4][2], const Unit& u, int wr, int wc, int fr, int fq) const {
        const int col0 = u.pn * BM + wc * 32 + 4 * fq; const float* gb = gate + (size_t)((u.pm * BM) >> 11) * gstride + col0;
        f32x4 gv[2][2];
#pragma unroll
        for (int bj = 0; bj < 2; ++bj)
#pragma unroll
            for (int n = 0; n < 2; ++n) gv[bj][n] = *(const f32x4*)(gb + bj * HALF + n * 16);
#pragma unroll
        for (int ai = 0; ai < 2; ++ai)
#pragma unroll
            for (int m = 0; m < 4; ++m) { const size_t off = (size_t)(u.pm * BM + ai * HALF + wr * 64 + m * 16 + fr) * 1024 + col0;
#pragma unroll
                for (int bj = 0; bj < 2; ++bj)
#pragma unroll
                    for (int n = 0; n < 2; ++n) { const f32x4 xv = *(const f32x4*)(x + off + bj * HALF + n * 16); *(f32x4*)(out + off + bj * HALF + n * 16) = xv * alpha + gv[bj][n] * acc[ai][bj][m][n]; } }
    }
};
__device__ __forceinline__ int tile_bucket(const int* BASES, int pm) { const int s = pm * BM; int p = 0;
#pragma unroll
    for (int q = 1; q < 24; ++q) p = (s >= BASES[q]) ? q : p;
    return p; }
struct MoeOrder1 {
    StaticOrder so; const int* BASES; const bf16_t* W1;
    __device__ __forceinline__ bool next(int i, Unit& u) const { return so.next(i, u); }
    __device__ __forceinline__ void a_ready(const Unit&) const {}
    __device__ __forceinline__ void done(const Unit&) const {}
    __device__ __forceinline__ const char* bbase(const Gemm&, const Unit& u) const {
        const int p = tile_bucket(BASES, u.pm), g = p / 6, pi = p % 6;
        const int ei = 4 * g + (pi < 3 ? 0 : (pi < 5 ? 1 : 2)), ej = 4 * g + (pi < 3 ? pi + 1 : (pi < 5 ? pi - 1 : 3));
        const int e = u.pn < 2 ? ei : ej;
        return (const char*)(W1 + ((size_t)e * 512 + (size_t)(u.pn & 1) * 256) * 1024); }
};
struct MoeOrder2 {
    StaticOrder so; const int* BASES; const bf16_t* W2P;
    __device__ __forceinline__ bool next(int i, Unit& u) const { return so.next(i, u); }
    __device__ __forceinline__ void a_ready(const Unit&) const {}
    __device__ __forceinline__ void done(const Unit&) const {}
    __device__ __forceinline__ const char* bbase(const Gemm&, const Unit& u) const {
        const int p = tile_bucket(BASES, u.pm); return (const char*)(W2P + ((size_t)p * 1024 + (size_t)u.pn * 256) * 512); }
};
struct EpiMoe1 {
    static constexpr bool PERM = true, AFTER_DRAIN = false;
    bf16_t* H; const float* SLOTW;
    __device__ __forceinline__ void operator()(const f32x4 (&acc)[2][2][4][2], const Unit& u, int wr, int wc, int fr, int fq) const {
        const int row0 = u.pm * BM + wr * 64 + fr, col0 = (u.pn >> 1) * 256 + (u.pn & 1) * 128 + wc * 32 + 8 * fq, wsel = u.pn >> 1;
#pragma unroll
        for (int ai = 0; ai < 2; ++ai)
#pragma unroll
            for (int m = 0; m < 4; ++m) { const int r = row0 + ai * HALF + m * 16; const float w = SLOTW[2 * r + wsel];
                float o[8];
#pragma unroll
                for (int n = 0; n < 2; ++n)
#pragma unroll
                    for (int i = 0; i < 4; ++i) { const float g = acc[ai][0][m][n][i], up = acc[ai][1][m][n][i]; o[4 * n + i] = g * sigm(g) * up * w; }
                u32x4 wv; wv.x = cvt_pk_bf16(o[0], o[1]); wv.y = cvt_pk_bf16(o[2], o[3]); wv.z = cvt_pk_bf16(o[4], o[5]); wv.w = cvt_pk_bf16(o[6], o[7]);
                *(u32x4*)(H + (size_t)r * 512 + col0) = wv; }
    }
};
struct EpiMoe2 {
    static constexpr bool PERM = false, AFTER_DRAIN = false;
    float* out; const int* PERMV; const float* gate; int gstride; float alpha; float* wout;
    __device__ __forceinline__ void operator()(const f32x4 (&acc)[2][2][4][2], const Unit& u, int wr, int wc, int fr, int fq) const {
        const int col0 = u.pn * BM + wc * 32 + 4 * fq;
#pragma unroll
        for (int ai = 0; ai < 2; ++ai)
#pragma unroll
            for (int m = 0; m < 4; ++m) { const int t = PERMV[u.pm * BM + ai * HALF + wr * 64 + m * 16 + fr];
                if (t >= 0) { const size_t off = (size_t)t * 1024 + col0; const float* gb = gate + (size_t)(t >> 11) * gstride + col0;
#pragma unroll
                    for (int bj = 0; bj < 2; ++bj)
#pragma unroll
                        for (int n = 0; n < 2; ++n) { const f32x4 xv = *(const f32x4*)(out + off + bj * HALF + n * 16); const f32x4 gv = *(const f32x4*)(gb + bj * HALF + n * 16);
                            *(f32x4*)(wout + off + bj * HALF + n * 16) = xv * alpha + gv * acc[ai][bj][m][n]; } } }
    }
};
struct EpiMoe2B {
    static constexpr bool PERM = true, AFTER_DRAIN = false;
    bf16_t* Y; const int* PERMV; const float* gate; int gstride;
    __device__ __forceinline__ void operator()(const f32x4 (&acc)[2][2][4][2], const Unit& u, int wr, int wc, int fr, int fq) const {
        const int col0 = u.pn * BM + wc * 32 + 8 * fq;
#pragma unroll
        for (int ai = 0; ai < 2; ++ai)
#pragma unroll
            for (int m = 0; m < 4; ++m) { const int t = PERMV[u.pm * BM + ai * HALF + wr * 64 + m * 16 + fr];
                if (t >= 0) { bf16_t* rowp = Y + (size_t)t * 1024 + col0; const float* gb = gate + (size_t)(t >> 11) * gstride + col0;
#pragma unroll
                    for (int bj = 0; bj < 2; ++bj) { const f32x4 g0 = *(const f32x4*)(gb + bj * HALF), g1 = *(const f32x4*)(gb + bj * HALF + 4);
                        const f32x4 v0 = acc[ai][bj][m][0] * g0, v1 = acc[ai][bj][m][1] * g1;
                        u32x4 w; w.x = cvt_pk_bf16(v0[0], v0[1]); w.y = cvt_pk_bf16(v0[2], v0[3]); w.z = cvt_pk_bf16(v1[0], v1[1]); w.w = cvt_pk_bf16(v1[2], v1[3]);
                        *(u32x4*)(rowp + bj * HALF) = w; } } }
    }
};
}


namespace att {
typedef short bf16x8 __attribute__((ext_vector_type(8)));
typedef short s16x4 __attribute__((ext_vector_type(4)));
typedef short v4i16_t __attribute__((ext_vector_type(4)));
typedef float f32x16 __attribute__((ext_vector_type(16)));
typedef unsigned u32x4 __attribute__((ext_vector_type(4)));
typedef float f32x2_t __attribute__((ext_vector_type(2))); typedef __bf16 bf16x2_t __attribute__((ext_vector_type(2)));
typedef LAS const char* lds_cptr;
constexpr float THR = 8.f;
__device__ __forceinline__ unsigned cvtpk(float lo, float hi) { f32x2_t v = {lo, hi}; bf16x2_t b = __builtin_convertvector(v, bf16x2_t); return __builtin_bit_cast(unsigned, b); }
__device__ __forceinline__ s16x4 vtr(lds_cptr p) { return __builtin_bit_cast(s16x4, __builtin_amdgcn_ds_read_tr16_b64_v4i16((LAS v4i16_t*)p)); }
__device__ __forceinline__ float swapmax(float m) { auto rr = __builtin_amdgcn_permlane32_swap(__float_as_uint(m), __float_as_uint(m), false, false); return fmaxf(__uint_as_float(rr[0]), __uint_as_float(rr[1])); }
__device__ __forceinline__ float swapsum(float m) { auto rr = __builtin_amdgcn_permlane32_swap(__float_as_uint(m), __float_as_uint(m), false, false); return __uint_as_float(rr[0]) + __uint_as_float(rr[1]); }
__device__ __forceinline__ void glds16(const void* g, LAS unsigned char* l) { __builtin_amdgcn_global_load_lds((const unsigned*)g, (LAS unsigned*)l, 16, 0, 0); }
__device__ __forceinline__ void qkt(f32x16& p0, f32x16& p1, lds_cptr kslot, const bf16x8 (&qr)[4], int r32, int hi) {
    lds_cptr kb = kslot + r32 * 128; const int sw = (r32 >> 1) & 7;
#pragma unroll
    for (int d0 = 0; d0 < 4; ++d0) {
        const int o_ = ((2 * d0 + hi) ^ sw) << 4;
        const bf16x8 b0 = *(const LAS bf16x8*)(kb + o_), b1 = *(const LAS bf16x8*)(kb + o_ + 4096);
        p0 = __builtin_amdgcn_mfma_f32_32x32x16_bf16(b0, qr[d0], p0, 0, 0, 0);
        p1 = __builtin_amdgcn_mfma_f32_32x32x16_bf16(b1, qr[d0], p1, 0, 0, 0);
    }
}
template <int ND, bool LM> __device__ __forceinline__ void pv(f32x16 (&o)[ND + (LM ? 1 : 0)], int vb, bf16x8 pa0, bf16x8 pa1, bf16x8 pa2, bf16x8 pa3) {
    if constexpr (LM) {
        const bf16x8 ones = (bf16x8){0x3F80, 0x3F80, 0x3F80, 0x3F80, 0x3F80, 0x3F80, 0x3F80, 0x3F80};
        o[ND] = __builtin_amdgcn_mfma_f32_32x32x16_bf16(pa0, ones, o[ND], 0, 0, 0); o[ND] = __builtin_amdgcn_mfma_f32_32x32x16_bf16(pa1, ones, o[ND], 0, 0, 0);
        o[ND] = __builtin_amdgcn_mfma_f32_32x32x16_bf16(pa2, ones, o[ND], 0, 0, 0); o[ND] = __builtin_amdgcn_mfma_f32_32x32x16_bf16(pa3, ones, o[ND], 0, 0, 0);
    }
#pragma unroll
    for (int d0 = 0; d0 < ND; ++d0) {
        s16x4 lo[4], hi[4];
#pragma unroll
        for (int ks = 0; ks < 4; ++ks) {
            asm volatile("ds_read_b64_tr_b16 %0, %1 offset:%c2" : "=&v"(lo[ks]) : "v"(vb), "i"(d0 * 4096 + ks * 1024) : "memory");
            asm volatile("ds_read_b64_tr_b16 %0, %1 offset:%c2" : "=&v"(hi[ks]) : "v"(vb), "i"(d0 * 4096 + ks * 1024 + 512) : "memory"); }
        asm volatile("s_waitcnt lgkmcnt(0)" ::: "memory"); __builtin_amdgcn_sched_barrier(0);
#define ATT_PK(k) (bf16x8){lo[k][0], lo[k][1], lo[k][2], lo[k][3], hi[k][0], hi[k][1], hi[k][2], hi[k][3]}
        o[d0] = __builtin_amdgcn_mfma_f32_32x32x16_bf16(pa0, ATT_PK(0), o[d0], 0, 0, 0);
        o[d0] = __builtin_amdgcn_mfma_f32_32x32x16_bf16(pa1, ATT_PK(1), o[d0], 0, 0, 0);
        o[d0] = __builtin_amdgcn_mfma_f32_32x32x16_bf16(pa2, ATT_PK(2), o[d0], 0, 0, 0);
        o[d0] = __builtin_amdgcn_mfma_f32_32x32x16_bf16(pa3, ATT_PK(3), o[d0], 0, 0, 0);
#undef ATT_PK
    }
}
__device__ __forceinline__ void alibi_cin(f32x16& p0, f32x16& p1, float qrel, float sl2, float m, bool past) {
    if (past) { const float bm = -sl2 * qrel - m;
#pragma unroll
        for (int r = 0; r < 16; ++r) { const float c = (float)((r & 3) + 8 * (r >> 2)); p0[r] = fmaf(sl2, c, bm); p1[r] = fmaf(sl2, c + 32.f, bm); }
    } else {
#pragma unroll
        for (int r = 0; r < 16; ++r) { const float c = (float)((r & 3) + 8 * (r >> 2)); p0[r] = -sl2 * fabsf(qrel - c) - m; p1[r] = -sl2 * fabsf(qrel - 32.f - c) - m; }
    }
}
template <int ND, bool LM> __device__ __forceinline__ bool softmax_step(f32x16& p0, f32x16& p1, float& m, float& l, f32x16 (&o)[ND + (LM ? 1 : 0)], LAS float* wsf, int r32, int hi, bool first) {
    float mxa = fmaxf(fmaxf(p0[0], p0[1]), p1[0]), mxb = fmaxf(fmaxf(p0[2], p0[3]), p1[1]);
    mxa = fmaxf(fmaxf(mxa, p1[2]), p1[3]);
#pragma unroll
    for (int r = 4; r < 16; r += 4) { mxa = fmaxf(fmaxf(mxa, p0[r]), p0[r + 1]); mxb = fmaxf(fmaxf(mxb, p0[r + 2]), p0[r + 3]); mxa = fmaxf(fmaxf(mxa, p1[r]), p1[r + 1]); mxb = fmaxf(fmaxf(mxb, p1[r + 2]), p1[r + 3]); }
    float mx = swapmax(fmaxf(mxa, mxb));
    if (!first && __all(mx < -160.f)) return false;
    float dl = 0.f; float fr[16];
#pragma unroll
    for (int r = 0; r < 16; ++r) fr[r] = 1.f;
    if (first) dl = (mx == -INFINITY) ? 0.f : mx;
    else if (__any(mx > THR)) {
        dl = fmaxf(mx, 0.f);
        const float f = __builtin_amdgcn_exp2f(-dl); if constexpr (!LM) l *= f; wsf[r32] = f;
        LDS_WAIT();
#pragma unroll
        for (int r = 0; r < 16; ++r) fr[r] = wsf[(r & 3) + 8 * (r >> 2) + 4 * hi];
        LDS_WAIT();
    }
    m += dl;
#pragma unroll
    for (int r = 0; r < 16; ++r) {
#pragma unroll
        for (int d = 0; d < ND + (LM ? 1 : 0); ++d) o[d][r] *= fr[r]; }
    if (__any(dl != 0.f)) {
#pragma unroll
        for (int r = 0; r < 16; ++r) { p0[r] -= dl; p1[r] -= dl; } }
    float sacc = 0.f;
#pragma unroll
    for (int r = 0; r < 16; ++r) { p0[r] = __builtin_amdgcn_exp2f(p0[r]); p1[r] = __builtin_amdgcn_exp2f(p1[r]); if constexpr (!LM) sacc += p0[r] + p1[r]; }
    if constexpr (!LM) l += sacc;
    return true;
}
#define ATT_PACK(P, B) (u32x4){cvtpk(P[B], P[B + 1]), cvtpk(P[B + 2], P[B + 3]), cvtpk(P[B + 4], P[B + 5]), cvtpk(P[B + 6], P[B + 7])}

#define ATT_WAITBAR(N) do { asm volatile("s_waitcnt vmcnt(" #N ") lgkmcnt(0)" ::: "memory"); __builtin_amdgcn_s_barrier(); asm volatile("" ::: "memory"); } while (0)
__device__ __forceinline__ void battn_unit(LAS unsigned char* L, int b, int h, int qb, bf16* P, const bf16* KV, const unsigned* MASK, bool dry, int WID_) {
    const int tid = otid(WID_), lane = tid & 63, wid = __builtin_amdgcn_readfirstlane(tid >> 6), r32 = lane & 31, hi = lane >> 5;
    const int q0 = qb * 256, qpos = q0 + wid * 32 + r32, cq = (q0 + wid * 32) >> 6, NT = (q0 + 256) >> 6;
    const size_t rowbase = (size_t)b * SEQ;
    const bf16* Kh = KV + rowbase * 1024 + h * 64;
    bf16* Qw = P + (rowbase + q0 + wid * 32) * NP + C_BQ + h * 64;
    const int krow = 8 * wid + (lane >> 3), kchunk = (lane & 7) ^ ((krow >> 1) & 7);
    const char* ksrc = (const char*)(Kh + (size_t)krow * 1024 + kchunk * 8);
    const char* vsrc = (const char*)(Kh + 512 + (size_t)(16 * (wid & 3) + (lane >> 2)) * 1024 + (wid >> 2) * 32 + (lane & 3) * 8);
    const char* msrc = (const char*)(MASK + (rowbase + q0 + wid * 32 + (lane >> 1)) * 64 + (lane & 1));
    LAS unsigned char* kdst = L + wid * 1024; LAS unsigned char* vdst = L + 8192 + wid * 1024; LAS unsigned char* mdst = L + 65536 + wid * 256;
    LAS float* wsf = (LAS float*)(L + 73728 + wid * 256);
    bf16x8 qr[4];
#pragma unroll
    for (int d0 = 0; d0 < 4; ++d0) qr[d0] = *(const bf16x8*)(Qw + (size_t)r32 * NP + d0 * 16 + hi * 8);
    __builtin_amdgcn_s_waitcnt(0x0F70);
    const float sl2 = SLOPE_B[h] * LOG2E;
    float m = 0.f; f32x16 o[3]; o[0] = f32x16{}; o[1] = f32x16{}; o[2] = f32x16{};
#define B_DMA(it_) do { const int t_ = NT - 1 - (it_) > 0 ? NT - 1 - (it_) : 0; const int s_ = (it_) & 3; \
        glds16(ksrc + (size_t)t_ * (64 * 1024 * 2), kdst + s_ * 16384); glds16(vsrc + (size_t)t_ * (64 * 1024 * 2), vdst + s_ * 16384); \
        __builtin_amdgcn_global_load_lds((const unsigned*)(msrc + t_ * 8), (LAS unsigned*)(mdst + s_ * 2048), 4, 0, 0); } while (0)
    B_DMA(0); B_DMA(1); B_DMA(2);
    const int vb0 = (int)(unsigned)(size_t)(L + 8192) + ((lane >> 4) & 1) * 32 + (lane & 3) * 8 + (4 * hi + ((lane & 15) >> 2)) * 64;
    for (int it = 0; it < NT; ++it) {
        const int t = NT - 1 - it, sl = it & 3;
        ATT_WAITBAR(6);
        B_DMA(it + 3);
        if (t <= cq) {
            f32x16 p0, p1;
            alibi_cin(p0, p1, (float)(qpos - 64 * t - 4 * hi), sl2, m, t < cq);
            const v2u mcur = *(const LAS v2u*)(mdst + sl * 2048 + r32 * 8);
            const unsigned mx0 = mcur.x >> (4 * hi), mx1 = mcur.y >> (4 * hi);
#pragma unroll
            for (int r = 0; r < 16; ++r) { const int c = (r & 3) + 8 * (r >> 2);
                const unsigned s0_ = (unsigned)__builtin_amdgcn_sbfe((int)mx0, c, 1), s1_ = (unsigned)__builtin_amdgcn_sbfe((int)mx1, c, 1);
                p0[r] = __uint_as_float((__float_as_uint(p0[r]) & s0_) | (0xff800000u & ~s0_)); p1[r] = __uint_as_float((__float_as_uint(p1[r]) & s1_) | (0xff800000u & ~s1_)); }
            qkt(p0, p1, (lds_cptr)L + sl * 16384, qr, r32, hi);
            if (softmax_step<2, true>(p0, p1, m, m  , o, wsf, r32, hi, t == cq)) {
                const u32x4 w0 = ATT_PACK(p0, 0), w1 = ATT_PACK(p0, 8), w2 = ATT_PACK(p1, 0), w3 = ATT_PACK(p1, 8);
                pv<2, true>(o, vb0 + sl * 16384, __builtin_bit_cast(bf16x8, w0), __builtin_bit_cast(bf16x8, w1), __builtin_bit_cast(bf16x8, w2), __builtin_bit_cast(bf16x8, w3)); }
        }
    }
#undef B_DMA
    LAS bf16* stg = (LAS bf16*)(L + 75776 + wid * 4096);
#pragma unroll
    for (int r = 0; r < 16; ++r) { const int orow = (r & 3) + 8 * (r >> 2) + 4 * hi; const float rl = 1.f / o[2][r];
        stg[orow * 64 + r32] = (bf16)f2bf(o[0][r] * rl); stg[orow * 64 + 32 + r32] = (bf16)f2bf(o[1][r] * rl); }
    LDS_WAIT();
#pragma unroll
    for (int i = 0; i < 4; ++i) { const int row = i * 8 + (lane >> 3), ch = lane & 7; const u32x4 v = *(const LAS u32x4*)(stg + row * 64 + ch * 8); if (!dry) *(u32x4*)(Qw + (size_t)row * NP + ch * 8) = v; }
    ATT_WAITBAR(0);
}
__device__ __forceinline__ void battn_phase(LAS unsigned char* L, const Ctx& a, bool dry, int WID_) {
    const int bx = blockIdx.x, x = bx & 7, c = (bx >> 3) & 31, b = 2 * x + (c >> 4), cc = c & 15, hpar = cc & 1, sel = (cc >> 1) & 1, rot = cc >> 2;
    bf16* P = (bf16*)(a.ws() + WS_PROJ); const bf16* KV = (const bf16*)(a.ws() + WS_KV); const unsigned* MASK = (const unsigned*)(a.ws() + WS_MASK);
    for (int i = 0; i < 4; ++i) { const int qb = i == 0 ? sel : (i == 1 ? 7 - sel : (i == 2 ? 2 + sel : 5 - sel)); const int h = 2 * ((i + rot) & 3) + hpar; battn_unit(L, b, h, qb, P, KV, MASK, dry, WID_); }
}

__device__ __forceinline__ void dattn_unit(LAS unsigned char* L, int b, int h, int qb, bf16* P, float lam, const float* subg, bool dry, int WID_) {
    const int tid = otid(WID_), lane = tid & 63, wid = __builtin_amdgcn_readfirstlane(tid >> 6), r32 = lane & 31, hi = lane >> 5, rg = wid & 3, mp = wid >> 2;
    const int q0 = qb * 128, qpos = q0 + rg * 32 + r32, cq = (q0 + rg * 32) >> 6, NT = (q0 + 128) >> 6;
    const size_t rowbase = (size_t)b * SEQ;
    const bf16* Kb = P + rowbase * NP + C_AK + h * 128;
    const bf16* Vb = P + rowbase * NP + C_AV + h * 128;
    bf16* Qw = P + (rowbase + q0 + rg * 32) * NP + C_AQ + h * 128;
    const int krow = 8 * wid + (lane >> 3), kchunk = (lane & 7) ^ ((krow >> 1) & 7);
    const char* k0src = (const char*)(Kb + (size_t)krow * NP + kchunk * 8);
    const char* k1src = (const char*)(Kb + (size_t)krow * NP + 64 + kchunk * 8);
    const char* v0src = (const char*)(Vb + (size_t)(16 * (wid & 3) + (lane >> 2)) * NP + (wid >> 2) * 32 + (lane & 3) * 8);
    const char* v1src = v0src + 64 * 2;
    LAS unsigned char* dst = L + wid * 1024;
    LAS float* wsf = (LAS float*)(L + 131072 + wid * 256);
    bf16x8 qr[4];
#pragma unroll
    for (int d0 = 0; d0 < 4; ++d0) qr[d0] = *(const bf16x8*)(Qw + (size_t)r32 * NP + mp * 64 + d0 * 16 + hi * 8);
    __builtin_amdgcn_s_waitcnt(0x0F70);
    const float sl2 = SLOPE_A[h] * LOG2E;
    float m = 0.f, l = 0.f; f32x16 o[4];
#pragma unroll
    for (int d = 0; d < 4; ++d) o[d] = f32x16{};
    constexpr size_t TS = (size_t)64 * NP * 2;
#define D_DMA(it_) do { const int t_ = NT - 1 - (it_) > 0 ? NT - 1 - (it_) : 0; LAS unsigned char* d2 = dst + ((it_) & 3) * 32768; const size_t go = (size_t)t_ * TS; \
        glds16(k0src + go, d2); glds16(k1src + go, d2 + 8192); glds16(v0src + go, d2 + 16384); glds16(v1src + go, d2 + 24576); } while (0)
    D_DMA(0); D_DMA(1); D_DMA(2);
    const int vb0 = (int)(unsigned)(size_t)(L + 16384) + ((lane >> 4) & 1) * 32 + (lane & 3) * 8 + (4 * hi + ((lane & 15) >> 2)) * 64;
    for (int it = 0; it < NT; ++it) {
        const int t = NT - 1 - it, sl = it & 3;
        ATT_WAITBAR(8);
        D_DMA(it + 3);
        if (t <= cq) {
            f32x16 p0, p1;
            alibi_cin(p0, p1, (float)(qpos - 64 * t - 4 * hi), sl2, m, t < cq);
            qkt(p0, p1, (lds_cptr)L + sl * 32768 + mp * 8192, qr, r32, hi);
            if (softmax_step<4, false>(p0, p1, m, l, o, wsf, r32, hi, t == cq)) {
                const u32x4 w0 = ATT_PACK(p0, 0), w1 = ATT_PACK(p0, 8), w2 = ATT_PACK(p1, 0), w3 = ATT_PACK(p1, 8);
                pv<4, false>(o, vb0 + sl * 32768, __builtin_bit_cast(bf16x8, w0), __builtin_bit_cast(bf16x8, w1), __builtin_bit_cast(bf16x8, w2), __builtin_bit_cast(bf16x8, w3)); }
        }
    }
#undef D_DMA
    ATT_WAITBAR(0);
    l = swapsum(l); wsf[32 + r32] = l; LDS_WAIT();
    LAS float* X = (LAS float*)L + rg * (32 * 132);
    if (mp == 1) {
#pragma unroll
        for (int r = 0; r < 16; ++r) { const int orow = (r & 3) + 8 * (r >> 2) + 4 * hi; const float rl = lam / wsf[32 + orow];
#pragma unroll
            for (int d = 0; d < 4; ++d) X[orow * 132 + d * 32 + r32] = o[d][r] * rl; }
    }
    asm volatile("s_waitcnt lgkmcnt(0)" ::: "memory"); __syncthreads();
    if (mp == 0) {
#pragma unroll
        for (int r = 0; r < 16; ++r) { const int orow = (r & 3) + 8 * (r >> 2) + 4 * hi; const float rl = 1.f / wsf[32 + orow];
#pragma unroll
            for (int d = 0; d < 4; ++d) { LAS float* xp = X + orow * 132 + d * 32 + r32; *xp = o[d][r] * rl - *xp; } }
        LDS_WAIT();
        const int row = lane >> 1, half = lane & 1; const LAS f32x4* xr = (const LAS f32x4*)(X + row * 132 + half * 64);
        f32x4 y[16]; float ss = 0.f;
#pragma unroll
        for (int j = 0; j < 16; ++j) { y[j] = xr[j]; ss += (y[j].x * y[j].x + y[j].y * y[j].y) + (y[j].z * y[j].z + y[j].w * y[j].w); }
        ss += __shfl_xor(ss, 1);
        const float rn = 0.8f / sqrtf(ss * (1.f / 128.f) + RMS_EPS);
        bf16* op = Qw + (size_t)row * NP + half * 64; const f32x4* gp = (const f32x4*)(subg + half * 64);
#pragma unroll
        for (int j = 0; j < 8; ++j) { const f32x4 g0 = gp[2 * j], g1 = gp[2 * j + 1]; const f32x4 a0 = y[2 * j] * rn * g0, a1 = y[2 * j + 1] * rn * g1;
            u32x4 w; w.x = cvtpk(a0.x, a0.y); w.y = cvtpk(a0.z, a0.w); w.z = cvtpk(a1.x, a1.y); w.w = cvtpk(a1.z, a1.w); if (!dry) *(u32x4*)(op + j * 8) = w; }
    }
    asm volatile("s_waitcnt lgkmcnt(0)" ::: "memory"); __syncthreads();
}
__device__ __forceinline__ void dattn_phase(LAS unsigned char* L, const Ctx& a, bool dry, int WID_) {
    const int bx = blockIdx.x, x = bx & 7, c = (bx >> 3) & 31, b = 2 * x + (c >> 4), cc = c & 15, rot = cc & 3, j = cc >> 2;
    bf16* P = (bf16*)(a.ws() + WS_PROJ); const float* SMv = (const float*)(a.ws() + WS_SMALL); const float lam = SMv[SM_LAM];
    for (int i = 0; i < 4; ++i) { const int qb = i == 0 ? j : (i == 1 ? 7 - j : (i == 2 ? 8 + j : 15 - j)); const int h = (i + rot) & 3; dattn_unit(L, b, h, qb, P, lam, SMv + SM_SUBLN, dry, WID_); }
}
#undef ATT_PACK
}


namespace idx {
typedef short bf16x8 __attribute__((ext_vector_type(8)));
typedef float f32x16 __attribute__((ext_vector_type(16)));
typedef unsigned u32x4 __attribute__((ext_vector_type(4)));
__device__ __forceinline__ void cnt_ge(int& c, unsigned key, unsigned t) { asm("v_cmp_ge_u32_e32 vcc, %1, %2\n\tv_addc_co_u32_e32 %0, vcc, 0, %0, vcc" : "+v"(c) : "v"(key), "v"(t) : "vcc"); }
__device__ __forceinline__ void cnt_gt(int& c, unsigned key, unsigned t) { asm("v_cmp_gt_u32_e32 vcc, %1, %2\n\tv_addc_co_u32_e32 %0, vcc, 0, %0, vcc" : "+v"(c) : "v"(key), "v"(t) : "vcc"); }
__device__ __forceinline__ int row16_sum(int x) {
    x += __builtin_amdgcn_update_dpp(0, x, 0xB1, 0xF, 0xF, true);
    x += __builtin_amdgcn_update_dpp(0, x, 0x4E, 0xF, 0xF, true);
    x += __builtin_amdgcn_update_dpp(0, x, 0x141, 0xF, 0xF, true);
    x += __builtin_amdgcn_update_dpp(0, x, 0x140, 0xF, 0xF, true);
    return x;
}
__device__ __forceinline__ int half_sum(int x, int hi) {
    x = row16_sum(x);
    const int s0 = __builtin_amdgcn_readlane(x, 0) + __builtin_amdgcn_readlane(x, 16), s1 = __builtin_amdgcn_readlane(x, 32) + __builtin_amdgcn_readlane(x, 48);
    return hi ? s1 : s0;
}
__device__ __forceinline__ float relu1(float x) { return __builtin_amdgcn_fmed3f(x, 0.f, __builtin_inff()); }
template <int NS> __device__ __forceinline__ void idx_unit_t(LAS unsigned char* L, int b, int g, const bf16* P, unsigned* MASK, int WID_) {
    const int tid = otid(WID_), lane = tid & 63, wid = __builtin_amdgcn_readfirstlane(tid >> 6), r32 = lane & 31, hi = lane >> 5;
    const int nblk = 2 * ((g >> 1) + 1);
    const size_t rowbase = (size_t)b * SEQ; const int tq0 = g * 32 + wid * 4;
    unsigned* mrow0 = MASK + (rowbase + tq0 + 2 * hi) * 64;
    const int qsel = 2 * ((r32 >> 2) & 1) + (r32 >> 4), hsel = ((r32 >> 3) & 1) * 4 + (r32 & 3);
    const bf16* qp = P + (rowbase + tq0 + qsel) * NP + C_IQ + hsel * 64 + hi * 8;
    bf16x8 qa[4];
#pragma unroll
    for (int ks = 0; ks < 4; ++ks) qa[ks] = *(const bf16x8*)(qp + ks * 16);
    float w[2][8];
#pragma unroll
    for (int q2 = 0; q2 < 2; ++q2) { const u32x4 wv = *(const u32x4*)(P + (rowbase + tq0 + 2 * hi + q2) * NP + C_IW);
        w[q2][0] = bflo(wv.x); w[q2][1] = bfhi(wv.x); w[q2][2] = bflo(wv.y); w[q2][3] = bfhi(wv.y); w[q2][4] = bflo(wv.z); w[q2][5] = bfhi(wv.z); w[q2][6] = bflo(wv.w); w[q2][7] = bfhi(wv.w); }
    const int krow = 8 * wid + (lane >> 3), kchunk = (lane & 7) ^ ((krow >> 1) & 7);
    const char* ksrc = (const char*)(P + (rowbase + krow) * NP + C_IK + kchunk * 8);
    LAS unsigned char* kdst = L + wid * 1024;
    const char* kp = ksrc;
#define IDX_DMA(s_) do { _Pragma("unroll") for (int sub = 0; sub < 4; ++sub) \
        __builtin_amdgcn_global_load_lds((const unsigned*)(kp + (size_t)(64 * sub) * (NP * 2)), (LAS unsigned*)(kdst + ((s_) % 3) * 32768 + sub * 8192), 16, 0, 0); \
        kp += (size_t)256 * (NP * 2); asm volatile("" : "+v"(kp)); } while (0)
    unsigned key[2][8 * NS];
    __builtin_amdgcn_s_waitcnt(0x0F70);
    IDX_DMA(0); if (NS > 1) IDX_DMA(1);
#pragma unroll
    for (int s_ = 0; s_ < NS; ++s_) {
        if (s_ + 1 < NS) asm volatile("s_waitcnt vmcnt(4) lgkmcnt(0)" ::: "memory"); else asm volatile("s_waitcnt vmcnt(0) lgkmcnt(0)" ::: "memory");
        __builtin_amdgcn_s_barrier(); asm volatile("" ::: "memory");
        if (s_ + 2 < NS) IDX_DMA(s_ + 2);
#pragma unroll
        for (int jj = 0; jj < 4; ++jj) {
            const LAS unsigned char* kb = L + (s_ % 3) * 32768 + jj * 8192 + r32 * 128; const int sw = (r32 >> 1) & 7;
            f32x16 acc0 = f32x16{}, acc1 = f32x16{};
#pragma unroll
            for (int ks = 0; ks < 4; ++ks) { const int o_ = ((2 * ks + hi) ^ sw) << 4; const bf16x8 kf0 = *(const LAS bf16x8*)(kb + o_), kf1 = *(const LAS bf16x8*)(kb + o_ + 4096);
                acc0 = __builtin_amdgcn_mfma_f32_32x32x16_bf16(qa[ks], kf0, acc0, 0, 0, 0); acc1 = __builtin_amdgcn_mfma_f32_32x32x16_bf16(qa[ks], kf1, acc1, 0, 0, 0); }
            const int blk = 8 * s_ + 2 * jj;
            const bool vis = blk < nblk;
            float sc[2][2];
#pragma unroll
            for (int q2 = 0; q2 < 2; ++q2) { float s0 = 0.f, s1 = 0.f;
#pragma unroll
                for (int h = 0; h < 8; ++h) { s0 = fmaf(w[q2][h], relu1(acc0[8 * q2 + h]), s0); s1 = fmaf(w[q2][h], relu1(acc1[8 * q2 + h]), s1); }
                sc[q2][0] = s0; sc[q2][1] = s1; }
#pragma unroll
            for (int q2 = 0; q2 < 2; ++q2) { key[q2][blk] = vis ? sortable(sc[q2][0] + 0.f) : 0u; key[q2][blk + 1] = vis ? sortable(sc[q2][1] + 0.f) : 0u; }
            asm volatile("" : "+v"(key[0][blk]), "+v"(key[0][blk + 1]), "+v"(key[1][blk]), "+v"(key[1][blk + 1]));
        }
    }
#undef IDX_DMA
    unsigned K0 = 0u, K1 = 0u; int g0 = 0x7fffffff, g1 = 0x7fffffff;
    for (int bit = 31; bit >= 0; --bit) {
        const unsigned t0 = K0 | (1u << bit), t1 = K1 | (1u << bit);
        int c0 = 0, c1 = 0;
#pragma unroll
        for (int i = 0; i < 8 * NS; ++i) { cnt_ge(c0, key[0][i], t0); cnt_ge(c1, key[1][i], t1); }
        c0 = half_sum(c0, hi); c1 = half_sum(c1, hi);
        if (c0 >= TOPK) { K0 = t0; g0 = c0; }
        if (c1 >= TOPK) { K1 = t1; g1 = c1; }
        if (__all(g0 == TOPK && g1 == TOPK)) break;
    }
    unsigned m00 = 0u, m01 = 0u, m10 = 0u, m11 = 0u;
    if (__all(g0 == TOPK && g1 == TOPK)) {
#pragma unroll
        for (int blk = 0; blk < 8 * NS; ++blk) {
            const unsigned long long b0 = __ballot(key[0][blk] >= K0), b1 = __ballot(key[1][blk] >= K1);
            const unsigned w0 = hi ? (unsigned)(b0 >> 32) : (unsigned)b0, w1 = hi ? (unsigned)(b1 >> 32) : (unsigned)b1;
            if (r32 == (blk & 31)) { if (blk < 32) { m00 = w0; m10 = w1; } else { m01 = w0; m11 = w1; } }
            __builtin_amdgcn_sched_barrier(0); }
    } else {
        int c0 = 0, c1 = 0;
#pragma unroll
        for (int i = 0; i < 8 * NS; ++i) { cnt_gt(c0, key[0][i], K0); cnt_gt(c1, key[1][i], K1); }
        const int need0 = TOPK - half_sum(c0, hi), need1 = TOPK - half_sum(c1, hi);
        int tk0 = 0, tk1 = 0; const unsigned lt = (1u << r32) - 1u;
#pragma unroll
        for (int blk = 0; blk < 8 * NS; ++blk) {
            const unsigned long long e0b = __ballot(key[0][blk] == K0), e1b = __ballot(key[1][blk] == K1);
            const unsigned e0 = hi ? (unsigned)(e0b >> 32) : (unsigned)e0b, e1 = hi ? (unsigned)(e1b >> 32) : (unsigned)e1b;
            const bool s0 = key[0][blk] > K0 || (key[0][blk] == K0 && tk0 + __popc(e0 & lt) < need0);
            const bool s1 = key[1][blk] > K1 || (key[1][blk] == K1 && tk1 + __popc(e1 & lt) < need1);
            tk0 += __popc(e0); tk1 += __popc(e1);
            const unsigned long long b0 = __ballot(s0), b1 = __ballot(s1);
            const unsigned w0 = hi ? (unsigned)(b0 >> 32) : (unsigned)b0, w1 = hi ? (unsigned)(b1 >> 32) : (unsigned)b1;
            if (r32 == (blk & 31)) { if (blk < 32) { m00 = w0; m10 = w1; } else { m01 = w0; m11 = w1; } }
            __builtin_amdgcn_sched_barrier(0); }
    }
    mrow0[r32] = m00; mrow0[32 + r32] = m01; mrow0[64 + r32] = m10; mrow0[96 + r32] = m11;
}
__device__ __forceinline__ void idx_unit(LAS unsigned char* L, int b, int g, const bf16* P, unsigned* MASK, int WID_) {
    const int nblk = 2 * ((g >> 1) + 1), ns = (nblk + 7) >> 3;
    if (ns <= 1) {
        const int tid = otid(WID_), lane = tid & 63, wid = __builtin_amdgcn_readfirstlane(tid >> 6), r32 = lane & 31, hi = lane >> 5;
        unsigned* mrow0 = MASK + ((size_t)b * SEQ + g * 32 + wid * 4 + 2 * hi) * 64;
        const unsigned wlo = r32 < nblk ? 0xffffffffu : 0u;
        mrow0[r32] = wlo; mrow0[32 + r32] = 0u; mrow0[64 + r32] = wlo; mrow0[96 + r32] = 0u;
    }
    else if (ns == 2) idx_unit_t<2>(L, b, g, P, MASK, WID_);
    else if (ns == 3) idx_unit_t<3>(L, b, g, P, MASK, WID_);
    else if (ns == 4) idx_unit_t<4>(L, b, g, P, MASK, WID_);
    else if (ns == 5) idx_unit_t<5>(L, b, g, P, MASK, WID_);
    else if (ns == 6) idx_unit_t<6>(L, b, g, P, MASK, WID_);
    else if (ns == 7) idx_unit_t<7>(L, b, g, P, MASK, WID_);
    else idx_unit_t<8>(L, b, g, P, MASK, WID_);
}
__device__ __forceinline__ void idx_phase(LAS unsigned char* L, const Ctx& a, int WID_) {
    const int G = gridDim.x, bx = blockIdx.x, vcu = (bx % 8) * (G / 8) + bx / 8, b = vcu >> 4, j = vcu & 15;
    const bf16* P = (const bf16*)(a.ws() + WS_PROJ); unsigned* MASK = (unsigned*)(a.ws() + WS_MASK);
    for (int i = 0; i < 4; ++i) { const int g = i == 0 ? j : (i == 1 ? 31 - j : (i == 2 ? 32 + j : 63 - j)); idx_unit(L, b, g, P, MASK, WID_);
        asm volatile("s_waitcnt lgkmcnt(0)" ::: "memory"); __syncthreads(); }
}
}

__global__ void __launch_bounds__(512, 2) fwd(Args karg) {
    extern __shared__ __attribute__((aligned(16))) unsigned char lds[];
    const int tid = threadIdx.x; const int WID_ = __builtin_amdgcn_readfirstlane(tid >> 6);
    if (tid < 27) ((LAS unsigned long long*)((LAS unsigned char*)lds + LDSCTL_OFF + 512))[tid] = (unsigned long long)karg.in[tid];
    if (tid == 27) ((LAS unsigned long long*)((LAS unsigned char*)lds + LDSCTL_OFF + 512))[27] = (unsigned long long)karg.out;
    if (tid == 28) ((LAS unsigned long long*)((LAS unsigned char*)lds + LDSCTL_OFF + 512))[28] = (unsigned long long)karg.ws;
    unsigned char* ws = karg.ws;
    Ctx a; a.tab = (LAS const unsigned long long*)((LAS unsigned char*)lds + LDSCTL_OFF + 512);
    if (tid < 128) ((LAS unsigned*)((LAS unsigned char*)lds + LDSCTL_OFF))[tid] = 0u;
    __syncthreads();
    XcdBarrier bar = xcd_barrier_post((unsigned*)(ws + WS_CTL) + CW_BAR, (volatile LAS unsigned*)((LAS unsigned char*)lds + MISC_OFF) + 8);
#define GRID_BAR() do { for (int br_ = 0; br_ < PROBE_BAR; ++br_) xcd_barrier(bar); } while (0)
    bf16* PROJ = (bf16*)(ws + WS_PROJ); bf16* U = (bf16*)(ws + WS_U);
    LAS unsigned char* LL = (LAS unsigned char*)lds;

    for (int rep = 0; rep < PROBE_P0P1; ++rep) {
    for (int r2 = 0; r2 < PROBE_P0; ++r2) {
#if FAST_P0
    p0_fast(a, LL, WID_);
#else
    p0_naive(a, lds, WID_);
#endif
    __syncthreads(); }
    GRID_BAR();
    for (int r2 = 0; r2 < PROBE_P1; ++r2) { p1_modulate(a, lds, WID_); __syncthreads(); }
    GRID_BAR();
    }
    for (int rep = 0; rep < PROBE_P2; ++rep) {
#if FAST_P2
    { pg8::Gemm g{U, (const bf16*)(ws + WS_WIN), T, NP, 1024, 1024, 1024}; pg8::StaticOrder S; S.init(T, NP, (int)gridDim.x, (int)blockIdx.x);
      pg8::EpiProjF E{PROJ, NP, QSCALE, (float*)(ws + WS_R), (LAS float*)(LL + 131072)}; pg8::gemm_phase<pg8::EpiProjF, pg8::StaticOrder, true, true, 1024, 1024, 1024>(LL, g, S, E, WID_); }
#else
    { EpiProj e{PROJ}; naive_gemm((float*)lds, U, 1024, (const bf16*)(ws + WS_WIN), 1024, T, NP, 1024, e, WID_); }
#endif
    GRID_BAR();
    }
#if !FAST_P2
    naive_rms_rows(a, WID_);
    GRID_BAR();
#endif
    for (int rep = 0; rep < PROBE_KVIDX; ++rep) {
    for (int r2 = 0; r2 < PROBE_KV; ++r2) {
#if FAST_KV
    { pg8::Gemm g{PROJ + C_BKV, (const bf16*)(ws + WS_WKV), T, 1024, 128, NP, 128}; pg8::StaticOrder S; S.init(T, 1024, (int)gridDim.x, (int)blockIdx.x);
      pg8::EpiRowScale E{(bf16*)(ws + WS_KV), 1024, (const float*)(ws + WS_R)}; pg8::gemm_phase<pg8::EpiRowScale, pg8::StaticOrder, true, true, 128, NP, 128>(LL, g, S, E, WID_); }
#else
    { EpiKV e{(bf16*)(ws + WS_KV), (const float*)(ws + WS_R)}; naive_gemm((float*)lds, PROJ + C_BKV, NP, (const bf16*)(ws + WS_WKV), 128, T, 1024, 128, e, WID_); }
#endif
    __syncthreads(); }
    for (int r2 = 0; r2 < PROBE_IDX; ++r2) {
#if FAST_IDX
    idx::idx_phase(LL, a, WID_);
#else
    naive_indexer(a, lds, WID_);
#endif
    __syncthreads(); }
    }
#if FAST_DATT
    for (int rep = PROBE_DATT - 1; rep >= 0; --rep) { att::dattn_phase(LL, a, rep > 0, WID_); __syncthreads(); }
#else
    naive_diffattn(a, lds, WID_);
#endif
    GRID_BAR();
#if FAST_BATT
    for (int rep = PROBE_BATT - 1; rep >= 0; --rep) { att::battn_phase(LL, a, rep > 0, WID_); __syncthreads(); }
#else
    naive_battn(a, lds, WID_);
#endif
    GRID_BAR();
    for (int rep = 0; rep < PROBE_MIXWO; ++rep) {
    for (int r2 = 0; r2 < PROBE_MIX; ++r2) {
#if FAST_MIX
    { pg8::StaticOrder S; S.init(T, 1024, (int)gridDim.x, (int)blockIdx.x);
      pg8::Gemm g{PROJ + C_AQ, (const bf16*)(ws + WS_WA), T, 1024, 1024, NP, 1024}; pg8::EpiMixFused E{U, 1024, PROJ + C_G, NP};
      pg8::gemm_phase<pg8::EpiMixFused, pg8::StaticOrder, true, true, 1024, NP, 1024, 8, (C_BQ - C_AQ - 512) * 2>(LL, g, S, E, WID_); }
#else
    { EpiMixA e{U, PROJ}; naive_gemm((float*)lds, PROJ + C_AQ, NP, (const bf16*)(ws + WS_WA), 512, T, 1024, 512, e, WID_); }
    __syncthreads();
    { EpiMixB e{U, PROJ}; naive_gemm((float*)lds, PROJ + C_BQ, NP, (const bf16*)(ws + WS_WB), 512, T, 1024, 512, e, WID_); }
#endif
    asm volatile("s_waitcnt vmcnt(0)" ::: "memory"); __syncthreads(); }
    GRID_BAR();
    for (int r2 = 0; r2 < PROBE_WO; ++r2) {
#if FAST_WO
    { pg8::Gemm g{U, (const bf16*)(ws + WS_WO), T, 1024, 1024, 1024, 1024}; pg8::StaticOrder S; S.init(T, 1024, (int)gridDim.x, (int)blockIdx.x);
      pg8::EpiGateBf16 E{(bf16*)(ws + WS_KV), 1024, (const float*)(ws + WS_MOD) + 2048, 6144};
      pg8::gemm_phase<pg8::EpiGateBf16, pg8::StaticOrder, true, true, 1024, 1024, 1024>(LL, g, S, E, WID_); }
#else
    { EpiWo e{a.out(), a.in(I_X), (const float*)(ws + WS_MOD)}; naive_gemm((float*)lds, U, 1024, (const bf16*)(ws + WS_WO), 1024, T, 1024, 1024, e, WID_); }
#endif
    __syncthreads(); }
    GRID_BAR();
    }
    for (int rep = PROBE_ROWS * PROBE_P7 - 1; rep >= 0; --rep) p7_ln_route(a, lds, rep > 0, WID_);
    GRID_BAR();
    for (int rep = 0; rep < PROBE_ROWS * PROBE_P8; ++rep) { p8_sort(a, lds, WID_);
    GRID_BAR(); }
    for (int rep = 0; rep < PROBE_MOE * PROBE_MOE1; ++rep) {
#if FAST_MOE
    { const int* BASES = (const int*)(ws + WS_ROUTE2 + 1024 * 1024 + 32768); const int nslot = BASES[24];
      pg8::Gemm g{(const bf16*)(ws + WS_U2), (const bf16*)(ws + WS_W1), nslot, 1024, 1024, 1024, 1024, (const int*)(ws + WS_ROUTE2 + 512 * 1024)};
      pg8::MoeOrder1 S; S.so.init(nslot, 1024, (int)gridDim.x, (int)blockIdx.x); S.BASES = BASES; S.W1 = (const bf16*)(ws + WS_W1);
      pg8::EpiMoe1 E{(bf16*)(ws + WS_H), (const float*)(ws + WS_ROUTE2 + 1280 * 1024)};
      pg8::gemm_phase<pg8::EpiMoe1, pg8::MoeOrder1, true, true, 1024, 1024, 1024, 0, 0, true>(LL, g, S, E, WID_); }
#else
    naive_moe1(a, lds, WID_);
#endif
    GRID_BAR();
    }
    for (int rep = PROBE_MOE * PROBE_MOE2 - 1; rep >= 0; --rep) {
#if FAST_MOE
    { const int* BASES = (const int*)(ws + WS_ROUTE2 + 1024 * 1024 + 32768); const int nslot = BASES[24];
      pg8::Gemm g{(const bf16*)(ws + WS_H), (const bf16*)(ws + WS_W2P), nslot, 1024, 512, 512, 512};
      pg8::MoeOrder2 S; S.so.init(nslot, 1024, (int)gridDim.x, (int)blockIdx.x); S.BASES = BASES; S.W2P = (const bf16*)(ws + WS_W2P);
      pg8::EpiMoe2B E{(bf16*)(ws + WS_U), (const int*)(ws + WS_ROUTE2 + 512 * 1024), (const float*)(ws + WS_MOD) + 5120, 6144};
      pg8::gemm_phase<pg8::EpiMoe2B, pg8::MoeOrder2, true, true, 512, 512, 512>(LL, g, S, E, WID_); }
#else
    naive_moe2(a, lds, WID_);
#endif
    GRID_BAR();
    }
    for (int rep = PROBE_ROWS * PROBE_P11 - 1; rep >= 0; --rep) p11_ln(a, rep > 0, WID_);
}

extern "C" void kernel_launch(void* const* d_in, const int* in_sizes, int n_in, void* d_out, int out_size, void* d_ws, size_t ws_size, hipStream_t stream) {
    static int grid = 0;
    if (grid == 0) {
        if (n_in != 27 || out_size != T * D || ws_size < WS_END) { fprintf(stderr, "kernel_launch: unexpected problem (n_in %d, out %d, ws %zu); nothing launched\n", n_in, out_size, ws_size); grid = -1; return; }
        int dev = 0, cus = 0;
        if (hipGetDevice(&dev) != hipSuccess || hipDeviceGetAttribute(&cus, hipDeviceAttributeMultiprocessorCount, dev) != hipSuccess) { grid = -1; return; }
        if (hipFuncSetAttribute((const void*)fwd, hipFuncAttributeMaxDynamicSharedMemorySize, LDS_BYTES) != hipSuccess) { fprintf(stderr, "kernel_launch: hipFuncSetAttribute failed\n"); grid = -1; return; }
        if (cus != 256) { fprintf(stderr, "kernel_launch: built for 256 CUs, device has %d; nothing launched\n", cus); grid = -1; return; }
        grid = cus;
    }
    if (grid < 0) return;
    if (hipMemsetAsync((char*)d_ws + WS_CTL, 0, CTL_ZERO_BYTES, stream) != hipSuccess) return;
    Args a{};
    for (int i = 0; i < 27; ++i) a.in[i] = (const float*)d_in[i];
    a.out = (float*)d_out; a.ws = (unsigned char*)d_ws;
    hipLaunchKernelGGL(fwd, dim3(grid), dim3(512), LDS_BYTES, stream, a);
}
```
